# Optimizing an MI355X kernel written in HIP

```python
import math
import jax, jax.numpy as jnp
from jax import lax
import numpy as np

D_MODEL = 1024
BATCH = 4
SEQ = 8192
DEPTH = 2
DEC_BATCH = 32
DEC_SEQ = 1
PAST_LEN = 16384
PAGE_SIZE = 128

D_MIX = D_MODEL
POOL_WINDOWS = (2, 4, 8, 16)
N_POOL_GROUPS = len(POOL_WINDOWS)
D_POOL = D_MIX // 4
POOL_GROUP = D_POOL // N_POOL_GROUPS
POOL_BUF = max(POOL_WINDOWS) - 1

HEAD_DIM = 64
N_ATT_HEADS = (D_MIX // 4) // HEAD_DIM
D_ATT = N_ATT_HEADS * HEAD_DIM
DILATED = ((128, 1), (512, 4), (2048, 16))
ATT_WIN = max(w for w, _ in DILATED)
ATT_BLOCK = 128
ROPE_THETA = 10000.0

D_SSM = D_MIX - D_POOL - D_ATT
SSM_HEAD_DIM = 64
N_SSM_HEADS = D_SSM // SSM_HEAD_DIM
SSM_STATE = 128
SSM_GROUPS = 2
CONV_WIDTH = 4
SSM_CHUNK = 128
D_CONV = D_SSM + 2 * SSM_GROUPS * SSM_STATE
D_IN_PROJ = D_POOL + 3 * D_ATT + D_SSM + D_CONV + N_SSM_HEADS

D_FF = ((8 * D_MODEL // 3 + 127) // 128) * 128
RMS_EPS = 1e-6

kernel_name = 'hybrid_pool_dilated_ssd_decoder_step'


def rms_norm(x, g):
    xf = x.astype(jnp.float32)
    y = xf * lax.rsqrt(jnp.mean(xf * xf, -1, keepdims=True) + RMS_EPS)
    return (y * g.astype(jnp.float32)).astype(x.dtype)


def swiglu(x, w_gate, w_up, w_down):
    return jnp.matmul(jax.nn.silu(jnp.matmul(x, w_gate)) * jnp.matmul(x, w_up), w_down)


def rope(x, pos):
    half = x.shape[-1] // 2
    inv = ROPE_THETA ** (-jnp.arange(half, dtype=jnp.float32) / half)
    ang = pos.astype(jnp.float32)[:, None] * inv[None]
    cos = jnp.cos(ang)[None, :, None, :]
    sin = jnp.sin(ang)[None, :, None, :]
    x1, x2 = x[..., :half], x[..., half:]
    return jnp.concatenate([x1 * cos - x2 * sin, x2 * cos + x1 * sin], -1)


def split_proj(proj):
    cuts = np.cumsum([D_POOL, D_ATT, D_ATT, D_ATT, D_SSM, D_CONV]).tolist()
    return jnp.split(proj, cuts, axis=-1)


def pool_mix(u, pos, pool_w, pool_scale):
    n, L, _ = u.shape
    pad = max(POOL_WINDOWS)
    cs = jnp.pad(jnp.cumsum(u, axis=1), ((0, 0), (pad, 0), (0, 0)))
    means = []
    for g, w in enumerate(POOL_WINDOWS):
        c = cs[:, :, g * POOL_GROUP:(g + 1) * POOL_GROUP]
        s = c[:, pad:pad + L] - c[:, pad - w:pad - w + L]
        cnt = jnp.minimum(w, pos + 1).astype(jnp.float32)
        means.append(s / cnt[None, :, None])
    d = jnp.stack(means, 2) - u.reshape(n, L, N_POOL_GROUPS, POOL_GROUP)
    y = jnp.einsum('nlgc,gcd->nlgd', d, pool_w).reshape(n, L, D_POOL)
    return y * pool_scale


def dilated_branch_prompt(q, k, v, dil, n_back):
    b, S, h, e = q.shape
    L = S // dil
    nb = -(-L // ATT_BLOCK)
    Lp = nb * ATT_BLOCK

    def to_res(t):
        return jnp.pad(t.reshape(b, L, dil, h, e), ((0, 0), (0, Lp - L), (0, 0), (0, 0), (0, 0)))

    def band(t):
        tp = jnp.pad(t, ((0, 0), (ATT_BLOCK, 0), (0, 0), (0, 0), (0, 0)))
        prev = tp[:, :Lp].reshape(b, nb, ATT_BLOCK, dil, h, e)
        cur = t.reshape(b, nb, ATT_BLOCK, dil, h, e)
        return jnp.concatenate([prev, cur], 2)

    qb = to_res(q).reshape(b, nb, ATT_BLOCK, dil, h, e)
    kb, vb = band(to_res(k)), band(to_res(v))
    s = jnp.einsum('bnqrhe,bnkrhe->bnrhqk', qb, kb) / math.sqrt(e)
    i = jnp.arange(ATT_BLOCK)[:, None]
    j = jnp.arange(2 * ATT_BLOCK)[None]
    dist = ATT_BLOCK + i - j
    blk = jnp.arange(nb)[:, None, None]
    valid = (dist >= 0) & (dist <= n_back) & ((blk > 0) | (j >= ATT_BLOCK))
    s = jnp.where(valid[None, :, None, None], s, -jnp.inf)
    m = jnp.max(s, -1, keepdims=True)
    p = jnp.exp(s - m)
    l = jnp.sum(p, -1, keepdims=True)
    o = jnp.einsum('bnrhqk,bnkrhe->bnqrhe', p / l, vb)
    lse = jnp.transpose((m + jnp.log(l))[..., 0], (0, 1, 4, 2, 3))
    o = o.reshape(b, Lp, dil, h, e)[:, :L].reshape(b, S, h, e)
    lse = lse.reshape(b, Lp, dil, h)[:, :L].reshape(b, S, h)
    return o, lse


def dilated_branch_sample(q, kc, vc, dil, n_back, lb):
    T, e = q.shape[1], q.shape[-1]
    idx = lb + jnp.arange(T)[:, None] - dil * jnp.arange(n_back + 1)[None]
    valid = idx >= 0
    idx = jnp.maximum(idx, 0)
    kg, vg = kc[:, idx], vc[:, idx]
    s = jnp.einsum('nthe,ntjhe->nthj', q, kg) / math.sqrt(e)
    s = jnp.where(valid[None, :, None, :], s, -jnp.inf)
    m = jnp.max(s, -1, keepdims=True)
    p = jnp.exp(s - m)
    l = jnp.sum(p, -1, keepdims=True)
    o = jnp.einsum('nthj,ntjhe->nthe', p / l, vg)
    return o, (m + jnp.log(l))[..., 0]


def combine_by_denominator(outs, lses):
    wts = jax.nn.softmax(jnp.stack(lses, 0), axis=0)
    return jnp.einsum('gnth,gnthe->nthe', wts, jnp.stack(outs, 0))


def causal_conv(u, w, bias):
    L = u.shape[1] - (CONV_WIDTH - 1)
    return sum(u[:, t:t + L] * w[t] for t in range(CONV_WIDTH)) + bias


def split_ssm(u):
    n, L, _ = u.shape
    gn = SSM_GROUPS * SSM_STATE
    xs = u[..., :D_SSM].reshape(n, L, N_SSM_HEADS, SSM_HEAD_DIM)
    bm = u[..., D_SSM:D_SSM + gn].reshape(n, L, SSM_GROUPS, SSM_STATE)
    cm = u[..., D_SSM + gn:].reshape(n, L, SSM_GROUPS, SSM_STATE)
    return xs, bm, cm


def ssd_chunked(x, dt, a, bm, cm):
    b, S, H, P = x.shape
    G, N = bm.shape[2], bm.shape[3]
    J = H // G
    Q = SSM_CHUNK
    nc = S // Q
    xc = x.reshape(b, nc, Q, G, J, P)
    dtc = dt.reshape(b, nc, Q, G, J)
    bc = bm.reshape(b, nc, Q, G, N)
    cc = cm.reshape(b, nc, Q, G, N)
    acs = jnp.cumsum(dtc * a.reshape(G, J), axis=2)
    diff = acs[:, :, :, None] - acs[:, :, None]
    causal = jnp.tril(jnp.ones((Q, Q), bool))
    decay = jnp.exp(jnp.where(causal[:, :, None, None], diff, -jnp.inf))
    cb = jnp.einsum('bclgn,bcsgn->bclsg', cc, bc)
    mat = cb[..., None] * decay * dtc[:, :, None]
    y_diag = jnp.einsum('bclsgj,bcsgjp->bclgjp', mat, xc)
    decay_end = jnp.exp(acs[:, :, -1:] - acs)
    states = jnp.einsum('bclgn,bclgj,bclgjp->bcgjpn', bc, decay_end * dtc, xc)
    chunk_decay = jnp.exp(acs[:, :, -1])

    def step(h, inp):
        st, dec = inp
        return dec[..., None, None] * h + st, h

    h0 = jnp.zeros((b, G, J, P, N), x.dtype)
    h_last, h_prev = lax.scan(step, h0, (jnp.moveaxis(states, 1, 0), jnp.moveaxis(chunk_decay, 1, 0)))
    h_prev = jnp.moveaxis(h_prev, 0, 1)
    y_off = jnp.einsum('bclgn,bcgjpn,bclgj->bclgjp', cc, h_prev, jnp.exp(acs))
    return (y_diag + y_off).reshape(b, S, H, P), h_last.reshape(b, H, P, N)


def ssd_recurrent(x, dt, a, bm, cm, h0):
    J = x.shape[2] // bm.shape[2]
    bh = jnp.repeat(bm, J, axis=2)
    ch = jnp.repeat(cm, J, axis=2)

    def step(h, inp):
        xt, dtt, bt, ct = inp
        h = jnp.exp(dtt * a)[..., None, None] * h + (dtt[..., None] * xt)[..., None] * bt[:, :, None, :]
        return h, jnp.einsum('nhpk,nhk->nhp', h, ct)

    h_last, ys = lax.scan(step, h0, tuple(jnp.moveaxis(t, 1, 0) for t in (x, dt, bh, ch)))
    return jnp.moveaxis(ys, 0, 1), h_last


def ssm_gate_norm(y, xs, z, d_skip, ssm_norm):
    n, L = xs.shape[:2]
    y = (y + d_skip[:, None] * xs).reshape(n, L, D_SSM) * jax.nn.silu(z)
    yg = y.reshape(n, L, SSM_GROUPS, D_SSM // SSM_GROUPS)
    yg = yg * lax.rsqrt(jnp.mean(yg * yg, -1, keepdims=True) + RMS_EPS)
    return yg.reshape(n, L, D_SSM) * ssm_norm


def mixer_prompt(hn, w_in, pool_w, pool_scale, conv_w, conv_b, dt_bias, a_log, d_skip, ssm_norm, w_out):
    n, L, _ = hn.shape
    xa, q, k, v, z, xbc, dtr = split_proj(jnp.matmul(hn, w_in).astype(jnp.float32))
    pos = jnp.arange(L)
    ya = pool_mix(xa, pos, pool_w, pool_scale)
    q = rope(q.reshape(n, L, N_ATT_HEADS, HEAD_DIM), pos)
    k = rope(k.reshape(n, L, N_ATT_HEADS, HEAD_DIM), pos)
    v = v.reshape(n, L, N_ATT_HEADS, HEAD_DIM)
    outs, lses = [], []
    for win, dil in DILATED:
        o, lse = dilated_branch_prompt(q, k, v, dil, win // dil)
        outs.append(o)
        lses.append(lse)
    yb = combine_by_denominator(outs, lses).reshape(n, L, D_ATT)
    u = jax.nn.silu(causal_conv(jnp.pad(xbc, ((0, 0), (CONV_WIDTH - 1, 0), (0, 0))), conv_w, conv_b))
    xs, bm, cm = split_ssm(u)
    dt = jax.nn.softplus(dtr + dt_bias)
    y, h_last = ssd_chunked(xs, dt, -jnp.exp(a_log.astype(jnp.float32)), bm, cm)
    yc = ssm_gate_norm(y, xs, z, d_skip, ssm_norm)
    out = jnp.matmul(jnp.concatenate([ya, yb, yc], -1).astype(hn.dtype), w_out)
    wb = min(ATT_WIN, L)
    return out, (xa[:, -POOL_BUF:], k[:, -wb:], v[:, -wb:], xbc[:, -(CONV_WIDTH - 1):], h_last)


def mixer_sample(hn, c_pool, c_k, c_v, s_conv, s_ssm, w_in, pool_w, pool_scale, conv_w, conv_b,
                 dt_bias, a_log, d_skip, ssm_norm, w_out):
    n, T, _ = hn.shape
    f32 = jnp.float32
    xa, q, k, v, z, xbc, dtr = split_proj(jnp.matmul(hn, w_in).astype(f32))
    pos = PAST_LEN + jnp.arange(T)
    xa_cat = jnp.concatenate([c_pool.astype(f32), xa], 1)
    pos_cat = PAST_LEN - POOL_BUF + jnp.arange(POOL_BUF + T)
    ya = pool_mix(xa_cat, pos_cat, pool_w, pool_scale)[:, POOL_BUF:]
    q = rope(q.reshape(n, T, N_ATT_HEADS, HEAD_DIM), pos)
    k = rope(k.reshape(n, T, N_ATT_HEADS, HEAD_DIM), pos)
    v = v.reshape(n, T, N_ATT_HEADS, HEAD_DIM)
    lb = c_k.shape[1]
    kc = jnp.concatenate([c_k.astype(f32), k], 1)
    vc = jnp.concatenate([c_v.astype(f32), v], 1)
    outs, lses = [], []
    for win, dil in DILATED:
        o, lse = dilated_branch_sample(q, kc, vc, dil, win // dil, lb)
        outs.append(o)
        lses.append(lse)
    yb = combine_by_denominator(outs, lses).reshape(n, T, D_ATT)
    xbc_cat = jnp.concatenate([s_conv.astype(f32), xbc], 1)
    u = jax.nn.silu(causal_conv(xbc_cat, conv_w, conv_b))
    xs, bm, cm = split_ssm(u)
    dt = jax.nn.softplus(dtr + dt_bias)
    y, h_last = ssd_recurrent(xs, dt, -jnp.exp(a_log.astype(f32)), bm, cm, s_ssm.astype(f32))
    yc = ssm_gate_norm(y, xs, z, d_skip, ssm_norm)
    out = jnp.matmul(jnp.concatenate([ya, yb, yc], -1).astype(hn.dtype), w_out)
    return out, (xa_cat[:, -POOL_BUF:], kc[:, -lb:], vc[:, -lb:], xbc_cat[:, -(CONV_WIDTH - 1):], h_last)


def setup_inputs(seed: int = 0) -> dict:
    key = jax.random.key(seed)
    ks = iter(jax.random.split(key, 32))
    f32 = jnp.float32

    def nrm(shape, scale=1.0):
        return scale * jax.random.normal(next(ks), shape, f32)

    wb = min(ATT_WIN, PAST_LEN)
    inp = {}
    inp['x_prompt'] = nrm((BATCH, SEQ, D_MODEL))
    inp['x_sample'] = nrm((DEC_BATCH, DEC_SEQ, D_MODEL))
    inp['cache_pool'] = nrm((DEPTH, DEC_BATCH, POOL_BUF, D_POOL))
    inp['cache_k'] = nrm((DEPTH, DEC_BATCH, wb, N_ATT_HEADS, HEAD_DIM))
    inp['cache_v'] = nrm((DEPTH, DEC_BATCH, wb, N_ATT_HEADS, HEAD_DIM))
    inp['state_conv'] = nrm((DEPTH, DEC_BATCH, CONV_WIDTH - 1, D_CONV))
    inp['state_ssm'] = nrm((DEPTH, DEC_BATCH, N_SSM_HEADS, SSM_HEAD_DIM, SSM_STATE), 0.1)
    inp['ffn1_norm'] = 1.0 + nrm((DEPTH, D_MODEL), 0.02)
    inp['ffn1_w_gate'] = nrm((DEPTH, D_MODEL, D_FF), D_MODEL ** -0.5)
    inp['ffn1_w_up'] = nrm((DEPTH, D_MODEL, D_FF), D_MODEL ** -0.5)
    inp['ffn1_w_down'] = nrm((DEPTH, D_FF, D_MODEL), D_FF ** -0.5)
    inp['mix_norm'] = 1.0 + nrm((DEPTH, D_MODEL), 0.02)
    inp['w_in'] = nrm((DEPTH, D_MODEL, D_IN_PROJ), D_MODEL ** -0.5)
    inp['pool_w'] = nrm((DEPTH, N_POOL_GROUPS, POOL_GROUP, POOL_GROUP), POOL_GROUP ** -0.5)
    inp['pool_scale'] = 1.0 + nrm((DEPTH, D_POOL), 0.02)
    inp['conv_w'] = nrm((DEPTH, CONV_WIDTH, D_CONV), CONV_WIDTH ** -0.5)
    inp['conv_b'] = nrm((DEPTH, D_CONV), 0.02)
    dt0 = jnp.exp(jax.random.uniform(next(ks), (DEPTH, N_SSM_HEADS), f32, math.log(1e-3), math.log(1e-1)))
    inp['dt_bias'] = dt0 + jnp.log(-jnp.expm1(-dt0))
    inp['a_log'] = jnp.log(jax.random.uniform(next(ks), (DEPTH, N_SSM_HEADS), f32, 1.0, 16.0))
    inp['d_skip'] = 1.0 + nrm((DEPTH, N_SSM_HEADS), 0.1)
    inp['ssm_norm'] = 1.0 + nrm((DEPTH, D_SSM), 0.02)
    inp['w_out'] = nrm((DEPTH, D_MIX, D_MODEL), D_MIX ** -0.5)
    inp['ffn2_norm'] = 1.0 + nrm((DEPTH, D_MODEL), 0.02)
    inp['ffn2_w_gate'] = nrm((DEPTH, D_MODEL, D_FF), D_MODEL ** -0.5)
    inp['ffn2_w_up'] = nrm((DEPTH, D_MODEL, D_FF), D_MODEL ** -0.5)
    inp['ffn2_w_down'] = nrm((DEPTH, D_FF, D_MODEL), D_FF ** -0.5)
    inp['final_norm'] = 1.0 + nrm((D_MODEL,), 0.02)
    return inp


def reference(x_prompt, x_sample, cache_pool, cache_k, cache_v, state_conv, state_ssm,
              ffn1_norm, ffn1_w_gate, ffn1_w_up, ffn1_w_down, mix_norm, w_in, pool_w, pool_scale,
              conv_w, conv_b, dt_bias, a_log, d_skip, ssm_norm, w_out,
              ffn2_norm, ffn2_w_gate, ffn2_w_up, ffn2_w_down, final_norm):
    yp, ys = x_prompt, x_sample
    st_p = [[] for _ in range(5)]
    st_s = [[] for _ in range(5)]
    for i in range(DEPTH):
        mw = (w_in[i], pool_w[i], pool_scale[i], conv_w[i], conv_b[i], dt_bias[i], a_log[i],
              d_skip[i], ssm_norm[i], w_out[i])
        f1 = (ffn1_w_gate[i], ffn1_w_up[i], ffn1_w_down[i])
        f2 = (ffn2_w_gate[i], ffn2_w_up[i], ffn2_w_down[i])
        yp = yp + 0.5 * swiglu(rms_norm(yp, ffn1_norm[i]), *f1)
        ys = ys + 0.5 * swiglu(rms_norm(ys, ffn1_norm[i]), *f1)
        mo_p, new_p = mixer_prompt(rms_norm(yp, mix_norm[i]), *mw)
        mo_s, new_s = mixer_sample(rms_norm(ys, mix_norm[i]), cache_pool[i], cache_k[i], cache_v[i],
                                   state_conv[i], state_ssm[i], *mw)
        yp = yp + mo_p.astype(yp.dtype)
        ys = ys + mo_s.astype(ys.dtype)
        yp = yp + 0.5 * swiglu(rms_norm(yp, ffn2_norm[i]), *f2)
        ys = ys + 0.5 * swiglu(rms_norm(ys, ffn2_norm[i]), *f2)
        for lst, val in zip(st_p, new_p):
            lst.append(val)
        for lst, val in zip(st_s, new_s):
            lst.append(val)
    y_prompt = rms_norm(yp, final_norm)
    y_sample = rms_norm(ys, final_norm)
    pool_p = jnp.stack(st_p[0], 0).astype(cache_pool.dtype)
    pool_s = jnp.stack(st_s[0], 0).astype(cache_pool.dtype)
    k_p = jnp.stack(st_p[1], 0).astype(cache_k.dtype)
    k_s = jnp.stack(st_s[1], 0).astype(cache_k.dtype)
    v_p = jnp.stack(st_p[2], 0).astype(cache_v.dtype)
    v_s = jnp.stack(st_s[2], 0).astype(cache_v.dtype)
    conv_p = jnp.stack(st_p[3], 0).astype(state_conv.dtype)
    conv_s = jnp.stack(st_s[3], 0).astype(state_conv.dtype)
    ssm_p = jnp.stack(st_p[4], 0).astype(state_ssm.dtype)
    ssm_s = jnp.stack(st_s[4], 0).astype(state_ssm.dtype)
    return (y_prompt, y_sample, pool_p, pool_s, k_p, k_s, v_p, v_s, conv_p, conv_s, ssm_p, ssm_s)
```

```cpp
#include <hip/hip_runtime.h>
#include <hip/hip_cooperative_groups.h>
#include <cstdio>
#include <cstdint>
namespace cg = cooperative_groups;

typedef unsigned short bf16_t;
typedef short bf16x8 __attribute__((ext_vector_type(8)));
typedef float f32x4 __attribute__((ext_vector_type(4)));

#define NT 512
constexpr int MP = 32768;
constexpr int MS = 32;
constexpr int MTOK = MP + MS;
constexpr int MPAD = 33024;
constexpr int DM = 1024, DFF = 2816, NPROJ = 2560, WINLD = 2568;
constexpr float EPS = 1e-6f;

constexpr size_t SZ_WGU = 5632ull * 1024 * 2, SZ_WD = 1024ull * 2816 * 2, SZ_WIN = 2560ull * 1024 * 2, SZ_WOUT = 1024ull * 1024 * 2;
constexpr size_t OFF_WGU1 = 0, OFF_WD1 = OFF_WGU1 + SZ_WGU, OFF_WIN = OFF_WD1 + SZ_WD, OFF_WOUT = OFF_WIN + SZ_WIN,
                 OFF_WGU2 = OFF_WOUT + SZ_WOUT, OFF_WD2 = OFF_WGU2 + SZ_WGU, LAYER_W = OFF_WD2 + SZ_WD;
constexpr size_t WS_XB = 2 * LAYER_W;
constexpr size_t WS_HB = WS_XB + (size_t)MPAD * 1024 * 2;
constexpr size_t WS_CAT = WS_HB + (size_t)MPAD * 2816 * 2;
constexpr size_t WS_OG = WS_CAT + (size_t)MPAD * 1024 * 2;
constexpr size_t WS_LSE = WS_OG + 3ull * MP * 256 * 2;
constexpr size_t WS_ST = WS_LSE + 3ull * MP * 4 * 4;
constexpr size_t WS_DEC = WS_ST + 256ull * 8 * 64 * 128 * 4;
constexpr size_t WS_DT = WS_DEC + 256 * 8 * 4;
constexpr size_t WS_PART = WS_DT + (size_t)MPAD * 8 * 4;
constexpr size_t WS_WDT = WS_PART + (size_t)MP * 16 * 4;
constexpr size_t WS_BAR = WS_WDT + 2 * 16 * 1024 * 2;
constexpr size_t WS_END = WS_BAR + 16384;

constexpr size_t O_Y = 0, O_POOLP = 33587200ull, O_POOLS = 33617920ull, O_KP = 33863680ull, O_KS = 38057984ull, O_VP = 71612416ull,
                 O_VS = 75806720ull, O_CONVP = 109361152ull, O_CONVS = 109385728ull, O_SSMP = 109582336ull, O_SSMS = 110106624ull,
                 O_END = 114300928ull;

struct Params { const float* in[27]; float* out; unsigned char* ws; };
enum { I_XP = 0, I_XS, I_CPOOL, I_CK, I_CV, I_SCONV, I_SSSM, I_F1N, I_F1G, I_F1U, I_F1D, I_MIXN, I_WIN, I_POOLW, I_POOLSC, I_CONVW, I_CONVB,
       I_DTB, I_ALOG, I_DSKIP, I_SSMN, I_WOUT, I_F2N, I_F2G, I_F2U, I_F2D, I_FINN };

typedef const __attribute__((address_space(4))) Params* KP;
__device__ __forceinline__ int otid() { int t = __builtin_amdgcn_workitem_id_x(); asm volatile("" : "+v"(t)); return t; }
__device__ __forceinline__ KP opaque_kp() { KP k = (KP)__builtin_amdgcn_kernarg_segment_ptr(); asm volatile("" : "+s"(k)); return k; }
__device__ __forceinline__ float bf2f(bf16_t v) { return __uint_as_float(((unsigned)v) << 16); }
__device__ __forceinline__ unsigned pk2(float lo, float hi) { unsigned r; asm("v_cvt_pk_bf16_f32 %0, %1, %2" : "=v"(r) : "v"(lo), "v"(hi)); return r; }
__device__ __forceinline__ bf16_t f2bf(float f) { return (bf16_t)(pk2(f, 0.f) & 0xffffu); }
__device__ __forceinline__ float lo16(unsigned u) { return __uint_as_float(u << 16); }
__device__ __forceinline__ float hi16(unsigned u) { return __uint_as_float(u & 0xffff0000u); }
__device__ __forceinline__ float silu(float x) { return x * __builtin_amdgcn_rcpf(1.f + __expf(-x)); }
__device__ __forceinline__ float wave_sum(float v) {
#pragma unroll
    for (int o = 32; o > 0; o >>= 1) v += __shfl_xor(v, o);
    return v;
}
__device__ __forceinline__ float wave_max(float v) {
#pragma unroll
    for (int o = 32; o > 0; o >>= 1) v = fmaxf(v, __shfl_xor(v, o));
    return v;
}
__device__ const float ROPE_INV[32] = {1.000000000e+00f, 7.498942018e-01f, 5.623413324e-01f, 4.216965139e-01f, 3.162277639e-01f, 2.371373773e-01f, 1.778279394e-01f, 1.333521456e-01f, 1.000000015e-01f, 7.498942316e-02f, 5.623413250e-02f, 4.216964915e-02f, 3.162277490e-02f, 2.371373773e-02f, 1.778279431e-02f, 1.333521400e-02f, 9.999999776e-03f, 7.498942316e-03f, 5.623413250e-03f, 4.216964822e-03f, 3.162277630e-03f, 2.371373819e-03f, 1.778279431e-03f, 1.333521446e-03f, 1.000000047e-03f, 7.498941850e-04f, 5.623413017e-04f, 4.216965172e-04f, 3.162277571e-04f, 2.371373703e-04f, 1.778279402e-04f, 1.333521504e-04f};
__device__ __forceinline__ float rope_inv(int i) { return ROPE_INV[i]; }
__device__ __forceinline__ void rope_cs(float ang, float& c, float& s) {
    const float k = rintf(ang * 0.15915494309189535f);
    float r = fmaf(-k, 6.28318548202514648f, ang); r = fmaf(-k, -1.74845553146951715e-07f, r);
    const float f = r * 0.15915494309189535f;
    s = __builtin_amdgcn_sinf(f); c = __builtin_amdgcn_cosf(f);
}
__device__ __forceinline__ uint4 zero4() { unsigned z; asm volatile("v_mov_b32 %0, 0" : "=v"(z)); uint4 r; r.x = z; r.y = z; r.z = z; r.w = z; return r; }
#define MFMA16(a, b, c) __builtin_amdgcn_mfma_f32_16x16x32_bf16((a), (b), (c), 0, 0, 0)
#define LDS_BARRIER() do { asm volatile("s_waitcnt lgkmcnt(0)" ::: "memory"); __builtin_amdgcn_s_barrier(); asm volatile("" ::: "memory"); } while (0)
#define SMEM_DECL extern __shared__ __attribute__((aligned(16))) unsigned char smem[]

constexpr int BM = 256, BK = 64, HALF = 128, HT = HALF * BK;
__device__ __forceinline__ int lds_byte(int r, int c) { int st = (r >> 4) * 2 + (c >> 5), rr = r & 15, cc = c & 31, ob = rr * 64 + cc * 2; return st * 1024 + (ob ^ (((ob >> 9) & 1) << 5)); }
__device__ __forceinline__ void stage_rc(int b, int& R, int& C) { int st = b / 1024, sb = b % 1024, swz = sb ^ (((sb >> 9) & 1) << 5); R = (st >> 1) * 16 + swz / 64; C = (st & 1) * 32 + (swz % 64) / 2; }

__device__ __forceinline__ void tile_of(int L, int nM, int nN, int& pm, int& pn) {
    const int nwg = nM * nN; int wgid = L;
    { const int q = nwg / 8, r = nwg % 8, xcd = wgid % 8, off = wgid / 8; wgid = (xcd < r ? xcd * (q + 1) : r * (q + 1) + (xcd - r) * q) + off; }
    const int nig = 8 * nN, gid = wgid / nig, fm = gid * 8, gsz = (nM - fm) < 8 ? (nM - fm) : 8;
    pm = fm + ((wgid % nig) % gsz); pn = (wgid % nig) / gsz;
}

#define LAS __attribute__((address_space(3)))
constexpr int HTB = HALF * BK * 2;
__device__ __forceinline__ float row_rstd(const float* PART, int row) {
    const float4* pp = (const float4*)(PART + (size_t)row * 16);
    const float4 a = pp[0], b = pp[1], c = pp[2], d = pp[3];
    const float ss = ((a.x + a.y) + (a.z + a.w)) + ((b.x + b.y) + (b.z + b.w)) + ((c.x + c.y) + (c.z + c.w)) + ((d.x + d.y) + (d.z + d.w));
    return rsqrtf(ss * (1.f / 1024.f) + EPS);
}
template <class Epi>
__device__ __forceinline__ void gemm_phase(const bf16_t* A, const bf16_t* Bt, const int K, const int nM, const int nN, const Epi& epi) {
    SMEM_DECL;
    LAS unsigned char* lds = (LAS unsigned char*)smem;
    const int tid = otid(), wid = __builtin_amdgcn_readfirstlane(tid >> 6), lane = tid & 63, wr = wid >> 2, wc = wid & 3, fr = lane & 15, fq = lane >> 4;
    const int nt = K / BK, ntiles = nM * nN;
    unsigned voff[2];
#pragma unroll
    for (int i = 0; i < 2; ++i) { int R, C; stage_rc(tid * 16 + i * 8192, R, C); voff[i] = (unsigned)(R * K + C) * 2u; }
    const size_t kstep = (size_t)(BK * 2), hstep = (size_t)HALF * K * 2;
    const unsigned ldsw = (unsigned)wid * 1024u;
    const int aoff = lds_byte(wr * 64 + fr, fq * 8), boff = lds_byte(wc * 32 + fr, fq * 8);
#define GSA(b, h) (((b) * 2 + (h)) * HTB)
#define GSB(b, h) ((4 + (b) * 2 + (h)) * HTB)
#define STAGE(bufoff, gbase) do { _Pragma("unroll") for (int _i = 0; _i < 2; ++_i) \
    __builtin_amdgcn_global_load_lds((const unsigned*)((const char*)(gbase) + voff[_i]), (LAS unsigned*)(lds + (bufoff) + ldsw + _i * 8192), 16, 0, 0); } while (0)
#define LDA(dst, b, h) do { _Pragma("unroll") for (int m = 0; m < 4; ++m) _Pragma("unroll") for (int k = 0; k < 2; ++k) dst[m][k] = *(const LAS bf16x8*)(lds + GSA(b, h) + aoff + m * 2048 + k * 1024); } while (0)
#define LDB(dst, b, h) do { _Pragma("unroll") for (int n = 0; n < 2; ++n) _Pragma("unroll") for (int k = 0; k < 2; ++k) dst[n][k] = *(const LAS bf16x8*)(lds + GSB(b, h) + boff + n * 2048 + k * 1024); } while (0)
#define MMA(ai, bj, At_, Bt_) do { __builtin_amdgcn_s_setprio(1); _Pragma("unroll") for (int m = 0; m < 4; ++m) _Pragma("unroll") for (int n = 0; n < 2; ++n) _Pragma("unroll") for (int k = 0; k < 2; ++k) \
      acc[ai][bj][m][n] = __builtin_amdgcn_mfma_f32_16x16x32_bf16(Bt_[n][k], At_[m][k], acc[ai][bj][m][n], 0, 0, 0); \
    __builtin_amdgcn_s_setprio(0); } while (0)
#define WAIT_V(n) asm volatile("s_waitcnt vmcnt(" #n ")" ::: "memory")
#define WAIT_L(n) asm volatile("s_waitcnt lgkmcnt(" #n ")" ::: "memory")
#define BAR __builtin_amdgcn_s_barrier()
#define SCHED __builtin_amdgcn_sched_barrier(0)
    int L = blockIdx.x;
    WAIT_V(0); __syncthreads();
    if (L >= ntiles) return;
    int pm, pn; tile_of(L, nM, nN, pm, pn);
    const char* cA = (const char*)A + (size_t)(pm * 256) * K * 2;
    const char* cB = (const char*)Bt + (size_t)(pn * 256) * K * 2;
    STAGE(GSB(0, 0), cB); STAGE(GSA(0, 0), cA); STAGE(GSB(0, 1), cB + hstep); STAGE(GSA(0, 1), cA + hstep);
    float* rsb = (float*)(smem + 131072 + 64 + 4096);
    int rbuf = 0;
    if (Epi::NEEDS_RS && tid < 256) rsb[tid] = row_rstd(epi.PART, pm * 256 + tid);
    bool first = true;
    for (;;) {
        f32x4 acc[2][2][4][2];
#pragma unroll
        for (int a = 0; a < 2; ++a)
#pragma unroll
            for (int b = 0; b < 2; ++b)
#pragma unroll
                for (int m = 0; m < 4; ++m)
#pragma unroll
                    for (int n = 0; n < 2; ++n) acc[a][b][m][n] = (f32x4){0.f, 0.f, 0.f, 0.f};
        bf16x8 At[4][2], B0[2][2], B1[2][2];
        if (wr == 1) BAR;
        if (first) { WAIT_V(4); } else { asm volatile("s_waitcnt vmcnt(%0)" :: "n"(Epi::NST) : "memory"); }
        BAR;
        STAGE(GSB(1, 0), cB + kstep); STAGE(GSA(1, 0), cA + kstep); STAGE(GSB(1, 1), cB + hstep + kstep);
        WAIT_V(6); BAR;
        for (int t = 0; t < nt - 2; t += 2) {
            const char* a1 = cA + (size_t)(t + 1) * kstep; const char* a2 = a1 + kstep; const char* a3 = a2 + kstep;
            const char* b2 = cB + (size_t)(t + 2) * kstep; const char* b3 = b2 + kstep;
            LDB(B0, 0, 0); SCHED; LDA(At, 0, 0); STAGE(GSA(1, 1), a1 + hstep);
            WAIT_L(8); BAR; WAIT_L(0); MMA(0, 0, At, B0); BAR; SCHED;
            LDB(B1, 0, 1); STAGE(GSB(0, 0), b2);
            BAR; WAIT_L(0); MMA(0, 1, At, B1); BAR;
            LDA(At, 0, 1); STAGE(GSA(0, 0), a2);
            BAR; WAIT_L(0); MMA(1, 0, At, B0); BAR; SCHED;
            STAGE(GSB(0, 1), b2 + hstep);
            WAIT_V(6); BAR; MMA(1, 1, At, B1); BAR;
            LDB(B0, 1, 0); SCHED; LDA(At, 1, 0); STAGE(GSA(0, 1), a2 + hstep);
            WAIT_L(8); BAR; WAIT_L(0); MMA(0, 0, At, B0); BAR; SCHED;
            LDB(B1, 1, 1); STAGE(GSB(1, 0), b3);
            BAR; WAIT_L(0); MMA(0, 1, At, B1); BAR;
            LDA(At, 1, 1); STAGE(GSA(1, 0), a3);
            BAR; WAIT_L(0); MMA(1, 0, At, B0); BAR; SCHED;
            STAGE(GSB(1, 1), b3 + hstep);
            WAIT_V(6); BAR; MMA(1, 1, At, B1); BAR;
        }
        { LDB(B0, 0, 0); LDA(At, 0, 0); STAGE(GSA(1, 1), cA + (size_t)(nt - 1) * kstep + hstep);
          BAR; WAIT_L(0); MMA(0, 0, At, B0); BAR;
          LDB(B1, 0, 1); BAR; WAIT_L(0); MMA(0, 1, At, B1); BAR;
          LDA(At, 0, 1); WAIT_V(4); BAR; WAIT_L(0); MMA(1, 0, At, B0); MMA(1, 1, At, B1); BAR; }
        { LDB(B0, 1, 0); LDA(At, 1, 0); WAIT_V(2); BAR; WAIT_L(0); MMA(0, 0, At, B0); BAR;
          LDB(B1, 1, 1); WAIT_V(0); BAR; WAIT_L(0); MMA(0, 1, At, B1); BAR;
          LDA(At, 1, 1); BAR; WAIT_L(0); MMA(1, 0, At, B0); MMA(1, 1, At, B1); BAR; }
        if (wr == 0) BAR;
        const int brow = pm * 256, bcol = pn * 256;
        L += gridDim.x;
        const bool more = L < ntiles;
        if (more) {
            tile_of(L, nM, nN, pm, pn);
            cA = (const char*)A + (size_t)(pm * 256) * K * 2; cB = (const char*)Bt + (size_t)(pn * 256) * K * 2;
            STAGE(GSB(0, 0), cB); STAGE(GSA(0, 0), cA); STAGE(GSB(0, 1), cB + hstep); STAGE(GSA(0, 1), cA + hstep);
            SCHED;
        }
        float rs_next = 0.f;
        if (Epi::NEEDS_RS && more && tid < 256) rs_next = row_rstd(epi.PART, pm * 256 + tid);
        epi(acc, brow, bcol, wr, wc, fr, fq, rsb + rbuf * 256);
        SCHED;
        if (!more) break;
        if (Epi::NEEDS_RS && tid < 256) rsb[(rbuf ^ 1) * 256 + tid] = rs_next;
        rbuf ^= 1;
        first = false;
    }
    asm volatile("s_waitcnt vmcnt(0)" ::: "memory");
    __syncthreads();
}

template <class Epi>
__device__ __forceinline__ void gemm_phase_cont(const bf16_t* A, const bf16_t* Bt, const int K, const int nM, const int nN, const Epi& epi) {
    SMEM_DECL;
    LAS unsigned char* lds = (LAS unsigned char*)smem;
    const int tid = otid(), wid = __builtin_amdgcn_readfirstlane(tid >> 6), lane = tid & 63, wr = wid >> 2, wc = wid & 3, fr = lane & 15, fq = lane >> 4;
    const int nt = K / BK, ntiles = nM * nN;
    unsigned voff[2];
#pragma unroll
    for (int i = 0; i < 2; ++i) { int R, C; stage_rc(tid * 16 + i * 8192, R, C); voff[i] = (unsigned)(R * K + C) * 2u; }
    const size_t kstep = (size_t)(BK * 2), hstep = (size_t)HALF * K * 2;
    const unsigned ldsw = (unsigned)wid * 1024u;
    const int aoff = lds_byte(wr * 64 + fr, fq * 8), boff = lds_byte(wc * 32 + fr, fq * 8);
    int L = blockIdx.x;
    WAIT_V(0); __syncthreads();
    if (L >= ntiles) return;
    int pm, pn; tile_of(L, nM, nN, pm, pn);
    const char* cA = (const char*)A + (size_t)(pm * 256) * K * 2;
    const char* cB = (const char*)Bt + (size_t)(pn * 256) * K * 2;
    f32x4 acc[2][2][4][2];
#pragma unroll
    for (int a = 0; a < 2; ++a)
#pragma unroll
        for (int b = 0; b < 2; ++b)
#pragma unroll
            for (int m = 0; m < 4; ++m)
#pragma unroll
                for (int n = 0; n < 2; ++n) acc[a][b][m][n] = (f32x4){0.f, 0.f, 0.f, 0.f};
    bf16x8 At[4][2], B0[2][2], B1[2][2];
    float* rsb = (float*)(smem + 131072 + 64 + 4096);
    int rbuf = 0;
    float rs0 = 0.f;
    if (Epi::NEEDS_RS && tid < 256) rs0 = row_rstd(epi.PART, pm * 256 + tid);
    STAGE(GSB(0, 0), cB); STAGE(GSB(0, 1), cB + hstep); STAGE(GSA(0, 0), cA); STAGE(GSA(0, 1), cA + hstep);
    if (wr == 1) BAR;
    WAIT_V(2); BAR;
    STAGE(GSB(1, 0), cB + kstep); STAGE(GSA(1, 0), cA + kstep); STAGE(GSB(1, 1), cB + hstep + kstep);
    WAIT_V(6); BAR;
    if (Epi::NEEDS_RS && tid < 256) rsb[tid] = rs0;
    for (;;) {
        const int Ln = L + gridDim.x; const bool has_next = Ln < ntiles;
        int npm = pm, npn = pn; if (has_next) tile_of(Ln, nM, nN, npm, npn);
        const char* nA = (const char*)A + (size_t)(npm * 256) * K * 2; const char* nB = (const char*)Bt + (size_t)(npn * 256) * K * 2;
        for (int t = 0; t < nt; t += 2) {
            const bool last = (t == nt - 2);
            const char* a1 = cA + (size_t)(t + 1) * kstep;
            const char* a2 = last ? nA : cA + (size_t)(t + 2) * kstep; const char* b2 = last ? nB : cB + (size_t)(t + 2) * kstep;
            const char* a3 = a2 + kstep; const char* b3 = b2 + kstep;
            LDB(B0, 0, 0); LDB(B1, 0, 1); SCHED; LDA(At, 0, 0); STAGE(GSA(1, 1), a1 + hstep);
            WAIT_V(8); WAIT_L(0); BAR; MMA(0, 0, At, B0); MMA(0, 1, At, B1); BAR; SCHED;
            LDA(At, 0, 1); STAGE(GSB(0, 0), b2); STAGE(GSB(0, 1), b2 + hstep); STAGE(GSA(0, 0), a2);
            WAIT_V(8); WAIT_L(0); BAR; MMA(1, 0, At, B0); MMA(1, 1, At, B1); BAR; SCHED;
            LDB(B0, 1, 0); LDB(B1, 1, 1); SCHED; LDA(At, 1, 0); STAGE(GSA(0, 1), a2 + hstep);
            WAIT_V(8); WAIT_L(0); BAR; MMA(0, 0, At, B0); MMA(0, 1, At, B1); BAR; SCHED;
            LDA(At, 1, 1); STAGE(GSB(1, 0), b3); STAGE(GSB(1, 1), b3 + hstep); STAGE(GSA(1, 0), a3);
            WAIT_V(8); WAIT_L(0); BAR; MMA(1, 0, At, B0); MMA(1, 1, At, B1); BAR; SCHED;
        }
        if (wr == 0) BAR;
        float rs_next = 0.f;
        if (Epi::NEEDS_RS && has_next && tid < 256) rs_next = row_rstd(epi.PART, npm * 256 + tid);
        epi(acc, pm * 256, pn * 256, wr, wc, fr, fq, rsb + rbuf * 256);
        SCHED;
        if (!has_next) break;
        if (Epi::NEEDS_RS && tid < 256) rsb[(rbuf ^ 1) * 256 + tid] = rs_next;
        rbuf ^= 1;
#pragma unroll
        for (int a = 0; a < 2; ++a)
#pragma unroll
            for (int b = 0; b < 2; ++b)
#pragma unroll
                for (int m = 0; m < 4; ++m)
#pragma unroll
                    for (int n = 0; n < 2; ++n) acc[a][b][m][n] = (f32x4){0.f, 0.f, 0.f, 0.f};
        L = Ln; pm = npm; pn = npn; cA = nA; cB = nB;
        if (wr == 1) BAR;
    }
    WAIT_V(0);
    BAR;
    __syncthreads();
}

struct EpiGU {
    static constexpr int NST = 16; static constexpr bool NEEDS_RS = true;
    bf16_t* __restrict__ H; const float* __restrict__ PART;
    __device__ __forceinline__ void operator()(const f32x4 (&acc)[2][2][4][2], int brow, int bcol, int wr, int wc, int fr, int fq, const float* rsl) const {
        const int cbase = (bcol >> 8) * 128 + wc * 32 + fq * 8;
        float rs[2][4];
#pragma unroll
        for (int ai = 0; ai < 2; ++ai)
#pragma unroll
            for (int m = 0; m < 4; ++m) rs[ai][m] = rsl[ai * 128 + wr * 64 + m * 16 + fr];
#pragma unroll
        for (int ai = 0; ai < 2; ++ai)
#pragma unroll
            for (int m = 0; m < 4; ++m) {
                const int row = brow + ai * 128 + wr * 64 + m * 16 + fr;
                const f32x4 g0 = acc[ai][0][m][0] * rs[ai][m], u0 = acc[ai][1][m][0] * rs[ai][m], g1 = acc[ai][0][m][1] * rs[ai][m], u1 = acc[ai][1][m][1] * rs[ai][m];
                uint4 o; o.x = pk2(silu(g0[0]) * u0[0], silu(g0[1]) * u0[1]); o.y = pk2(silu(g0[2]) * u0[2], silu(g0[3]) * u0[3]);
                o.z = pk2(silu(g1[0]) * u1[0], silu(g1[1]) * u1[1]); o.w = pk2(silu(g1[2]) * u1[2], silu(g1[3]) * u1[3]);
                *(uint4*)(H + (size_t)row * DFF + cbase) = o;
            }
    }
};
struct EpiRes {
    static constexpr int NST = 16; static constexpr bool NEEDS_RS = false;
    bf16_t* XB; float* PART; float scale;
    __device__ __forceinline__ void operator()(const f32x4 (&acc)[2][2][4][2], int brow, int bcol, int wr, int wc, int fr, int fq, const float*) const {
        uint4 v[2][4][2];
#pragma unroll
        for (int ai = 0; ai < 2; ++ai)
#pragma unroll
            for (int m = 0; m < 4; ++m)
#pragma unroll
                for (int bj = 0; bj < 2; ++bj)
                    v[ai][m][bj] = *(const uint4*)(XB + (size_t)(brow + ai * 128 + wr * 64 + m * 16 + fr) * DM + bcol + bj * 128 + wc * 32 + fq * 8);
#pragma unroll
        for (int ai = 0; ai < 2; ++ai)
#pragma unroll
            for (int m = 0; m < 4; ++m) {
                const int row = brow + ai * 128 + wr * 64 + m * 16 + fr;
                float ss = 0.f;
#pragma unroll
                for (int bj = 0; bj < 2; ++bj) {
                    const uint4 xv = v[ai][m][bj]; const f32x4 a0 = acc[ai][bj][m][0], a1 = acc[ai][bj][m][1];
                    uint4 o; o.x = pk2(lo16(xv.x) + scale * a0[0], hi16(xv.x) + scale * a0[1]); o.y = pk2(lo16(xv.y) + scale * a0[2], hi16(xv.y) + scale * a0[3]);
                    o.z = pk2(lo16(xv.z) + scale * a1[0], hi16(xv.z) + scale * a1[1]); o.w = pk2(lo16(xv.w) + scale * a1[2], hi16(xv.w) + scale * a1[3]);
                    *(uint4*)(XB + (size_t)row * DM + bcol + bj * 128 + wc * 32 + fq * 8) = o;
                    const float r0 = lo16(o.x), r1 = hi16(o.x), r2 = lo16(o.y), r3 = hi16(o.y), r4 = lo16(o.z), r5 = hi16(o.z), r6 = lo16(o.w), r7 = hi16(o.w);
                    ss += (r0 * r0 + r1 * r1) + (r2 * r2 + r3 * r3) + (r4 * r4 + r5 * r5) + (r6 * r6 + r7 * r7);
                }
                ss += __shfl_xor(ss, 16); ss += __shfl_xor(ss, 32);
                if (fq == 0) PART[(size_t)row * 16 + (bcol >> 8) * 4 + wc] = ss;
            }
    }
};
struct EpiProj {
    static constexpr int NST = 32; static constexpr bool NEEDS_RS = true;
    bf16_t* __restrict__ P; int ld; const float* __restrict__ PART;
    __device__ __forceinline__ void operator()(const f32x4 (&acc)[2][2][4][2], int brow, int bcol, int wr, int wc, int fr, int fq, const float* rsl) const {
        float rs[2][4];
#pragma unroll
        for (int ai = 0; ai < 2; ++ai)
#pragma unroll
            for (int m = 0; m < 4; ++m) rs[ai][m] = rsl[ai * 128 + wr * 64 + m * 16 + fr];
#pragma unroll
        for (int ai = 0; ai < 2; ++ai)
#pragma unroll
            for (int m = 0; m < 4; ++m) {
                const int row = brow + ai * 128 + wr * 64 + m * 16 + fr;
#pragma unroll
                for (int bj = 0; bj < 2; ++bj) {
                    const f32x4 a0 = acc[ai][bj][m][0] * rs[ai][m], a1 = acc[ai][bj][m][1] * rs[ai][m];
                    uint4 o; o.x = pk2(a0[0], a0[1]); o.y = pk2(a0[2], a0[3]); o.z = pk2(a1[0], a1[1]); o.w = pk2(a1[2], a1[3]);
                    *(uint4*)(P + (size_t)row * ld + bcol + bj * 128 + wc * 32 + fq * 8) = o;
                }
            }
    }
};

template <int NB, bool RS, int NKS, class Fin>
__device__ __forceinline__ void skinny_task(const bf16_t* __restrict__ A, int lda, const bf16_t* __restrict__ Bt, int K, int brow0, int brow1, const bf16_t* Xs, const Fin& fin) {
    SMEM_DECL;
    float* red = (float*)smem;
    float* rsd = red + 8 * NB * 2 * 64 * 4;
    const int tid = otid(), lane = tid & 63, w = tid >> 6, fr = lane & 15, fq = lane >> 4;
    const int kw = K >> 3;
    f32x4 acc[NB][2];
#pragma unroll
    for (int nb = 0; nb < NB; ++nb) { acc[nb][0] = (f32x4){0.f, 0.f, 0.f, 0.f}; acc[nb][1] = (f32x4){0.f, 0.f, 0.f, 0.f}; }
    __syncthreads();
    float rsv[4];
    if (RS) {
#pragma unroll
        for (int rr = 0; rr < 4; ++rr) {
            const bf16_t* xr = Xs + (size_t)(w * 4 + rr) * DM;
            float ss = 0.f;
#pragma unroll
            for (int i = 0; i < 2; ++i) { const uint4 v = *(const uint4*)(xr + i * 512 + lane * 8);
                ss += lo16(v.x) * lo16(v.x) + hi16(v.x) * hi16(v.x) + lo16(v.y) * lo16(v.y) + hi16(v.y) * hi16(v.y) + lo16(v.z) * lo16(v.z) + hi16(v.z) * hi16(v.z) + lo16(v.w) * lo16(v.w) + hi16(v.w) * hi16(v.w); }
            rsv[rr] = ss;
        }
    }
    {
        bf16x8 a0[NKS], a1[NKS], b0[NKS], b1[NKS];
#pragma unroll
        for (int ks = 0; ks < NKS; ++ks) {
            const int k0 = w * kw + ks * 32 + fq * 8;
            a0[ks] = *(const bf16x8*)(A + (size_t)fr * lda + k0); a1[ks] = *(const bf16x8*)(A + (size_t)(16 + fr) * lda + k0);
            b0[ks] = *(const bf16x8*)(Bt + (size_t)(brow0 + fr) * K + k0);
            if (NB == 2) b1[ks] = *(const bf16x8*)(Bt + (size_t)(brow1 + fr) * K + k0);
        }
#pragma unroll
        for (int ks = 0; ks < NKS; ++ks) {
            acc[0][0] = MFMA16(b0[ks], a0[ks], acc[0][0]); acc[0][1] = MFMA16(b0[ks], a1[ks], acc[0][1]);
            if (NB == 2) { acc[NB - 1][0] = MFMA16(b1[ks], a0[ks], acc[NB - 1][0]); acc[NB - 1][1] = MFMA16(b1[ks], a1[ks], acc[NB - 1][1]); }
        }
    }
    if (RS) {
#pragma unroll
        for (int rr = 0; rr < 4; ++rr) { const float ss = wave_sum(rsv[rr]); if (lane == 0) rsd[w * 4 + rr] = rsqrtf(ss * (1.f / 1024.f) + EPS); }
    }
#pragma unroll
    for (int nb = 0; nb < NB; ++nb)
#pragma unroll
        for (int mt = 0; mt < 2; ++mt) { float4 v; v.x = acc[nb][mt][0]; v.y = acc[nb][mt][1]; v.z = acc[nb][mt][2]; v.w = acc[nb][mt][3];
            *(float4*)(red + (((w * NB + nb) * 2 + mt) * 64 + lane) * 4) = v; }
    __syncthreads();
    {
        const int mt = tid >> 8, ln = (tid >> 2) & 63, jj = tid & 3;
        float v0 = 0.f, v1 = 0.f;
#pragma unroll
        for (int ww = 0; ww < 8; ++ww) {
            v0 += red[(((ww * NB + 0) * 2 + mt) * 64 + ln) * 4 + jj];
            if (NB == 2) v1 += red[(((ww * NB + NB - 1) * 2 + mt) * 64 + ln) * 4 + jj];
        }
        const float rs = RS ? rsd[mt * 16 + (ln & 15)] : 1.f;
        fin(mt * 16 + (ln & 15), (ln >> 4) * 4 + jj, v0 * rs, v1 * rs);
    }
}

struct FinGU { bf16_t* H; int c0; __device__ __forceinline__ void operator()(int m, int j, float g, float u) const { const int col = (c0 & ~31) + 8 * (j >> 2) + 4 * ((c0 >> 4) & 1) + (j & 3); H[(size_t)(MP + m) * DFF + col] = f2bf(silu(g) * u); } };
struct FinRes { bf16_t* XB; float scale; int c0; __device__ __forceinline__ void operator()(int m, int j, float v, float) const { const size_t o = (size_t)(MP + m) * DM + (c0 & ~31) + 8 * (j >> 2) + 4 * ((c0 >> 4) & 1) + (j & 3); XB[o] = f2bf(bf2f(XB[o]) + scale * v); } };
struct FinProj { bf16_t* P; int c0; __device__ __forceinline__ void operator()(int m, int j, float v, float) const { const int col = (c0 & ~31) + 8 * (j >> 2) + 4 * ((c0 >> 4) & 1) + (j & 3); P[(size_t)(MP + m) * NPROJ + col] = f2bf(v); } };

__device__ __forceinline__ void transpose_tile(const float* __restrict__ src, int ldn, int K, int k0, int c0, bf16_t* __restrict__ dst, int drow0, const float* __restrict__ gk, bool perm) {
    SMEM_DECL;
    float* tile = (float*)smem;
    const int tid = otid();
    __syncthreads();
#pragma unroll
    for (int r = 0; r < 32; ++r) { const int k = r * 8 + (tid >> 6), n = tid & 63;
        tile[k * 65 + n] = src[(size_t)(k0 + k) * ldn + c0 + n] * (gk ? gk[k0 + k] : 1.f); }
    __syncthreads();
#pragma unroll
    for (int r = 0; r < 16; ++r) { const int id = tid + r * 512, n = id >> 7, kp = id & 127;
        const int c32 = n & 31, nd = perm ? (n & ~31) + 16 * ((c32 >> 2) & 1) + 4 * (c32 >> 3) + (c32 & 3) : n;
        *(unsigned*)(dst + (size_t)(drow0 + nd) * K + k0 + 2 * kp) = pk2(tile[(2 * kp) * 65 + n], tile[(2 * kp + 1) * 65 + n]); }
}

__device__ void weights_phase(KP p) {
    for (int it = blockIdx.x; it < 2 * 1280; it += gridDim.x) {
        const int L = it / 1280; int r = it % 1280;
        unsigned char* wb = p->ws + (size_t)L * LAYER_W;
        if (r < 528 || r >= 752) {
            const bool second = r >= 752; if (second) r -= 752;
            const float* G = (second ? p->in[I_F2G] : p->in[I_F1G]) + (size_t)L * 1024 * 2816;
            const float* U = (second ? p->in[I_F2U] : p->in[I_F1U]) + (size_t)L * 1024 * 2816;
            const float* D = (second ? p->in[I_F2D] : p->in[I_F1D]) + (size_t)L * 2816 * 1024;
            bf16_t* wgu = (bf16_t*)(wb + (second ? OFF_WGU2 : OFF_WGU1));
            bf16_t* wd = (bf16_t*)(wb + (second ? OFF_WD2 : OFF_WD1));
            if (r < 352) { const bool up = r >= 176; if (up) r -= 176; const int kt = r / 44, nt = r % 44, c0 = nt * 64;
                transpose_tile(up ? U : G, 2816, 1024, kt * 256, c0, wgu, (c0 >> 7) * 256 + (c0 & 127) + (up ? 128 : 0), (second ? p->in[I_F2N] : p->in[I_F1N]) + L * 1024, true); }
            else { r -= 352; const int kt = r / 16, nt = r % 16; transpose_tile(D, 1024, 2816, kt * 256, nt * 64, wd, nt * 64, nullptr, true); }
        } else if (r < 688) { r -= 528; const int kt = r / 40, nt = r % 40;
            transpose_tile(p->in[I_WIN] + (size_t)L * 1024 * WINLD, WINLD, 1024, kt * 256, nt * 64, (bf16_t*)(wb + OFF_WIN), nt * 64, p->in[I_MIXN] + L * 1024, true);
        } else { r -= 688; const int kt = r / 16, nt = r % 16;
            transpose_tile(p->in[I_WOUT] + (size_t)L * 1024 * 1024, 1024, 1024, kt * 256, nt * 64, (bf16_t*)(wb + OFF_WOUT), nt * 64, nullptr, true); }
    }
    for (int it = blockIdx.x; it < 2; it += gridDim.x) {
        const int L = it; bf16_t* wdt = (bf16_t*)(p->ws + WS_WDT) + (size_t)L * 16 * 1024;
        for (int e = otid(); e < 16 * 1024; e += NT) { const int h = e >> 10, k = e & 1023;
            wdt[e] = h < 8 ? f2bf(p->in[I_WIN][((size_t)L * 1024 + k) * WINLD + 2560 + h] * p->in[I_MIXN][L * 1024 + k]) : (bf16_t)0; }
    }
    __syncthreads();
}

__device__ void cache_copy_phase(KP p) {
    constexpr unsigned per = 2047u * 256u / 4u;
    constexpr unsigned total = 128u * per;
    const unsigned stride = gridDim.x * NT;
    const float* ck = p->in[I_CK]; const float* cv = p->in[I_CV]; float* out = p->out;
#define CC_IDX(j) unsigned i##j = ib + (j) * stride; i##j = i##j < total ? i##j : total - 1u; \
    const unsigned seg##j = i##j / per, e##j = i##j % per, kv##j = seg##j >> 6, ln##j = seg##j & 63u; \
    const float4* s##j = (const float4*)((kv##j ? cv : ck) + (size_t)ln##j * 2048 * 256 + 256) + e##j; \
    float4* d##j = (float4*)(out + (kv##j ? O_VS : O_KS) + (size_t)ln##j * 2048 * 256) + e##j;
    for (unsigned ib = blockIdx.x * NT + otid(); ib < total; ib += 8u * stride) {
        CC_IDX(0) CC_IDX(1) CC_IDX(2) CC_IDX(3) CC_IDX(4) CC_IDX(5) CC_IDX(6) CC_IDX(7)
        const float4 v0 = *s0, v1 = *s1, v2 = *s2, v3 = *s3, v4 = *s4, v5 = *s5, v6 = *s6, v7 = *s7;
        *d0 = v0; *d1 = v1; *d2 = v2; *d3 = v3; *d4 = v4; *d5 = v5; *d6 = v6; *d7 = v7;
    }
#undef CC_IDX
}

__device__ void copy_phase(KP p, bf16_t* XB, float* PART) {
    const int lane = otid() & 63, wave = otid() >> 6;
    const int nw = gridDim.x * 8;
    for (int row0 = blockIdx.x * 8 + wave; row0 < MTOK; row0 += 4 * nw) {
        float4 v[4][4];
#pragma unroll
        for (int r = 0; r < 4; ++r) {
            int row = row0 + r * nw; row = row < MTOK ? row : MTOK - 1;
            const float* src = row < MP ? p->in[I_XP] + (size_t)row * DM : p->in[I_XS] + (size_t)(row - MP) * DM;
#pragma unroll
            for (int i = 0; i < 4; ++i) v[r][i] = *(const float4*)(src + i * 256 + lane * 4);
        }
#pragma unroll
        for (int r = 0; r < 4; ++r) {
            int row = row0 + r * nw; row = row < MTOK ? row : MTOK - 1;
            float ss = 0.f;
#pragma unroll
            for (int i = 0; i < 4; ++i) ss += v[r][i].x * v[r][i].x + v[r][i].y * v[r][i].y + v[r][i].z * v[r][i].z + v[r][i].w * v[r][i].w;
            ss = wave_sum(ss);
#pragma unroll
            for (int i = 0; i < 4; ++i) { uint2 o; o.x = pk2(v[r][i].x, v[r][i].y); o.y = pk2(v[r][i].z, v[r][i].w); *(uint2*)(XB + (size_t)row * DM + i * 256 + lane * 4) = o; }
            if (row < MP && lane < 16) PART[(size_t)row * 16 + lane] = lane == 0 ? ss : 0.f;
        }
    }
}
__device__ void final_phase(KP p, const bf16_t* XB, float* Y) {
    const int lane = otid() & 63, wave = otid() >> 6;
    const int nw = gridDim.x * 8;
    float4 gv[4];
#pragma unroll
    for (int i = 0; i < 4; ++i) gv[i] = *(const float4*)(p->in[I_FINN] + i * 256 + lane * 4);
    for (int row0 = blockIdx.x * 8 + wave; row0 < MTOK; row0 += 4 * nw) {
        uint2 u[4][4];
#pragma unroll
        for (int r = 0; r < 4; ++r) {
            int row = row0 + r * nw; row = row < MTOK ? row : MTOK - 1;
#pragma unroll
            for (int i = 0; i < 4; ++i) u[r][i] = *(const uint2*)(XB + (size_t)row * DM + i * 256 + lane * 4);
        }
#pragma unroll
        for (int r = 0; r < 4; ++r) {
            int row = row0 + r * nw; row = row < MTOK ? row : MTOK - 1;
            float4 v[4]; float ss = 0.f;
#pragma unroll
            for (int i = 0; i < 4; ++i) { v[i] = make_float4(lo16(u[r][i].x), hi16(u[r][i].x), lo16(u[r][i].y), hi16(u[r][i].y)); ss += v[i].x * v[i].x + v[i].y * v[i].y + v[i].z * v[i].z + v[i].w * v[i].w; }
            ss = wave_sum(ss);
            const float rstd = rsqrtf(ss * (1.f / 1024.f) + EPS);
#pragma unroll
            for (int i = 0; i < 4; ++i) { float4 o; o.x = v[i].x * rstd * gv[i].x; o.y = v[i].y * rstd * gv[i].y; o.z = v[i].z * rstd * gv[i].z; o.w = v[i].w * rstd * gv[i].w;
                *(float4*)(Y + (size_t)row * DM + i * 256 + lane * 4) = o; }
        }
    }
}

__device__ void prep_phase(KP p, int L, bf16_t* PROJ, bf16_t* U, bf16_t* CAT, const bf16_t* XB, const float* PART, float* DT) {
    SMEM_DECL;
    float* PW = (float*)smem; float* XA = PW + 16384; float* Dm = XA + 31 * 256; float* CS = Dm + 4096; float* INV = CS + 1024; float* DTP = INV + 32;
    const int tid = otid(), lane = tid & 63, w = tid >> 6, fr = lane & 15, fq = lane >> 4;
    __syncthreads();
    bf16_t* PWT = (bf16_t*)PW;
    bf16_t* DmB = (bf16_t*)Dm;
    for (int i = tid; i < 16384; i += NT) { const int gg = i >> 12, c = (i >> 6) & 63, dd = i & 63; PWT[(gg * 64 + 32 * (dd >> 5) + 16 * ((dd >> 2) & 1) + 4 * ((dd >> 3) & 3) + (dd & 3)) * 72 + c] = f2bf(p->in[I_POOLW][L * 16384 + i]); }
    if (tid < 32) INV[tid] = rope_inv(tid);
    __syncthreads();
    float* out = p->out;
    const bf16_t* wdt = (const bf16_t*)(p->ws + WS_WDT) + (size_t)L * 16 * 1024;
    const int tiles_per = 8 * ((256 + gridDim.x - 1) / gridDim.x);
    for (int tile = blockIdx.x * tiles_per; tile < 2048 && tile < (blockIdx.x + 1) * tiles_per; ++tile) {
        const int token0 = tile * 16, b = token0 >> 13, t0 = token0 & 8191;
        bf16x8 da[4], db[4];
#pragma unroll
        for (int ks = 0; ks < 4; ++ks) { const int k0 = w * 128 + ks * 32 + fq * 8;
            da[ks] = *(const bf16x8*)(XB + (size_t)(token0 + fr) * DM + k0); db[ks] = *(const bf16x8*)(wdt + fr * 1024 + k0); }
        uint4 xav[2];
#pragma unroll
        for (int it = 0; it < 2; ++it) { const int id = tid + it * NT, rr = id >> 5, ch = id & 31, t = t0 - 15 + rr;
            xav[it] = zero4();
            if (id < 992 && t >= 0) xav[it] = *(const uint4*)(PROJ + (size_t)(b * 8192 + t) * NPROJ + ch * 8); }
        const int r_tk = tid >> 5, r_rest = tid & 31, r_qk = r_rest >> 4, r_h = (r_rest >> 2) & 3, r_i0 = (r_rest & 3) * 8;
        bf16_t* rbase = PROJ + (size_t)(token0 + r_tk) * NPROJ + 256 + r_qk * 256 + r_h * 64 + r_i0;
        const uint4 rxa = *(const uint4*)rbase, rxb = *(const uint4*)(rbase + 32);
        uint4 vld = zero4();
        if (t0 >= 6144) vld = *(const uint4*)(PROJ + (size_t)(token0 + (tid >> 5)) * NPROJ + 768 + (tid & 31) * 8);
        const int q4 = tid >> 7, c0 = (tid & 127) * 8;
        uint4 xr[7];
#pragma unroll
        for (int rr = 0; rr < 7; ++rr) { const int tt = t0 + q4 * 4 - 3 + rr;
            xr[rr] = zero4();
            if (tt >= 0) xr[rr] = *(const uint4*)(PROJ + (size_t)(b * 8192 + tt) * NPROJ + 1536 + c0); }
        {
            f32x4 acc = (f32x4){0.f, 0.f, 0.f, 0.f};
#pragma unroll
            for (int ks = 0; ks < 4; ++ks) acc = MFMA16(db[ks], da[ks], acc);
            if (fq < 2) { float4 v; v.x = acc[0]; v.y = acc[1]; v.z = acc[2]; v.w = acc[3]; *(float4*)(DTP + (w * 16 + fr) * 8 + fq * 4) = v; }
        }
#pragma unroll
        for (int it = 0; it < 2; ++it) { const int id = tid + it * NT, rr = id >> 5, ch = id & 31;
            if (id < 992) { float* d = XA + rr * 256 + ch * 8; const uint4 v = xav[it];
                d[0] = lo16(v.x); d[1] = hi16(v.x); d[2] = lo16(v.y); d[3] = hi16(v.y); d[4] = lo16(v.z); d[5] = hi16(v.z); d[6] = lo16(v.w); d[7] = hi16(v.w); } }
        { const int tk = tid >> 5, i = tid & 31; float c, sn; rope_cs((float)(t0 + tk) * INV[i], c, sn); CS[(tk * 32 + i) * 2] = c; CS[(tk * 32 + i) * 2 + 1] = sn; }
        __syncthreads();
        if (tid < 128) {
            const int tk = tid >> 3, h = tid & 7;
            float d = 0.f;
#pragma unroll
            for (int ww = 0; ww < 8; ++ww) d += DTP[(ww * 16 + tk) * 8 + h];
            const float x = d * row_rstd(PART, token0 + tk) + p->in[I_DTB][L * 8 + h];
            DT[(size_t)(token0 + tk) * 8 + h] = x > 20.f ? x : log1pf(__expf(x));
        }
        for (int id = tid; id < 4096; id += NT) {
            const int tk = id >> 8, ch = id & 255, g = ch >> 6, ww = 2 << g, t = t0 + tk;
            float sum = 0.f;
            for (int i = 0; i < ww; ++i) sum += XA[(15 + tk - i) * 256 + ch];
            const float xc = XA[(15 + tk) * 256 + ch];
            const int cnt = (t + 1) < ww ? (t + 1) : ww;
            DmB[tk * 264 + ch] = f2bf(sum / (float)cnt - xc);
            if (t >= 8177) out[O_POOLP + ((size_t)(L * 4 + b) * 15 + (t - 8177)) * 256 + ch] = xc;
        }
        __syncthreads();
        {
            const int g = w >> 1;
            f32x4 r[2];
#pragma unroll
            for (int dq = 0; dq < 2; ++dq) {
                const int dtile = (w & 1) * 2 + dq;
                r[dq] = (f32x4){0.f, 0.f, 0.f, 0.f};
#pragma unroll
                for (int ks = 0; ks < 2; ++ks) {
                    const bf16x8 pf = *(const bf16x8*)(PWT + (g * 64 + 16 * dtile + fr) * 72 + ks * 32 + fq * 8);
                    const bf16x8 qf = *(const bf16x8*)(DmB + fr * 264 + g * 64 + ks * 32 + fq * 8);
                    r[dq] = MFMA16(pf, qf, r[dq]);
                }
            }
            const int o = g * 64 + 32 * (w & 1) + fq * 8;
            const float4 p0 = *(const float4*)(p->in[I_POOLSC] + L * 256 + o), p1 = *(const float4*)(p->in[I_POOLSC] + L * 256 + o + 4);
            uint4 ov; ov.x = pk2(r[0][0] * p0.x, r[0][1] * p0.y); ov.y = pk2(r[0][2] * p0.z, r[0][3] * p0.w);
            ov.z = pk2(r[1][0] * p1.x, r[1][1] * p1.y); ov.w = pk2(r[1][2] * p1.z, r[1][3] * p1.w);
            *(uint4*)(CAT + (size_t)(token0 + fr) * DM + o) = ov;
        }
        {
            const int t = t0 + r_tk;
            const float x1[8] = {lo16(rxa.x), hi16(rxa.x), lo16(rxa.y), hi16(rxa.y), lo16(rxa.z), hi16(rxa.z), lo16(rxa.w), hi16(rxa.w)};
            const float x2[8] = {lo16(rxb.x), hi16(rxb.x), lo16(rxb.y), hi16(rxb.y), lo16(rxb.z), hi16(rxb.z), lo16(rxb.w), hi16(rxb.w)};
            float r1[8], r2[8];
            const float sc = r_qk == 0 ? 0.125f : 1.f;
#pragma unroll
            for (int e = 0; e < 8; e += 2) {
                const float4 cs = *(const float4*)(CS + (r_tk * 32 + r_i0 + e) * 2);
                r1[e] = (x1[e] * cs.x - x2[e] * cs.y) * sc; r2[e] = (x2[e] * cs.x + x1[e] * cs.y) * sc;
                r1[e + 1] = (x1[e + 1] * cs.z - x2[e + 1] * cs.w) * sc; r2[e + 1] = (x2[e + 1] * cs.z + x1[e + 1] * cs.w) * sc;
            }
            uint4 o1, o2;
            o1.x = pk2(r1[0], r1[1]); o1.y = pk2(r1[2], r1[3]); o1.z = pk2(r1[4], r1[5]); o1.w = pk2(r1[6], r1[7]);
            o2.x = pk2(r2[0], r2[1]); o2.y = pk2(r2[2], r2[3]); o2.z = pk2(r2[4], r2[5]); o2.w = pk2(r2[6], r2[7]);
            *(uint4*)rbase = o1; *(uint4*)(rbase + 32) = o2;
            if (r_qk == 1 && t >= 6144) {
                float* kp = out + O_KP + (((size_t)(L * 4 + b) * 2048 + (t - 6144)) * 4 + r_h) * 64 + r_i0;
                *(float4*)kp = make_float4(r1[0], r1[1], r1[2], r1[3]); *(float4*)(kp + 4) = make_float4(r1[4], r1[5], r1[6], r1[7]);
                *(float4*)(kp + 32) = make_float4(r2[0], r2[1], r2[2], r2[3]); *(float4*)(kp + 36) = make_float4(r2[4], r2[5], r2[6], r2[7]);
            }
        }
        if (t0 >= 6144) {
            const int tk = tid >> 5, cc = (tid & 31) * 8, t = t0 + tk;
            float* vp = out + O_VP + ((size_t)(L * 4 + b) * 2048 + (t - 6144)) * 256 + cc;
            *(float4*)vp = make_float4(lo16(vld.x), hi16(vld.x), lo16(vld.y), hi16(vld.y)); *(float4*)(vp + 4) = make_float4(lo16(vld.z), hi16(vld.z), lo16(vld.w), hi16(vld.w));
        }
        {
            float wv[4][8], bv[8];
            { const float4 b0 = *(const float4*)(p->in[I_CONVB] + L * 1024 + c0), b1 = *(const float4*)(p->in[I_CONVB] + L * 1024 + c0 + 4);
              bv[0] = b0.x; bv[1] = b0.y; bv[2] = b0.z; bv[3] = b0.w; bv[4] = b1.x; bv[5] = b1.y; bv[6] = b1.z; bv[7] = b1.w; }
#pragma unroll
            for (int tau = 0; tau < 4; ++tau) {
                const float* cw = p->in[I_CONVW] + (size_t)(L * 4 + tau) * 1024 + c0;
                const float4 w0 = *(const float4*)cw, w1 = *(const float4*)(cw + 4);
                wv[tau][0] = w0.x; wv[tau][1] = w0.y; wv[tau][2] = w0.z; wv[tau][3] = w0.w; wv[tau][4] = w1.x; wv[tau][5] = w1.y; wv[tau][6] = w1.z; wv[tau][7] = w1.w;
            }
            float acc[4][8];
#pragma unroll
            for (int it = 0; it < 4; ++it)
#pragma unroll
                for (int e = 0; e < 8; ++e) acc[it][e] = bv[e];
#pragma unroll
            for (int rr = 0; rr < 7; ++rr) {
                const float xf[8] = {lo16(xr[rr].x), hi16(xr[rr].x), lo16(xr[rr].y), hi16(xr[rr].y), lo16(xr[rr].z), hi16(xr[rr].z), lo16(xr[rr].w), hi16(xr[rr].w)};
#pragma unroll
                for (int it = 0; it < 4; ++it) {
                    const int tau = rr - it;
                    if (tau >= 0 && tau < 4) {
#pragma unroll
                        for (int e = 0; e < 8; ++e) acc[it][e] += xf[e] * wv[tau][e];
                    }
                }
            }
#pragma unroll
            for (int it = 0; it < 4; ++it) {
                const int tk = q4 * 4 + it, t = t0 + tk;
                uint4 o; o.x = pk2(silu(acc[it][0]), silu(acc[it][1])); o.y = pk2(silu(acc[it][2]), silu(acc[it][3]));
                o.z = pk2(silu(acc[it][4]), silu(acc[it][5])); o.w = pk2(silu(acc[it][6]), silu(acc[it][7]));
                *(uint4*)(U + (size_t)(token0 + tk) * DM + c0) = o;
                if (t >= 8189) { float* cp = out + O_CONVP + ((size_t)(L * 4 + b) * 3 + (t - 8189)) * 1024 + c0; const uint4 xv = xr[it + 3];
                    *(float4*)cp = make_float4(lo16(xv.x), hi16(xv.x), lo16(xv.y), hi16(xv.y)); *(float4*)(cp + 4) = make_float4(lo16(xv.z), hi16(xv.z), lo16(xv.w), hi16(xv.w)); }
            }
        }
        __syncthreads();
    }
}

__device__ void prep_sample_item(KP p, int L, int n, bf16_t* PROJ, bf16_t* U, bf16_t* CAT, const bf16_t* XB, float* DT) {
    SMEM_DECL;
    float* dsm = (float*)smem;
    const int tid = otid();
    const size_t row = MP + n;
    float* out = p->out;
    const int ln = L * 32 + n;
    __syncthreads();
    {
        const int lane = tid & 63, h = tid >> 6;
        const bf16_t* wdt = (const bf16_t*)(p->ws + WS_WDT) + (size_t)L * 16 * 1024 + h * 1024;
        float d = 0.f, ss = 0.f;
#pragma unroll
        for (int i = 0; i < 16; ++i) { const int k = i * 64 + lane; const float xf = bf2f(XB[row * DM + k]); ss += xf * xf; d += xf * bf2f(wdt[k]); }
        d = wave_sum(d); ss = wave_sum(ss);
        if (lane == 0) { const float x = d * rsqrtf(ss * (1.f / 1024.f) + EPS) + p->in[I_DTB][L * 8 + h]; DT[row * 8 + h] = x > 20.f ? x : log1pf(__expf(x)); }
    }
    __syncthreads();
    if (tid < 256) {
        const int ch = tid, g = ch >> 6, w = 2 << g;
        const float* cp = p->in[I_CPOOL] + (size_t)ln * 15 * 256;
        const float xn = bf2f(PROJ[row * NPROJ + ch]);
        float cpr[15];
#pragma unroll
        for (int i = 1; i < 16; ++i) cpr[i - 1] = cp[(15 - i) * 256 + ch];
        float sum = xn;
#pragma unroll
        for (int i = 1; i < 16; ++i) sum += (i < w) ? cpr[i - 1] : 0.f;
        dsm[ch] = sum / (float)w - xn;
        float* ps = out + O_POOLS + (size_t)ln * 15 * 256;
        float cpv[14];
#pragma unroll
        for (int j = 0; j < 14; ++j) cpv[j] = cp[(j + 1) * 256 + ch];
#pragma unroll
        for (int j = 0; j < 14; ++j) ps[j * 256 + ch] = cpv[j];
        ps[14 * 256 + ch] = xn;
    }
    __syncthreads();
    if (tid < 256) {
        const int o = tid, g = o >> 6, dout = o & 63;
        const float* pw = p->in[I_POOLW] + (size_t)(L * 4 + g) * 4096;
        float acc = 0.f;
#pragma unroll 32
        for (int c = 0; c < 64; ++c) acc += dsm[g * 64 + c] * pw[c * 64 + dout];
        CAT[row * DM + o] = f2bf(acc * p->in[I_POOLSC][L * 256 + o]);
        const int qk = tid >> 7, h = (tid >> 5) & 3, i = tid & 31;
        const float inv = rope_inv(i);
        float c, s; rope_cs(16384.f * inv, c, s);
        bf16_t* base = PROJ + row * NPROJ + 256 + qk * 256 + h * 64;
        const float x1 = bf2f(base[i]), x2 = bf2f(base[i + 32]);
        float r1 = x1 * c - x2 * s, r2 = x2 * c + x1 * s;
        if (qk == 0) { r1 *= 0.125f; r2 *= 0.125f; }
        base[i] = f2bf(r1); base[i + 32] = f2bf(r2);
        if (qk == 1) { float* ks = out + O_KS + (((size_t)ln * 2048 + 2047) * 4 + h) * 64; ks[i] = r1; ks[i + 32] = r2; }
        out[O_VS + ((size_t)ln * 2048 + 2047) * 256 + tid] = bf2f(PROJ[row * NPROJ + 768 + tid]);
    }
    for (int c = tid; c < 1024; c += NT) {
        const float* sc = p->in[I_SCONV] + (size_t)ln * 3 * 1024;
        const float* cw = p->in[I_CONVW] + (size_t)L * 4 * 1024;
        const float xnew = bf2f(PROJ[row * NPROJ + 1536 + c]);
        const float s0 = sc[c], s1 = sc[1024 + c], s2 = sc[2048 + c];
        const float acc = p->in[I_CONVB][L * 1024 + c] + s0 * cw[c] + s1 * cw[1024 + c] + s2 * cw[2048 + c] + xnew * cw[3072 + c];
        U[row * DM + c] = f2bf(silu(acc));
        float* cs = out + O_CONVS + (size_t)ln * 3 * 1024;
        cs[c] = s1; cs[1024 + c] = s2; cs[2048 + c] = xnew;
    }
    __syncthreads();
}

struct AttnPf { uint4 k[4], v[4]; bf16x8 q[2]; };
__device__ __forceinline__ void attn_decode(int a, int& b, int& h, int& br, int& dsh, int& r, int& n) {
    const int bh = a / 192, rem = a % 192, idx = rem & 63; br = rem >> 6;
    b = bh >> 2; h = bh & 3; dsh = br * 2; const int nb = 64 >> dsh; r = idx / nb; n = idx % nb;
}
__device__ __forceinline__ void attn_load(int a, const bf16_t* PROJ, int tid, AttnPf& pf) {
    int b, h, br, dsh, r, n; attn_decode(a, b, h, br, dsh, r, n);
    const int lane = tid & 63, w = tid >> 6, fr = lane & 15, fq = lane >> 4;
#pragma unroll
    for (int it = 0; it < 4; ++it) {
        const int id = tid + it * NT, rowk = id >> 3, ch = id & 7, lk = (n - 1) * 128 + rowk;
        pf.k[it] = zero4();
        if (lk >= 0) pf.k[it] = *(const uint4*)(PROJ + (size_t)(b * 8192 + (lk << dsh) + r) * NPROJ + 512 + h * 64 + ch * 8);
    }
#pragma unroll
    for (int it = 0; it < 4; ++it) {
        const int id = tid + it * NT, key = id & 255, ch = id >> 8, lk = (n - 1) * 128 + key;
        pf.v[it] = zero4();
        if (lk >= 0) pf.v[it] = *(const uint4*)(PROJ + (size_t)(b * 8192 + (lk << dsh) + r) * NPROJ + 768 + h * 64 + ch * 8);
    }
    const int qi = 16 * w + fr, lq = n * 128 + qi;
    const size_t tq = (size_t)b * 8192 + ((size_t)lq << dsh) + r;
#pragma unroll
    for (int ks = 0; ks < 2; ++ks) pf.q[ks] = *(const bf16x8*)(PROJ + tq * NPROJ + 256 + h * 64 + ks * 32 + fq * 8);
}
__device__ void attn_items(int a0, int astep, const bf16_t* PROJ, bf16_t* OG, float* LSE) {
    SMEM_DECL;
    bf16_t* Ks = (bf16_t*)smem;
    bf16_t* Vt = (bf16_t*)(smem + 272 * 144);
    const int tid = otid(), lane = tid & 63, w = tid >> 6, fr = lane & 15, fq = lane >> 4;
    AttnPf pf;
    if (a0 < 3072) attn_load(a0, PROJ, tid, pf);
#pragma unroll 1
    for (int a = a0; a < 3072; a += astep) {
        int b, h, br, dsh, r, n; attn_decode(a, b, h, br, dsh, r, n);
        LDS_BARRIER();
#pragma unroll
        for (int it = 0; it < 4; ++it) { const int id = tid + it * NT, rowk = id >> 3, ch = id & 7; *(uint4*)(Ks + rowk * 72 + ch * 8) = pf.k[it]; }
        if (tid < 128) { const uint4 z = zero4(); *(uint4*)(Ks + (256 + (tid >> 3)) * 72 + (tid & 7) * 8) = z; }
#pragma unroll
        for (int it = 0; it < 4; ++it) {
            const int id = tid + it * NT, key = id & 255, ch = id >> 8; const uint4 v = pf.v[it];
            bf16_t* d = Vt + (32 * (ch >> 2) + 4 * (ch & 3)) * 280 + key;
            d[0] = (bf16_t)(v.x & 0xffff); d[280] = (bf16_t)(v.x >> 16); d[560] = (bf16_t)(v.y & 0xffff); d[840] = (bf16_t)(v.y >> 16);
            d[16 * 280] = (bf16_t)(v.z & 0xffff); d[17 * 280] = (bf16_t)(v.z >> 16); d[18 * 280] = (bf16_t)(v.w & 0xffff); d[19 * 280] = (bf16_t)(v.w >> 16);
        }
        { const int d = tid >> 3, kk = (tid & 7) * 2; *(unsigned*)(Vt + d * 280 + 256 + kk) = 0u; }
        const bf16x8 qf0 = pf.q[0], qf1 = pf.q[1];
        if (a + astep < 3072) attn_load(a + astep, PROJ, tid, pf);
        LDS_BARRIER();
        const int qi = 16 * w + fr, lq = n * 128 + qi;
        const size_t tq = (size_t)b * 8192 + ((size_t)lq << dsh) + r;
        f32x4 s[10];
#pragma unroll
        for (int t = 0; t < 10; ++t) {
            s[t] = (f32x4){0.f, 0.f, 0.f, 0.f};
            const bf16x8 kf0 = *(const bf16x8*)(Ks + (16 * (w + t) + fr) * 72 + fq * 8);
            const bf16x8 kf1 = *(const bf16x8*)(Ks + (16 * (w + t) + fr) * 72 + 32 + fq * 8);
            s[t] = MFMA16(kf0, qf0, s[t]); s[t] = MFMA16(kf1, qf1, s[t]);
        }
        float mx = -INFINITY;
#pragma unroll
        for (int t = 0; t < 10; ++t)
#pragma unroll
            for (int jj = 0; jj < 4; ++jj) {
                const int key = 16 * (w + t) + fq * 4 + jj, dist = 128 + qi - key;
                const bool valid = (dist >= 0) && (dist <= 128) && (key < 256) && (n > 0 || key >= 128);
                const float sv = valid ? s[t][jj] : -INFINITY;
                s[t][jj] = sv; mx = fmaxf(mx, sv);
            }
        mx = fmaxf(mx, __shfl_xor(mx, 16)); mx = fmaxf(mx, __shfl_xor(mx, 32));
        float lsum = 0.f;
#pragma unroll
        for (int t = 0; t < 10; ++t)
#pragma unroll
            for (int jj = 0; jj < 4; ++jj) { const float pv = __expf(s[t][jj] - mx); s[t][jj] = pv; lsum += pv; }
        lsum += __shfl_xor(lsum, 16); lsum += __shfl_xor(lsum, 32);
        f32x4 o[4];
#pragma unroll
        for (int dt = 0; dt < 4; ++dt) o[dt] = (f32x4){0.f, 0.f, 0.f, 0.f};
#pragma unroll
        for (int kp = 0; kp < 5; ++kp) {
            const int ta = 2 * kp, tb = 2 * kp + 1;
            union { bf16x8 v; unsigned u[4]; } pfr;
            pfr.u[0] = pk2(s[ta][0], s[ta][1]); pfr.u[1] = pk2(s[ta][2], s[ta][3]); pfr.u[2] = pk2(s[tb][0], s[tb][1]); pfr.u[3] = pk2(s[tb][2], s[tb][3]);
#pragma unroll
            for (int dt = 0; dt < 4; ++dt) {
                union { bf16x8 v; uint2 u[2]; } vf;
                vf.u[0] = *(const uint2*)(Vt + (16 * dt + fr) * 280 + 16 * (w + ta) + fq * 4);
                vf.u[1] = *(const uint2*)(Vt + (16 * dt + fr) * 280 + 16 * (w + tb) + fq * 4);
                o[dt] = MFMA16(vf.v, pfr.v, o[dt]);
            }
        }
        const float inv = 1.f / lsum;
#pragma unroll
        for (int a2 = 0; a2 < 2; ++a2) {
            uint4 ov; ov.x = pk2(o[2 * a2][0] * inv, o[2 * a2][1] * inv); ov.y = pk2(o[2 * a2][2] * inv, o[2 * a2][3] * inv);
            ov.z = pk2(o[2 * a2 + 1][0] * inv, o[2 * a2 + 1][1] * inv); ov.w = pk2(o[2 * a2 + 1][2] * inv, o[2 * a2 + 1][3] * inv);
            *(uint4*)(OG + ((size_t)br * MP + tq) * 256 + h * 64 + 32 * a2 + fq * 8) = ov;
        }
        if (fq == 0) LSE[((size_t)br * MP + tq) * 4 + h] = mx + __logf(lsum);
    }
}

__device__ void combine_item(int item, const bf16_t* __restrict__ OG, const float* __restrict__ LSE, bf16_t* __restrict__ CAT) {
    const int tid = otid();
    uint4 a[4], bb[4], c[4]; float l0[4], l1[4], l2[4];
#pragma unroll
    for (int it = 0; it < 4; ++it) {
        const int id = tid + it * NT, tk = id >> 5, ch = id & 31, h = ch >> 3;
        const size_t token = (size_t)item * 64 + tk;
        l0[it] = LSE[token * 4 + h]; l1[it] = LSE[((size_t)MP + token) * 4 + h]; l2[it] = LSE[(2ull * MP + token) * 4 + h];
        a[it] = *(const uint4*)(OG + token * 256 + ch * 8); bb[it] = *(const uint4*)(OG + ((size_t)MP + token) * 256 + ch * 8);
        c[it] = *(const uint4*)(OG + (2ull * MP + token) * 256 + ch * 8);
    }
#pragma unroll
    for (int it = 0; it < 4; ++it) {
        const int id = tid + it * NT, tk = id >> 5, ch = id & 31;
        const size_t token = (size_t)item * 64 + tk;
        const float m = fmaxf(l0[it], fmaxf(l1[it], l2[it]));
        float w0 = __expf(l0[it] - m), w1 = __expf(l1[it] - m), w2 = __expf(l2[it] - m);
        const float inv = 1.f / (w0 + w1 + w2); w0 *= inv; w1 *= inv; w2 *= inv;
        uint4 o;
        o.x = pk2(w0 * lo16(a[it].x) + w1 * lo16(bb[it].x) + w2 * lo16(c[it].x), w0 * hi16(a[it].x) + w1 * hi16(bb[it].x) + w2 * hi16(c[it].x));
        o.y = pk2(w0 * lo16(a[it].y) + w1 * lo16(bb[it].y) + w2 * lo16(c[it].y), w0 * hi16(a[it].y) + w1 * hi16(bb[it].y) + w2 * hi16(c[it].y));
        o.z = pk2(w0 * lo16(a[it].z) + w1 * lo16(bb[it].z) + w2 * lo16(c[it].z), w0 * hi16(a[it].z) + w1 * hi16(bb[it].z) + w2 * hi16(c[it].z));
        o.w = pk2(w0 * lo16(a[it].w) + w1 * lo16(bb[it].w) + w2 * lo16(c[it].w), w0 * hi16(a[it].w) + w1 * hi16(bb[it].w) + w2 * hi16(c[it].w));
        *(uint4*)(CAT + token * DM + 256 + ch * 8) = o;
    }
}

__device__ __forceinline__ void ssd_acs(KP p, int L, int g, int token0, const float* DT, float* acs, float* dts) {
    const int lane = otid() & 63, w = otid() >> 6;
    if (w < 4) {
        const int h = g * 4 + w; const float a = -__expf(p->in[I_ALOG][L * 8 + h]);
        const float d0 = DT[(size_t)(token0 + 2 * lane) * 8 + h], d1 = DT[(size_t)(token0 + 2 * lane + 1) * 8 + h];
        const float v0 = d0 * a, v1 = d1 * a, sum = v0 + v1; float inc = sum;
#pragma unroll
        for (int off = 1; off < 64; off <<= 1) { const float t = __shfl_up(inc, off); if (lane >= off) inc += t; }
        const float exc = inc - sum;
        acs[w * 128 + 2 * lane] = exc + v0; acs[w * 128 + 2 * lane + 1] = exc + v0 + v1;
        dts[w * 128 + 2 * lane] = d0; dts[w * 128 + 2 * lane + 1] = d1;
    }
}

__device__ void s1_item(KP p, int L, int item, const bf16_t* U, const float* DT, float* ST, float* DEC) {
    SMEM_DECL;
    bf16_t* BT = (bf16_t*)smem;
    bf16_t* XWT = (bf16_t*)(smem + 34816);
    float* acs = (float*)(smem + 104448);
    float* dts = (float*)(smem + 106496);
    const int tid = otid(), lane = tid & 63, w = tid >> 6, fr = lane & 15, fq = lane >> 4;
    const int cb = item >> 1, g = item & 1, token0 = cb * 128;
    __syncthreads();
    ssd_acs(p, L, g, token0, DT, acs, dts);
    __syncthreads();
    { const int j = tid >> 7, l = tid & 127; const float wv = __expf(acs[j * 128 + 127] - acs[j * 128 + l]) * dts[j * 128 + l];
      if (tid < 4) DEC[cb * 8 + g * 4 + tid] = __expf(acs[tid * 128 + 127]);
      __syncthreads();
      dts[j * 128 + l] = wv; }
    __syncthreads();
#pragma unroll
    for (int it = 0; it < 4; ++it) {
        const int id = tid + it * NT, l = id & 127, ch = id >> 7;
        const uint4 v = *(const uint4*)(U + (size_t)(token0 + l) * DM + 512 + g * 128 + ch * 8);
        bf16_t* d = BT + (ch * 8) * 136 + l;
        d[0] = (bf16_t)(v.x & 0xffff); d[136] = (bf16_t)(v.x >> 16); d[272] = (bf16_t)(v.y & 0xffff); d[408] = (bf16_t)(v.y >> 16);
        d[544] = (bf16_t)(v.z & 0xffff); d[680] = (bf16_t)(v.z >> 16); d[816] = (bf16_t)(v.w & 0xffff); d[952] = (bf16_t)(v.w >> 16);
    }
#pragma unroll
    for (int it = 0; it < 8; ++it) {
        const int id = tid + it * NT, l = id & 127, ch = id >> 7, j = ch >> 3;
        const uint4 v = *(const uint4*)(U + (size_t)(token0 + l) * DM + g * 256 + ch * 8);
        const float wv = dts[j * 128 + l];
        bf16_t* d = XWT + (ch * 8) * 136 + l;
        d[0] = f2bf(lo16(v.x) * wv); d[136] = f2bf(hi16(v.x) * wv); d[272] = f2bf(lo16(v.y) * wv); d[408] = f2bf(hi16(v.y) * wv);
        d[544] = f2bf(lo16(v.z) * wv); d[680] = f2bf(hi16(v.z) * wv); d[816] = f2bf(lo16(v.w) * wv); d[952] = f2bf(hi16(v.w) * wv);
    }
    __syncthreads();
    f32x4 acc[2][8];
#pragma unroll
    for (int qq = 0; qq < 2; ++qq)
#pragma unroll
        for (int nt = 0; nt < 8; ++nt) acc[qq][nt] = (f32x4){0.f, 0.f, 0.f, 0.f};
#pragma unroll
    for (int ks = 0; ks < 4; ++ks) {
        bf16x8 qf[2];
#pragma unroll
        for (int qq = 0; qq < 2; ++qq) qf[qq] = *(const bf16x8*)(XWT + (16 * (2 * w + qq) + fr) * 136 + ks * 32 + fq * 8);
#pragma unroll
        for (int nt = 0; nt < 8; ++nt) {
            const bf16x8 pf = *(const bf16x8*)(BT + (16 * nt + fr) * 136 + ks * 32 + fq * 8);
#pragma unroll
            for (int qq = 0; qq < 2; ++qq) acc[qq][nt] = MFMA16(pf, qf[qq], acc[qq][nt]);
        }
    }
#pragma unroll
    for (int qq = 0; qq < 2; ++qq) {
        const int rowjp = 16 * (2 * w + qq) + fr, j = rowjp >> 6, pp = rowjp & 63, h = g * 4 + j;
        float* dst = ST + ((size_t)(cb * 8 + h) * 64 + pp) * 128 + fq * 4;
#pragma unroll
        for (int nt = 0; nt < 8; ++nt) { float4 v; v.x = acc[qq][nt][0]; v.y = acc[qq][nt][1]; v.z = acc[qq][nt][2]; v.w = acc[qq][nt][3]; *(float4*)(dst + 16 * nt) = v; }
    }
}

__device__ void scan_phase(KP p, int L, float* ST, const float* DEC) {
    for (int e = blockIdx.x * NT + otid(); e < 131072; e += gridDim.x * NT) {
        const int idx = e * 2, n = idx & 127, pp = (idx >> 7) & 63, h = (idx >> 13) & 7, b = idx >> 16;
        float2 hr = {0.f, 0.f};
        float* base = ST + ((size_t)((b * 64) * 8 + h) * 64 + pp) * 128 + n;
        const float* dbase = DEC + (b * 64) * 8 + h;
#pragma unroll 1
        for (int c0 = 0; c0 < 64; c0 += 16) {
            float2 t[16]; float d[16];
#pragma unroll
            for (int j = 0; j < 16; ++j) { t[j] = *(const float2*)(base + (size_t)(c0 + j) * 65536); d[j] = dbase[(c0 + j) * 8]; }
#pragma unroll
            for (int j = 0; j < 16; ++j) { *(float2*)(base + (size_t)(c0 + j) * 65536) = hr; hr.x = d[j] * hr.x + t[j].x; hr.y = d[j] * hr.y + t[j].y; }
        }
        *(float2*)(p->out + O_SSMP + (((size_t)(L * 4 + b) * 8 + h) * 64 + pp) * 128 + n) = hr;
    }
}

__device__ void s3_item(KP p, int L, int item, const bf16_t* U, const bf16_t* PROJ, const float* DT, const float* ST, bf16_t* CAT) {
    SMEM_DECL;
    bf16_t* Cs = (bf16_t*)smem;
    bf16_t* Bs = (bf16_t*)(smem + 34816);
    bf16_t* XT = (bf16_t*)(smem + 69632);
    bf16_t* Hp = (bf16_t*)(smem + 87040);
    float* acs = (float*)(smem + 104448);
    float* dts = (float*)(smem + 106496);
    const int tid = otid(), lane = tid & 63, w = tid >> 6, fr = lane & 15, fq = lane >> 4;
    const int cb = item >> 1, g = item & 1, token0 = cb * 128;
    const int l = 16 * w + fr;
    const size_t token = (size_t)token0 + l;
    uint4 xt[2]; float4 hp[4]; uint4 xv[2], zv[2];
#define S3_LOAD(hh) do { \
        _Pragma("unroll") for (int it = 0; it < 2; ++it) { const int id = tid + it * NT, s_ = id & 127, ch = id >> 7; \
            xt[it] = *(const uint4*)(U + (size_t)(token0 + s_) * DM + (hh) * 64 + ch * 8); } \
        _Pragma("unroll") for (int it = 0; it < 4; ++it) { const int id = tid + it * NT, pp = id >> 5, c4 = id & 31; \
            hp[it] = *(const float4*)(ST + ((size_t)(cb * 8 + (hh)) * 64 + pp) * 128 + c4 * 4); } \
        _Pragma("unroll") for (int a2 = 0; a2 < 2; ++a2) { const int ch = (hh) * 64 + 32 * a2 + fq * 8; \
            xv[a2] = *(const uint4*)(U + token * DM + ch); zv[a2] = *(const uint4*)(PROJ + token * NPROJ + 1024 + ch); } } while (0)
    LDS_BARRIER();
    S3_LOAD(g * 4);
    ssd_acs(p, L, g, token0, DT, acs, dts);
#pragma unroll
    for (int it = 0; it < 4; ++it) {
        const int id = tid + it * NT, ll = id >> 4, ch = id & 15;
        *(uint4*)(Cs + ll * 136 + ch * 8) = *(const uint4*)(U + (size_t)(token0 + ll) * DM + 768 + g * 128 + ch * 8);
        *(uint4*)(Bs + ll * 136 + ch * 8) = *(const uint4*)(U + (size_t)(token0 + ll) * DM + 512 + g * 128 + ch * 8);
    }
    LDS_BARRIER();
    f32x4 cbv[8];
#pragma unroll
    for (int st = 0; st < 8; ++st) cbv[st] = (f32x4){0.f, 0.f, 0.f, 0.f};
#pragma unroll
    for (int ks = 0; ks < 4; ++ks) {
        const bf16x8 qf = *(const bf16x8*)(Cs + (16 * w + fr) * 136 + ks * 32 + fq * 8);
#pragma unroll
        for (int st = 0; st < 8; ++st)
            if (st <= w) { const bf16x8 pf = *(const bf16x8*)(Bs + (16 * st + fr) * 136 + ks * 32 + fq * 8); cbv[st] = MFMA16(pf, qf, cbv[st]); }
    }
    LDS_BARRIER();
    bf16_t* Mb = Bs;
    float ssq = 0.f;
#pragma unroll 1
    for (int j = 0; j < 4; ++j) {
        const int h = g * 4 + j;
#pragma unroll
        for (int it = 0; it < 2; ++it) {
            const int id = tid + it * NT, s_ = id & 127, ch = id >> 7; const uint4 v = xt[it];
            bf16_t* d = XT + (32 * (ch >> 2) + 4 * (ch & 3)) * 136 + s_;
            d[0] = (bf16_t)(v.x & 0xffff); d[136] = (bf16_t)(v.x >> 16); d[272] = (bf16_t)(v.y & 0xffff); d[408] = (bf16_t)(v.y >> 16);
            d[16 * 136] = (bf16_t)(v.z & 0xffff); d[17 * 136] = (bf16_t)(v.z >> 16); d[18 * 136] = (bf16_t)(v.w & 0xffff); d[19 * 136] = (bf16_t)(v.w >> 16);
        }
#pragma unroll
        for (int it = 0; it < 4; ++it) {
            const int id = tid + it * NT, pp = id >> 5, c4 = id & 31; const float4 v = hp[it];
            uint2 o; o.x = pk2(v.x, v.y); o.y = pk2(v.z, v.w);
            *(uint2*)(Hp + (32 * (pp >> 5) + 16 * ((pp >> 2) & 1) + 4 * ((pp >> 3) & 3) + (pp & 3)) * 136 + c4 * 4) = o;
        }
        uint4 xvc[2], zvc[2];
#pragma unroll
        for (int a2 = 0; a2 < 2; ++a2) { xvc[a2] = xv[a2]; zvc[a2] = zv[a2]; }
        if (j < 3) S3_LOAD(h + 1);
        const float al = acs[j * 128 + l];
#pragma unroll
        for (int st = 0; st < 8; ++st)
            if (st <= (w | 1)) {
                float mv[4];
#pragma unroll
                for (int jj = 0; jj < 4; ++jj) { const int s_ = 16 * st + fq * 4 + jj;
                    mv[jj] = (s_ <= l) ? cbv[st][jj] * __expf(al - acs[j * 128 + s_]) * dts[j * 128 + s_] : 0.f; }
                uint2 o; o.x = pk2(mv[0], mv[1]); o.y = pk2(mv[2], mv[3]);
                *(uint2*)(Mb + l * 136 + 16 * st + fq * 4) = o;
            }
        LDS_BARRIER();
        f32x4 yy[4];
#pragma unroll
        for (int pt = 0; pt < 4; ++pt) yy[pt] = (f32x4){0.f, 0.f, 0.f, 0.f};
#pragma unroll
        for (int ks = 0; ks < 4; ++ks) {
            const bf16x8 qf = *(const bf16x8*)(Cs + (16 * w + fr) * 136 + ks * 32 + fq * 8);
#pragma unroll
            for (int pt = 0; pt < 4; ++pt) { const bf16x8 pf = *(const bf16x8*)(Hp + (16 * pt + fr) * 136 + ks * 32 + fq * 8); yy[pt] = MFMA16(pf, qf, yy[pt]); }
        }
        const float ea = __expf(al);
#pragma unroll
        for (int pt = 0; pt < 4; ++pt) yy[pt] = yy[pt] * ea;
#pragma unroll
        for (int ks = 0; ks < 4; ++ks)
            if (2 * ks <= w) {
                const bf16x8 qf = *(const bf16x8*)(Mb + (16 * w + fr) * 136 + ks * 32 + fq * 8);
#pragma unroll
                for (int pt = 0; pt < 4; ++pt) { const bf16x8 pf = *(const bf16x8*)(XT + (16 * pt + fr) * 136 + ks * 32 + fq * 8); yy[pt] = MFMA16(pf, qf, yy[pt]); }
            }
        const float dsk = p->in[I_DSKIP][L * 8 + h];
#pragma unroll
        for (int a2 = 0; a2 < 2; ++a2) {
            const int ch = h * 64 + 32 * a2 + fq * 8;
            const uint4 xq = xvc[a2], zq = zvc[a2];
            const float xs[8] = {lo16(xq.x), hi16(xq.x), lo16(xq.y), hi16(xq.y), lo16(xq.z), hi16(xq.z), lo16(xq.w), hi16(xq.w)};
            const float zs[8] = {lo16(zq.x), hi16(zq.x), lo16(zq.y), hi16(zq.y), lo16(zq.z), hi16(zq.z), lo16(zq.w), hi16(zq.w)};
            float v[8];
#pragma unroll
            for (int e = 0; e < 8; ++e) { v[e] = (yy[2 * a2 + (e >> 2)][e & 3] + dsk * xs[e]) * silu(zs[e]); ssq += v[e] * v[e]; }
            uint4 o; o.x = pk2(v[0], v[1]); o.y = pk2(v[2], v[3]); o.z = pk2(v[4], v[5]); o.w = pk2(v[6], v[7]);
            *(uint4*)(CAT + token * DM + 512 + ch) = o;
        }
        LDS_BARRIER();
    }
#undef S3_LOAD
    asm volatile("s_waitcnt vmcnt(0)" ::: "memory");
    ssq += __shfl_xor(ssq, 16); ssq += __shfl_xor(ssq, 32);
    const float rstd = rsqrtf(ssq * (1.f / 256.f) + EPS);
    {
        uint4 vv[4][2];
#pragma unroll
        for (int j = 0; j < 4; ++j)
#pragma unroll
            for (int a2 = 0; a2 < 2; ++a2) vv[j][a2] = *(const uint4*)(CAT + token * DM + 512 + (g * 4 + j) * 64 + 32 * a2 + fq * 8);
#pragma unroll
        for (int j = 0; j < 4; ++j)
#pragma unroll
            for (int a2 = 0; a2 < 2; ++a2) {
                const int ch = (g * 4 + j) * 64 + 32 * a2 + fq * 8;
                const float4 n0 = *(const float4*)(p->in[I_SSMN] + L * 512 + ch), n1 = *(const float4*)(p->in[I_SSMN] + L * 512 + ch + 4);
                const uint4 v = vv[j][a2];
                uint4 o; o.x = pk2(lo16(v.x) * rstd * n0.x, hi16(v.x) * rstd * n0.y); o.y = pk2(lo16(v.y) * rstd * n0.z, hi16(v.y) * rstd * n0.w);
                o.z = pk2(lo16(v.z) * rstd * n1.x, hi16(v.z) * rstd * n1.y); o.w = pk2(lo16(v.w) * rstd * n1.z, hi16(v.w) * rstd * n1.w);
                *(uint4*)(CAT + token * DM + 512 + ch) = o;
            }
    }
}

__device__ void sample_attn_item(KP p, int L, int item, const bf16_t* PROJ, bf16_t* CAT) {
    SMEM_DECL;
    float* qs = (float*)smem; float* kn = qs + 64; float* vn = kn + 64; float* sc = vn + 64; float* red = sc + 512; float* part = red + 32;
    const int tid = otid(), lane = tid & 63, w = tid >> 6;
    const int n = item >> 2, h = item & 3;
    const size_t row = MP + n; const int ln = L * 32 + n;
    __syncthreads();
    if (tid < 64) { qs[tid] = bf2f(PROJ[row * NPROJ + 256 + h * 64 + tid]); kn[tid] = bf2f(PROJ[row * NPROJ + 512 + h * 64 + tid]); vn[tid] = bf2f(PROJ[row * NPROJ + 768 + h * 64 + tid]); }
    __syncthreads();
    const float* ck = p->in[I_CK] + (size_t)ln * 2048 * 256 + h * 64;
    const float* cv = p->in[I_CV] + (size_t)ln * 2048 * 256 + h * 64;
    float s = -INFINITY;
    if (tid < 387) {
        const int gg = tid / 129, j = tid % 129;
        s = 0.f;
        if (j == 0) { for (int d = 0; d < 64; ++d) s += qs[d] * kn[d]; }
        else { const float* kr = ck + (size_t)(2048 - (j << (2 * gg))) * 256;
#pragma unroll
            for (int d = 0; d < 64; d += 4) { const float4 kv = *(const float4*)(kr + d); s += qs[d] * kv.x + qs[d + 1] * kv.y + qs[d + 2] * kv.z + qs[d + 3] * kv.w; } }
    }
    const float wm = wave_max(s);
    if (lane == 0) red[w] = wm;
    __syncthreads();
    float mx = red[0];
#pragma unroll
    for (int i = 1; i < 8; ++i) mx = fmaxf(mx, red[i]);
    const float pv = (tid < 387) ? __expf(s - mx) : 0.f;
    sc[tid] = pv;
    const float wsum = wave_sum(pv);
    if (lane == 0) red[8 + w] = wsum;
    __syncthreads();
    float tot = 0.f;
#pragma unroll
    for (int i = 0; i < 8; ++i) tot += red[8 + i];
    {
        const int d = lane;
        float o = 0.f;
#pragma unroll 1
        for (int k0 = 0; k0 < 49; k0 += 7) {
            float vv[7], pp[7];
#pragma unroll
            for (int i = 0; i < 7; ++i) {
                const int e = w + 8 * (k0 + i);
                pp[i] = 0.f; vv[i] = 0.f;
                if (e < 387) { const int gg = e / 129, j = e % 129; pp[i] = sc[e];
                    vv[i] = (j == 0) ? vn[d] : cv[(size_t)(2048 - (j << (2 * gg))) * 256 + d]; }
            }
#pragma unroll
            for (int i = 0; i < 7; ++i) o += pp[i] * vv[i];
        }
        part[w * 64 + d] = o;
    }
    __syncthreads();
    if (tid < 64) {
        float o = 0.f;
#pragma unroll
        for (int i = 0; i < 8; ++i) o += part[i * 64 + tid];
        CAT[row * DM + 256 + h * 64 + tid] = f2bf(o / tot);
    }
}

__device__ void sample_ssd_item(KP p, int L, int n, const bf16_t* PROJ, const bf16_t* U, const float* DT, bf16_t* CAT) {
    SMEM_DECL;
    float* us = (float*)smem; float* zs = us + 1024; float* ys = zs + 512; float* red = ys + 512;
    const int tid = otid(), lane = tid & 63, w = tid >> 6;
    const size_t row = MP + n; const int ln = L * 32 + n;
    __syncthreads();
    for (int i = tid; i < 1024; i += NT) us[i] = bf2f(U[row * DM + i]);
    zs[tid] = bf2f(PROJ[row * NPROJ + 1024 + tid]);
    __syncthreads();
    {
        const int h = w, g = h >> 2;
        const float dt = DT[row * 8 + h], a = -__expf(p->in[I_ALOG][L * 8 + h]), dec = __expf(dt * a);
        const float B0 = us[512 + g * 128 + 2 * lane], B1 = us[512 + g * 128 + 2 * lane + 1], C0 = us[768 + g * 128 + 2 * lane], C1 = us[768 + g * 128 + 2 * lane + 1];
        const float* h0 = p->in[I_SSSM] + ((size_t)ln * 8 + h) * 64 * 128;
        float* hs = p->out + O_SSMS + ((size_t)ln * 8 + h) * 64 * 128;
#pragma unroll 1
        for (int r0 = 0; r0 < 64; r0 += 16) {
            float2 hv[16];
#pragma unroll
            for (int i = 0; i < 16; ++i) hv[i] = *(const float2*)(h0 + (r0 + i) * 128 + 2 * lane);
#pragma unroll
            for (int i = 0; i < 16; ++i) {
                const int rr = r0 + i;
                const float x = us[h * 64 + rr];
                float2 hn; hn.x = dec * hv[i].x + dt * x * B0; hn.y = dec * hv[i].y + dt * x * B1;
                *(float2*)(hs + rr * 128 + 2 * lane) = hn;
                const float part = wave_sum(hn.x * C0 + hn.y * C1);
                if (lane == 0) ys[h * 64 + rr] = part;
            }
        }
    }
    __syncthreads();
    {
        const int ch = tid, gch = ch >> 8;
        const float v = (ys[ch] + p->in[I_DSKIP][L * 8 + (ch >> 6)] * us[ch]) * silu(zs[ch]);
        const float part = wave_sum(v * v);
        if (lane == 0) red[w] = part;
        __syncthreads();
        const float tot = red[gch * 4] + red[gch * 4 + 1] + red[gch * 4 + 2] + red[gch * 4 + 3];
        const float rstd = rsqrtf(tot * (1.f / 256.f) + EPS);
        CAT[row * DM + 512 + ch] = f2bf(v * rstd * p->in[I_SSMN][L * 512 + ch]);
    }
}


#define XB_TMO      128
#define XB_XCNT(j)  (256  + 64 * (j))
#define XB_XSUB(j)  (1280 + 64 * (j))
#define XB_XGEN(j)  (2304 + 64 * (j))
#define XB_TOP      3328
#define XB_TOPGEN   3392
#define XCD_BAR_WORDS 3456
#define XB_SPIN_CAP (1u << 18)
__device__ __forceinline__ unsigned xb_ld(unsigned* p)              { return __hip_atomic_load(p, __ATOMIC_RELAXED, __HIP_MEMORY_SCOPE_AGENT); }
__device__ __forceinline__ unsigned xb_add(unsigned* p, unsigned v) { return __hip_atomic_fetch_add(p, v, __ATOMIC_RELAXED, __HIP_MEMORY_SCOPE_AGENT); }
__device__ __forceinline__ unsigned xb_xcc_id() { return (unsigned)__builtin_amdgcn_s_getreg((3 << 11) | 20) & 0xFu; }
#define XB_SPIN(cond, bar) do { unsigned _sp = 0; while (cond) { __builtin_amdgcn_s_sleep(1); \
    if ((++_sp & 255u) == 0u) { if (xb_ld(&(bar)[XB_TMO])) break; if (_sp > XB_SPIN_CAP) { atomicAdd(&(bar)[XB_TMO], 1u); break; } } } } while (0)
struct XcdBarrier { unsigned* bar; unsigned x; volatile LAS unsigned* st; };
__device__ __forceinline__ XcdBarrier xcd_barrier_post(unsigned* bar, volatile LAS unsigned* st) {
    XcdBarrier b; b.bar = bar; b.x = xb_xcc_id(); b.st = st;
    if (__builtin_amdgcn_workitem_id_x() == 0) (void)xb_add(&bar[XB_XCNT(b.x)], 1u);
    return b;
}
__device__ __forceinline__ void xcd_barrier_complete(unsigned* bar, unsigned x, unsigned& nloc, unsigned& nx) {
    const unsigned G = gridDim.x * gridDim.y * gridDim.z;
    unsigned sum, cnt, mine, sp = 0u;
    for (;;) {
        sum = 0u; cnt = 0u; mine = 0u;
#pragma unroll
        for (unsigned j = 0; j < 16; ++j) { const unsigned c = xb_ld(&bar[XB_XCNT(j)]); sum += c; cnt += (c > 0u) ? 1u : 0u; mine = (j == x) ? c : mine; }
        if (sum == G) break;
        __builtin_amdgcn_s_sleep(1);
        if ((++sp & 255u) == 0u) { if (xb_ld(&bar[XB_TMO])) break; if (sp > XB_SPIN_CAP) { atomicAdd(&bar[XB_TMO], 1u); break; } }
    }
    nloc = mine > 0u ? mine : 1u; nx = cnt > 0u ? cnt : 1u;
}
__device__ __forceinline__ void xcd_barrier(const XcdBarrier& b) {
    asm volatile("s_waitcnt vmcnt(0)" ::: "memory");
    __syncthreads();
    if (__builtin_amdgcn_workitem_id_x() == 0) {
        unsigned* bar = b.bar;
        __builtin_amdgcn_s_waitcnt(0);
        unsigned nloc = b.st[0], nx = b.st[1];
        if (nloc == 0u) { xcd_barrier_complete(bar, b.x, nloc, nx); b.st[0] = nloc; b.st[1] = nx; }
        const unsigned old = xb_add(&bar[XB_XSUB(b.x)], 1u);
        const unsigned gen = old / nloc;
        if (old + 1u == (gen + 1u) * nloc) {
            __builtin_amdgcn_fence(__ATOMIC_RELEASE, "agent");
            asm volatile("s_waitcnt vmcnt(0)" ::: "memory");
            const unsigned og = xb_add(&bar[XB_TOP], 1u);
            const unsigned tg = og / nx;
            if (og + 1u == (tg + 1u) * nx) xb_add(&bar[XB_TOPGEN], 1u);
            else XB_SPIN(xb_ld(&bar[XB_TOPGEN]) == tg, bar);
            __builtin_amdgcn_fence(__ATOMIC_ACQUIRE, "agent");
            xb_add(&bar[XB_XGEN(b.x)], 1u);
            asm volatile("s_waitcnt vmcnt(0)" ::: "memory");
        } else {
            XB_SPIN(xb_ld(&bar[XB_XGEN(b.x)]) == gen, bar);
            __builtin_amdgcn_fence(__ATOMIC_ACQUIRE, "agent");
            asm volatile("s_waitcnt vmcnt(0)" ::: "memory");
        }
    }
    __syncthreads();
}

#ifndef PHMASK
#define PHMASK 0xFFFFF
#endif
constexpr int PH_PER_LAYER = 9, NPHASE = 1 + 2 * PH_PER_LAYER + 1;

__global__ void __launch_bounds__(NT, 2) mega(Params pv, int ph_lo, int ph_hi) {
    cg::grid_group grid = cg::this_grid();
    XcdBarrier xb;
    {
        SMEM_DECL;
        volatile LAS unsigned* st = (volatile LAS unsigned*)((LAS unsigned char*)smem + 131072);
        if (__builtin_amdgcn_workitem_id_x() < 4) st[__builtin_amdgcn_workitem_id_x()] = 0u;
        __syncthreads();
        xb = xcd_barrier_post((unsigned*)(pv.ws + WS_BAR), st);
    }
    for (int ph = ph_lo; ph < ph_hi; ++ph) {
        if (ph == ph_lo + 1) grid.sync();
        else if (ph > ph_lo) xcd_barrier(xb);
        KP p = opaque_kp();
        unsigned char* ws = p->ws;
        bf16_t* XB = (bf16_t*)(ws + WS_XB); bf16_t* Ub = (bf16_t*)p->out;
        bf16_t* HB = (bf16_t*)(ws + WS_HB); bf16_t* PROJ = HB;
        bf16_t* CAT = (bf16_t*)(ws + WS_CAT);
        bf16_t* OG = (bf16_t*)(ws + WS_OG);
        float* LSE = (float*)(ws + WS_LSE);
        float* ST = (float*)(ws + WS_ST);
        float* DEC = (float*)(ws + WS_DEC);
        float* DT = (float*)(ws + WS_DT);
        float* X = p->out;
        float* PART = (float*)(ws + WS_PART);
        if (ph == 0) {
            weights_phase(p);
            cache_copy_phase(p);
            copy_phase(p, XB, PART);
            continue;
        }
        if (ph == NPHASE - 1) { final_phase(p, XB, X); continue; }
        const int L = (ph - 1) / PH_PER_LAYER, q = (ph - 1) % PH_PER_LAYER;
        unsigned char* wb = ws + (size_t)L * LAYER_W;
        const bf16_t* XBs = XB + (size_t)MP * DM; const bf16_t* Xs = XBs;
#ifndef REPMASK
#define REPMASK 0
#endif
        for (int rep = 0; rep < 1 + ((REPMASK >> q) & 1); ++rep)
        switch (q) {
        case 0: case 7: { EpiGU e{HB, PART}; const bf16_t* W = (const bf16_t*)(wb + (q == 0 ? OFF_WGU1 : OFF_WGU2)); gemm_phase_cont(XB, W, 1024, MP / 256, 22, e);
            for (int t = blockIdx.x; t < 176; t += gridDim.x) { const int c0 = t * 16, r0 = (c0 >> 7) * 256 + (c0 & 127); FinGU f{HB, c0}; skinny_task<2, true, 4>(XBs, DM, W, 1024, r0, r0 + 128, Xs, f); } } break;
        case 1: case 8: { EpiRes e{XB, PART, 0.5f}; const bf16_t* W = (const bf16_t*)(wb + (q == 1 ? OFF_WD1 : OFF_WD2)); gemm_phase_cont(HB, W, 2816, MP / 256, 4, e);
            for (int t = blockIdx.x; t < 64; t += gridDim.x) { FinRes f{XB, 0.5f, t * 16}; skinny_task<1, false, 11>(HB + (size_t)MP * DFF, DFF, W, 2816, t * 16, 0, nullptr, f); } } break;
        case 2: { EpiProj e{PROJ, NPROJ, PART}; const bf16_t* W = (const bf16_t*)(wb + OFF_WIN); gemm_phase_cont(XB, W, 1024, MP / 256, 10, e);
            for (int t = blockIdx.x; t < 160; t += gridDim.x) { FinProj f{PROJ, t * 16}; skinny_task<1, true, 4>(XBs, DM, W, 1024, t * 16, 0, Xs, f); } } break;
        case 3:
            prep_phase(p, L, PROJ, Ub, CAT, XB, PART, DT);
            for (int it = blockIdx.x; it < MS; it += gridDim.x) prep_sample_item(p, L, it, PROJ, Ub, CAT, XB, DT);
            {
                asm volatile("s_waitcnt vmcnt(0)" ::: "memory");
                __syncthreads();
                __builtin_amdgcn_fence(__ATOMIC_ACQUIRE, "agent");
                const int cpb = (256 + gridDim.x - 1) / gridDim.x;
                for (int cbk = blockIdx.x * cpb; cbk < 256 && cbk < (blockIdx.x + 1) * cpb; ++cbk) {
                    s1_item(p, L, cbk * 2, Ub, DT, ST, DEC);
                    s1_item(p, L, cbk * 2 + 1, Ub, DT, ST, DEC);
                }
            }
            break;
        case 4:
            {
                int it = blockIdx.x;
                for (; it < 160; it += gridDim.x) {
                    if (it < 128) sample_attn_item(p, L, it, PROJ, CAT);
                    else sample_ssd_item(p, L, it - 128, PROJ, Ub, DT, CAT);
                }
                attn_items(it - 160, gridDim.x, PROJ, OG, LSE);
            }
            scan_phase(p, L, ST, DEC);
            break;
        case 5:
            for (int it = blockIdx.x; it < 1024; it += gridDim.x) {
                if (it < 512) s3_item(p, L, it, Ub, PROJ, DT, ST, CAT);
                else combine_item(it - 512, OG, LSE, CAT);
            }
            break;
        case 6: { EpiRes e{XB, PART, 1.0f}; const bf16_t* W = (const bf16_t*)(wb + OFF_WOUT); gemm_phase_cont(CAT, W, 1024, MP / 256, 4, e);
            for (int t = blockIdx.x; t < 64; t += gridDim.x) { FinRes f{XB, 1.0f, t * 16}; skinny_task<1, false, 4>(CAT + (size_t)MP * DM, DM, W, 1024, t * 16, 0, nullptr, f); } } break;
        }
    }
}

constexpr int LDS_BYTES = 131072 + 64 + 4096 + 2048;

extern "C" void kernel_launch(void* const* d_in, const int* in_sizes, int n_in, void* d_out, int out_size, void* d_ws, size_t ws_size, hipStream_t stream) {
    static int grid = 0;
    if (grid == 0) {
        if (n_in != 27 || (size_t)out_size != O_END || ws_size < WS_END) {
            fprintf(stderr, "kernel_launch: unexpected shapes n_in %d out %d ws %zu (need %zu)\n", n_in, out_size, ws_size, (size_t)WS_END); grid = -1; return; }
        int dev = 0, cus = 0, per_cu = 0;
        hipGetDevice(&dev);
        hipDeviceGetAttribute(&cus, hipDeviceAttributeMultiprocessorCount, dev);
        if (hipFuncSetAttribute((const void*)mega, hipFuncAttributeMaxDynamicSharedMemorySize, LDS_BYTES) != hipSuccess) { fprintf(stderr, "hipFuncSetAttribute failed\n"); grid = -1; return; }
        hipOccupancyMaxActiveBlocksPerMultiprocessor(&per_cu, (const void*)mega, NT, LDS_BYTES);
        if (per_cu < 1) { fprintf(stderr, "occupancy query says %d blocks/CU\n", per_cu); per_cu = 1; }
        (void)hipGetLastError();
        grid = cus;
    }
    if (grid < 0) return;
    if (hipMemsetAsync((char*)d_ws + WS_BAR, 0, 16384, stream) != hipSuccess) { fprintf(stderr, "memset failed\n"); return; }
    Params p{};
    for (int i = 0; i < 27; ++i) p.in[i] = (const float*)d_in[i];
    p.out = (float*)d_out; p.ws = (unsigned char*)d_ws;
    int lo = 0, hi = NPHASE;
    void* args[] = {&p, &lo, &hi};
    hipError_t e = hipLaunchCooperativeKernel((const void*)mega, dim3(grid), dim3(NT), args, LDS_BYTES, stream);
    if (e != hipSuccess) fprintf(stderr, "cooperative launch failed: %s (grid %d)\n", hipGetErrorString(e), grid);
}
```

```cpp
#include <hip/hip_runtime.h>
#include <hip/hip_cooperative_groups.h>
#include <cstdio>
#include <cstdint>
namespace cg = cooperative_groups;

typedef unsigned short bf16_t;
typedef short bf16x8 __attribute__((ext_vector_type(8)));
typedef float f32x4 __attribute__((ext_vector_type(4)));

#define NT 512
constexpr int MP = 32768;
constexpr int MS = 32;
constexpr int MTOK = MP + MS;
constexpr int MPAD = 33024;
constexpr int DM = 1024, DFF = 2816, NPROJ = 2560, WINLD = 2568;
constexpr float EPS = 1e-6f;

constexpr size_t SZ_WGU = 5632ull * 1024 * 2, SZ_WD = 1024ull * 2816 * 2, SZ_WIN = 2560ull * 1024 * 2, SZ_WOUT = 1024ull * 1024 * 2;
constexpr size_t OFF_WGU1 = 0, OFF_WD1 = OFF_WGU1 + SZ_WGU, OFF_WIN = OFF_WD1 + SZ_WD, OFF_WOUT = OFF_WIN + SZ_WIN,
                 OFF_WGU2 = OFF_WOUT + SZ_WOUT, OFF_WD2 = OFF_WGU2 + SZ_WGU, LAYER_W = OFF_WD2 + SZ_WD;
constexpr size_t WS_XB = 2 * LAYER_W;
constexpr size_t WS_HB = WS_XB + (size_t)MPAD * 1024 * 2;
constexpr size_t WS_CAT = WS_HB + (size_t)MPAD * 2816 * 2;
constexpr size_t WS_OG = WS_CAT + (size_t)MPAD * 1024 * 2;
constexpr size_t WS_LSE = WS_OG + 3ull * MP * 256 * 2;
constexpr size_t WS_ST = WS_LSE + 3ull * MP * 4 * 4;
constexpr size_t WS_DEC = WS_ST + 256ull * 8 * 64 * 128 * 4;
constexpr size_t WS_DT = WS_DEC + 256 * 8 * 4;
constexpr size_t WS_PART = WS_DT + (size_t)MPAD * 8 * 4;
constexpr size_t WS_WDT = WS_PART + (size_t)MP * 16 * 4;
constexpr size_t WS_BAR = WS_WDT + 2 * 16 * 1024 * 2;
constexpr size_t WS_END = WS_BAR + 16384;

constexpr size_t O_Y = 0, O_POOLP = 33587200ull, O_POOLS = 33617920ull, O_KP = 33863680ull, O_KS = 38057984ull, O_VP = 71612416ull,
                 O_VS = 75806720ull, O_CONVP = 109361152ull, O_CONVS = 109385728ull, O_SSMP = 109582336ull, O_SSMS = 110106624ull,
                 O_END = 114300928ull;

struct Params { const float* in[27]; float* out; unsigned char* ws; };
enum { I_XP = 0, I_XS, I_CPOOL, I_CK, I_CV, I_SCONV, I_SSSM, I_F1N, I_F1G, I_F1U, I_F1D, I_MIXN, I_WIN, I_POOLW, I_POOLSC, I_CONVW, I_CONVB,
       I_DTB, I_ALOG, I_DSKIP, I_SSMN, I_WOUT, I_F2N, I_F2G, I_F2U, I_F2D, I_FINN };

typedef const __attribute__((address_space(4))) Params* KP;
__device__ __forceinline__ int otid() { int t = __builtin_amdgcn_workitem_id_x(); asm volatile("" : "+v"(t)); return t; }
__device__ __forceinline__ KP opaque_kp() { KP k = (KP)__builtin_amdgcn_kernarg_segment_ptr(); asm volatile("" : "+s"(k)); return k; }
__device__ __forceinline__ float bf2f(bf16_t v) { return __uint_as_float(((unsigned)v) << 16); }
__device__ __forceinline__ unsigned pk2(float lo, float hi) { unsigned r; asm("v_cvt_pk_bf16_f32 %0, %1, %2" : "=v"(r) : "v"(lo), "v"(hi)); return r; }
__device__ __forceinline__ bf16_t f2bf(float f) { return (bf16_t)(pk2(f, 0.f) & 0xffffu); }
__device__ __forceinline__ float lo16(unsigned u) { return __uint_as_float(u << 16); }
__device__ __forceinline__ float hi16(unsigned u) { return __uint_as_float(u & 0xffff0000u); }
__device__ __forceinline__ float silu(float x) { return x * __builtin_amdgcn_rcpf(1.f + __expf(-x)); }
__device__ __forceinline__ float wave_sum(float v) {
#pragma unroll
    for (int o = 32; o > 0; o >>= 1) v += __shfl_xor(v, o);
    return v;
}
__device__ __forceinline__ float wave_max(float v) {
#pragma unroll
    for (int o = 32; o > 0; o >>= 1) v = fmaxf(v, __shfl_xor(v, o));
    return v;
}
__device__ const float ROPE_INV[32] = {1.000000000e+00f, 7.498942018e-01f, 5.623413324e-01f, 4.216965139e-01f, 3.162277639e-01f, 2.371373773e-01f, 1.778279394e-01f, 1.333521456e-01f, 1.000000015e-01f, 7.498942316e-02f, 5.623413250e-02f, 4.216964915e-02f, 3.162277490e-02f, 2.371373773e-02f, 1.778279431e-02f, 1.333521400e-02f, 9.999999776e-03f, 7.498942316e-03f, 5.623413250e-03f, 4.216964822e-03f, 3.162277630e-03f, 2.371373819e-03f, 1.778279431e-03f, 1.333521446e-03f, 1.000000047e-03f, 7.498941850e-04f, 5.623413017e-04f, 4.216965172e-04f, 3.162277571e-04f, 2.371373703e-04f, 1.778279402e-04f, 1.333521504e-04f};
__device__ __forceinline__ float rope_inv(int i) { return ROPE_INV[i]; }
__device__ __forceinline__ void rope_cs(float ang, float& c, float& s) {
    const float k = rintf(ang * 0.15915494309189535f);
    float r = fmaf(-k, 6.28318548202514648f, ang); r = fmaf(-k, -1.74845553146951715e-07f, r);
    const float f = r * 0.15915494309189535f;
    s = __builtin_amdgcn_sinf(f); c = __builtin_amdgcn_cosf(f);
}
__device__ __forceinline__ uint4 zero4() { unsigned z; asm volatile("v_mov_b32 %0, 0" : "=v"(z)); uint4 r; r.x = z; r.y = z; r.z = z; r.w = z; return r; }
#define MFMA16(a, b, c) __builtin_amdgcn_mfma_f32_16x16x32_bf16((a), (b), (c), 0, 0, 0)
#define LDS_BARRIER() do { asm volatile("s_waitcnt lgkmcnt(0)" ::: "memory"); __builtin_amdgcn_s_barrier(); asm volatile("" ::: "memory"); } while (0)
#define SMEM_DECL extern __shared__ __attribute__((aligned(16))) unsigned char smem[]

constexpr int BM = 256, BK = 64, HALF = 128, HT = HALF * BK;
__device__ __forceinline__ int lds_byte(int r, int c) { int st = (r >> 4) * 2 + (c >> 5), rr = r & 15, cc = c & 31, ob = rr * 64 + cc * 2; return st * 1024 + (ob ^ (((ob >> 9) & 1) << 5)); }
__device__ __forceinline__ void stage_rc(int b, int& R, int& C) { int st = b / 1024, sb = b % 1024, swz = sb ^ (((sb >> 9) & 1) << 5); R = (st >> 1) * 16 + swz / 64; C = (st & 1) * 32 + (swz % 64) / 2; }

__device__ __forceinline__ void tile_of(int L, int nM, int nN, int& pm, int& pn) {
    const int nwg = nM * nN; int wgid = L;
    { const int q = nwg / 8, r = nwg % 8, xcd = wgid % 8, off = wgid / 8; wgid = (xcd < r ? xcd * (q + 1) : r * (q + 1) + (xcd - r) * q) + off; }
    const int nig = 8 * nN, gid = wgid / nig, fm = gid * 8, gsz = (nM - fm) < 8 ? (nM - fm) : 8;
    pm = fm + ((wgid % nig) % gsz); pn = (wgid % nig) / gsz;
}

#define LAS __attribute__((address_space(3)))
constexpr int HTB = HALF * BK * 2;
__device__ __forceinline__ float row_rstd(const float* PART, int row) {
    const float4* pp = (const float4*)(PART + (size_t)row * 16);
    const float4 a = pp[0], b = pp[1], c = pp[2], d = pp[3];
    const float ss = ((a.x + a.y) + (a.z + a.w)) + ((b.x + b.y) + (b.z + b.w)) + ((c.x + c.y) + (c.z + c.w)) + ((d.x + d.y) + (d.z + d.w));
    return rsqrtf(ss * (1.f / 1024.f) + EPS);
}
template <class Epi>
__device__ __forceinline__ void gemm_phase(const bf16_t* A, const bf16_t* Bt, const int K, const int nM, const int nN, const Epi& epi) {
    SMEM_DECL;
    LAS unsigned char* lds = (LAS unsigned char*)smem;
    const int tid = otid(), wid = __builtin_amdgcn_readfirstlane(tid >> 6), lane = tid & 63, wr = wid >> 2, wc = wid & 3, fr = lane & 15, fq = lane >> 4;
    const int nt = K / BK, ntiles = nM * nN;
    unsigned voff[2];
#pragma unroll
    for (int i = 0; i < 2; ++i) { int R, C; stage_rc(tid * 16 + i * 8192, R, C); voff[i] = (unsigned)(R * K + C) * 2u; }
    const size_t kstep = (size_t)(BK * 2), hstep = (size_t)HALF * K * 2;
    const unsigned ldsw = (unsigned)wid * 1024u;
    const int aoff = lds_byte(wr * 64 + fr, fq * 8), boff = lds_byte(wc * 32 + fr, fq * 8);
#define GSA(b, h) (((b) * 2 + (h)) * HTB)
#define GSB(b, h) ((4 + (b) * 2 + (h)) * HTB)
#define STAGE(bufoff, gbase) do { _Pragma("unroll") for (int _i = 0; _i < 2; ++_i) \
    __builtin_amdgcn_global_load_lds((const unsigned*)((const char*)(gbase) + voff[_i]), (LAS unsigned*)(lds + (bufoff) + ldsw + _i * 8192), 16, 0, 0); } while (0)
#define LDA(dst, b, h) do { _Pragma("unroll") for (int m = 0; m < 4; ++m) _Pragma("unroll") for (int k = 0; k < 2; ++k) dst[m][k] = *(const LAS bf16x8*)(lds + GSA(b, h) + aoff + m * 2048 + k * 1024); } while (0)
#define LDB(dst, b, h) do { _Pragma("unroll") for (int n = 0; n < 2; ++n) _Pragma("unroll") for (int k = 0; k < 2; ++k) dst[n][k] = *(const LAS bf16x8*)(lds + GSB(b, h) + boff + n * 2048 + k * 1024); } while (0)
#define MMA(ai, bj, At_, Bt_) do { __builtin_amdgcn_s_setprio(1); _Pragma("unroll") for (int m = 0; m < 4; ++m) _Pragma("unroll") for (int n = 0; n < 2; ++n) _Pragma("unroll") for (int k = 0; k < 2; ++k) \
      acc[ai][bj][m][n] = __builtin_amdgcn_mfma_f32_16x16x32_bf16(Bt_[n][k], At_[m][k], acc[ai][bj][m][n], 0, 0, 0); \
    __builtin_amdgcn_s_setprio(0); } while (0)
#define WAIT_V(n) asm volatile("s_waitcnt vmcnt(" #n ")" ::: "memory")
#define WAIT_L(n) asm volatile("s_waitcnt lgkmcnt(" #n ")" ::: "memory")
#define BAR __builtin_amdgcn_s_barrier()
#define SCHED __builtin_amdgcn_sched_barrier(0)
    int L = blockIdx.x;
    WAIT_V(0); __syncthreads();
    if (L >= ntiles) return;
    int pm, pn; tile_of(L, nM, nN, pm, pn);
    const char* cA = (const char*)A + (size_t)(pm * 256) * K * 2;
    const char* cB = (const char*)Bt + (size_t)(pn * 256) * K * 2;
    STAGE(GSB(0, 0), cB); STAGE(GSA(0, 0), cA); STAGE(GSB(0, 1), cB + hstep); STAGE(GSA(0, 1), cA + hstep);
    float* rsb = (float*)(smem + 131072 + 64 + 4096);
    int rbuf = 0;
    if (Epi::NEEDS_RS && tid < 256) rsb[tid] = row_rstd(epi.PART, pm * 256 + tid);
    bool first = true;
    for (;;) {
        f32x4 acc[2][2][4][2];
#pragma unroll
        for (int a = 0; a < 2; ++a)
#pragma unroll
            for (int b = 0; b < 2; ++b)
#pragma unroll
                for (int m = 0; m < 4; ++m)
#pragma unroll
                    for (int n = 0; n < 2; ++n) acc[a][b][m][n] = (f32x4){0.f, 0.f, 0.f, 0.f};
        bf16x8 At[4][2], B0[2][2], B1[2][2];
        if (wr == 1) BAR;
        if (first) { WAIT_V(4); } else { asm volatile("s_waitcnt vmcnt(%0)" :: "n"(Epi::NST) : "memory"); }
        BAR;
        STAGE(GSB(1, 0), cB + kstep); STAGE(GSA(1, 0), cA + kstep); STAGE(GSB(1, 1), cB + hstep + kstep);
        WAIT_V(6); BAR;
        for (int t = 0; t < nt - 2; t += 2) {
            const char* a1 = cA + (size_t)(t + 1) * kstep; const char* a2 = a1 + kstep; const char* a3 = a2 + kstep;
            const char* b2 = cB + (size_t)(t + 2) * kstep; const char* b3 = b2 + kstep;
            LDB(B0, 0, 0); SCHED; LDA(At, 0, 0); STAGE(GSA(1, 1), a1 + hstep);
            WAIT_L(8); BAR; WAIT_L(0); MMA(0, 0, At, B0); BAR; SCHED;
            LDB(B1, 0, 1); STAGE(GSB(0, 0), b2);
            BAR; WAIT_L(0); MMA(0, 1, At, B1); BAR;
            LDA(At, 0, 1); STAGE(GSA(0, 0), a2);
            BAR; WAIT_L(0); MMA(1, 0, At, B0); BAR; SCHED;
            STAGE(GSB(0, 1), b2 + hstep);
            WAIT_V(6); BAR; MMA(1, 1, At, B1); BAR;
            LDB(B0, 1, 0); SCHED; LDA(At, 1, 0); STAGE(GSA(0, 1), a2 + hstep);
            WAIT_L(8); BAR; WAIT_L(0); MMA(0, 0, At, B0); BAR; SCHED;
            LDB(B1, 1, 1); STAGE(GSB(1, 0), b3);
            BAR; WAIT_L(0); MMA(0, 1, At, B1); BAR;
            LDA(At, 1, 1); STAGE(GSA(1, 0), a3);
            BAR; WAIT_L(0); MMA(1, 0, At, B0); BAR; SCHED;
            STAGE(GSB(1, 1), b3 + hstep);
            WAIT_V(6); BAR; MMA(1, 1, At, B1); BAR;
        }
        { LDB(B0, 0, 0); LDA(At, 0, 0); STAGE(GSA(1, 1), cA + (size_t)(nt - 1) * kstep + hstep);
          BAR; WAIT_L(0); MMA(0, 0, At, B0); BAR;
          LDB(B1, 0, 1); BAR; WAIT_L(0); MMA(0, 1, At, B1); BAR;
          LDA(At, 0, 1); WAIT_V(4); BAR; WAIT_L(0); MMA(1, 0, At, B0); MMA(1, 1, At, B1); BAR; }
        { LDB(B0, 1, 0); LDA(At, 1, 0); WAIT_V(2); BAR; WAIT_L(0); MMA(0, 0, At, B0); BAR;
          LDB(B1, 1, 1); WAIT_V(0); BAR; WAIT_L(0); MMA(0, 1, At, B1); BAR;
          LDA(At, 1, 1); BAR; WAIT_L(0); MMA(1, 0, At, B0); MMA(1, 1, At, B1); BAR; }
        if (wr == 0) BAR;
        const int brow = pm * 256, bcol = pn * 256;
        L += gridDim.x;
        const bool more = L < ntiles;
        if (more) {
            tile_of(L, nM, nN, pm, pn);
            cA = (const char*)A + (size_t)(pm * 256) * K * 2; cB = (const char*)Bt + (size_t)(pn * 256) * K * 2;
            STAGE(GSB(0, 0), cB); STAGE(GSA(0, 0), cA); STAGE(GSB(0, 1), cB + hstep); STAGE(GSA(0, 1), cA + hstep);
            SCHED;
        }
        float rs_next = 0.f;
        if (Epi::NEEDS_RS && more && tid < 256) rs_next = row_rstd(epi.PART, pm * 256 + tid);
        epi(acc, brow, bcol, wr, wc, fr, fq, rsb + rbuf * 256);
        SCHED;
        if (!more) break;
        if (Epi::NEEDS_RS && tid < 256) rsb[(rbuf ^ 1) * 256 + tid] = rs_next;
        rbuf ^= 1;
        first = false;
    }
    asm volatile("s_waitcnt vmcnt(0)" ::: "memory");
    __syncthreads();
}

template <class Epi>
__device__ __forceinline__ void gemm_phase_cont(const bf16_t* A, const bf16_t* Bt, const int K, const int nM, const int nN, const Epi& epi) {
    SMEM_DECL;
    LAS unsigned char* lds = (LAS unsigned char*)smem;
    const int tid = otid(), wid = __builtin_amdgcn_readfirstlane(tid >> 6), lane = tid & 63, wr = wid >> 2, wc = wid & 3, fr = lane & 15, fq = lane >> 4;
    const int nt = K / BK, ntiles = nM * nN;
    unsigned voff[2];
#pragma unroll
    for (int i = 0; i < 2; ++i) { int R, C; stage_rc(tid * 16 + i * 8192, R, C); voff[i] = (unsigned)(R * K + C) * 2u; }
    const size_t kstep = (size_t)(BK * 2), hstep = (size_t)HALF * K * 2;
    const unsigned ldsw = (unsigned)wid * 1024u;
    const int aoff = lds_byte(wr * 64 + fr, fq * 8), boff = lds_byte(wc * 32 + fr, fq * 8);
    int L = blockIdx.x;
    WAIT_V(0); __syncthreads();
    if (L >= ntiles) return;
    int pm, pn; tile_of(L, nM, nN, pm, pn);
    const char* cA = (const char*)A + (size_t)(pm * 256) * K * 2;
    const char* cB = (const char*)Bt + (size_t)(pn * 256) * K * 2;
    f32x4 acc[2][2][4][2];
#pragma unroll
    for (int a = 0; a < 2; ++a)
#pragma unroll
        for (int b = 0; b < 2; ++b)
#pragma unroll
            for (int m = 0; m < 4; ++m)
#pragma unroll
                for (int n = 0; n < 2; ++n) acc[a][b][m][n] = (f32x4){0.f, 0.f, 0.f, 0.f};
    bf16x8 At[4][2], B0[2][2], B1[2][2];
    float* rsb = (float*)(smem + 131072 + 64 + 4096);
    int rbuf = 0;
    float rs0 = 0.f;
    if (Epi::NEEDS_RS && tid < 256) rs0 = row_rstd(epi.PART, pm * 256 + tid);
    STAGE(GSB(0, 0), cB); STAGE(GSB(0, 1), cB + hstep); STAGE(GSA(0, 0), cA); STAGE(GSA(0, 1), cA + hstep);
    if (wr == 1) BAR;
    WAIT_V(2); BAR;
    STAGE(GSB(1, 0), cB + kstep); STAGE(GSA(1, 0), cA + kstep); STAGE(GSB(1, 1), cB + hstep + kstep);
    WAIT_V(6); BAR;
    if (Epi::NEEDS_RS && tid < 256) rsb[tid] = rs0;
    for (;;) {
        const int Ln = L + gridDim.x; const bool has_next = Ln < ntiles;
        int npm = pm, npn = pn; if (has_next) tile_of(Ln, nM, nN, npm, npn);
        const char* nA = (const char*)A + (size_t)(npm * 256) * K * 2; const char* nB = (const char*)Bt + (size_t)(npn * 256) * K * 2;
        for (int t = 0; t < nt; t += 2) {
            const bool last = (t == nt - 2);
            const char* a1 = cA + (size_t)(t + 1) * kstep;
            const char* a2 = last ? nA : cA + (size_t)(t + 2) * kstep; const char* b2 = last ? nB : cB + (size_t)(t + 2) * kstep;
            const char* a3 = a2 + kstep; const char* b3 = b2 + kstep;
            LDB(B0, 0, 0); LDB(B1, 0, 1); SCHED; LDA(At, 0, 0); STAGE(GSA(1, 1), a1 + hstep);
            WAIT_V(8); WAIT_L(0); BAR; MMA(0, 0, At, B0); MMA(0, 1, At, B1); BAR; SCHED;
            LDA(At, 0, 1); STAGE(GSB(0, 0), b2); STAGE(GSB(0, 1), b2 + hstep); STAGE(GSA(0, 0), a2);
            WAIT_V(8); WAIT_L(0); BAR; MMA(1, 0, At, B0); MMA(1, 1, At, B1); BAR; SCHED;
            LDB(B0, 1, 0); LDB(B1, 1, 1); SCHED; LDA(At, 1, 0); STAGE(GSA(0, 1), a2 + hstep);
            WAIT_V(8); WAIT_L(0); BAR; MMA(0, 0, At, B0); MMA(0, 1, At, B1); BAR; SCHED;
            LDA(At, 1, 1); STAGE(GSB(1, 0), b3); STAGE(GSB(1, 1), b3 + hstep); STAGE(GSA(1, 0), a3);
            WAIT_V(8); WAIT_L(0); BAR; MMA(1, 0, At, B0); MMA(1, 1, At, B1); BAR; SCHED;
        }
        if (wr == 0) BAR;
        float rs_next = 0.f;
        if (Epi::NEEDS_RS && has_next && tid < 256) rs_next = row_rstd(epi.PART, npm * 256 + tid);
        epi(acc, pm * 256, pn * 256, wr, wc, fr, fq, rsb + rbuf * 256);
        SCHED;
        if (!has_next) break;
        if (Epi::NEEDS_RS && tid < 256) rsb[(rbuf ^ 1) * 256 + tid] = rs_next;
        rbuf ^= 1;
#pragma unroll
        for (int a = 0; a < 2; ++a)
#pragma unroll
            for (int b = 0; b < 2; ++b)
#pragma unroll
                for (int m = 0; m < 4; ++m)
#pragma unroll
                    for (int n = 0; n < 2; ++n) acc[a][b][m][n] = (f32x4){0.f, 0.f, 0.f, 0.f};
        L = Ln; pm = npm; pn = npn; cA = nA; cB = nB;
        if (wr == 1) BAR;
    }
    WAIT_V(0);
    BAR;
    __syncthreads();
}

struct EpiGU {
    static constexpr int NST = 16; static constexpr bool NEEDS_RS = true;
    bf16_t* __restrict__ H; const float* __restrict__ PART;
    __device__ __forceinline__ void operator()(const f32x4 (&acc)[2][2][4][2], int brow, int bcol, int wr, int wc, int fr, int fq, const float* rsl) const {
        const int cbase = (bcol >> 8) * 128 + wc * 32 + fq * 8;
        float rs[2][4];
#pragma unroll
        for (int ai = 0; ai < 2; ++ai)
#pragma unroll
            for (int m = 0; m < 4; ++m) rs[ai][m] = rsl[ai * 128 + wr * 64 + m * 16 + fr];
#pragma unroll
        for (int ai = 0; ai < 2; ++ai)
#pragma unroll
            for (int m = 0; m < 4; ++m) {
                const int row = brow + ai * 128 + wr * 64 + m * 16 + fr;
                const f32x4 g0 = acc[ai][0][m][0] * rs[ai][m], u0 = acc[ai][1][m][0] * rs[ai][m], g1 = acc[ai][0][m][1] * rs[ai][m], u1 = acc[ai][1][m][1] * rs[ai][m];
                uint4 o; o.x = pk2(silu(g0[0]) * u0[0], silu(g0[1]) * u0[1]); o.y = pk2(silu(g0[2]) * u0[2], silu(g0[3]) * u0[3]);
                o.z = pk2(silu(g1[0]) * u1[0], silu(g1[1]) * u1[1]); o.w = pk2(silu(g1[2]) * u1[2], silu(g1[3]) * u1[3]);
                *(uint4*)(H + (size_t)row * DFF + cbase) = o;
            }
    }
};
struct EpiRes {
    static constexpr int NST = 16; static constexpr bool NEEDS_RS = false;
    bf16_t* XB; float* PART; float scale;
    __device__ __forceinline__ void operator()(const f32x4 (&acc)[2][2][4][2], int brow, int bcol, int wr, int wc, int fr, int fq, const float*) const {
        uint4 v[2][4][2];
#pragma unroll
        for (int ai = 0; ai < 2; ++ai)
#pragma unroll
            for (int m = 0; m < 4; ++m)
#pragma unroll
                for (int bj = 0; bj < 2; ++bj)
                    v[ai][m][bj] = *(const uint4*)(XB + (size_t)(brow + ai * 128 + wr * 64 + m * 16 + fr) * DM + bcol + bj * 128 + wc * 32 + fq * 8);
#pragma unroll
        for (int ai = 0; ai < 2; ++ai)
#pragma unroll
            for (int m = 0; m < 4; ++m) {
                const int row = brow + ai * 128 + wr * 64 + m * 16 + fr;
                float ss = 0.f;
#pragma unroll
                for (int bj = 0; bj < 2; ++bj) {
                    const uint4 xv = v[ai][m][bj]; const f32x4 a0 = acc[ai][bj][m][0], a1 = acc[ai][bj][m][1];
                    uint4 o; o.x = pk2(lo16(xv.x) + scale * a0[0], hi16(xv.x) + scale * a0[1]); o.y = pk2(lo16(xv.y) + scale * a0[2], hi16(xv.y) + scale * a0[3]);
                    o.z = pk2(lo16(xv.z) + scale * a1[0], hi16(xv.z) + scale * a1[1]); o.w = pk2(lo16(xv.w) + scale * a1[2], hi16(xv.w) + scale * a1[3]);
                    *(uint4*)(XB + (size_t)row * DM + bcol + bj * 128 + wc * 32 + fq * 8) = o;
                    const float r0 = lo16(o.x), r1 = hi16(o.x), r2 = lo16(o.y), r3 = hi16(o.y), r4 = lo16(o.z), r5 = hi16(o.z), r6 = lo16(o.w), r7 = hi16(o.w);
                    ss += (r0 * r0 + r1 * r1) + (r2 * r2 + r3 * r3) + (r4 * r4 + r5 * r5) + (r6 * r6 + r7 * r7);
                }
                ss += __shfl_xor(ss, 16); ss += __shfl_xor(ss, 32);
                if (fq == 0) PART[(size_t)row * 16 + (bcol >> 8) * 4 + wc] = ss;
            }
    }
};
struct EpiProj {
    static constexpr int NST = 32; static constexpr bool NEEDS_RS = true;
    bf16_t* __restrict__ P; int ld; const float* __restrict__ PART;
    __device__ __forceinline__ void operator()(const f32x4 (&acc)[2][2][4][2], int brow, int bcol, int wr, int wc, int fr, int fq, const float* rsl) const {
        float rs[2][4];
#pragma unroll
        for (int ai = 0; ai < 2; ++ai)
#pragma unroll
            for (int m = 0; m < 4; ++m) rs[ai][m] = rsl[ai * 128 + wr * 64 + m * 16 + fr];
#pragma unroll
        for (int ai = 0; ai < 2; ++ai)
#pragma unroll
            for (int m = 0; m < 4; ++m) {
                const int row = brow + ai * 128 + wr * 64 + m * 16 + fr;
#pragma unroll
                for (int bj = 0; bj < 2; ++bj) {
                    const f32x4 a0 = acc[ai][bj][m][0] * rs[ai][m], a1 = acc[ai][bj][m][1] * rs[ai][m];
                    uint4 o; o.x = pk2(a0[0], a0[1]); o.y = pk2(a0[2], a0[3]); o.z = pk2(a1[0], a1[1]); o.w = pk2(a1[2], a1[3]);
                    *(uint4*)(P + (size_t)row * ld + bcol + bj * 128 + wc * 32 + fq * 8) = o;
                }
            }
    }
};

template <int NB, bool RS, int NKS, class Fin>
__device__ __forceinline__ void skinny_task(const bf16_t* __restrict__ A, int lda, const bf16_t* __restrict__ Bt, int K, int brow0, int brow1, const bf16_t* Xs, const Fin& fin) {
    SMEM_DECL;
    float* red = (float*)smem;
    float* rsd = red + 8 * NB * 2 * 64 * 4;
    const int tid = otid(), lane = tid & 63, w = __builtin_amdgcn_readfirstlane(tid >> 6), fr = lane & 15, fq = lane >> 4;
    const int kw = K >> 3;
    f32x4 acc[NB][2];
#pragma unroll
    for (int nb = 0; nb < NB; ++nb) { acc[nb][0] = (f32x4){0.f, 0.f, 0.f, 0.f}; acc[nb][1] = (f32x4){0.f, 0.f, 0.f, 0.f}; }
    __syncthreads();
    float rsv[4];
    if (RS) {
#pragma unroll
        for (int rr = 0; rr < 4; ++rr) {
            const bf16_t* xr = Xs + (size_t)(w * 4 + rr) * DM;
            float ss = 0.f;
#pragma unroll
            for (int i = 0; i < 2; ++i) { const uint4 v = *(const uint4*)(xr + i * 512 + lane * 8);
                ss += lo16(v.x) * lo16(v.x) + hi16(v.x) * hi16(v.x) + lo16(v.y) * lo16(v.y) + hi16(v.y) * hi16(v.y) + lo16(v.z) * lo16(v.z) + hi16(v.z) * hi16(v.z) + lo16(v.w) * lo16(v.w) + hi16(v.w) * hi16(v.w); }
            rsv[rr] = ss;
        }
    }
    {
        bf16x8 a0[NKS], a1[NKS], b0[NKS], b1[NKS];
#pragma unroll
        for (int ks = 0; ks < NKS; ++ks) {
            const int k0 = w * kw + ks * 32 + fq * 8;
            a0[ks] = *(const bf16x8*)(A + (size_t)fr * lda + k0); a1[ks] = *(const bf16x8*)(A + (size_t)(16 + fr) * lda + k0);
            b0[ks] = *(const bf16x8*)(Bt + (size_t)(brow0 + fr) * K + k0);
            if (NB == 2) b1[ks] = *(const bf16x8*)(Bt + (size_t)(brow1 + fr) * K + k0);
        }
#pragma unroll
        for (int ks = 0; ks < NKS; ++ks) {
            acc[0][0] = MFMA16(b0[ks], a0[ks], acc[0][0]); acc[0][1] = MFMA16(b0[ks], a1[ks], acc[0][1]);
            if (NB == 2) { acc[NB - 1][0] = MFMA16(b1[ks], a0[ks], acc[NB - 1][0]); acc[NB - 1][1] = MFMA16(b1[ks], a1[ks], acc[NB - 1][1]); }
        }
    }
    if (RS) {
#pragma unroll
        for (int rr = 0; rr < 4; ++rr) { const float ss = wave_sum(rsv[rr]); if (lane == 0) rsd[w * 4 + rr] = rsqrtf(ss * (1.f / 1024.f) + EPS); }
    }
#pragma unroll
    for (int nb = 0; nb < NB; ++nb)
#pragma unroll
        for (int mt = 0; mt < 2; ++mt) { float4 v; v.x = acc[nb][mt][0]; v.y = acc[nb][mt][1]; v.z = acc[nb][mt][2]; v.w = acc[nb][mt][3];
            *(float4*)(red + (((w * NB + nb) * 2 + mt) * 64 + lane) * 4) = v; }
    __syncthreads();
    {
        const int mt = tid >> 8, ln = (tid >> 2) & 63, jj = tid & 3;
        float v0 = 0.f, v1 = 0.f;
#pragma unroll
        for (int ww = 0; ww < 8; ++ww) {
            v0 += red[(((ww * NB + 0) * 2 + mt) * 64 + ln) * 4 + jj];
            if (NB == 2) v1 += red[(((ww * NB + NB - 1) * 2 + mt) * 64 + ln) * 4 + jj];
        }
        const float rs = RS ? rsd[mt * 16 + (ln & 15)] : 1.f;
        fin(mt * 16 + (ln & 15), (ln >> 4) * 4 + jj, v0 * rs, v1 * rs);
    }
}

struct FinGU { bf16_t* H; int c0; __device__ __forceinline__ void operator()(int m, int j, float g, float u) const { const int col = (c0 & ~31) + 8 * (j >> 2) + 4 * ((c0 >> 4) & 1) + (j & 3); H[(size_t)(MP + m) * DFF + col] = f2bf(silu(g) * u); } };
struct FinRes { bf16_t* XB; float scale; int c0; __device__ __forceinline__ void operator()(int m, int j, float v, float) const { const size_t o = (size_t)(MP + m) * DM + (c0 & ~31) + 8 * (j >> 2) + 4 * ((c0 >> 4) & 1) + (j & 3); XB[o] = f2bf(bf2f(XB[o]) + scale * v); } };
struct FinProj { bf16_t* P; int c0; __device__ __forceinline__ void operator()(int m, int j, float v, float) const { const int col = (c0 & ~31) + 8 * (j >> 2) + 4 * ((c0 >> 4) & 1) + (j & 3); P[(size_t)(MP + m) * NPROJ + col] = f2bf(v); } };

__device__ __forceinline__ void transpose_tile(const float* __restrict__ src, int ldn, int K, int k0, int c0, bf16_t* __restrict__ dst, int drow0, const float* __restrict__ gk, bool perm) {
    SMEM_DECL;
    float* tile = (float*)smem;
    const int tid = otid();
    __syncthreads();
#pragma unroll
    for (int r = 0; r < 32; ++r) { const int k = r * 8 + (tid >> 6), n = tid & 63;
        tile[k * 65 + n] = src[(size_t)(k0 + k) * ldn + c0 + n] * (gk ? gk[k0 + k] : 1.f); }
    __syncthreads();
#pragma unroll
    for (int r = 0; r < 16; ++r) { const int id = tid + r * 512, n = id >> 7, kp = id & 127;
        const int c32 = n & 31, nd = perm ? (n & ~31) + 16 * ((c32 >> 2) & 1) + 4 * (c32 >> 3) + (c32 & 3) : n;
        *(unsigned*)(dst + (size_t)(drow0 + nd) * K + k0 + 2 * kp) = pk2(tile[(2 * kp) * 65 + n], tile[(2 * kp + 1) * 65 + n]); }
}

__device__ void weights_phase(KP p) {
    for (int it = blockIdx.x; it < 2 * 1280; it += gridDim.x) {
        const int L = it / 1280; int r = it % 1280;
        unsigned char* wb = p->ws + (size_t)L * LAYER_W;
        if (r < 528 || r >= 752) {
            const bool second = r >= 752; if (second) r -= 752;
            const float* G = (second ? p->in[I_F2G] : p->in[I_F1G]) + (size_t)L * 1024 * 2816;
            const float* U = (second ? p->in[I_F2U] : p->in[I_F1U]) + (size_t)L * 1024 * 2816;
            const float* D = (second ? p->in[I_F2D] : p->in[I_F1D]) + (size_t)L * 2816 * 1024;
            bf16_t* wgu = (bf16_t*)(wb + (second ? OFF_WGU2 : OFF_WGU1));
            bf16_t* wd = (bf16_t*)(wb + (second ? OFF_WD2 : OFF_WD1));
            if (r < 352) { const bool up = r >= 176; if (up) r -= 176; const int kt = r / 44, nt = r % 44, c0 = nt * 64;
                transpose_tile(up ? U : G, 2816, 1024, kt * 256, c0, wgu, (c0 >> 7) * 256 + (c0 & 127) + (up ? 128 : 0), (second ? p->in[I_F2N] : p->in[I_F1N]) + L * 1024, true); }
            else { r -= 352; const int kt = r / 16, nt = r % 16; transpose_tile(D, 1024, 2816, kt * 256, nt * 64, wd, nt * 64, nullptr, true); }
        } else if (r < 688) { r -= 528; const int kt = r / 40, nt = r % 40;
            transpose_tile(p->in[I_WIN] + (size_t)L * 1024 * WINLD, WINLD, 1024, kt * 256, nt * 64, (bf16_t*)(wb + OFF_WIN), nt * 64, p->in[I_MIXN] + L * 1024, true);
        } else { r -= 688; const int kt = r / 16, nt = r % 16;
            transpose_tile(p->in[I_WOUT] + (size_t)L * 1024 * 1024, 1024, 1024, kt * 256, nt * 64, (bf16_t*)(wb + OFF_WOUT), nt * 64, nullptr, true); }
    }
    for (int it = blockIdx.x; it < 2; it += gridDim.x) {
        const int L = it; bf16_t* wdt = (bf16_t*)(p->ws + WS_WDT) + (size_t)L * 16 * 1024;
        for (int e = otid(); e < 16 * 1024; e += NT) { const int h = e >> 10, k = e & 1023;
            wdt[e] = h < 8 ? f2bf(p->in[I_WIN][((size_t)L * 1024 + k) * WINLD + 2560 + h] * p->in[I_MIXN][L * 1024 + k]) : (bf16_t)0; }
    }
    __syncthreads();
}

__device__ void cache_copy_phase(KP p) {
    constexpr unsigned per = 2047u * 256u / 4u;
    constexpr unsigned total = 128u * per;
    const unsigned stride = gridDim.x * NT;
    const float* ck = p->in[I_CK]; const float* cv = p->in[I_CV]; float* out = p->out;
#define CC_IDX(j) unsigned i##j = ib + (j) * stride; i##j = i##j < total ? i##j : total - 1u; \
    const unsigned seg##j = i##j / per, e##j = i##j % per, kv##j = seg##j >> 6, ln##j = seg##j & 63u; \
    const float4* s##j = (const float4*)((kv##j ? cv : ck) + (size_t)ln##j * 2048 * 256 + 256) + e##j; \
    float4* d##j = (float4*)(out + (kv##j ? O_VS : O_KS) + (size_t)ln##j * 2048 * 256) + e##j;
    for (unsigned ib = blockIdx.x * NT + otid(); ib < total; ib += 8u * stride) {
        CC_IDX(0) CC_IDX(1) CC_IDX(2) CC_IDX(3) CC_IDX(4) CC_IDX(5) CC_IDX(6) CC_IDX(7)
        const float4 v0 = *s0, v1 = *s1, v2 = *s2, v3 = *s3, v4 = *s4, v5 = *s5, v6 = *s6, v7 = *s7;
        *d0 = v0; *d1 = v1; *d2 = v2; *d3 = v3; *d4 = v4; *d5 = v5; *d6 = v6; *d7 = v7;
    }
#undef CC_IDX
}

__device__ void copy_phase(KP p, bf16_t* XB, float* PART) {
    const int lane = otid() & 63, wave = __builtin_amdgcn_readfirstlane(otid() >> 6);
    const int nw = gridDim.x * 8;
    for (int row0 = blockIdx.x * 8 + wave; row0 < MTOK; row0 += 4 * nw) {
        float4 v[4][4];
#pragma unroll
        for (int r = 0; r < 4; ++r) {
            int row = row0 + r * nw; row = row < MTOK ? row : MTOK - 1;
            const float* src = row < MP ? p->in[I_XP] + (size_t)row * DM : p->in[I_XS] + (size_t)(row - MP) * DM;
#pragma unroll
            for (int i = 0; i < 4; ++i) v[r][i] = *(const float4*)(src + i * 256 + lane * 4);
        }
#pragma unroll
        for (int r = 0; r < 4; ++r) {
            int row = row0 + r * nw; row = row < MTOK ? row : MTOK - 1;
            float ss = 0.f;
#pragma unroll
            for (int i = 0; i < 4; ++i) ss += v[r][i].x * v[r][i].x + v[r][i].y * v[r][i].y + v[r][i].z * v[r][i].z + v[r][i].w * v[r][i].w;
            ss = wave_sum(ss);
#pragma unroll
            for (int i = 0; i < 4; ++i) { uint2 o; o.x = pk2(v[r][i].x, v[r][i].y); o.y = pk2(v[r][i].z, v[r][i].w); *(uint2*)(XB + (size_t)row * DM + i * 256 + lane * 4) = o; }
            if (row < MP && lane < 16) PART[(size_t)row * 16 + lane] = lane == 0 ? ss : 0.f;
        }
    }
}
__device__ void final_phase(KP p, const bf16_t* XB, float* Y) {
    const int lane = otid() & 63, wave = __builtin_amdgcn_readfirstlane(otid() >> 6);
    const int nw = gridDim.x * 8;
    float4 gv[4];
#pragma unroll
    for (int i = 0; i < 4; ++i) gv[i] = *(const float4*)(p->in[I_FINN] + i * 256 + lane * 4);
    for (int row0 = blockIdx.x * 8 + wave; row0 < MTOK; row0 += 4 * nw) {
        uint2 u[4][4];
#pragma unroll
        for (int r = 0; r < 4; ++r) {
            int row = row0 + r * nw; row = row < MTOK ? row : MTOK - 1;
#pragma unroll
            for (int i = 0; i < 4; ++i) u[r][i] = *(const uint2*)(XB + (size_t)row * DM + i * 256 + lane * 4);
        }
#pragma unroll
        for (int r = 0; r < 4; ++r) {
            int row = row0 + r * nw; row = row < MTOK ? row : MTOK - 1;
            float4 v[4]; float ss = 0.f;
#pragma unroll
            for (int i = 0; i < 4; ++i) { v[i] = make_float4(lo16(u[r][i].x), hi16(u[r][i].x), lo16(u[r][i].y), hi16(u[r][i].y)); ss += v[i].x * v[i].x + v[i].y * v[i].y + v[i].z * v[i].z + v[i].w * v[i].w; }
            ss = wave_sum(ss);
            const float rstd = rsqrtf(ss * (1.f / 1024.f) + EPS);
#pragma unroll
            for (int i = 0; i < 4; ++i) { float4 o; o.x = v[i].x * rstd * gv[i].x; o.y = v[i].y * rstd * gv[i].y; o.z = v[i].z * rstd * gv[i].z; o.w = v[i].w * rstd * gv[i].w;
                *(float4*)(Y + (size_t)row * DM + i * 256 + lane * 4) = o; }
        }
    }
}

__device__ void prep_phase(KP p, int L, bf16_t* PROJ, bf16_t* U, bf16_t* CAT, const bf16_t* XB, const float* PART, float* DT) {
    SMEM_DECL;
    float* PW = (float*)smem; float* XA = PW + 16384; float* Dm = XA + 31 * 256; float* CS = Dm + 4096; float* INV = CS + 1024; float* DTP = INV + 32;
    const int tid = otid(), lane = tid & 63, w = __builtin_amdgcn_readfirstlane(tid >> 6), fr = lane & 15, fq = lane >> 4;
    __syncthreads();
    bf16_t* PWT = (bf16_t*)PW;
    bf16_t* DmB = (bf16_t*)Dm;
    for (int i = tid; i < 16384; i += NT) { const int gg = i >> 12, c = (i >> 6) & 63, dd = i & 63; PWT[(gg * 64 + 32 * (dd >> 5) + 16 * ((dd >> 2) & 1) + 4 * ((dd >> 3) & 3) + (dd & 3)) * 72 + c] = f2bf(p->in[I_POOLW][L * 16384 + i]); }
    if (tid < 32) INV[tid] = rope_inv(tid);
    __syncthreads();
    float* out = p->out;
    const bf16_t* wdt = (const bf16_t*)(p->ws + WS_WDT) + (size_t)L * 16 * 1024;
    const int tiles_per = (2048 + gridDim.x - 1) / gridDim.x;
    for (int tile = blockIdx.x * tiles_per; tile < 2048 && tile < (blockIdx.x + 1) * tiles_per; ++tile) {
        const int token0 = tile * 16, b = token0 >> 13, t0 = token0 & 8191;
        bf16x8 da[4], db[4];
#pragma unroll
        for (int ks = 0; ks < 4; ++ks) { const int k0 = w * 128 + ks * 32 + fq * 8;
            da[ks] = *(const bf16x8*)(XB + (size_t)(token0 + fr) * DM + k0); db[ks] = *(const bf16x8*)(wdt + fr * 1024 + k0); }
        uint4 xav[2];
#pragma unroll
        for (int it = 0; it < 2; ++it) { const int id = tid + it * NT, rr = id >> 5, ch = id & 31, t = t0 - 15 + rr;
            xav[it] = zero4();
            if (id < 992 && t >= 0) xav[it] = *(const uint4*)(PROJ + (size_t)(b * 8192 + t) * NPROJ + ch * 8); }
        const int r_tk = tid >> 5, r_rest = tid & 31, r_qk = r_rest >> 4, r_h = (r_rest >> 2) & 3, r_i0 = (r_rest & 3) * 8;
        bf16_t* rbase = PROJ + (size_t)(token0 + r_tk) * NPROJ + 256 + r_qk * 256 + r_h * 64 + r_i0;
        const uint4 rxa = *(const uint4*)rbase, rxb = *(const uint4*)(rbase + 32);
        uint4 vld = zero4();
        if (t0 >= 6144) vld = *(const uint4*)(PROJ + (size_t)(token0 + (tid >> 5)) * NPROJ + 768 + (tid & 31) * 8);
        const int q4 = tid >> 7, c0 = (tid & 127) * 8;
        uint4 xr[7];
#pragma unroll
        for (int rr = 0; rr < 7; ++rr) { const int tt = t0 + q4 * 4 - 3 + rr;
            xr[rr] = zero4();
            if (tt >= 0) xr[rr] = *(const uint4*)(PROJ + (size_t)(b * 8192 + tt) * NPROJ + 1536 + c0); }
        {
            f32x4 acc = (f32x4){0.f, 0.f, 0.f, 0.f};
#pragma unroll
            for (int ks = 0; ks < 4; ++ks) acc = MFMA16(db[ks], da[ks], acc);
            if (fq < 2) { float4 v; v.x = acc[0]; v.y = acc[1]; v.z = acc[2]; v.w = acc[3]; *(float4*)(DTP + (w * 16 + fr) * 8 + fq * 4) = v; }
        }
#pragma unroll
        for (int it = 0; it < 2; ++it) { const int id = tid + it * NT, rr = id >> 5, ch = id & 31;
            if (id < 992) { float* d = XA + rr * 256 + ch * 8; const uint4 v = xav[it];
                d[0] = lo16(v.x); d[1] = hi16(v.x); d[2] = lo16(v.y); d[3] = hi16(v.y); d[4] = lo16(v.z); d[5] = hi16(v.z); d[6] = lo16(v.w); d[7] = hi16(v.w); } }
        { const int tk = tid >> 5, i = tid & 31; float c, sn; rope_cs((float)(t0 + tk) * INV[i], c, sn); CS[(tk * 32 + i) * 2] = c; CS[(tk * 32 + i) * 2 + 1] = sn; }
        __syncthreads();
        if (tid < 128) {
            const int tk = tid >> 3, h = tid & 7;
            float d = 0.f;
#pragma unroll
            for (int ww = 0; ww < 8; ++ww) d += DTP[(ww * 16 + tk) * 8 + h];
            const float x = d * row_rstd(PART, token0 + tk) + p->in[I_DTB][L * 8 + h];
            DT[(size_t)(token0 + tk) * 8 + h] = x > 20.f ? x : log1pf(__expf(x));
        }
        for (int id = tid; id < 4096; id += NT) {
            const int tk = id >> 8, ch = id & 255, g = ch >> 6, ww = 2 << g, t = t0 + tk;
            float sum = 0.f;
            for (int i = 0; i < ww; ++i) sum += XA[(15 + tk - i) * 256 + ch];
            const float xc = XA[(15 + tk) * 256 + ch];
            const int cnt = (t + 1) < ww ? (t + 1) : ww;
            DmB[tk * 264 + ch] = f2bf(sum / (float)cnt - xc);
            if (t >= 8177) out[O_POOLP + ((size_t)(L * 4 + b) * 15 + (t - 8177)) * 256 + ch] = xc;
        }
        __syncthreads();
        {
            const int g = w >> 1;
            f32x4 r[2];
#pragma unroll
            for (int dq = 0; dq < 2; ++dq) {
                const int dtile = (w & 1) * 2 + dq;
                r[dq] = (f32x4){0.f, 0.f, 0.f, 0.f};
#pragma unroll
                for (int ks = 0; ks < 2; ++ks) {
                    const bf16x8 pf = *(const bf16x8*)(PWT + (g * 64 + 16 * dtile + fr) * 72 + ks * 32 + fq * 8);
                    const bf16x8 qf = *(const bf16x8*)(DmB + fr * 264 + g * 64 + ks * 32 + fq * 8);
                    r[dq] = MFMA16(pf, qf, r[dq]);
                }
            }
            const int o = g * 64 + 32 * (w & 1) + fq * 8;
            const float4 p0 = *(const float4*)(p->in[I_POOLSC] + L * 256 + o), p1 = *(const float4*)(p->in[I_POOLSC] + L * 256 + o + 4);
            uint4 ov; ov.x = pk2(r[0][0] * p0.x, r[0][1] * p0.y); ov.y = pk2(r[0][2] * p0.z, r[0][3] * p0.w);
            ov.z = pk2(r[1][0] * p1.x, r[1][1] * p1.y); ov.w = pk2(r[1][2] * p1.z, r[1][3] * p1.w);
            *(uint4*)(CAT + (size_t)(token0 + fr) * DM + o) = ov;
        }
        {
            const int t = t0 + r_tk;
            const float x1[8] = {lo16(rxa.x), hi16(rxa.x), lo16(rxa.y), hi16(rxa.y), lo16(rxa.z), hi16(rxa.z), lo16(rxa.w), hi16(rxa.w)};
            const float x2[8] = {lo16(rxb.x), hi16(rxb.x), lo16(rxb.y), hi16(rxb.y), lo16(rxb.z), hi16(rxb.z), lo16(rxb.w), hi16(rxb.w)};
            float r1[8], r2[8];
            const float sc = r_qk == 0 ? 0.125f : 1.f;
#pragma unroll
            for (int e = 0; e < 8; e += 2) {
                const float4 cs = *(const float4*)(CS + (r_tk * 32 + r_i0 + e) * 2);
                r1[e] = (x1[e] * cs.x - x2[e] * cs.y) * sc; r2[e] = (x2[e] * cs.x + x1[e] * cs.y) * sc;
                r1[e + 1] = (x1[e + 1] * cs.z - x2[e + 1] * cs.w) * sc; r2[e + 1] = (x2[e + 1] * cs.z + x1[e + 1] * cs.w) * sc;
            }
            uint4 o1, o2;
            o1.x = pk2(r1[0], r1[1]); o1.y = pk2(r1[2], r1[3]); o1.z = pk2(r1[4], r1[5]); o1.w = pk2(r1[6], r1[7]);
            o2.x = pk2(r2[0], r2[1]); o2.y = pk2(r2[2], r2[3]); o2.z = pk2(r2[4], r2[5]); o2.w = pk2(r2[6], r2[7]);
            *(uint4*)rbase = o1; *(uint4*)(rbase + 32) = o2;
            if (r_qk == 1 && t >= 6144) {
                float* kp = out + O_KP + (((size_t)(L * 4 + b) * 2048 + (t - 6144)) * 4 + r_h) * 64 + r_i0;
                *(float4*)kp = make_float4(r1[0], r1[1], r1[2], r1[3]); *(float4*)(kp + 4) = make_float4(r1[4], r1[5], r1[6], r1[7]);
                *(float4*)(kp + 32) = make_float4(r2[0], r2[1], r2[2], r2[3]); *(float4*)(kp + 36) = make_float4(r2[4], r2[5], r2[6], r2[7]);
            }
        }
        if (t0 >= 6144) {
            const int tk = tid >> 5, cc = (tid & 31) * 8, t = t0 + tk;
            float* vp = out + O_VP + ((size_t)(L * 4 + b) * 2048 + (t - 6144)) * 256 + cc;
            *(float4*)vp = make_float4(lo16(vld.x), hi16(vld.x), lo16(vld.y), hi16(vld.y)); *(float4*)(vp + 4) = make_float4(lo16(vld.z), hi16(vld.z), lo16(vld.w), hi16(vld.w));
        }
        {
            float wv[4][8], bv[8];
            { const float4 b0 = *(const float4*)(p->in[I_CONVB] + L * 1024 + c0), b1 = *(const float4*)(p->in[I_CONVB] + L * 1024 + c0 + 4);
              bv[0] = b0.x; bv[1] = b0.y; bv[2] = b0.z; bv[3] = b0.w; bv[4] = b1.x; bv[5] = b1.y; bv[6] = b1.z; bv[7] = b1.w; }
#pragma unroll
            for (int tau = 0; tau < 4; ++tau) {
                const float* cw = p->in[I_CONVW] + (size_t)(L * 4 + tau) * 1024 + c0;
                const float4 w0 = *(const float4*)cw, w1 = *(const float4*)(cw + 4);
                wv[tau][0] = w0.x; wv[tau][1] = w0.y; wv[tau][2] = w0.z; wv[tau][3] = w0.w; wv[tau][4] = w1.x; wv[tau][5] = w1.y; wv[tau][6] = w1.z; wv[tau][7] = w1.w;
            }
            float acc[4][8];
#pragma unroll
            for (int it = 0; it < 4; ++it)
#pragma unroll
                for (int e = 0; e < 8; ++e) acc[it][e] = bv[e];
#pragma unroll
            for (int rr = 0; rr < 7; ++rr) {
                const float xf[8] = {lo16(xr[rr].x), hi16(xr[rr].x), lo16(xr[rr].y), hi16(xr[rr].y), lo16(xr[rr].z), hi16(xr[rr].z), lo16(xr[rr].w), hi16(xr[rr].w)};
#pragma unroll
                for (int it = 0; it < 4; ++it) {
                    const int tau = rr - it;
                    if (tau >= 0 && tau < 4) {
#pragma unroll
                        for (int e = 0; e < 8; ++e) acc[it][e] += xf[e] * wv[tau][e];
                    }
                }
            }
#pragma unroll
            for (int it = 0; it < 4; ++it) {
                const int tk = q4 * 4 + it, t = t0 + tk;
                uint4 o; o.x = pk2(silu(acc[it][0]), silu(acc[it][1])); o.y = pk2(silu(acc[it][2]), silu(acc[it][3]));
                o.z = pk2(silu(acc[it][4]), silu(acc[it][5])); o.w = pk2(silu(acc[it][6]), silu(acc[it][7]));
                *(uint4*)(U + (size_t)(token0 + tk) * DM + c0) = o;
                if (t >= 8189) { float* cp = out + O_CONVP + ((size_t)(L * 4 + b) * 3 + (t - 8189)) * 1024 + c0; const uint4 xv = xr[it + 3];
                    *(float4*)cp = make_float4(lo16(xv.x), hi16(xv.x), lo16(xv.y), hi16(xv.y)); *(float4*)(cp + 4) = make_float4(lo16(xv.z), hi16(xv.z), lo16(xv.w), hi16(xv.w)); }
            }
        }
        __syncthreads();
    }
}

__device__ void prep_sample_item(KP p, int L, int n, bf16_t* PROJ, bf16_t* U, bf16_t* CAT, const bf16_t* XB, float* DT) {
    SMEM_DECL;
    float* dsm = (float*)smem;
    const int tid = otid();
    const size_t row = MP + n;
    float* out = p->out;
    const int ln = L * 32 + n;
    __syncthreads();
    {
        const int lane = tid & 63, h = tid >> 6;
        const bf16_t* wdt = (const bf16_t*)(p->ws + WS_WDT) + (size_t)L * 16 * 1024 + h * 1024;
        float d = 0.f, ss = 0.f;
#pragma unroll
        for (int i = 0; i < 16; ++i) { const int k = i * 64 + lane; const float xf = bf2f(XB[row * DM + k]); ss += xf * xf; d += xf * bf2f(wdt[k]); }
        d = wave_sum(d); ss = wave_sum(ss);
        if (lane == 0) { const float x = d * rsqrtf(ss * (1.f / 1024.f) + EPS) + p->in[I_DTB][L * 8 + h]; DT[row * 8 + h] = x > 20.f ? x : log1pf(__expf(x)); }
    }
    __syncthreads();
    if (tid < 256) {
        const int ch = tid, g = ch >> 6, w = 2 << g;
        const float* cp = p->in[I_CPOOL] + (size_t)ln * 15 * 256;
        const float xn = bf2f(PROJ[row * NPROJ + ch]);
        float cpr[15];
#pragma unroll
        for (int i = 1; i < 16; ++i) cpr[i - 1] = cp[(15 - i) * 256 + ch];
        float sum = xn;
#pragma unroll
        for (int i = 1; i < 16; ++i) sum += (i < w) ? cpr[i - 1] : 0.f;
        dsm[ch] = sum / (float)w - xn;
        float* ps = out + O_POOLS + (size_t)ln * 15 * 256;
        float cpv[14];
#pragma unroll
        for (int j = 0; j < 14; ++j) cpv[j] = cp[(j + 1) * 256 + ch];
#pragma unroll
        for (int j = 0; j < 14; ++j) ps[j * 256 + ch] = cpv[j];
        ps[14 * 256 + ch] = xn;
    }
    __syncthreads();
    if (tid < 256) {
        const int o = tid, g = o >> 6, dout = o & 63;
        const float* pw = p->in[I_POOLW] + (size_t)(L * 4 + g) * 4096;
        float acc = 0.f;
#pragma unroll 32
        for (int c = 0; c < 64; ++c) acc += dsm[g * 64 + c] * pw[c * 64 + dout];
        CAT[row * DM + o] = f2bf(acc * p->in[I_POOLSC][L * 256 + o]);
        const int qk = tid >> 7, h = (tid >> 5) & 3, i = tid & 31;
        const float inv = rope_inv(i);
        float c, s; rope_cs(16384.f * inv, c, s);
        bf16_t* base = PROJ + row * NPROJ + 256 + qk * 256 + h * 64;
        const float x1 = bf2f(base[i]), x2 = bf2f(base[i + 32]);
        float r1 = x1 * c - x2 * s, r2 = x2 * c + x1 * s;
        if (qk == 0) { r1 *= 0.125f; r2 *= 0.125f; }
        base[i] = f2bf(r1); base[i + 32] = f2bf(r2);
        if (qk == 1) { float* ks = out + O_KS + (((size_t)ln * 2048 + 2047) * 4 + h) * 64; ks[i] = r1; ks[i + 32] = r2; }
        out[O_VS + ((size_t)ln * 2048 + 2047) * 256 + tid] = bf2f(PROJ[row * NPROJ + 768 + tid]);
    }
    for (int c = tid; c < 1024; c += NT) {
        const float* sc = p->in[I_SCONV] + (size_t)ln * 3 * 1024;
        const float* cw = p->in[I_CONVW] + (size_t)L * 4 * 1024;
        const float xnew = bf2f(PROJ[row * NPROJ + 1536 + c]);
        const float s0 = sc[c], s1 = sc[1024 + c], s2 = sc[2048 + c];
        const float acc = p->in[I_CONVB][L * 1024 + c] + s0 * cw[c] + s1 * cw[1024 + c] + s2 * cw[2048 + c] + xnew * cw[3072 + c];
        U[row * DM + c] = f2bf(silu(acc));
        float* cs = out + O_CONVS + (size_t)ln * 3 * 1024;
        cs[c] = s1; cs[1024 + c] = s2; cs[2048 + c] = xnew;
    }
    __syncthreads();
}

struct AttnPf { uint4 k[4], v[4]; bf16x8 q[2]; };
__device__ __forceinline__ void attn_decode(int a, int& b, int& h, int& br, int& dsh, int& r, int& n) {
    const int bh = a / 192, rem = a % 192, idx = rem & 63; br = rem >> 6;
    b = bh >> 2; h = bh & 3; dsh = br * 2; const int nb = 64 >> dsh; r = idx / nb; n = idx % nb;
}
__device__ __forceinline__ void attn_load(int a, const bf16_t* PROJ, int tid, AttnPf& pf) {
    int b, h, br, dsh, r, n; attn_decode(a, b, h, br, dsh, r, n);
    const int lane = tid & 63, w = __builtin_amdgcn_readfirstlane(tid >> 6), fr = lane & 15, fq = lane >> 4;
#pragma unroll
    for (int it = 0; it < 4; ++it) {
        const int id = tid + it * NT, rowk = id >> 3, ch = id & 7, lk = (n - 1) * 128 + rowk;
        pf.k[it] = zero4();
        if (lk >= 0) pf.k[it] = *(const uint4*)(PROJ + (size_t)(b * 8192 + (lk << dsh) + r) * NPROJ + 512 + h * 64 + ch * 8);
    }
#pragma unroll
    for (int it = 0; it < 4; ++it) {
        const int id = tid + it * NT, key = id & 255, ch = id >> 8, lk = (n - 1) * 128 + key;
        pf.v[it] = zero4();
        if (lk >= 0) pf.v[it] = *(const uint4*)(PROJ + (size_t)(b * 8192 + (lk << dsh) + r) * NPROJ + 768 + h * 64 + ch * 8);
    }
    const int qi = 16 * w + fr, lq = n * 128 + qi;
    const size_t tq = (size_t)b * 8192 + ((size_t)lq << dsh) + r;
#pragma unroll
    for (int ks = 0; ks < 2; ++ks) pf.q[ks] = *(const bf16x8*)(PROJ + tq * NPROJ + 256 + h * 64 + ks * 32 + fq * 8);
}
__device__ void attn_items(int a0, int astep, const bf16_t* PROJ, bf16_t* OG, float* LSE) {
    SMEM_DECL;
    bf16_t* Ks = (bf16_t*)smem;
    bf16_t* Vt = (bf16_t*)(smem + 272 * 144);
    const int tid = otid(), lane = tid & 63, w = __builtin_amdgcn_readfirstlane(tid >> 6), fr = lane & 15, fq = lane >> 4;
    AttnPf pf;
    if (a0 < 3072) attn_load(a0, PROJ, tid, pf);
#pragma unroll 1
    for (int a = a0; a < 3072; a += astep) {
        int b, h, br, dsh, r, n; attn_decode(a, b, h, br, dsh, r, n);
        LDS_BARRIER();
#pragma unroll
        for (int it = 0; it < 4; ++it) { const int id = tid + it * NT, rowk = id >> 3, ch = id & 7; *(uint4*)(Ks + rowk * 72 + ch * 8) = pf.k[it]; }
        if (tid < 128) { const uint4 z = zero4(); *(uint4*)(Ks + (256 + (tid >> 3)) * 72 + (tid & 7) * 8) = z; }
#pragma unroll
        for (int it = 0; it < 4; ++it) {
            const int id = tid + it * NT, key = id & 255, ch = id >> 8; const uint4 v = pf.v[it];
            bf16_t* d = Vt + (32 * (ch >> 2) + 4 * (ch & 3)) * 280 + key;
            d[0] = (bf16_t)(v.x & 0xffff); d[280] = (bf16_t)(v.x >> 16); d[560] = (bf16_t)(v.y & 0xffff); d[840] = (bf16_t)(v.y >> 16);
            d[16 * 280] = (bf16_t)(v.z & 0xffff); d[17 * 280] = (bf16_t)(v.z >> 16); d[18 * 280] = (bf16_t)(v.w & 0xffff); d[19 * 280] = (bf16_t)(v.w >> 16);
        }
        { const int d = tid >> 3, kk = (tid & 7) * 2; *(unsigned*)(Vt + d * 280 + 256 + kk) = 0u; }
        const bf16x8 qf0 = pf.q[0], qf1 = pf.q[1];
        if (a + astep < 3072) attn_load(a + astep, PROJ, tid, pf);
        LDS_BARRIER();
        const int qi = 16 * w + fr, lq = n * 128 + qi;
        const size_t tq = (size_t)b * 8192 + ((size_t)lq << dsh) + r;
        f32x4 s[10];
#pragma unroll
        for (int t = 0; t < 10; ++t) {
            s[t] = (f32x4){0.f, 0.f, 0.f, 0.f};
            const bf16x8 kf0 = *(const bf16x8*)(Ks + (16 * (w + t) + fr) * 72 + fq * 8);
            const bf16x8 kf1 = *(const bf16x8*)(Ks + (16 * (w + t) + fr) * 72 + 32 + fq * 8);
            s[t] = MFMA16(kf0, qf0, s[t]); s[t] = MFMA16(kf1, qf1, s[t]);
        }
        float mx = -INFINITY;
#pragma unroll
        for (int t = 0; t < 10; ++t)
#pragma unroll
            for (int jj = 0; jj < 4; ++jj) {
                const int key = 16 * (w + t) + fq * 4 + jj, dist = 128 + qi - key;
                const bool valid = (dist >= 0) && (dist <= 128) && (key < 256) && (n > 0 || key >= 128);
                const float sv = valid ? s[t][jj] : -INFINITY;
                s[t][jj] = sv; mx = fmaxf(mx, sv);
            }
        mx = fmaxf(mx, __shfl_xor(mx, 16)); mx = fmaxf(mx, __shfl_xor(mx, 32));
        float lsum = 0.f;
#pragma unroll
        for (int t = 0; t < 10; ++t)
#pragma unroll
            for (int jj = 0; jj < 4; ++jj) { const float pv = __expf(s[t][jj] - mx); s[t][jj] = pv; lsum += pv; }
        lsum += __shfl_xor(lsum, 16); lsum += __shfl_xor(lsum, 32);
        f32x4 o[4];
#pragma unroll
        for (int dt = 0; dt < 4; ++dt) o[dt] = (f32x4){0.f, 0.f, 0.f, 0.f};
#pragma unroll
        for (int kp = 0; kp < 5; ++kp) {
            const int ta = 2 * kp, tb = 2 * kp + 1;
            union { bf16x8 v; unsigned u[4]; } pfr;
            pfr.u[0] = pk2(s[ta][0], s[ta][1]); pfr.u[1] = pk2(s[ta][2], s[ta][3]); pfr.u[2] = pk2(s[tb][0], s[tb][1]); pfr.u[3] = pk2(s[tb][2], s[tb][3]);
#pragma unroll
            for (int dt = 0; dt < 4; ++dt) {
                union { bf16x8 v; uint2 u[2]; } vf;
                vf.u[0] = *(const uint2*)(Vt + (16 * dt + fr) * 280 + 16 * (w + ta) + fq * 4);
                vf.u[1] = *(const uint2*)(Vt + (16 * dt + fr) * 280 + 16 * (w + tb) + fq * 4);
                o[dt] = MFMA16(vf.v, pfr.v, o[dt]);
            }
        }
        const float inv = 1.f / lsum;
#pragma unroll
        for (int a2 = 0; a2 < 2; ++a2) {
            uint4 ov; ov.x = pk2(o[2 * a2][0] * inv, o[2 * a2][1] * inv); ov.y = pk2(o[2 * a2][2] * inv, o[2 * a2][3] * inv);
            ov.z = pk2(o[2 * a2 + 1][0] * inv, o[2 * a2 + 1][1] * inv); ov.w = pk2(o[2 * a2 + 1][2] * inv, o[2 * a2 + 1][3] * inv);
            *(uint4*)(OG + ((size_t)br * MP + tq) * 256 + h * 64 + 32 * a2 + fq * 8) = ov;
        }
        if (fq == 0) LSE[((size_t)br * MP + tq) * 4 + h] = mx + __logf(lsum);
    }
}

__device__ void combine_item(int item, const bf16_t* __restrict__ OG, const float* __restrict__ LSE, bf16_t* __restrict__ CAT) {
    const int tid = otid();
    uint4 a[4], bb[4], c[4]; float l0[4], l1[4], l2[4];
#pragma unroll
    for (int it = 0; it < 4; ++it) {
        const int id = tid + it * NT, tk = id >> 5, ch = id & 31, h = ch >> 3;
        const size_t token = (size_t)item * 64 + tk;
        l0[it] = LSE[token * 4 + h]; l1[it] = LSE[((size_t)MP + token) * 4 + h]; l2[it] = LSE[(2ull * MP + token) * 4 + h];
        a[it] = *(const uint4*)(OG + token * 256 + ch * 8); bb[it] = *(const uint4*)(OG + ((size_t)MP + token) * 256 + ch * 8);
        c[it] = *(const uint4*)(OG + (2ull * MP + token) * 256 + ch * 8);
    }
#pragma unroll
    for (int it = 0; it < 4; ++it) {
        const int id = tid + it * NT, tk = id >> 5, ch = id & 31;
        const size_t token = (size_t)item * 64 + tk;
        const float m = fmaxf(l0[it], fmaxf(l1[it], l2[it]));
        float w0 = __expf(l0[it] - m), w1 = __expf(l1[it] - m), w2 = __expf(l2[it] - m);
        const float inv = 1.f / (w0 + w1 + w2); w0 *= inv; w1 *= inv; w2 *= inv;
        uint4 o;
        o.x = pk2(w0 * lo16(a[it].x) + w1 * lo16(bb[it].x) + w2 * lo16(c[it].x), w0 * hi16(a[it].x) + w1 * hi16(bb[it].x) + w2 * hi16(c[it].x));
        o.y = pk2(w0 * lo16(a[it].y) + w1 * lo16(bb[it].y) + w2 * lo16(c[it].y), w0 * hi16(a[it].y) + w1 * hi16(bb[it].y) + w2 * hi16(c[it].y));
        o.z = pk2(w0 * lo16(a[it].z) + w1 * lo16(bb[it].z) + w2 * lo16(c[it].z), w0 * hi16(a[it].z) + w1 * hi16(bb[it].z) + w2 * hi16(c[it].z));
        o.w = pk2(w0 * lo16(a[it].w) + w1 * lo16(bb[it].w) + w2 * lo16(c[it].w), w0 * hi16(a[it].w) + w1 * hi16(bb[it].w) + w2 * hi16(c[it].w));
        *(uint4*)(CAT + token * DM + 256 + ch * 8) = o;
    }
}

__device__ __forceinline__ void ssd_acs(KP p, int L, int g, int token0, const float* DT, float* acs, float* dts) {
    const int lane = otid() & 63, w = __builtin_amdgcn_readfirstlane(otid() >> 6);
    if (w < 4) {
        const int h = g * 4 + w; const float a = -__expf(p->in[I_ALOG][L * 8 + h]);
        const float d0 = DT[(size_t)(token0 + 2 * lane) * 8 + h], d1 = DT[(size_t)(token0 + 2 * lane + 1) * 8 + h];
        const float v0 = d0 * a, v1 = d1 * a, sum = v0 + v1; float inc = sum;
#pragma unroll
        for (int off = 1; off < 64; off <<= 1) { const float t = __shfl_up(inc, off); if (lane >= off) inc += t; }
        const float exc = inc - sum;
        acs[w * 128 + 2 * lane] = exc + v0; acs[w * 128 + 2 * lane + 1] = exc + v0 + v1;
        dts[w * 128 + 2 * lane] = d0; dts[w * 128 + 2 * lane + 1] = d1;
    }
}

__device__ void s1_item(KP p, int L, int item, const bf16_t* U, const float* DT, float* ST, float* DEC) {
    SMEM_DECL;
    bf16_t* BT = (bf16_t*)smem;
    bf16_t* XWT = (bf16_t*)(smem + 34816);
    float* acs = (float*)(smem + 104448);
    float* dts = (float*)(smem + 106496);
    const int tid = otid(), lane = tid & 63, w = __builtin_amdgcn_readfirstlane(tid >> 6), fr = lane & 15, fq = lane >> 4;
    const int cb = item >> 1, g = item & 1, token0 = cb * 128;
    __syncthreads();
    ssd_acs(p, L, g, token0, DT, acs, dts);
    __syncthreads();
    { const int j = tid >> 7, l = tid & 127; const float wv = __expf(acs[j * 128 + 127] - acs[j * 128 + l]) * dts[j * 128 + l];
      if (tid < 4) DEC[cb * 8 + g * 4 + tid] = __expf(acs[tid * 128 + 127]);
      __syncthreads();
      dts[j * 128 + l] = wv; }
    __syncthreads();
#pragma unroll
    for (int it = 0; it < 4; ++it) {
        const int id = tid + it * NT, l = id & 127, ch = id >> 7;
        const uint4 v = *(const uint4*)(U + (size_t)(token0 + l) * DM + 512 + g * 128 + ch * 8);
        bf16_t* d = BT + (ch * 8) * 136 + l;
        d[0] = (bf16_t)(v.x & 0xffff); d[136] = (bf16_t)(v.x >> 16); d[272] = (bf16_t)(v.y & 0xffff); d[408] = (bf16_t)(v.y >> 16);
        d[544] = (bf16_t)(v.z & 0xffff); d[680] = (bf16_t)(v.z >> 16); d[816] = (bf16_t)(v.w & 0xffff); d[952] = (bf16_t)(v.w >> 16);
    }
#pragma unroll
    for (int it = 0; it < 8; ++it) {
        const int id = tid + it * NT, l = id & 127, ch = id >> 7, j = ch >> 3;
        const uint4 v = *(const uint4*)(U + (size_t)(token0 + l) * DM + g * 256 + ch * 8);
        const float wv = dts[j * 128 + l];
        bf16_t* d = XWT + (ch * 8) * 136 + l;
        d[0] = f2bf(lo16(v.x) * wv); d[136] = f2bf(hi16(v.x) * wv); d[272] = f2bf(lo16(v.y) * wv); d[408] = f2bf(hi16(v.y) * wv);
        d[544] = f2bf(lo16(v.z) * wv); d[680] = f2bf(hi16(v.z) * wv); d[816] = f2bf(lo16(v.w) * wv); d[952] = f2bf(hi16(v.w) * wv);
    }
    __syncthreads();
    f32x4 acc[2][8];
#pragma unroll
    for (int qq = 0; qq < 2; ++qq)
#pragma unroll
        for (int nt = 0; nt < 8; ++nt) acc[qq][nt] = (f32x4){0.f, 0.f, 0.f, 0.f};
#pragma unroll
    for (int ks = 0; ks < 4; ++ks) {
        bf16x8 qf[2];
#pragma unroll
        for (int qq = 0; qq < 2; ++qq) qf[qq] = *(const bf16x8*)(XWT + (16 * (2 * w + qq) + fr) * 136 + ks * 32 + fq * 8);
#pragma unroll
        for (int nt = 0; nt < 8; ++nt) {
            const bf16x8 pf = *(const bf16x8*)(BT + (16 * nt + fr) * 136 + ks * 32 + fq * 8);
#pragma unroll
            for (int qq = 0; qq < 2; ++qq) acc[qq][nt] = MFMA16(pf, qf[qq], acc[qq][nt]);
        }
    }
#pragma unroll
    for (int qq = 0; qq < 2; ++qq) {
        const int rowjp = 16 * (2 * w + qq) + fr, j = rowjp >> 6, pp = rowjp & 63, h = g * 4 + j;
        float* dst = ST + ((size_t)(cb * 8 + h) * 64 + pp) * 128 + fq * 4;
#pragma unroll
        for (int nt = 0; nt < 8; ++nt) { float4 v; v.x = acc[qq][nt][0]; v.y = acc[qq][nt][1]; v.z = acc[qq][nt][2]; v.w = acc[qq][nt][3]; *(float4*)(dst + 16 * nt) = v; }
    }
}

__device__ void scan_phase(KP p, int L, float* ST, const float* DEC) {
    for (int e = blockIdx.x * NT + otid(); e < 131072; e += gridDim.x * NT) {
        const int idx = e * 2, n = idx & 127, pp = (idx >> 7) & 63, h = (idx >> 13) & 7, b = idx >> 16;
        float2 hr = {0.f, 0.f};
        float* base = ST + ((size_t)((b * 64) * 8 + h) * 64 + pp) * 128 + n;
        const float* dbase = DEC + (b * 64) * 8 + h;
#pragma unroll 1
        for (int c0 = 0; c0 < 64; c0 += 16) {
            float2 t[16]; float d[16];
#pragma unroll
            for (int j = 0; j < 16; ++j) { t[j] = *(const float2*)(base + (size_t)(c0 + j) * 65536); d[j] = dbase[(c0 + j) * 8]; }
#pragma unroll
            for (int j = 0; j < 16; ++j) { *(float2*)(base + (size_t)(c0 + j) * 65536) = hr; hr.x = d[j] * hr.x + t[j].x; hr.y = d[j] * hr.y + t[j].y; }
        }
        *(float2*)(p->out + O_SSMP + (((size_t)(L * 4 + b) * 8 + h) * 64 + pp) * 128 + n) = hr;
    }
}

__device__ void s3_item(KP p, int L, int item, const bf16_t* U, const bf16_t* PROJ, const float* DT, const float* ST, bf16_t* CAT) {
    SMEM_DECL;
    bf16_t* Cs = (bf16_t*)smem;
    bf16_t* Bs = (bf16_t*)(smem + 34816);
    bf16_t* XT = (bf16_t*)(smem + 69632);
    bf16_t* Hp = (bf16_t*)(smem + 87040);
    float* acs = (float*)(smem + 104448);
    float* dts = (float*)(smem + 106496);
    const int tid = otid(), lane = tid & 63, w = __builtin_amdgcn_readfirstlane(tid >> 6), fr = lane & 15, fq = lane >> 4;
    const int cb = item >> 1, g = item & 1, token0 = cb * 128;
    const int l = 16 * w + fr;
    const size_t token = (size_t)token0 + l;
    uint4 xt[2]; float4 hp[4]; uint4 xv[2], zv[2];
#define S3_LOAD(hh) do { \
        _Pragma("unroll") for (int it = 0; it < 2; ++it) { const int id = tid + it * NT, s_ = id & 127, ch = id >> 7; \
            xt[it] = *(const uint4*)(U + (size_t)(token0 + s_) * DM + (hh) * 64 + ch * 8); } \
        _Pragma("unroll") for (int it = 0; it < 4; ++it) { const int id = tid + it * NT, pp = id >> 5, c4 = id & 31; \
            hp[it] = *(const float4*)(ST + ((size_t)(cb * 8 + (hh)) * 64 + pp) * 128 + c4 * 4); } \
        _Pragma("unroll") for (int a2 = 0; a2 < 2; ++a2) { const int ch = (hh) * 64 + 32 * a2 + fq * 8; \
            xv[a2] = *(const uint4*)(U + token * DM + ch); zv[a2] = *(const uint4*)(PROJ + token * NPROJ + 1024 + ch); } } while (0)
    LDS_BARRIER();
    S3_LOAD(g * 4);
    ssd_acs(p, L, g, token0, DT, acs, dts);
#pragma unroll
    for (int it = 0; it < 4; ++it) {
        const int id = tid + it * NT, ll = id >> 4, ch = id & 15;
        *(uint4*)(Cs + ll * 136 + ch * 8) = *(const uint4*)(U + (size_t)(token0 + ll) * DM + 768 + g * 128 + ch * 8);
        *(uint4*)(Bs + ll * 136 + ch * 8) = *(const uint4*)(U + (size_t)(token0 + ll) * DM + 512 + g * 128 + ch * 8);
    }
    LDS_BARRIER();
    f32x4 cbv[8];
#pragma unroll
    for (int st = 0; st < 8; ++st) cbv[st] = (f32x4){0.f, 0.f, 0.f, 0.f};
#pragma unroll
    for (int ks = 0; ks < 4; ++ks) {
        const bf16x8 qf = *(const bf16x8*)(Cs + (16 * w + fr) * 136 + ks * 32 + fq * 8);
#pragma unroll
        for (int st = 0; st < 8; ++st)
            if (st <= w) { const bf16x8 pf = *(const bf16x8*)(Bs + (16 * st + fr) * 136 + ks * 32 + fq * 8); cbv[st] = MFMA16(pf, qf, cbv[st]); }
    }
    LDS_BARRIER();
    bf16_t* Mb = Bs;
    float ssq = 0.f;
#pragma unroll 1
    for (int j = 0; j < 4; ++j) {
        const int h = g * 4 + j;
#pragma unroll
        for (int it = 0; it < 2; ++it) {
            const int id = tid + it * NT, s_ = id & 127, ch = id >> 7; const uint4 v = xt[it];
            bf16_t* d = XT + (32 * (ch >> 2) + 4 * (ch & 3)) * 136 + s_;
            d[0] = (bf16_t)(v.x & 0xffff); d[136] = (bf16_t)(v.x >> 16); d[272] = (bf16_t)(v.y & 0xffff); d[408] = (bf16_t)(v.y >> 16);
            d[16 * 136] = (bf16_t)(v.z & 0xffff); d[17 * 136] = (bf16_t)(v.z >> 16); d[18 * 136] = (bf16_t)(v.w & 0xffff); d[19 * 136] = (bf16_t)(v.w >> 16);
        }
#pragma unroll
        for (int it = 0; it < 4; ++it) {
            const int id = tid + it * NT, pp = id >> 5, c4 = id & 31; const float4 v = hp[it];
            uint2 o; o.x = pk2(v.x, v.y); o.y = pk2(v.z, v.w);
            *(uint2*)(Hp + (32 * (pp >> 5) + 16 * ((pp >> 2) & 1) + 4 * ((pp >> 3) & 3) + (pp & 3)) * 136 + c4 * 4) = o;
        }
        uint4 xvc[2], zvc[2];
#pragma unroll
        for (int a2 = 0; a2 < 2; ++a2) { xvc[a2] = xv[a2]; zvc[a2] = zv[a2]; }
        if (j < 3) S3_LOAD(h + 1);
        const float al = acs[j * 128 + l];
#pragma unroll
        for (int st = 0; st < 8; ++st)
            if (st <= (w | 1)) {
                float mv[4];
#pragma unroll
                for (int jj = 0; jj < 4; ++jj) { const int s_ = 16 * st + fq * 4 + jj;
                    mv[jj] = (s_ <= l) ? cbv[st][jj] * __expf(al - acs[j * 128 + s_]) * dts[j * 128 + s_] : 0.f; }
                uint2 o; o.x = pk2(mv[0], mv[1]); o.y = pk2(mv[2], mv[3]);
                *(uint2*)(Mb + l * 136 + 16 * st + fq * 4) = o;
            }
        LDS_BARRIER();
        f32x4 yy[4];
#pragma unroll
        for (int pt = 0; pt < 4; ++pt) yy[pt] = (f32x4){0.f, 0.f, 0.f, 0.f};
#pragma unroll
        for (int ks = 0; ks < 4; ++ks) {
            const bf16x8 qf = *(const bf16x8*)(Cs + (16 * w + fr) * 136 + ks * 32 + fq * 8);
#pragma unroll
            for (int pt = 0; pt < 4; ++pt) { const bf16x8 pf = *(const bf16x8*)(Hp + (16 * pt + fr) * 136 + ks * 32 + fq * 8); yy[pt] = MFMA16(pf, qf, yy[pt]); }
        }
        const float ea = __expf(al);
#pragma unroll
        for (int pt = 0; pt < 4; ++pt) yy[pt] = yy[pt] * ea;
#pragma unroll
        for (int ks = 0; ks < 4; ++ks)
            if (2 * ks <= w) {
                const bf16x8 qf = *(const bf16x8*)(Mb + (16 * w + fr) * 136 + ks * 32 + fq * 8);
#pragma unroll
                for (int pt = 0; pt < 4; ++pt) { const bf16x8 pf = *(const bf16x8*)(XT + (16 * pt + fr) * 136 + ks * 32 + fq * 8); yy[pt] = MFMA16(pf, qf, yy[pt]); }
            }
        const float dsk = p->in[I_DSKIP][L * 8 + h];
#pragma unroll
        for (int a2 = 0; a2 < 2; ++a2) {
            const int ch = h * 64 + 32 * a2 + fq * 8;
            const uint4 xq = xvc[a2], zq = zvc[a2];
            const float xs[8] = {lo16(xq.x), hi16(xq.x), lo16(xq.y), hi16(xq.y), lo16(xq.z), hi16(xq.z), lo16(xq.w), hi16(xq.w)};
            const float zs[8] = {lo16(zq.x), hi16(zq.x), lo16(zq.y), hi16(zq.y), lo16(zq.z), hi16(zq.z), lo16(zq.w), hi16(zq.w)};
            float v[8];
#pragma unroll
            for (int e = 0; e < 8; ++e) { v[e] = (yy[2 * a2 + (e >> 2)][e & 3] + dsk * xs[e]) * silu(zs[e]); ssq += v[e] * v[e]; }
            uint4 o; o.x = pk2(v[0], v[1]); o.y = pk2(v[2], v[3]); o.z = pk2(v[4], v[5]); o.w = pk2(v[6], v[7]);
            *(uint4*)(CAT + token * DM + 512 + ch) = o;
        }
        LDS_BARRIER();
    }
#undef S3_LOAD
    asm volatile("s_waitcnt vmcnt(0)" ::: "memory");
    ssq += __shfl_xor(ssq, 16); ssq += __shfl_xor(ssq, 32);
    const float rstd = rsqrtf(ssq * (1.f / 256.f) + EPS);
    {
        uint4 vv[4][2];
#pragma unroll
        for (int j = 0; j < 4; ++j)
#pragma unroll
            for (int a2 = 0; a2 < 2; ++a2) vv[j][a2] = *(const uint4*)(CAT + token * DM + 512 + (g * 4 + j) * 64 + 32 * a2 + fq * 8);
#pragma unroll
        for (int j = 0; j < 4; ++j)
#pragma unroll
            for (int a2 = 0; a2 < 2; ++a2) {
                const int ch = (g * 4 + j) * 64 + 32 * a2 + fq * 8;
                const float4 n0 = *(const float4*)(p->in[I_SSMN] + L * 512 + ch), n1 = *(const float4*)(p->in[I_SSMN] + L * 512 + ch + 4);
                const uint4 v = vv[j][a2];
                uint4 o; o.x = pk2(lo16(v.x) * rstd * n0.x, hi16(v.x) * rstd * n0.y); o.y = pk2(lo16(v.y) * rstd * n0.z, hi16(v.y) * rstd * n0.w);
                o.z = pk2(lo16(v.z) * rstd * n1.x, hi16(v.z) * rstd * n1.y); o.w = pk2(lo16(v.w) * rstd * n1.z, hi16(v.w) * rstd * n1.w);
                *(uint4*)(CAT + token * DM + 512 + ch) = o;
            }
    }
}

__device__ void sample_attn_item(KP p, int L, int item, const bf16_t* PROJ, bf16_t* CAT) {
    SMEM_DECL;
    float* qs = (float*)smem; float* kn = qs + 64; float* vn = kn + 64; float* sc = vn + 64; float* red = sc + 512; float* part = red + 32;
    const int tid = otid(), lane = tid & 63, w = __builtin_amdgcn_readfirstlane(tid >> 6);
    const int n = item >> 2, h = item & 3;
    const size_t row = MP + n; const int ln = L * 32 + n;
    __syncthreads();
    if (tid < 64) { qs[tid] = bf2f(PROJ[row * NPROJ + 256 + h * 64 + tid]); kn[tid] = bf2f(PROJ[row * NPROJ + 512 + h * 64 + tid]); vn[tid] = bf2f(PROJ[row * NPROJ + 768 + h * 64 + tid]); }
    __syncthreads();
    const float* ck = p->in[I_CK] + (size_t)ln * 2048 * 256 + h * 64;
    const float* cv = p->in[I_CV] + (size_t)ln * 2048 * 256 + h * 64;
    float s = -INFINITY;
    if (tid < 387) {
        const int gg = tid / 129, j = tid % 129;
        s = 0.f;
        if (j == 0) { for (int d = 0; d < 64; ++d) s += qs[d] * kn[d]; }
        else { const float* kr = ck + (size_t)(2048 - (j << (2 * gg))) * 256;
#pragma unroll
            for (int d = 0; d < 64; d += 4) { const float4 kv = *(const float4*)(kr + d); s += qs[d] * kv.x + qs[d + 1] * kv.y + qs[d + 2] * kv.z + qs[d + 3] * kv.w; } }
    }
    const float wm = wave_max(s);
    if (lane == 0) red[w] = wm;
    __syncthreads();
    float mx = red[0];
#pragma unroll
    for (int i = 1; i < 8; ++i) mx = fmaxf(mx, red[i]);
    const float pv = (tid < 387) ? __expf(s - mx) : 0.f;
    sc[tid] = pv;
    const float wsum = wave_sum(pv);
    if (lane == 0) red[8 + w] = wsum;
    __syncthreads();
    float tot = 0.f;
#pragma unroll
    for (int i = 0; i < 8; ++i) tot += red[8 + i];
    {
        const int d = lane;
        float o = 0.f;
#pragma unroll 1
        for (int k0 = 0; k0 < 49; k0 += 7) {
            float vv[7], pp[7];
#pragma unroll
            for (int i = 0; i < 7; ++i) {
                const int e = w + 8 * (k0 + i);
                pp[i] = 0.f; vv[i] = 0.f;
                if (e < 387) { const int gg = e / 129, j = e % 129; pp[i] = sc[e];
                    vv[i] = (j == 0) ? vn[d] : cv[(size_t)(2048 - (j << (2 * gg))) * 256 + d]; }
            }
#pragma unroll
            for (int i = 0; i < 7; ++i) o += pp[i] * vv[i];
        }
        part[w * 64 + d] = o;
    }
    __syncthreads();
    if (tid < 64) {
        float o = 0.f;
#pragma unroll
        for (int i = 0; i < 8; ++i) o += part[i * 64 + tid];
        CAT[row * DM + 256 + h * 64 + tid] = f2bf(o / tot);
    }
}

__device__ void sample_ssd_item(KP p, int L, int n, const bf16_t* PROJ, const bf16_t* U, const float* DT, bf16_t* CAT) {
    SMEM_DECL;
    float* us = (float*)smem; float* zs = us + 1024; float* ys = zs + 512; float* red = ys + 512;
    const int tid = otid(), lane = tid & 63, w = __builtin_amdgcn_readfirstlane(tid >> 6);
    const size_t row = MP + n; const int ln = L * 32 + n;
    __syncthreads();
    for (int i = tid; i < 1024; i += NT) us[i] = bf2f(U[row * DM + i]);
    zs[tid] = bf2f(PROJ[row * NPROJ + 1024 + tid]);
    __syncthreads();
    {
        const int h = w, g = h >> 2;
        const float dt = DT[row * 8 + h], a = -__expf(p->in[I_ALOG][L * 8 + h]), dec = __expf(dt * a);
        const float B0 = us[512 + g * 128 + 2 * lane], B1 = us[512 + g * 128 + 2 * lane + 1], C0 = us[768 + g * 128 + 2 * lane], C1 = us[768 + g * 128 + 2 * lane + 1];
        const float* h0 = p->in[I_SSSM] + ((size_t)ln * 8 + h) * 64 * 128;
        float* hs = p->out + O_SSMS + ((size_t)ln * 8 + h) * 64 * 128;
#pragma unroll 1
        for (int r0 = 0; r0 < 64; r0 += 16) {
            float2 hv[16];
#pragma unroll
            for (int i = 0; i < 16; ++i) hv[i] = *(const float2*)(h0 + (r0 + i) * 128 + 2 * lane);
#pragma unroll
            for (int i = 0; i < 16; ++i) {
                const int rr = r0 + i;
                const float x = us[h * 64 + rr];
                float2 hn; hn.x = dec * hv[i].x + dt * x * B0; hn.y = dec * hv[i].y + dt * x * B1;
                *(float2*)(hs + rr * 128 + 2 * lane) = hn;
                const float part = wave_sum(hn.x * C0 + hn.y * C1);
                if (lane == 0) ys[h * 64 + rr] = part;
            }
        }
    }
    __syncthreads();
    {
        const int ch = tid, gch = ch >> 8;
        const float v = (ys[ch] + p->in[I_DSKIP][L * 8 + (ch >> 6)] * us[ch]) * silu(zs[ch]);
        const float part = wave_sum(v * v);
        if (lane == 0) red[w] = part;
        __syncthreads();
        const float tot = red[gch * 4] + red[gch * 4 + 1] + red[gch * 4 + 2] + red[gch * 4 + 3];
        const float rstd = rsqrtf(tot * (1.f / 256.f) + EPS);
        CAT[row * DM + 512 + ch] = f2bf(v * rstd * p->in[I_SSMN][L * 512 + ch]);
    }
}


#define XB_TMO      128
#define XB_XCNT(j)  (256  + 64 * (j))
#define XB_XSUB(j)  (1280 + 64 * (j))
#define XB_XGEN(j)  (2304 + 64 * (j))
#define XB_TOP      3328
#define XB_TOPGEN   3392
#define XCD_BAR_WORDS 3456
#define XB_SPIN_CAP (1u << 18)
__device__ __forceinline__ unsigned xb_ld(unsigned* p)              { return __hip_atomic_load(p, __ATOMIC_RELAXED, __HIP_MEMORY_SCOPE_AGENT); }
__device__ __forceinline__ unsigned xb_add(unsigned* p, unsigned v) { return __hip_atomic_fetch_add(p, v, __ATOMIC_RELAXED, __HIP_MEMORY_SCOPE_AGENT); }
__device__ __forceinline__ unsigned xb_xcc_id() { return (unsigned)__builtin_amdgcn_s_getreg((3 << 11) | 20) & 0xFu; }
#define XB_SPIN(cond, bar) do { unsigned _sp = 0; while (cond) { __builtin_amdgcn_s_sleep(1); \
    if ((++_sp & 255u) == 0u) { if (xb_ld(&(bar)[XB_TMO])) break; if (_sp > XB_SPIN_CAP) { atomicAdd(&(bar)[XB_TMO], 1u); break; } } } } while (0)
struct XcdBarrier { unsigned* bar; unsigned x; volatile LAS unsigned* st; };
__device__ __forceinline__ XcdBarrier xcd_barrier_post(unsigned* bar, volatile LAS unsigned* st) {
    XcdBarrier b; b.bar = bar; b.x = xb_xcc_id(); b.st = st;
    if (__builtin_amdgcn_workitem_id_x() == 0) (void)xb_add(&bar[XB_XCNT(b.x)], 1u);
    return b;
}
__device__ __forceinline__ void xcd_barrier_complete(unsigned* bar, unsigned x, unsigned& nloc, unsigned& nx) {
    const unsigned G = gridDim.x * gridDim.y * gridDim.z;
    unsigned sum, cnt, mine, sp = 0u;
    for (;;) {
        sum = 0u; cnt = 0u; mine = 0u;
#pragma unroll
        for (unsigned j = 0; j < 16; ++j) { const unsigned c = xb_ld(&bar[XB_XCNT(j)]); sum += c; cnt += (c > 0u) ? 1u : 0u; mine = (j == x) ? c : mine; }
        if (sum == G) break;
        __builtin_amdgcn_s_sleep(1);
        if ((++sp & 255u) == 0u) { if (xb_ld(&bar[XB_TMO])) break; if (sp > XB_SPIN_CAP) { atomicAdd(&bar[XB_TMO], 1u); break; } }
    }
    nloc = mine > 0u ? mine : 1u; nx = cnt > 0u ? cnt : 1u;
}
__device__ __forceinline__ void xcd_barrier(const XcdBarrier& b) {
    asm volatile("s_waitcnt vmcnt(0)" ::: "memory");
    __syncthreads();
    if (__builtin_amdgcn_workitem_id_x() == 0) {
        unsigned* bar = b.bar;
        __builtin_amdgcn_s_waitcnt(0);
        unsigned nloc = b.st[0], nx = b.st[1];
        if (nloc == 0u) { xcd_barrier_complete(bar, b.x, nloc, nx); b.st[0] = nloc; b.st[1] = nx; }
        const unsigned old = xb_add(&bar[XB_XSUB(b.x)], 1u);
        const unsigned gen = old / nloc;
        if (old + 1u == (gen + 1u) * nloc) {
            __builtin_amdgcn_fence(__ATOMIC_RELEASE, "agent");
            asm volatile("s_waitcnt vmcnt(0)" ::: "memory");
            const unsigned og = xb_add(&bar[XB_TOP], 1u);
            const unsigned tg = og / nx;
            if (og + 1u == (tg + 1u) * nx) xb_add(&bar[XB_TOPGEN], 1u);
            else XB_SPIN(xb_ld(&bar[XB_TOPGEN]) == tg, bar);
            __builtin_amdgcn_fence(__ATOMIC_ACQUIRE, "agent");
            xb_add(&bar[XB_XGEN(b.x)], 1u);
            asm volatile("s_waitcnt vmcnt(0)" ::: "memory");
        } else {
            XB_SPIN(xb_ld(&bar[XB_XGEN(b.x)]) == gen, bar);
            __builtin_amdgcn_fence(__ATOMIC_ACQUIRE, "agent");
            asm volatile("s_waitcnt vmcnt(0)" ::: "memory");
        }
    }
    __syncthreads();
}

#ifndef PHMASK
#define PHMASK 0xFFFFF
#endif
constexpr int PH_PER_LAYER = 10, NPHASE = 1 + 2 * PH_PER_LAYER + 1;

__global__ void __launch_bounds__(NT, 2) mega(Params pv, int ph_lo, int ph_hi) {
    cg::grid_group grid = cg::this_grid();
    XcdBarrier xb;
    {
        SMEM_DECL;
        volatile LAS unsigned* st = (volatile LAS unsigned*)((LAS unsigned char*)smem + 131072);
        if (__builtin_amdgcn_workitem_id_x() < 4) st[__builtin_amdgcn_workitem_id_x()] = 0u;
        __syncthreads();
        xb = xcd_barrier_post((unsigned*)(pv.ws + WS_BAR), st);
    }
    for (int ph = ph_lo; ph < ph_hi; ++ph) {
        if (ph == ph_lo + 1) grid.sync();
        else if (ph > ph_lo) xcd_barrier(xb);
        KP p = opaque_kp();
        unsigned char* ws = p->ws;
        bf16_t* XB = (bf16_t*)(ws + WS_XB); bf16_t* Ub = (bf16_t*)p->out;
        bf16_t* HB = (bf16_t*)(ws + WS_HB); bf16_t* PROJ = HB;
        bf16_t* CAT = (bf16_t*)(ws + WS_CAT);
        bf16_t* OG = (bf16_t*)(ws + WS_OG);
        float* LSE = (float*)(ws + WS_LSE);
        float* ST = (float*)(ws + WS_ST);
        float* DEC = (float*)(ws + WS_DEC);
        float* DT = (float*)(ws + WS_DT);
        float* X = p->out;
        float* PART = (float*)(ws + WS_PART);
        if (ph == 0) {
            weights_phase(p);
            cache_copy_phase(p);
            copy_phase(p, XB, PART);
            continue;
        }
        if (ph == NPHASE - 1) { final_phase(p, XB, X); continue; }
        const int L = (ph - 1) / PH_PER_LAYER, q = (ph - 1) % PH_PER_LAYER;
        unsigned char* wb = ws + (size_t)L * LAYER_W;
        const bf16_t* XBs = XB + (size_t)MP * DM; const bf16_t* Xs = XBs;
#ifndef REPMASK
#define REPMASK 0
#endif
        for (int rep = 0; rep < 1 + ((REPMASK >> q) & 1); ++rep)
        switch (q) {
        case 0: case 8: { EpiGU e{HB, PART}; const bf16_t* W = (const bf16_t*)(wb + (q == 0 ? OFF_WGU1 : OFF_WGU2)); gemm_phase_cont(XB, W, 1024, MP / 256, 22, e);
            for (int t = blockIdx.x; t < 176; t += gridDim.x) { const int c0 = t * 16, r0 = (c0 >> 7) * 256 + (c0 & 127); FinGU f{HB, c0}; skinny_task<2, true, 4>(XBs, DM, W, 1024, r0, r0 + 128, Xs, f); } } break;
        case 1: case 9: { EpiRes e{XB, PART, 0.5f}; const bf16_t* W = (const bf16_t*)(wb + (q == 1 ? OFF_WD1 : OFF_WD2)); gemm_phase_cont(HB, W, 2816, MP / 256, 4, e);
            for (int t = blockIdx.x; t < 64; t += gridDim.x) { FinRes f{XB, 0.5f, t * 16}; skinny_task<1, false, 11>(HB + (size_t)MP * DFF, DFF, W, 2816, t * 16, 0, nullptr, f); } } break;
        case 2: { EpiProj e{PROJ, NPROJ, PART}; const bf16_t* W = (const bf16_t*)(wb + OFF_WIN); gemm_phase_cont(XB, W, 1024, MP / 256, 10, e);
            for (int t = blockIdx.x; t < 160; t += gridDim.x) { FinProj f{PROJ, t * 16}; skinny_task<1, true, 4>(XBs, DM, W, 1024, t * 16, 0, Xs, f); } } break;
        case 3:
            prep_phase(p, L, PROJ, Ub, CAT, XB, PART, DT);
            for (int it = blockIdx.x; it < MS; it += gridDim.x) prep_sample_item(p, L, it, PROJ, Ub, CAT, XB, DT);
            break;
        case 4:
            {
                int it = blockIdx.x;
                for (; it < 160 + 512; it += gridDim.x) {
                    if (it < 128) sample_attn_item(p, L, it, PROJ, CAT);
                    else if (it < 160) sample_ssd_item(p, L, it - 128, PROJ, Ub, DT, CAT);
                    else s1_item(p, L, it - 160, Ub, DT, ST, DEC);
                }
                attn_items(it - 160 - 512, gridDim.x, PROJ, OG, LSE);
            }
            break;
        case 5: scan_phase(p, L, ST, DEC); break;
        case 6:
            for (int it = blockIdx.x; it < 1024; it += gridDim.x) {
                if (it < 512) s3_item(p, L, it, Ub, PROJ, DT, ST, CAT);
                else combine_item(it - 512, OG, LSE, CAT);
            }
            break;
        case 7: { EpiRes e{XB, PART, 1.0f}; const bf16_t* W = (const bf16_t*)(wb + OFF_WOUT); gemm_phase_cont(CAT, W, 1024, MP / 256, 4, e);
            for (int t = blockIdx.x; t < 64; t += gridDim.x) { FinRes f{XB, 1.0f, t * 16}; skinny_task<1, false, 4>(CAT + (size_t)MP * DM, DM, W, 1024, t * 16, 0, nullptr, f); } } break;
        }
    }
}

constexpr int LDS_BYTES = 131072 + 64 + 4096 + 2048;

extern "C" void kernel_launch(void* const* d_in, const int* in_sizes, int n_in, void* d_out, int out_size, void* d_ws, size_t ws_size, hipStream_t stream) {
    static int grid = 0;
    if (grid == 0) {
        if (n_in != 27 || (size_t)out_size != O_END || ws_size < WS_END) {
            fprintf(stderr, "kernel_launch: unexpected shapes n_in %d out %d ws %zu (need %zu)\n", n_in, out_size, ws_size, (size_t)WS_END); grid = -1; return; }
        int dev = 0, cus = 0, per_cu = 0;
        hipGetDevice(&dev);
        hipDeviceGetAttribute(&cus, hipDeviceAttributeMultiprocessorCount, dev);
        if (hipFuncSetAttribute((const void*)mega, hipFuncAttributeMaxDynamicSharedMemorySize, LDS_BYTES) != hipSuccess) { fprintf(stderr, "hipFuncSetAttribute failed\n"); grid = -1; return; }
        hipOccupancyMaxActiveBlocksPerMultiprocessor(&per_cu, (const void*)mega, NT, LDS_BYTES);
        if (per_cu < 1) { fprintf(stderr, "occupancy query says %d blocks/CU\n", per_cu); per_cu = 1; }
        (void)hipGetLastError();
        grid = cus;
    }
    if (grid < 0) return;
    if (hipMemsetAsync((char*)d_ws + WS_BAR, 0, 16384, stream) != hipSuccess) { fprintf(stderr, "memset failed\n"); return; }
    Params p{};
    for (int i = 0; i < 27; ++i) p.in[i] = (const float*)d_in[i];
    p.out = (float*)d_out; p.ws = (unsigned char*)d_ws;
    int lo = 0, hi = NPHASE;
    void* args[] = {&p, &lo, &hi};
    hipError_t e = hipLaunchCooperativeKernel((const void*)mega, dim3(grid), dim3(NT), args, LDS_BYTES, stream);
    if (e != hipSuccess) fprintf(stderr, "cooperative launch failed: %s (grid %d)\n", hipGetErrorString(e), grid);
}
```

```cpp
#include <hip/hip_runtime.h>
#include <hip/hip_cooperative_groups.h>
#include <cstdio>
#include <cstdint>
namespace cg = cooperative_groups;

typedef unsigned short bf16_t;
typedef short bf16x8 __attribute__((ext_vector_type(8)));
typedef float f32x4 __attribute__((ext_vector_type(4)));

#define NT 512
constexpr int MP = 32768;
constexpr int MS = 32;
constexpr int MTOK = MP + MS;
constexpr int MPAD = 33024;
constexpr int DM = 1024, DFF = 2816, NPROJ = 2560, WINLD = 2568;
constexpr float EPS = 1e-6f;

constexpr size_t SZ_WGU = 5632ull * 1024 * 2, SZ_WD = 1024ull * 2816 * 2, SZ_WIN = 2560ull * 1024 * 2, SZ_WOUT = 1024ull * 1024 * 2;
constexpr size_t OFF_WGU1 = 0, OFF_WD1 = OFF_WGU1 + SZ_WGU, OFF_WIN = OFF_WD1 + SZ_WD, OFF_WOUT = OFF_WIN + SZ_WIN,
                 OFF_WGU2 = OFF_WOUT + SZ_WOUT, OFF_WD2 = OFF_WGU2 + SZ_WGU, LAYER_W = OFF_WD2 + SZ_WD;
constexpr size_t WS_XB = 2 * LAYER_W;
constexpr size_t WS_HB = WS_XB + (size_t)MPAD * 1024 * 2;
constexpr size_t WS_CAT = WS_HB + (size_t)MPAD * 2816 * 2;
constexpr size_t WS_OG = WS_CAT + (size_t)MPAD * 1024 * 2;
constexpr size_t WS_LSE = WS_OG + 3ull * MP * 256 * 2;
constexpr size_t WS_ST = WS_LSE + 3ull * MP * 4 * 4;
constexpr size_t WS_DEC = WS_ST + 256ull * 8 * 64 * 128 * 4;
constexpr size_t WS_DT = WS_DEC + 256 * 8 * 4;
constexpr size_t WS_PART = WS_DT + (size_t)MPAD * 8 * 4;
constexpr size_t WS_WDT = WS_PART + (size_t)MP * 16 * 4;
constexpr size_t WS_BAR = WS_WDT + 2 * 16 * 1024 * 2;
constexpr size_t WS_END = WS_BAR + 16384;

constexpr size_t O_Y = 0, O_POOLP = 33587200ull, O_POOLS = 33617920ull, O_KP = 33863680ull, O_KS = 38057984ull, O_VP = 71612416ull,
                 O_VS = 75806720ull, O_CONVP = 109361152ull, O_CONVS = 109385728ull, O_SSMP = 109582336ull, O_SSMS = 110106624ull,
                 O_END = 114300928ull;

struct Params { const float* in[27]; float* out; unsigned char* ws; };
enum { I_XP = 0, I_XS, I_CPOOL, I_CK, I_CV, I_SCONV, I_SSSM, I_F1N, I_F1G, I_F1U, I_F1D, I_MIXN, I_WIN, I_POOLW, I_POOLSC, I_CONVW, I_CONVB,
       I_DTB, I_ALOG, I_DSKIP, I_SSMN, I_WOUT, I_F2N, I_F2G, I_F2U, I_F2D, I_FINN };

typedef const __attribute__((address_space(4))) Params* KP;
__device__ __forceinline__ int otid() { int t = __builtin_amdgcn_workitem_id_x(); asm volatile("" : "+v"(t)); return t; }
__device__ __forceinline__ KP opaque_kp() { KP k = (KP)__builtin_amdgcn_kernarg_segment_ptr(); asm volatile("" : "+s"(k)); return k; }
__device__ __forceinline__ float bf2f(bf16_t v) { return __uint_as_float(((unsigned)v) << 16); }
__device__ __forceinline__ unsigned pk2(float lo, float hi) { unsigned r; asm("v_cvt_pk_bf16_f32 %0, %1, %2" : "=v"(r) : "v"(lo), "v"(hi)); return r; }
__device__ __forceinline__ bf16_t f2bf(float f) { return (bf16_t)(pk2(f, 0.f) & 0xffffu); }
__device__ __forceinline__ float lo16(unsigned u) { return __uint_as_float(u << 16); }
__device__ __forceinline__ float hi16(unsigned u) { return __uint_as_float(u & 0xffff0000u); }
__device__ __forceinline__ float silu(float x) { return x * __builtin_amdgcn_rcpf(1.f + __expf(-x)); }
__device__ __forceinline__ float wave_sum(float v) {
#pragma unroll
    for (int o = 32; o > 0; o >>= 1) v += __shfl_xor(v, o);
    return v;
}
__device__ __forceinline__ float wave_max(float v) {
#pragma unroll
    for (int o = 32; o > 0; o >>= 1) v = fmaxf(v, __shfl_xor(v, o));
    return v;
}
__device__ const float ROPE_INV[32] = {1.000000000e+00f, 7.498942018e-01f, 5.623413324e-01f, 4.216965139e-01f, 3.162277639e-01f, 2.371373773e-01f, 1.778279394e-01f, 1.333521456e-01f, 1.000000015e-01f, 7.498942316e-02f, 5.623413250e-02f, 4.216964915e-02f, 3.162277490e-02f, 2.371373773e-02f, 1.778279431e-02f, 1.333521400e-02f, 9.999999776e-03f, 7.498942316e-03f, 5.623413250e-03f, 4.216964822e-03f, 3.162277630e-03f, 2.371373819e-03f, 1.778279431e-03f, 1.333521446e-03f, 1.000000047e-03f, 7.498941850e-04f, 5.623413017e-04f, 4.216965172e-04f, 3.162277571e-04f, 2.371373703e-04f, 1.778279402e-04f, 1.333521504e-04f};
__device__ __forceinline__ float rope_inv(int i) { return ROPE_INV[i]; }
__device__ __forceinline__ void rope_cs(float ang, float& c, float& s) {
    const float k = rintf(ang * 0.15915494309189535f);
    float r = fmaf(-k, 6.28318548202514648f, ang); r = fmaf(-k, -1.74845553146951715e-07f, r);
    const float f = r * 0.15915494309189535f;
    s = __builtin_amdgcn_sinf(f); c = __builtin_amdgcn_cosf(f);
}
__device__ __forceinline__ uint4 zero4() { unsigned z; asm volatile("v_mov_b32 %0, 0" : "=v"(z)); uint4 r; r.x = z; r.y = z; r.z = z; r.w = z; return r; }
#define MFMA16(a, b, c) __builtin_amdgcn_mfma_f32_16x16x32_bf16((a), (b), (c), 0, 0, 0)
#define LDS_BARRIER() do { asm volatile("s_waitcnt lgkmcnt(0)" ::: "memory"); __builtin_amdgcn_s_barrier(); asm volatile("" ::: "memory"); } while (0)
#define SMEM_DECL extern __shared__ __attribute__((aligned(16))) unsigned char smem[]

constexpr int BM = 256, BK = 64, HALF = 128, HT = HALF * BK;
__device__ __forceinline__ int lds_byte(int r, int c) { int st = (r >> 4) * 2 + (c >> 5), rr = r & 15, cc = c & 31, ob = rr * 64 + cc * 2; return st * 1024 + (ob ^ (((ob >> 9) & 1) << 5)); }
__device__ __forceinline__ void stage_rc(int b, int& R, int& C) { int st = b / 1024, sb = b % 1024, swz = sb ^ (((sb >> 9) & 1) << 5); R = (st >> 1) * 16 + swz / 64; C = (st & 1) * 32 + (swz % 64) / 2; }

__device__ __forceinline__ void tile_of(int L, int nM, int nN, int& pm, int& pn) {
    const int nwg = nM * nN; int wgid = L;
    { const int q = nwg / 8, r = nwg % 8, xcd = wgid % 8, off = wgid / 8; wgid = (xcd < r ? xcd * (q + 1) : r * (q + 1) + (xcd - r) * q) + off; }
    const int nig = 8 * nN, gid = wgid / nig, fm = gid * 8, gsz = (nM - fm) < 8 ? (nM - fm) : 8;
    pm = fm + ((wgid % nig) % gsz); pn = (wgid % nig) / gsz;
}

#define LAS __attribute__((address_space(3)))
constexpr int HTB = HALF * BK * 2;
__device__ __forceinline__ float row_rstd(const float* PART, int row) {
    const float4* pp = (const float4*)(PART + (size_t)row * 16);
    const float4 a = pp[0], b = pp[1], c = pp[2], d = pp[3];
    const float ss = ((a.x + a.y) + (a.z + a.w)) + ((b.x + b.y) + (b.z + b.w)) + ((c.x + c.y) + (c.z + c.w)) + ((d.x + d.y) + (d.z + d.w));
    return rsqrtf(ss * (1.f / 1024.f) + EPS);
}
template <class Epi>
__device__ __forceinline__ void gemm_phase(const bf16_t* A, const bf16_t* Bt, const int K, const int nM, const int nN, const Epi& epi) {
    SMEM_DECL;
    LAS unsigned char* lds = (LAS unsigned char*)smem;
    const int tid = otid(), wid = __builtin_amdgcn_readfirstlane(tid >> 6), lane = tid & 63, wr = wid >> 2, wc = wid & 3, fr = lane & 15, fq = lane >> 4;
    const int nt = K / BK, ntiles = nM * nN;
    unsigned voff[2];
#pragma unroll
    for (int i = 0; i < 2; ++i) { int R, C; stage_rc(tid * 16 + i * 8192, R, C); voff[i] = (unsigned)(R * K + C) * 2u; }
    const size_t kstep = (size_t)(BK * 2), hstep = (size_t)HALF * K * 2;
    const unsigned ldsw = (unsigned)wid * 1024u;
    const int aoff = lds_byte(wr * 64 + fr, fq * 8), boff = lds_byte(wc * 32 + fr, fq * 8);
#define GSA(b, h) (((b) * 2 + (h)) * HTB)
#define GSB(b, h) ((4 + (b) * 2 + (h)) * HTB)
#define STAGE(bufoff, gbase) do { _Pragma("unroll") for (int _i = 0; _i < 2; ++_i) \
    __builtin_amdgcn_global_load_lds((const unsigned*)((const char*)(gbase) + voff[_i]), (LAS unsigned*)(lds + (bufoff) + ldsw + _i * 8192), 16, 0, 0); } while (0)
#define LDA(dst, b, h) do { _Pragma("unroll") for (int m = 0; m < 4; ++m) _Pragma("unroll") for (int k = 0; k < 2; ++k) dst[m][k] = *(const LAS bf16x8*)(lds + GSA(b, h) + aoff + m * 2048 + k * 1024); } while (0)
#define LDB(dst, b, h) do { _Pragma("unroll") for (int n = 0; n < 2; ++n) _Pragma("unroll") for (int k = 0; k < 2; ++k) dst[n][k] = *(const LAS bf16x8*)(lds + GSB(b, h) + boff + n * 2048 + k * 1024); } while (0)
#define MMA(ai, bj, At_, Bt_) do { __builtin_amdgcn_s_setprio(1); _Pragma("unroll") for (int m = 0; m < 4; ++m) _Pragma("unroll") for (int n = 0; n < 2; ++n) _Pragma("unroll") for (int k = 0; k < 2; ++k) \
      acc[ai][bj][m][n] = __builtin_amdgcn_mfma_f32_16x16x32_bf16(Bt_[n][k], At_[m][k], acc[ai][bj][m][n], 0, 0, 0); \
    __builtin_amdgcn_s_setprio(0); } while (0)
#define WAIT_V(n) asm volatile("s_waitcnt vmcnt(" #n ")" ::: "memory")
#define WAIT_L(n) asm volatile("s_waitcnt lgkmcnt(" #n ")" ::: "memory")
#define BAR __builtin_amdgcn_s_barrier()
#define SCHED __builtin_amdgcn_sched_barrier(0)
    int L = blockIdx.x;
    WAIT_V(0); __syncthreads();
    if (L >= ntiles) return;
    int pm, pn; tile_of(L, nM, nN, pm, pn);
    const char* cA = (const char*)A + (size_t)(pm * 256) * K * 2;
    const char* cB = (const char*)Bt + (size_t)(pn * 256) * K * 2;
    STAGE(GSB(0, 0), cB); STAGE(GSA(0, 0), cA); STAGE(GSB(0, 1), cB + hstep); STAGE(GSA(0, 1), cA + hstep);
    float* rsb = (float*)(smem + 131072 + 64 + 4096);
    int rbuf = 0;
    if (Epi::NEEDS_RS && tid < 256) rsb[tid] = row_rstd(epi.PART, pm * 256 + tid);
    bool first = true;
    for (;;) {
        f32x4 acc[2][2][4][2];
#pragma unroll
        for (int a = 0; a < 2; ++a)
#pragma unroll
            for (int b = 0; b < 2; ++b)
#pragma unroll
                for (int m = 0; m < 4; ++m)
#pragma unroll
                    for (int n = 0; n < 2; ++n) acc[a][b][m][n] = (f32x4){0.f, 0.f, 0.f, 0.f};
        bf16x8 At[4][2], B0[2][2], B1[2][2];
        if (wr == 1) BAR;
        if (first) { WAIT_V(4); } else { asm volatile("s_waitcnt vmcnt(%0)" :: "n"(Epi::NST) : "memory"); }
        BAR;
        STAGE(GSB(1, 0), cB + kstep); STAGE(GSA(1, 0), cA + kstep); STAGE(GSB(1, 1), cB + hstep + kstep);
        WAIT_V(6); BAR;
        for (int t = 0; t < nt - 2; t += 2) {
            const char* a1 = cA + (size_t)(t + 1) * kstep; const char* a2 = a1 + kstep; const char* a3 = a2 + kstep;
            const char* b2 = cB + (size_t)(t + 2) * kstep; const char* b3 = b2 + kstep;
            LDB(B0, 0, 0); SCHED; LDA(At, 0, 0); STAGE(GSA(1, 1), a1 + hstep);
            WAIT_L(8); BAR; WAIT_L(0); MMA(0, 0, At, B0); BAR; SCHED;
            LDB(B1, 0, 1); STAGE(GSB(0, 0), b2);
            BAR; WAIT_L(0); MMA(0, 1, At, B1); BAR;
            LDA(At, 0, 1); STAGE(GSA(0, 0), a2);
            BAR; WAIT_L(0); MMA(1, 0, At, B0); BAR; SCHED;
            STAGE(GSB(0, 1), b2 + hstep);
            WAIT_V(6); BAR; MMA(1, 1, At, B1); BAR;
            LDB(B0, 1, 0); SCHED; LDA(At, 1, 0); STAGE(GSA(0, 1), a2 + hstep);
            WAIT_L(8); BAR; WAIT_L(0); MMA(0, 0, At, B0); BAR; SCHED;
            LDB(B1, 1, 1); STAGE(GSB(1, 0), b3);
            BAR; WAIT_L(0); MMA(0, 1, At, B1); BAR;
            LDA(At, 1, 1); STAGE(GSA(1, 0), a3);
            BAR; WAIT_L(0); MMA(1, 0, At, B0); BAR; SCHED;
            STAGE(GSB(1, 1), b3 + hstep);
            WAIT_V(6); BAR; MMA(1, 1, At, B1); BAR;
        }
        { LDB(B0, 0, 0); LDA(At, 0, 0); STAGE(GSA(1, 1), cA + (size_t)(nt - 1) * kstep + hstep);
          BAR; WAIT_L(0); MMA(0, 0, At, B0); BAR;
          LDB(B1, 0, 1); BAR; WAIT_L(0); MMA(0, 1, At, B1); BAR;
          LDA(At, 0, 1); WAIT_V(4); BAR; WAIT_L(0); MMA(1, 0, At, B0); MMA(1, 1, At, B1); BAR; }
        { LDB(B0, 1, 0); LDA(At, 1, 0); WAIT_V(2); BAR; WAIT_L(0); MMA(0, 0, At, B0); BAR;
          LDB(B1, 1, 1); WAIT_V(0); BAR; WAIT_L(0); MMA(0, 1, At, B1); BAR;
          LDA(At, 1, 1); BAR; WAIT_L(0); MMA(1, 0, At, B0); MMA(1, 1, At, B1); BAR; }
        if (wr == 0) BAR;
        const int brow = pm * 256, bcol = pn * 256;
        L += gridDim.x;
        const bool more = L < ntiles;
        if (more) {
            tile_of(L, nM, nN, pm, pn);
            cA = (const char*)A + (size_t)(pm * 256) * K * 2; cB = (const char*)Bt + (size_t)(pn * 256) * K * 2;
            STAGE(GSB(0, 0), cB); STAGE(GSA(0, 0), cA); STAGE(GSB(0, 1), cB + hstep); STAGE(GSA(0, 1), cA + hstep);
            SCHED;
        }
        float rs_next = 0.f;
        if (Epi::NEEDS_RS && more && tid < 256) rs_next = row_rstd(epi.PART, pm * 256 + tid);
        epi(acc, brow, bcol, wr, wc, fr, fq, rsb + rbuf * 256);
        SCHED;
        if (!more) break;
        if (Epi::NEEDS_RS && tid < 256) rsb[(rbuf ^ 1) * 256 + tid] = rs_next;
        rbuf ^= 1;
        first = false;
    }
    asm volatile("s_waitcnt vmcnt(0)" ::: "memory");
    __syncthreads();
}

template <class Epi>
__device__ __forceinline__ void gemm_phase_cont(const bf16_t* A, const bf16_t* Bt, const int K, const int nM, const int nN, const Epi& epi) {
    SMEM_DECL;
    LAS unsigned char* lds = (LAS unsigned char*)smem;
    const int tid = otid(), wid = __builtin_amdgcn_readfirstlane(tid >> 6), lane = tid & 63, wr = wid >> 2, wc = wid & 3, fr = lane & 15, fq = lane >> 4;
    const int nt = K / BK, ntiles = nM * nN;
    unsigned voff[2];
#pragma unroll
    for (int i = 0; i < 2; ++i) { int R, C; stage_rc(tid * 16 + i * 8192, R, C); voff[i] = (unsigned)(R * K + C) * 2u; }
    const size_t kstep = (size_t)(BK * 2), hstep = (size_t)HALF * K * 2;
    const unsigned ldsw = (unsigned)wid * 1024u;
    const int aoff = lds_byte(wr * 64 + fr, fq * 8), boff = lds_byte(wc * 32 + fr, fq * 8);
    int L = blockIdx.x;
    WAIT_V(0); __syncthreads();
    if (L >= ntiles) return;
    int pm, pn; tile_of(L, nM, nN, pm, pn);
    const char* cA = (const char*)A + (size_t)(pm * 256) * K * 2;
    const char* cB = (const char*)Bt + (size_t)(pn * 256) * K * 2;
    f32x4 acc[2][2][4][2];
#pragma unroll
    for (int a = 0; a < 2; ++a)
#pragma unroll
        for (int b = 0; b < 2; ++b)
#pragma unroll
            for (int m = 0; m < 4; ++m)
#pragma unroll
                for (int n = 0; n < 2; ++n) acc[a][b][m][n] = (f32x4){0.f, 0.f, 0.f, 0.f};
    bf16x8 At[4][2], B0[2][2], B1[2][2];
    float* rsb = (float*)(smem + 131072 + 64 + 4096);
    int rbuf = 0;
    float rs0 = 0.f;
    if (Epi::NEEDS_RS && tid < 256) rs0 = row_rstd(epi.PART, pm * 256 + tid);
    STAGE(GSB(0, 0), cB); STAGE(GSB(0, 1), cB + hstep); STAGE(GSA(0, 0), cA); STAGE(GSA(0, 1), cA + hstep);
    if (wr == 1) BAR;
    WAIT_V(2); BAR;
    STAGE(GSB(1, 0), cB + kstep); STAGE(GSA(1, 0), cA + kstep); STAGE(GSB(1, 1), cB + hstep + kstep);
    WAIT_V(6); BAR;
    if (Epi::NEEDS_RS && tid < 256) rsb[tid] = rs0;
    for (;;) {
        const int Ln = L + gridDim.x; const bool has_next = Ln < ntiles;
        int npm = pm, npn = pn; if (has_next) tile_of(Ln, nM, nN, npm, npn);
        const char* nA = (const char*)A + (size_t)(npm * 256) * K * 2; const char* nB = (const char*)Bt + (size_t)(npn * 256) * K * 2;
        for (int t = 0; t < nt; t += 2) {
            const bool last = (t == nt - 2);
            const char* a1 = cA + (size_t)(t + 1) * kstep;
            const char* a2 = last ? nA : cA + (size_t)(t + 2) * kstep; const char* b2 = last ? nB : cB + (size_t)(t + 2) * kstep;
            const char* a3 = a2 + kstep; const char* b3 = b2 + kstep;
            LDB(B0, 0, 0); LDB(B1, 0, 1); SCHED; LDA(At, 0, 0); STAGE(GSA(1, 1), a1 + hstep);
            WAIT_V(8); WAIT_L(0); BAR; MMA(0, 0, At, B0); MMA(0, 1, At, B1); BAR; SCHED;
            LDA(At, 0, 1); STAGE(GSB(0, 0), b2); STAGE(GSB(0, 1), b2 + hstep); STAGE(GSA(0, 0), a2);
            WAIT_V(8); WAIT_L(0); BAR; MMA(1, 0, At, B0); MMA(1, 1, At, B1); BAR; SCHED;
            LDB(B0, 1, 0); LDB(B1, 1, 1); SCHED; LDA(At, 1, 0); STAGE(GSA(0, 1), a2 + hstep);
            WAIT_V(8); WAIT_L(0); BAR; MMA(0, 0, At, B0); MMA(0, 1, At, B1); BAR; SCHED;
            LDA(At, 1, 1); STAGE(GSB(1, 0), b3); STAGE(GSB(1, 1), b3 + hstep); STAGE(GSA(1, 0), a3);
            WAIT_V(8); WAIT_L(0); BAR; MMA(1, 0, At, B0); MMA(1, 1, At, B1); BAR; SCHED;
        }
        if (wr == 0) BAR;
        float rs_next = 0.f;
        if (Epi::NEEDS_RS && has_next && tid < 256) rs_next = row_rstd(epi.PART, npm * 256 + tid);
        epi(acc, pm * 256, pn * 256, wr, wc, fr, fq, rsb + rbuf * 256);
        SCHED;
        if (!has_next) break;
        if (Epi::NEEDS_RS && tid < 256) rsb[(rbuf ^ 1) * 256 + tid] = rs_next;
        rbuf ^= 1;
#pragma unroll
        for (int a = 0; a < 2; ++a)
#pragma unroll
            for (int b = 0; b < 2; ++b)
#pragma unroll
                for (int m = 0; m < 4; ++m)
#pragma unroll
                    for (int n = 0; n < 2; ++n) acc[a][b][m][n] = (f32x4){0.f, 0.f, 0.f, 0.f};
        L = Ln; pm = npm; pn = npn; cA = nA; cB = nB;
        if (wr == 1) BAR;
    }
    WAIT_V(0);
    BAR;
    __syncthreads();
}

struct EpiGU {
    static constexpr int NST = 16; static constexpr bool NEEDS_RS = true;
    bf16_t* __restrict__ H; const float* __restrict__ PART;
    __device__ __forceinline__ void operator()(const f32x4 (&acc)[2][2][4][2], int brow, int bcol, int wr, int wc, int fr, int fq, const float* rsl) const {
        const int cbase = (bcol >> 8) * 128 + wc * 32 + fq * 8;
        float rs[2][4];
#pragma unroll
        for (int ai = 0; ai < 2; ++ai)
#pragma unroll
            for (int m = 0; m < 4; ++m) rs[ai][m] = rsl[ai * 128 + wr * 64 + m * 16 + fr];
#pragma unroll
        for (int ai = 0; ai < 2; ++ai)
#pragma unroll
            for (int m = 0; m < 4; ++m) {
                const int row = brow + ai * 128 + wr * 64 + m * 16 + fr;
                const f32x4 g0 = acc[ai][0][m][0] * rs[ai][m], u0 = acc[ai][1][m][0] * rs[ai][m], g1 = acc[ai][0][m][1] * rs[ai][m], u1 = acc[ai][1][m][1] * rs[ai][m];
                uint4 o; o.x = pk2(silu(g0[0]) * u0[0], silu(g0[1]) * u0[1]); o.y = pk2(silu(g0[2]) * u0[2], silu(g0[3]) * u0[3]);
                o.z = pk2(silu(g1[0]) * u1[0], silu(g1[1]) * u1[1]); o.w = pk2(silu(g1[2]) * u1[2], silu(g1[3]) * u1[3]);
                *(uint4*)(H + (size_t)row * DFF + cbase) = o;
            }
    }
};
struct EpiRes {
    static constexpr int NST = 16; static constexpr bool NEEDS_RS = false;
    bf16_t* XB; float* PART; float scale;
    __device__ __forceinline__ void operator()(const f32x4 (&acc)[2][2][4][2], int brow, int bcol, int wr, int wc, int fr, int fq, const float*) const {
        uint4 v[2][4][2];
#pragma unroll
        for (int ai = 0; ai < 2; ++ai)
#pragma unroll
            for (int m = 0; m < 4; ++m)
#pragma unroll
                for (int bj = 0; bj < 2; ++bj)
                    v[ai][m][bj] = *(const uint4*)(XB + (size_t)(brow + ai * 128 + wr * 64 + m * 16 + fr) * DM + bcol + bj * 128 + wc * 32 + fq * 8);
#pragma unroll
        for (int ai = 0; ai < 2; ++ai)
#pragma unroll
            for (int m = 0; m < 4; ++m) {
                const int row = brow + ai * 128 + wr * 64 + m * 16 + fr;
                float ss = 0.f;
#pragma unroll
                for (int bj = 0; bj < 2; ++bj) {
                    const uint4 xv = v[ai][m][bj]; const f32x4 a0 = acc[ai][bj][m][0], a1 = acc[ai][bj][m][1];
                    uint4 o; o.x = pk2(lo16(xv.x) + scale * a0[0], hi16(xv.x) + scale * a0[1]); o.y = pk2(lo16(xv.y) + scale * a0[2], hi16(xv.y) + scale * a0[3]);
                    o.z = pk2(lo16(xv.z) + scale * a1[0], hi16(xv.z) + scale * a1[1]); o.w = pk2(lo16(xv.w) + scale * a1[2], hi16(xv.w) + scale * a1[3]);
                    *(uint4*)(XB + (size_t)row * DM + bcol + bj * 128 + wc * 32 + fq * 8) = o;
                    const float r0 = lo16(o.x), r1 = hi16(o.x), r2 = lo16(o.y), r3 = hi16(o.y), r4 = lo16(o.z), r5 = hi16(o.z), r6 = lo16(o.w), r7 = hi16(o.w);
                    ss += (r0 * r0 + r1 * r1) + (r2 * r2 + r3 * r3) + (r4 * r4 + r5 * r5) + (r6 * r6 + r7 * r7);
                }
                ss += __shfl_xor(ss, 16); ss += __shfl_xor(ss, 32);
                if (fq == 0) PART[(size_t)row * 16 + (bcol >> 8) * 4 + wc] = ss;
            }
    }
};
struct EpiProj {
    static constexpr int NST = 32; static constexpr bool NEEDS_RS = true;
    bf16_t* __restrict__ P; int ld; const float* __restrict__ PART;
    __device__ __forceinline__ void operator()(const f32x4 (&acc)[2][2][4][2], int brow, int bcol, int wr, int wc, int fr, int fq, const float* rsl) const {
        float rs[2][4];
#pragma unroll
        for (int ai = 0; ai < 2; ++ai)
#pragma unroll
            for (int m = 0; m < 4; ++m) rs[ai][m] = rsl[ai * 128 + wr * 64 + m * 16 + fr];
#pragma unroll
        for (int ai = 0; ai < 2; ++ai)
#pragma unroll
            for (int m = 0; m < 4; ++m) {
                const int row = brow + ai * 128 + wr * 64 + m * 16 + fr;
#pragma unroll
                for (int bj = 0; bj < 2; ++bj) {
                    const f32x4 a0 = acc[ai][bj][m][0] * rs[ai][m], a1 = acc[ai][bj][m][1] * rs[ai][m];
                    uint4 o; o.x = pk2(a0[0], a0[1]); o.y = pk2(a0[2], a0[3]); o.z = pk2(a1[0], a1[1]); o.w = pk2(a1[2], a1[3]);
                    *(uint4*)(P + (size_t)row * ld + bcol + bj * 128 + wc * 32 + fq * 8) = o;
                }
            }
    }
};

template <int NB, bool RS, int NKS, class Fin>
__device__ __forceinline__ void skinny_task(const bf16_t* __restrict__ A, int lda, const bf16_t* __restrict__ Bt, int K, int brow0, int brow1, const bf16_t* Xs, const Fin& fin) {
    SMEM_DECL;
    float* red = (float*)smem;
    float* rsd = red + 8 * NB * 2 * 64 * 4;
    const int tid = otid(), lane = tid & 63, w = tid >> 6, fr = lane & 15, fq = lane >> 4;
    const int kw = K >> 3;
    f32x4 acc[NB][2];
#pragma unroll
    for (int nb = 0; nb < NB; ++nb) { acc[nb][0] = (f32x4){0.f, 0.f, 0.f, 0.f}; acc[nb][1] = (f32x4){0.f, 0.f, 0.f, 0.f}; }
    __syncthreads();
    float rsv[4];
    if (RS) {
#pragma unroll
        for (int rr = 0; rr < 4; ++rr) {
            const bf16_t* xr = Xs + (size_t)(w * 4 + rr) * DM;
            float ss = 0.f;
#pragma unroll
            for (int i = 0; i < 2; ++i) { const uint4 v = *(const uint4*)(xr + i * 512 + lane * 8);
                ss += lo16(v.x) * lo16(v.x) + hi16(v.x) * hi16(v.x) + lo16(v.y) * lo16(v.y) + hi16(v.y) * hi16(v.y) + lo16(v.z) * lo16(v.z) + hi16(v.z) * hi16(v.z) + lo16(v.w) * lo16(v.w) + hi16(v.w) * hi16(v.w); }
            rsv[rr] = ss;
        }
    }
    {
        bf16x8 a0[NKS], a1[NKS], b0[NKS], b1[NKS];
#pragma unroll
        for (int ks = 0; ks < NKS; ++ks) {
            const int k0 = w * kw + ks * 32 + fq * 8;
            a0[ks] = *(const bf16x8*)(A + (size_t)fr * lda + k0); a1[ks] = *(const bf16x8*)(A + (size_t)(16 + fr) * lda + k0);
            b0[ks] = *(const bf16x8*)(Bt + (size_t)(brow0 + fr) * K + k0);
            if (NB == 2) b1[ks] = *(const bf16x8*)(Bt + (size_t)(brow1 + fr) * K + k0);
        }
#pragma unroll
        for (int ks = 0; ks < NKS; ++ks) {
            acc[0][0] = MFMA16(b0[ks], a0[ks], acc[0][0]); acc[0][1] = MFMA16(b0[ks], a1[ks], acc[0][1]);
            if (NB == 2) { acc[NB - 1][0] = MFMA16(b1[ks], a0[ks], acc[NB - 1][0]); acc[NB - 1][1] = MFMA16(b1[ks], a1[ks], acc[NB - 1][1]); }
        }
    }
    if (RS) {
#pragma unroll
        for (int rr = 0; rr < 4; ++rr) { const float ss = wave_sum(rsv[rr]); if (lane == 0) rsd[w * 4 + rr] = rsqrtf(ss * (1.f / 1024.f) + EPS); }
    }
#pragma unroll
    for (int nb = 0; nb < NB; ++nb)
#pragma unroll
        for (int mt = 0; mt < 2; ++mt) { float4 v; v.x = acc[nb][mt][0]; v.y = acc[nb][mt][1]; v.z = acc[nb][mt][2]; v.w = acc[nb][mt][3];
            *(float4*)(red + (((w * NB + nb) * 2 + mt) * 64 + lane) * 4) = v; }
    __syncthreads();
    {
        const int mt = tid >> 8, ln = (tid >> 2) & 63, jj = tid & 3;
        float v0 = 0.f, v1 = 0.f;
#pragma unroll
        for (int ww = 0; ww < 8; ++ww) {
            v0 += red[(((ww * NB + 0) * 2 + mt) * 64 + ln) * 4 + jj];
            if (NB == 2) v1 += red[(((ww * NB + NB - 1) * 2 + mt) * 64 + ln) * 4 + jj];
        }
        const float rs = RS ? rsd[mt * 16 + (ln & 15)] : 1.f;
        fin(mt * 16 + (ln & 15), (ln >> 4) * 4 + jj, v0 * rs, v1 * rs);
    }
}

struct FinGU { bf16_t* H; int c0; __device__ __forceinline__ void operator()(int m, int j, float g, float u) const { const int col = (c0 & ~31) + 8 * (j >> 2) + 4 * ((c0 >> 4) & 1) + (j & 3); H[(size_t)(MP + m) * DFF + col] = f2bf(silu(g) * u); } };
struct FinRes { bf16_t* XB; float scale; int c0; __device__ __forceinline__ void operator()(int m, int j, float v, float) const { const size_t o = (size_t)(MP + m) * DM + (c0 & ~31) + 8 * (j >> 2) + 4 * ((c0 >> 4) & 1) + (j & 3); XB[o] = f2bf(bf2f(XB[o]) + scale * v); } };
struct FinProj { bf16_t* P; int c0; __device__ __forceinline__ void operator()(int m, int j, float v, float) const { const int col = (c0 & ~31) + 8 * (j >> 2) + 4 * ((c0 >> 4) & 1) + (j & 3); P[(size_t)(MP + m) * NPROJ + col] = f2bf(v); } };

__device__ __forceinline__ void transpose_tile(const float* __restrict__ src, int ldn, int K, int k0, int c0, bf16_t* __restrict__ dst, int drow0, const float* __restrict__ gk, bool perm) {
    SMEM_DECL;
    float* tile = (float*)smem;
    const int tid = otid();
    __syncthreads();
    {
        float4 v[8];
#pragma unroll
        for (int r = 0; r < 8; ++r) { const int id = tid + r * NT, k = id >> 4, n4 = (id & 15) * 4; v[r] = *(const float4*)(src + (size_t)(k0 + k) * ldn + c0 + n4); }
#pragma unroll
        for (int r = 0; r < 8; ++r) { const int id = tid + r * NT, k = id >> 4, n4 = (id & 15) * 4; const float gs = gk ? gk[k0 + k] : 1.f;
            float* t = tile + k * 65 + n4; t[0] = v[r].x * gs; t[1] = v[r].y * gs; t[2] = v[r].z * gs; t[3] = v[r].w * gs; }
    }
    __syncthreads();
#pragma unroll
    for (int r = 0; r < 4; ++r) {
        const int id = tid + r * NT, a = id & 3, n16 = (id >> 2) & 15, rest = id >> 6, n = (rest & 3) * 16 + n16, kc = (rest >> 2) * 4 + a;
        const int c32 = n & 31, nd = perm ? (n & ~31) + 16 * ((c32 >> 2) & 1) + 4 * (c32 >> 3) + (c32 & 3) : n;
        const float* t = tile + (8 * kc) * 65 + n;
        uint4 o; o.x = pk2(t[0], t[65]); o.y = pk2(t[130], t[195]); o.z = pk2(t[260], t[325]); o.w = pk2(t[390], t[455]);
        *(uint4*)(dst + (size_t)(drow0 + nd) * K + k0 + 8 * kc) = o;
    }
}

__device__ void weights_phase(KP p) {
    for (int it = blockIdx.x; it < 2 * 1280; it += gridDim.x) {
        const int L = it / 1280; int r = it % 1280;
        unsigned char* wb = p->ws + (size_t)L * LAYER_W;
        if (r < 528 || r >= 752) {
            const bool second = r >= 752; if (second) r -= 752;
            const float* G = (second ? p->in[I_F2G] : p->in[I_F1G]) + (size_t)L * 1024 * 2816;
            const float* U = (second ? p->in[I_F2U] : p->in[I_F1U]) + (size_t)L * 1024 * 2816;
            const float* D = (second ? p->in[I_F2D] : p->in[I_F1D]) + (size_t)L * 2816 * 1024;
            bf16_t* wgu = (bf16_t*)(wb + (second ? OFF_WGU2 : OFF_WGU1));
            bf16_t* wd = (bf16_t*)(wb + (second ? OFF_WD2 : OFF_WD1));
            if (r < 352) { const bool up = r >= 176; if (up) r -= 176; const int kt = r / 44, nt = r % 44, c0 = nt * 64;
                transpose_tile(up ? U : G, 2816, 1024, kt * 256, c0, wgu, (c0 >> 7) * 256 + (c0 & 127) + (up ? 128 : 0), (second ? p->in[I_F2N] : p->in[I_F1N]) + L * 1024, true); }
            else { r -= 352; const int kt = r / 16, nt = r % 16; transpose_tile(D, 1024, 2816, kt * 256, nt * 64, wd, nt * 64, nullptr, true); }
        } else if (r < 688) { r -= 528; const int kt = r / 40, nt = r % 40;
            transpose_tile(p->in[I_WIN] + (size_t)L * 1024 * WINLD, WINLD, 1024, kt * 256, nt * 64, (bf16_t*)(wb + OFF_WIN), nt * 64, p->in[I_MIXN] + L * 1024, true);
        } else { r -= 688; const int kt = r / 16, nt = r % 16;
            transpose_tile(p->in[I_WOUT] + (size_t)L * 1024 * 1024, 1024, 1024, kt * 256, nt * 64, (bf16_t*)(wb + OFF_WOUT), nt * 64, nullptr, true); }
    }
    for (int it = blockIdx.x; it < 2; it += gridDim.x) {
        const int L = it; bf16_t* wdt = (bf16_t*)(p->ws + WS_WDT) + (size_t)L * 16 * 1024;
        for (int e = otid(); e < 16 * 1024; e += NT) { const int h = e >> 10, k = e & 1023;
            wdt[e] = h < 8 ? f2bf(p->in[I_WIN][((size_t)L * 1024 + k) * WINLD + 2560 + h] * p->in[I_MIXN][L * 1024 + k]) : (bf16_t)0; }
    }
    __syncthreads();
}

__device__ void cache_copy_phase(KP p) {
    constexpr unsigned per = 2047u * 256u / 4u;
    constexpr unsigned total = 128u * per;
    const unsigned stride = gridDim.x * NT;
    const float* ck = p->in[I_CK]; const float* cv = p->in[I_CV]; float* out = p->out;
#define CC_IDX(j) unsigned i##j = ib + (j) * stride; i##j = i##j < total ? i##j : total - 1u; \
    const unsigned seg##j = i##j / per, e##j = i##j % per, kv##j = seg##j >> 6, ln##j = seg##j & 63u; \
    const float4* s##j = (const float4*)((kv##j ? cv : ck) + (size_t)ln##j * 2048 * 256 + 256) + e##j; \
    float4* d##j = (float4*)(out + (kv##j ? O_VS : O_KS) + (size_t)ln##j * 2048 * 256) + e##j;
    for (unsigned ib = blockIdx.x * NT + otid(); ib < total; ib += 8u * stride) {
        CC_IDX(0) CC_IDX(1) CC_IDX(2) CC_IDX(3) CC_IDX(4) CC_IDX(5) CC_IDX(6) CC_IDX(7)
        const float4 v0 = *s0, v1 = *s1, v2 = *s2, v3 = *s3, v4 = *s4, v5 = *s5, v6 = *s6, v7 = *s7;
        *d0 = v0; *d1 = v1; *d2 = v2; *d3 = v3; *d4 = v4; *d5 = v5; *d6 = v6; *d7 = v7;
    }
#undef CC_IDX
}

__device__ void copy_phase(KP p, bf16_t* XB, float* PART) {
    const int lane = otid() & 63, wave = otid() >> 6;
    const int nw = gridDim.x * 8;
    for (int row0 = blockIdx.x * 8 + wave; row0 < MTOK; row0 += 4 * nw) {
        float4 v[4][4];
#pragma unroll
        for (int r = 0; r < 4; ++r) {
            int row = row0 + r * nw; row = row < MTOK ? row : MTOK - 1;
            const float* src = row < MP ? p->in[I_XP] + (size_t)row * DM : p->in[I_XS] + (size_t)(row - MP) * DM;
#pragma unroll
            for (int i = 0; i < 4; ++i) v[r][i] = *(const float4*)(src + i * 256 + lane * 4);
        }
#pragma unroll
        for (int r = 0; r < 4; ++r) {
            int row = row0 + r * nw; row = row < MTOK ? row : MTOK - 1;
            float ss = 0.f;
#pragma unroll
            for (int i = 0; i < 4; ++i) ss += v[r][i].x * v[r][i].x + v[r][i].y * v[r][i].y + v[r][i].z * v[r][i].z + v[r][i].w * v[r][i].w;
            ss = wave_sum(ss);
#pragma unroll
            for (int i = 0; i < 4; ++i) { uint2 o; o.x = pk2(v[r][i].x, v[r][i].y); o.y = pk2(v[r][i].z, v[r][i].w); *(uint2*)(XB + (size_t)row * DM + i * 256 + lane * 4) = o; }
            if (row < MP && lane < 16) PART[(size_t)row * 16 + lane] = lane == 0 ? ss : 0.f;
        }
    }
}
__device__ void final_phase(KP p, const bf16_t* XB, float* Y) {
    const int lane = otid() & 63, wave = otid() >> 6;
    const int nw = gridDim.x * 8;
    float4 gv[4];
#pragma unroll
    for (int i = 0; i < 4; ++i) gv[i] = *(const float4*)(p->in[I_FINN] + i * 256 + lane * 4);
    for (int row0 = blockIdx.x * 8 + wave; row0 < MTOK; row0 += 4 * nw) {
        uint2 u[4][4];
#pragma unroll
        for (int r = 0; r < 4; ++r) {
            int row = row0 + r * nw; row = row < MTOK ? row : MTOK - 1;
#pragma unroll
            for (int i = 0; i < 4; ++i) u[r][i] = *(const uint2*)(XB + (size_t)row * DM + i * 256 + lane * 4);
        }
#pragma unroll
        for (int r = 0; r < 4; ++r) {
            int row = row0 + r * nw; row = row < MTOK ? row : MTOK - 1;
            float4 v[4]; float ss = 0.f;
#pragma unroll
            for (int i = 0; i < 4; ++i) { v[i] = make_float4(lo16(u[r][i].x), hi16(u[r][i].x), lo16(u[r][i].y), hi16(u[r][i].y)); ss += v[i].x * v[i].x + v[i].y * v[i].y + v[i].z * v[i].z + v[i].w * v[i].w; }
            ss = wave_sum(ss);
            const float rstd = rsqrtf(ss * (1.f / 1024.f) + EPS);
#pragma unroll
            for (int i = 0; i < 4; ++i) { float4 o; o.x = v[i].x * rstd * gv[i].x; o.y = v[i].y * rstd * gv[i].y; o.z = v[i].z * rstd * gv[i].z; o.w = v[i].w * rstd * gv[i].w;
                *(float4*)(Y + (size_t)row * DM + i * 256 + lane * 4) = o; }
        }
    }
}

__device__ void prep_phase(KP p, int L, bf16_t* PROJ, bf16_t* U, bf16_t* CAT, const bf16_t* XB, const float* PART, float* DT) {
    SMEM_DECL;
    float* PW = (float*)smem; float* XA = PW + 16384; float* Dm = XA + 31 * 256; float* CS = Dm + 4096; float* INV = CS + 1024; float* DTP = INV + 32;
    const int tid = otid(), lane = tid & 63, w = tid >> 6, fr = lane & 15, fq = lane >> 4;
    __syncthreads();
    bf16_t* PWT = (bf16_t*)PW;
    bf16_t* DmB = (bf16_t*)Dm;
    for (int i = tid; i < 16384; i += NT) { const int gg = i >> 12, c = (i >> 6) & 63, dd = i & 63; PWT[(gg * 64 + 32 * (dd >> 5) + 16 * ((dd >> 2) & 1) + 4 * ((dd >> 3) & 3) + (dd & 3)) * 72 + c] = f2bf(p->in[I_POOLW][L * 16384 + i]); }
    if (tid < 32) INV[tid] = rope_inv(tid);
    __syncthreads();
    float* out = p->out;
    const bf16_t* wdt = (const bf16_t*)(p->ws + WS_WDT) + (size_t)L * 16 * 1024;
    const int tiles_per = (2048 + gridDim.x - 1) / gridDim.x;
    for (int tile = blockIdx.x * tiles_per; tile < 2048 && tile < (blockIdx.x + 1) * tiles_per; ++tile) {
        const int token0 = tile * 16, b = token0 >> 13, t0 = token0 & 8191;
        bf16x8 da[4], db[4];
#pragma unroll
        for (int ks = 0; ks < 4; ++ks) { const int k0 = w * 128 + ks * 32 + fq * 8;
            da[ks] = *(const bf16x8*)(XB + (size_t)(token0 + fr) * DM + k0); db[ks] = *(const bf16x8*)(wdt + fr * 1024 + k0); }
        uint4 xav[2];
#pragma unroll
        for (int it = 0; it < 2; ++it) { const int id = tid + it * NT, rr = id >> 5, ch = id & 31, t = t0 - 15 + rr;
            xav[it] = zero4();
            if (id < 992 && t >= 0) xav[it] = *(const uint4*)(PROJ + (size_t)(b * 8192 + t) * NPROJ + ch * 8); }
        const int r_tk = tid >> 5, r_rest = tid & 31, r_qk = r_rest >> 4, r_h = (r_rest >> 2) & 3, r_i0 = (r_rest & 3) * 8;
        bf16_t* rbase = PROJ + (size_t)(token0 + r_tk) * NPROJ + 256 + r_qk * 256 + r_h * 64 + r_i0;
        const uint4 rxa = *(const uint4*)rbase, rxb = *(const uint4*)(rbase + 32);
        uint4 vld = zero4();
        if (t0 >= 6144) vld = *(const uint4*)(PROJ + (size_t)(token0 + (tid >> 5)) * NPROJ + 768 + (tid & 31) * 8);
        const int q4 = tid >> 7, c0 = (tid & 127) * 8;
        uint4 xr[7];
#pragma unroll
        for (int rr = 0; rr < 7; ++rr) { const int tt = t0 + q4 * 4 - 3 + rr;
            xr[rr] = zero4();
            if (tt >= 0) xr[rr] = *(const uint4*)(PROJ + (size_t)(b * 8192 + tt) * NPROJ + 1536 + c0); }
        {
            f32x4 acc = (f32x4){0.f, 0.f, 0.f, 0.f};
#pragma unroll
            for (int ks = 0; ks < 4; ++ks) acc = MFMA16(db[ks], da[ks], acc);
            if (fq < 2) { float4 v; v.x = acc[0]; v.y = acc[1]; v.z = acc[2]; v.w = acc[3]; *(float4*)(DTP + (w * 16 + fr) * 8 + fq * 4) = v; }
        }
#pragma unroll
        for (int it = 0; it < 2; ++it) { const int id = tid + it * NT, rr = id >> 5, ch = id & 31;
            if (id < 992) { float* d = XA + rr * 256 + ch * 8; const uint4 v = xav[it];
                d[0] = lo16(v.x); d[1] = hi16(v.x); d[2] = lo16(v.y); d[3] = hi16(v.y); d[4] = lo16(v.z); d[5] = hi16(v.z); d[6] = lo16(v.w); d[7] = hi16(v.w); } }
        { const int tk = tid >> 5, i = tid & 31; float c, sn; rope_cs((float)(t0 + tk) * INV[i], c, sn); CS[(tk * 32 + i) * 2] = c; CS[(tk * 32 + i) * 2 + 1] = sn; }
        __syncthreads();
        if (tid < 128) {
            const int tk = tid >> 3, h = tid & 7;
            float d = 0.f;
#pragma unroll
            for (int ww = 0; ww < 8; ++ww) d += DTP[(ww * 16 + tk) * 8 + h];
            const float x = d * row_rstd(PART, token0 + tk) + p->in[I_DTB][L * 8 + h];
            DT[(size_t)(token0 + tk) * 8 + h] = x > 20.f ? x : log1pf(__expf(x));
        }
        for (int id = tid; id < 4096; id += NT) {
            const int tk = id >> 8, ch = id & 255, g = ch >> 6, ww = 2 << g, t = t0 + tk;
            float sum = 0.f;
            for (int i = 0; i < ww; ++i) sum += XA[(15 + tk - i) * 256 + ch];
            const float xc = XA[(15 + tk) * 256 + ch];
            const int cnt = (t + 1) < ww ? (t + 1) : ww;
            DmB[tk * 264 + ch] = f2bf(sum / (float)cnt - xc);
            if (t >= 8177) out[O_POOLP + ((size_t)(L * 4 + b) * 15 + (t - 8177)) * 256 + ch] = xc;
        }
        __syncthreads();
        {
            const int g = w >> 1;
            f32x4 r[2];
#pragma unroll
            for (int dq = 0; dq < 2; ++dq) {
                const int dtile = (w & 1) * 2 + dq;
                r[dq] = (f32x4){0.f, 0.f, 0.f, 0.f};
#pragma unroll
                for (int ks = 0; ks < 2; ++ks) {
                    const bf16x8 pf = *(const bf16x8*)(PWT + (g * 64 + 16 * dtile + fr) * 72 + ks * 32 + fq * 8);
                    const bf16x8 qf = *(const bf16x8*)(DmB + fr * 264 + g * 64 + ks * 32 + fq * 8);
                    r[dq] = MFMA16(pf, qf, r[dq]);
                }
            }
            const int o = g * 64 + 32 * (w & 1) + fq * 8;
            const float4 p0 = *(const float4*)(p->in[I_POOLSC] + L * 256 + o), p1 = *(const float4*)(p->in[I_POOLSC] + L * 256 + o + 4);
            uint4 ov; ov.x = pk2(r[0][0] * p0.x, r[0][1] * p0.y); ov.y = pk2(r[0][2] * p0.z, r[0][3] * p0.w);
            ov.z = pk2(r[1][0] * p1.x, r[1][1] * p1.y); ov.w = pk2(r[1][2] * p1.z, r[1][3] * p1.w);
            *(uint4*)(CAT + (size_t)(token0 + fr) * DM + o) = ov;
        }
        {
            const int t = t0 + r_tk;
            const float x1[8] = {lo16(rxa.x), hi16(rxa.x), lo16(rxa.y), hi16(rxa.y), lo16(rxa.z), hi16(rxa.z), lo16(rxa.w), hi16(rxa.w)};
            const float x2[8] = {lo16(rxb.x), hi16(rxb.x), lo16(rxb.y), hi16(rxb.y), lo16(rxb.z), hi16(rxb.z), lo16(rxb.w), hi16(rxb.w)};
            float r1[8], r2[8];
            const float sc = r_qk == 0 ? 0.125f : 1.f;
#pragma unroll
            for (int e = 0; e < 8; e += 2) {
                const float4 cs = *(const float4*)(CS + (r_tk * 32 + r_i0 + e) * 2);
                r1[e] = (x1[e] * cs.x - x2[e] * cs.y) * sc; r2[e] = (x2[e] * cs.x + x1[e] * cs.y) * sc;
                r1[e + 1] = (x1[e + 1] * cs.z - x2[e + 1] * cs.w) * sc; r2[e + 1] = (x2[e + 1] * cs.z + x1[e + 1] * cs.w) * sc;
            }
            uint4 o1, o2;
            o1.x = pk2(r1[0], r1[1]); o1.y = pk2(r1[2], r1[3]); o1.z = pk2(r1[4], r1[5]); o1.w = pk2(r1[6], r1[7]);
            o2.x = pk2(r2[0], r2[1]); o2.y = pk2(r2[2], r2[3]); o2.z = pk2(r2[4], r2[5]); o2.w = pk2(r2[6], r2[7]);
            *(uint4*)rbase = o1; *(uint4*)(rbase + 32) = o2;
            if (r_qk == 1 && t >= 6144) {
                float* kp = out + O_KP + (((size_t)(L * 4 + b) * 2048 + (t - 6144)) * 4 + r_h) * 64 + r_i0;
                *(float4*)kp = make_float4(r1[0], r1[1], r1[2], r1[3]); *(float4*)(kp + 4) = make_float4(r1[4], r1[5], r1[6], r1[7]);
                *(float4*)(kp + 32) = make_float4(r2[0], r2[1], r2[2], r2[3]); *(float4*)(kp + 36) = make_float4(r2[4], r2[5], r2[6], r2[7]);
            }
        }
        if (t0 >= 6144) {
            const int tk = tid >> 5, cc = (tid & 31) * 8, t = t0 + tk;
            float* vp = out + O_VP + ((size_t)(L * 4 + b) * 2048 + (t - 6144)) * 256 + cc;
            *(float4*)vp = make_float4(lo16(vld.x), hi16(vld.x), lo16(vld.y), hi16(vld.y)); *(float4*)(vp + 4) = make_float4(lo16(vld.z), hi16(vld.z), lo16(vld.w), hi16(vld.w));
        }
        {
            float wv[4][8], bv[8];
            { const float4 b0 = *(const float4*)(p->in[I_CONVB] + L * 1024 + c0), b1 = *(const float4*)(p->in[I_CONVB] + L * 1024 + c0 + 4);
              bv[0] = b0.x; bv[1] = b0.y; bv[2] = b0.z; bv[3] = b0.w; bv[4] = b1.x; bv[5] = b1.y; bv[6] = b1.z; bv[7] = b1.w; }
#pragma unroll
            for (int tau = 0; tau < 4; ++tau) {
                const float* cw = p->in[I_CONVW] + (size_t)(L * 4 + tau) * 1024 + c0;
                const float4 w0 = *(const float4*)cw, w1 = *(const float4*)(cw + 4);
                wv[tau][0] = w0.x; wv[tau][1] = w0.y; wv[tau][2] = w0.z; wv[tau][3] = w0.w; wv[tau][4] = w1.x; wv[tau][5] = w1.y; wv[tau][6] = w1.z; wv[tau][7] = w1.w;
            }
            float acc[4][8];
#pragma unroll
            for (int it = 0; it < 4; ++it)
#pragma unroll
                for (int e = 0; e < 8; ++e) acc[it][e] = bv[e];
#pragma unroll
            for (int rr = 0; rr < 7; ++rr) {
                const float xf[8] = {lo16(xr[rr].x), hi16(xr[rr].x), lo16(xr[rr].y), hi16(xr[rr].y), lo16(xr[rr].z), hi16(xr[rr].z), lo16(xr[rr].w), hi16(xr[rr].w)};
#pragma unroll
                for (int it = 0; it < 4; ++it) {
                    const int tau = rr - it;
                    if (tau >= 0 && tau < 4) {
#pragma unroll
                        for (int e = 0; e < 8; ++e) acc[it][e] += xf[e] * wv[tau][e];
                    }
                }
            }
#pragma unroll
            for (int it = 0; it < 4; ++it) {
                const int tk = q4 * 4 + it, t = t0 + tk;
                uint4 o; o.x = pk2(silu(acc[it][0]), silu(acc[it][1])); o.y = pk2(silu(acc[it][2]), silu(acc[it][3]));
                o.z = pk2(silu(acc[it][4]), silu(acc[it][5])); o.w = pk2(silu(acc[it][6]), silu(acc[it][7]));
                *(uint4*)(U + (size_t)(token0 + tk) * DM + c0) = o;
                if (t >= 8189) { float* cp = out + O_CONVP + ((size_t)(L * 4 + b) * 3 + (t - 8189)) * 1024 + c0; const uint4 xv = xr[it + 3];
                    *(float4*)cp = make_float4(lo16(xv.x), hi16(xv.x), lo16(xv.y), hi16(xv.y)); *(float4*)(cp + 4) = make_float4(lo16(xv.z), hi16(xv.z), lo16(xv.w), hi16(xv.w)); }
            }
        }
        __syncthreads();
    }
}

__device__ void prep_sample_item(KP p, int L, int n, bf16_t* PROJ, bf16_t* U, bf16_t* CAT, const bf16_t* XB, float* DT) {
    SMEM_DECL;
    float* dsm = (float*)smem;
    const int tid = otid();
    const size_t row = MP + n;
    float* out = p->out;
    const int ln = L * 32 + n;
    __syncthreads();
    {
        const int lane = tid & 63, h = tid >> 6;
        const bf16_t* wdt = (const bf16_t*)(p->ws + WS_WDT) + (size_t)L * 16 * 1024 + h * 1024;
        float d = 0.f, ss = 0.f;
#pragma unroll
        for (int i = 0; i < 16; ++i) { const int k = i * 64 + lane; const float xf = bf2f(XB[row * DM + k]); ss += xf * xf; d += xf * bf2f(wdt[k]); }
        d = wave_sum(d); ss = wave_sum(ss);
        if (lane == 0) { const float x = d * rsqrtf(ss * (1.f / 1024.f) + EPS) + p->in[I_DTB][L * 8 + h]; DT[row * 8 + h] = x > 20.f ? x : log1pf(__expf(x)); }
    }
    __syncthreads();
    if (tid < 256) {
        const int ch = tid, g = ch >> 6, w = 2 << g;
        const float* cp = p->in[I_CPOOL] + (size_t)ln * 15 * 256;
        const float xn = bf2f(PROJ[row * NPROJ + ch]);
        float cpr[15];
#pragma unroll
        for (int i = 1; i < 16; ++i) cpr[i - 1] = cp[(15 - i) * 256 + ch];
        float sum = xn;
#pragma unroll
        for (int i = 1; i < 16; ++i) sum += (i < w) ? cpr[i - 1] : 0.f;
        dsm[ch] = sum / (float)w - xn;
        float* ps = out + O_POOLS + (size_t)ln * 15 * 256;
        float cpv[14];
#pragma unroll
        for (int j = 0; j < 14; ++j) cpv[j] = cp[(j + 1) * 256 + ch];
#pragma unroll
        for (int j = 0; j < 14; ++j) ps[j * 256 + ch] = cpv[j];
        ps[14 * 256 + ch] = xn;
    }
    __syncthreads();
    if (tid < 256) {
        const int o = tid, g = o >> 6, dout = o & 63;
        const float* pw = p->in[I_POOLW] + (size_t)(L * 4 + g) * 4096;
        float acc = 0.f;
#pragma unroll 32
        for (int c = 0; c < 64; ++c) acc += dsm[g * 64 + c] * pw[c * 64 + dout];
        CAT[row * DM + o] = f2bf(acc * p->in[I_POOLSC][L * 256 + o]);
        const int qk = tid >> 7, h = (tid >> 5) & 3, i = tid & 31;
        const float inv = rope_inv(i);
        float c, s; rope_cs(16384.f * inv, c, s);
        bf16_t* base = PROJ + row * NPROJ + 256 + qk * 256 + h * 64;
        const float x1 = bf2f(base[i]), x2 = bf2f(base[i + 32]);
        float r1 = x1 * c - x2 * s, r2 = x2 * c + x1 * s;
        if (qk == 0) { r1 *= 0.125f; r2 *= 0.125f; }
        base[i] = f2bf(r1); base[i + 32] = f2bf(r2);
        if (qk == 1) { float* ks = out + O_KS + (((size_t)ln * 2048 + 2047) * 4 + h) * 64; ks[i] = r1; ks[i + 32] = r2; }
        out[O_VS + ((size_t)ln * 2048 + 2047) * 256 + tid] = bf2f(PROJ[row * NPROJ + 768 + tid]);
    }
    for (int c = tid; c < 1024; c += NT) {
        const float* sc = p->in[I_SCONV] + (size_t)ln * 3 * 1024;
        const float* cw = p->in[I_CONVW] + (size_t)L * 4 * 1024;
        const float xnew = bf2f(PROJ[row * NPROJ + 1536 + c]);
        const float s0 = sc[c], s1 = sc[1024 + c], s2 = sc[2048 + c];
        const float acc = p->in[I_CONVB][L * 1024 + c] + s0 * cw[c] + s1 * cw[1024 + c] + s2 * cw[2048 + c] + xnew * cw[3072 + c];
        U[row * DM + c] = f2bf(silu(acc));
        float* cs = out + O_CONVS + (size_t)ln * 3 * 1024;
        cs[c] = s1; cs[1024 + c] = s2; cs[2048 + c] = xnew;
    }
    __syncthreads();
}

struct AttnPf { uint4 k[4], v[4]; bf16x8 q[2]; };
__device__ __forceinline__ void attn_decode(int a, int& b, int& h, int& br, int& dsh, int& r, int& n) {
    const int bh = a / 192, rem = a % 192, idx = rem & 63; br = rem >> 6;
    b = bh >> 2; h = bh & 3; dsh = br * 2; const int nb = 64 >> dsh; r = idx / nb; n = idx % nb;
}
__device__ __forceinline__ void attn_load(int a, const bf16_t* PROJ, int tid, AttnPf& pf) {
    int b, h, br, dsh, r, n; attn_decode(a, b, h, br, dsh, r, n);
    const int lane = tid & 63, w = tid >> 6, fr = lane & 15, fq = lane >> 4;
#pragma unroll
    for (int it = 0; it < 4; ++it) {
        const int id = tid + it * NT, rowk = id >> 3, ch = id & 7, lk = (n - 1) * 128 + rowk;
        pf.k[it] = zero4();
        if (lk >= 0) pf.k[it] = *(const uint4*)(PROJ + (size_t)(b * 8192 + (lk << dsh) + r) * NPROJ + 512 + h * 64 + ch * 8);
    }
#pragma unroll
    for (int it = 0; it < 4; ++it) {
        const int id = tid + it * NT, key = id & 255, ch = id >> 8, lk = (n - 1) * 128 + key;
        pf.v[it] = zero4();
        if (lk >= 0) pf.v[it] = *(const uint4*)(PROJ + (size_t)(b * 8192 + (lk << dsh) + r) * NPROJ + 768 + h * 64 + ch * 8);
    }
    const int qi = 16 * w + fr, lq = n * 128 + qi;
    const size_t tq = (size_t)b * 8192 + ((size_t)lq << dsh) + r;
#pragma unroll
    for (int ks = 0; ks < 2; ++ks) pf.q[ks] = *(const bf16x8*)(PROJ + tq * NPROJ + 256 + h * 64 + ks * 32 + fq * 8);
}
__device__ void attn_items(int a0, int astep, const bf16_t* PROJ, bf16_t* OG, float* LSE) {
    SMEM_DECL;
    bf16_t* Ks = (bf16_t*)smem;
    bf16_t* Vt = (bf16_t*)(smem + 272 * 144);
    const int tid = otid(), lane = tid & 63, w = tid >> 6, fr = lane & 15, fq = lane >> 4;
    AttnPf pf;
    if (a0 < 3072) attn_load(a0, PROJ, tid, pf);
#pragma unroll 1
    for (int a = a0; a < 3072; a += astep) {
        int b, h, br, dsh, r, n; attn_decode(a, b, h, br, dsh, r, n);
        LDS_BARRIER();
#pragma unroll
        for (int it = 0; it < 4; ++it) { const int id = tid + it * NT, rowk = id >> 3, ch = id & 7; *(uint4*)(Ks + rowk * 72 + ch * 8) = pf.k[it]; }
        if (tid < 128) { const uint4 z = zero4(); *(uint4*)(Ks + (256 + (tid >> 3)) * 72 + (tid & 7) * 8) = z; }
#pragma unroll
        for (int it = 0; it < 4; ++it) {
            const int id = tid + it * NT, key = id & 255, ch = id >> 8; const uint4 v = pf.v[it];
            bf16_t* d = Vt + (32 * (ch >> 2) + 4 * (ch & 3)) * 280 + key;
            d[0] = (bf16_t)(v.x & 0xffff); d[280] = (bf16_t)(v.x >> 16); d[560] = (bf16_t)(v.y & 0xffff); d[840] = (bf16_t)(v.y >> 16);
            d[16 * 280] = (bf16_t)(v.z & 0xffff); d[17 * 280] = (bf16_t)(v.z >> 16); d[18 * 280] = (bf16_t)(v.w & 0xffff); d[19 * 280] = (bf16_t)(v.w >> 16);
        }
        { const int d = tid >> 3, kk = (tid & 7) * 2; *(unsigned*)(Vt + d * 280 + 256 + kk) = 0u; }
        const bf16x8 qf0 = pf.q[0], qf1 = pf.q[1];
        if (a + astep < 3072) attn_load(a + astep, PROJ, tid, pf);
        LDS_BARRIER();
        const int qi = 16 * w + fr, lq = n * 128 + qi;
        const size_t tq = (size_t)b * 8192 + ((size_t)lq << dsh) + r;
        f32x4 s[10];
#pragma unroll
        for (int t = 0; t < 10; ++t) {
            s[t] = (f32x4){0.f, 0.f, 0.f, 0.f};
            const bf16x8 kf0 = *(const bf16x8*)(Ks + (16 * (w + t) + fr) * 72 + fq * 8);
            const bf16x8 kf1 = *(const bf16x8*)(Ks + (16 * (w + t) + fr) * 72 + 32 + fq * 8);
            s[t] = MFMA16(kf0, qf0, s[t]); s[t] = MFMA16(kf1, qf1, s[t]);
        }
        float mx = -INFINITY;
#pragma unroll
        for (int t = 0; t < 10; ++t)
#pragma unroll
            for (int jj = 0; jj < 4; ++jj) {
                const int key = 16 * (w + t) + fq * 4 + jj, dist = 128 + qi - key;
                const bool valid = (dist >= 0) && (dist <= 128) && (key < 256) && (n > 0 || key >= 128);
                const float sv = valid ? s[t][jj] : -INFINITY;
                s[t][jj] = sv; mx = fmaxf(mx, sv);
            }
        mx = fmaxf(mx, __shfl_xor(mx, 16)); mx = fmaxf(mx, __shfl_xor(mx, 32));
        float lsum = 0.f;
#pragma unroll
        for (int t = 0; t < 10; ++t)
#pragma unroll
            for (int jj = 0; jj < 4; ++jj) { const float pv = __expf(s[t][jj] - mx); s[t][jj] = pv; lsum += pv; }
        lsum += __shfl_xor(lsum, 16); lsum += __shfl_xor(lsum, 32);
        f32x4 o[4];
#pragma unroll
        for (int dt = 0; dt < 4; ++dt) o[dt] = (f32x4){0.f, 0.f, 0.f, 0.f};
#pragma unroll
        for (int kp = 0; kp < 5; ++kp) {
            const int ta = 2 * kp, tb = 2 * kp + 1;
            union { bf16x8 v; unsigned u[4]; } pfr;
            pfr.u[0] = pk2(s[ta][0], s[ta][1]); pfr.u[1] = pk2(s[ta][2], s[ta][3]); pfr.u[2] = pk2(s[tb][0], s[tb][1]); pfr.u[3] = pk2(s[tb][2], s[tb][3]);
#pragma unroll
            for (int dt = 0; dt < 4; ++dt) {
                union { bf16x8 v; uint2 u[2]; } vf;
                vf.u[0] = *(const uint2*)(Vt + (16 * dt + fr) * 280 + 16 * (w + ta) + fq * 4);
                vf.u[1] = *(const uint2*)(Vt + (16 * dt + fr) * 280 + 16 * (w + tb) + fq * 4);
                o[dt] = MFMA16(vf.v, pfr.v, o[dt]);
            }
        }
        const float inv = 1.f / lsum;
#pragma unroll
        for (int a2 = 0; a2 < 2; ++a2) {
            uint4 ov; ov.x = pk2(o[2 * a2][0] * inv, o[2 * a2][1] * inv); ov.y = pk2(o[2 * a2][2] * inv, o[2 * a2][3] * inv);
            ov.z = pk2(o[2 * a2 + 1][0] * inv, o[2 * a2 + 1][1] * inv); ov.w = pk2(o[2 * a2 + 1][2] * inv, o[2 * a2 + 1][3] * inv);
            *(uint4*)(OG + ((size_t)br * MP + tq) * 256 + h * 64 + 32 * a2 + fq * 8) = ov;
        }
        if (fq == 0) LSE[((size_t)br * MP + tq) * 4 + h] = mx + __logf(lsum);
    }
}

__device__ void combine_item(int item, const bf16_t* __restrict__ OG, const float* __restrict__ LSE, bf16_t* __restrict__ CAT) {
    const int tid = otid();
    uint4 a[4], bb[4], c[4]; float l0[4], l1[4], l2[4];
#pragma unroll
    for (int it = 0; it < 4; ++it) {
        const int id = tid + it * NT, tk = id >> 5, ch = id & 31, h = ch >> 3;
        const size_t token = (size_t)item * 64 + tk;
        l0[it] = LSE[token * 4 + h]; l1[it] = LSE[((size_t)MP + token) * 4 + h]; l2[it] = LSE[(2ull * MP + token) * 4 + h];
        a[it] = *(const uint4*)(OG + token * 256 + ch * 8); bb[it] = *(const uint4*)(OG + ((size_t)MP + token) * 256 + ch * 8);
        c[it] = *(const uint4*)(OG + (2ull * MP + token) * 256 + ch * 8);
    }
#pragma unroll
    for (int it = 0; it < 4; ++it) {
        const int id = tid + it * NT, tk = id >> 5, ch = id & 31;
        const size_t token = (size_t)item * 64 + tk;
        const float m = fmaxf(l0[it], fmaxf(l1[it], l2[it]));
        float w0 = __expf(l0[it] - m), w1 = __expf(l1[it] - m), w2 = __expf(l2[it] - m);
        const float inv = 1.f / (w0 + w1 + w2); w0 *= inv; w1 *= inv; w2 *= inv;
        uint4 o;
        o.x = pk2(w0 * lo16(a[it].x) + w1 * lo16(bb[it].x) + w2 * lo16(c[it].x), w0 * hi16(a[it].x) + w1 * hi16(bb[it].x) + w2 * hi16(c[it].x));
        o.y = pk2(w0 * lo16(a[it].y) + w1 * lo16(bb[it].y) + w2 * lo16(c[it].y), w0 * hi16(a[it].y) + w1 * hi16(bb[it].y) + w2 * hi16(c[it].y));
        o.z = pk2(w0 * lo16(a[it].z) + w1 * lo16(bb[it].z) + w2 * lo16(c[it].z), w0 * hi16(a[it].z) + w1 * hi16(bb[it].z) + w2 * hi16(c[it].z));
        o.w = pk2(w0 * lo16(a[it].w) + w1 * lo16(bb[it].w) + w2 * lo16(c[it].w), w0 * hi16(a[it].w) + w1 * hi16(bb[it].w) + w2 * hi16(c[it].w));
        *(uint4*)(CAT + token * DM + 256 + ch * 8) = o;
    }
}

__device__ __forceinline__ void ssd_acs(KP p, int L, int g, int token0, const float* DT, float* acs, float* dts) {
    const int lane = otid() & 63, w = otid() >> 6;
    if (w < 4) {
        const int h = g * 4 + w; const float a = -__expf(p->in[I_ALOG][L * 8 + h]);
        const float d0 = DT[(size_t)(token0 + 2 * lane) * 8 + h], d1 = DT[(size_t)(token0 + 2 * lane + 1) * 8 + h];
        const float v0 = d0 * a, v1 = d1 * a, sum = v0 + v1; float inc = sum;
#pragma unroll
        for (int off = 1; off < 64; off <<= 1) { const float t = __shfl_up(inc, off); if (lane >= off) inc += t; }
        const float exc = inc - sum;
        acs[w * 128 + 2 * lane] = exc + v0; acs[w * 128 + 2 * lane + 1] = exc + v0 + v1;
        dts[w * 128 + 2 * lane] = d0; dts[w * 128 + 2 * lane + 1] = d1;
    }
}

__device__ void s1_item(KP p, int L, int item, const bf16_t* U, const float* DT, float* ST, float* DEC) {
    SMEM_DECL;
    bf16_t* BT = (bf16_t*)smem;
    bf16_t* XWT = (bf16_t*)(smem + 34816);
    float* acs = (float*)(smem + 104448);
    float* dts = (float*)(smem + 106496);
    const int tid = otid(), lane = tid & 63, w = tid >> 6, fr = lane & 15, fq = lane >> 4;
    const int cb = item >> 1, g = item & 1, token0 = cb * 128;
    __syncthreads();
    ssd_acs(p, L, g, token0, DT, acs, dts);
    __syncthreads();
    { const int j = tid >> 7, l = tid & 127; const float wv = __expf(acs[j * 128 + 127] - acs[j * 128 + l]) * dts[j * 128 + l];
      if (tid < 4) DEC[cb * 8 + g * 4 + tid] = __expf(acs[tid * 128 + 127]);
      __syncthreads();
      dts[j * 128 + l] = wv; }
    __syncthreads();
#pragma unroll
    for (int it = 0; it < 4; ++it) {
        const int id = tid + it * NT, l = id & 127, ch = id >> 7;
        const uint4 v = *(const uint4*)(U + (size_t)(token0 + l) * DM + 512 + g * 128 + ch * 8);
        bf16_t* d = BT + (ch * 8) * 136 + l;
        d[0] = (bf16_t)(v.x & 0xffff); d[136] = (bf16_t)(v.x >> 16); d[272] = (bf16_t)(v.y & 0xffff); d[408] = (bf16_t)(v.y >> 16);
        d[544] = (bf16_t)(v.z & 0xffff); d[680] = (bf16_t)(v.z >> 16); d[816] = (bf16_t)(v.w & 0xffff); d[952] = (bf16_t)(v.w >> 16);
    }
#pragma unroll
    for (int it = 0; it < 8; ++it) {
        const int id = tid + it * NT, l = id & 127, ch = id >> 7, j = ch >> 3;
        const uint4 v = *(const uint4*)(U + (size_t)(token0 + l) * DM + g * 256 + ch * 8);
        const float wv = dts[j * 128 + l];
        bf16_t* d = XWT + (ch * 8) * 136 + l;
        d[0] = f2bf(lo16(v.x) * wv); d[136] = f2bf(hi16(v.x) * wv); d[272] = f2bf(lo16(v.y) * wv); d[408] = f2bf(hi16(v.y) * wv);
        d[544] = f2bf(lo16(v.z) * wv); d[680] = f2bf(hi16(v.z) * wv); d[816] = f2bf(lo16(v.w) * wv); d[952] = f2bf(hi16(v.w) * wv);
    }
    __syncthreads();
    f32x4 acc[2][8];
#pragma unroll
    for (int qq = 0; qq < 2; ++qq)
#pragma unroll
        for (int nt = 0; nt < 8; ++nt) acc[qq][nt] = (f32x4){0.f, 0.f, 0.f, 0.f};
#pragma unroll
    for (int ks = 0; ks < 4; ++ks) {
        bf16x8 qf[2];
#pragma unroll
        for (int qq = 0; qq < 2; ++qq) qf[qq] = *(const bf16x8*)(XWT + (16 * (2 * w + qq) + fr) * 136 + ks * 32 + fq * 8);
#pragma unroll
        for (int nt = 0; nt < 8; ++nt) {
            const bf16x8 pf = *(const bf16x8*)(BT + (16 * nt + fr) * 136 + ks * 32 + fq * 8);
#pragma unroll
            for (int qq = 0; qq < 2; ++qq) acc[qq][nt] = MFMA16(pf, qf[qq], acc[qq][nt]);
        }
    }
#pragma unroll
    for (int qq = 0; qq < 2; ++qq) {
        const int rowjp = 16 * (2 * w + qq) + fr, j = rowjp >> 6, pp = rowjp & 63, h = g * 4 + j;
        float* dst = ST + ((size_t)(cb * 8 + h) * 64 + pp) * 128 + fq * 4;
#pragma unroll
        for (int nt = 0; nt < 8; ++nt) { float4 v; v.x = acc[qq][nt][0]; v.y = acc[qq][nt][1]; v.z = acc[qq][nt][2]; v.w = acc[qq][nt][3]; *(float4*)(dst + 16 * nt) = v; }
    }
}

__device__ void scan_phase(KP p, int L, float* ST, const float* DEC) {
    for (int e = blockIdx.x * NT + otid(); e < 131072; e += gridDim.x * NT) {
        const int idx = e * 2, n = idx & 127, pp = (idx >> 7) & 63, h = (idx >> 13) & 7, b = idx >> 16;
        float2 hr = {0.f, 0.f};
        float* base = ST + ((size_t)((b * 64) * 8 + h) * 64 + pp) * 128 + n;
        const float* dbase = DEC + (b * 64) * 8 + h;
#pragma unroll 1
        for (int c0 = 0; c0 < 64; c0 += 16) {
            float2 t[16]; float d[16];
#pragma unroll
            for (int j = 0; j < 16; ++j) { t[j] = *(const float2*)(base + (size_t)(c0 + j) * 65536); d[j] = dbase[(c0 + j) * 8]; }
#pragma unroll
            for (int j = 0; j < 16; ++j) { *(float2*)(base + (size_t)(c0 + j) * 65536) = hr; hr.x = d[j] * hr.x + t[j].x; hr.y = d[j] * hr.y + t[j].y; }
        }
        *(float2*)(p->out + O_SSMP + (((size_t)(L * 4 + b) * 8 + h) * 64 + pp) * 128 + n) = hr;
    }
}

__device__ void s3_item(KP p, int L, int item, const bf16_t* U, const bf16_t* PROJ, const float* DT, const float* ST, bf16_t* CAT) {
    SMEM_DECL;
    bf16_t* Cs = (bf16_t*)smem;
    bf16_t* Bs = (bf16_t*)(smem + 34816);
    bf16_t* XT = (bf16_t*)(smem + 69632);
    bf16_t* Hp = (bf16_t*)(smem + 87040);
    float* acs = (float*)(smem + 104448);
    float* dts = (float*)(smem + 106496);
    const int tid = otid(), lane = tid & 63, w = tid >> 6, fr = lane & 15, fq = lane >> 4;
    const int cb = item >> 1, g = item & 1, token0 = cb * 128;
    const int l = 16 * w + fr;
    const size_t token = (size_t)token0 + l;
    uint4 xt[2]; float4 hp[4]; uint4 xv[2], zv[2];
#define S3_LOAD(hh) do { \
        _Pragma("unroll") for (int it = 0; it < 2; ++it) { const int id = tid + it * NT, s_ = id & 127, ch = id >> 7; \
            xt[it] = *(const uint4*)(U + (size_t)(token0 + s_) * DM + (hh) * 64 + ch * 8); } \
        _Pragma("unroll") for (int it = 0; it < 4; ++it) { const int id = tid + it * NT, pp = id >> 5, c4 = id & 31; \
            hp[it] = *(const float4*)(ST + ((size_t)(cb * 8 + (hh)) * 64 + pp) * 128 + c4 * 4); } \
        _Pragma("unroll") for (int a2 = 0; a2 < 2; ++a2) { const int ch = (hh) * 64 + 32 * a2 + fq * 8; \
            xv[a2] = *(const uint4*)(U + token * DM + ch); zv[a2] = *(const uint4*)(PROJ + token * NPROJ + 1024 + ch); } } while (0)
    LDS_BARRIER();
    S3_LOAD(g * 4);
    ssd_acs(p, L, g, token0, DT, acs, dts);
#pragma unroll
    for (int it = 0; it < 4; ++it) {
        const int id = tid + it * NT, ll = id >> 4, ch = id & 15;
        *(uint4*)(Cs + ll * 136 + ch * 8) = *(const uint4*)(U + (size_t)(token0 + ll) * DM + 768 + g * 128 + ch * 8);
        *(uint4*)(Bs + ll * 136 + ch * 8) = *(const uint4*)(U + (size_t)(token0 + ll) * DM + 512 + g * 128 + ch * 8);
    }
    LDS_BARRIER();
    f32x4 cbv[8];
#pragma unroll
    for (int st = 0; st < 8; ++st) cbv[st] = (f32x4){0.f, 0.f, 0.f, 0.f};
#pragma unroll
    for (int ks = 0; ks < 4; ++ks) {
        const bf16x8 qf = *(const bf16x8*)(Cs + (16 * w + fr) * 136 + ks * 32 + fq * 8);
#pragma unroll
        for (int st = 0; st < 8; ++st)
            if (st <= w) { const bf16x8 pf = *(const bf16x8*)(Bs + (16 * st + fr) * 136 + ks * 32 + fq * 8); cbv[st] = MFMA16(pf, qf, cbv[st]); }
    }
    LDS_BARRIER();
    bf16_t* Mb = Bs;
    float ssq = 0.f;
#pragma unroll 1
    for (int j = 0; j < 4; ++j) {
        const int h = g * 4 + j;
#pragma unroll
        for (int it = 0; it < 2; ++it) {
            const int id = tid + it * NT, s_ = id & 127, ch = id >> 7; const uint4 v = xt[it];
            bf16_t* d = XT + (32 * (ch >> 2) + 4 * (ch & 3)) * 136 + s_;
            d[0] = (bf16_t)(v.x & 0xffff); d[136] = (bf16_t)(v.x >> 16); d[272] = (bf16_t)(v.y & 0xffff); d[408] = (bf16_t)(v.y >> 16);
            d[16 * 136] = (bf16_t)(v.z & 0xffff); d[17 * 136] = (bf16_t)(v.z >> 16); d[18 * 136] = (bf16_t)(v.w & 0xffff); d[19 * 136] = (bf16_t)(v.w >> 16);
        }
#pragma unroll
        for (int it = 0; it < 4; ++it) {
            const int id = tid + it * NT, pp = id >> 5, c4 = id & 31; const float4 v = hp[it];
            uint2 o; o.x = pk2(v.x, v.y); o.y = pk2(v.z, v.w);
            *(uint2*)(Hp + (32 * (pp >> 5) + 16 * ((pp >> 2) & 1) + 4 * ((pp >> 3) & 3) + (pp & 3)) * 136 + c4 * 4) = o;
        }
        uint4 xvc[2], zvc[2];
#pragma unroll
        for (int a2 = 0; a2 < 2; ++a2) { xvc[a2] = xv[a2]; zvc[a2] = zv[a2]; }
        if (j < 3) S3_LOAD(h + 1);
        const float al = acs[j * 128 + l];
#pragma unroll
        for (int st = 0; st < 8; ++st)
            if (st <= (w | 1)) {
                float mv[4];
#pragma unroll
                for (int jj = 0; jj < 4; ++jj) { const int s_ = 16 * st + fq * 4 + jj;
                    mv[jj] = (s_ <= l) ? cbv[st][jj] * __expf(al - acs[j * 128 + s_]) * dts[j * 128 + s_] : 0.f; }
                uint2 o; o.x = pk2(mv[0], mv[1]); o.y = pk2(mv[2], mv[3]);
                *(uint2*)(Mb + l * 136 + 16 * st + fq * 4) = o;
            }
        LDS_BARRIER();
        f32x4 yy[4];
#pragma unroll
        for (int pt = 0; pt < 4; ++pt) yy[pt] = (f32x4){0.f, 0.f, 0.f, 0.f};
#pragma unroll
        for (int ks = 0; ks < 4; ++ks) {
            const bf16x8 qf = *(const bf16x8*)(Cs + (16 * w + fr) * 136 + ks * 32 + fq * 8);
#pragma unroll
            for (int pt = 0; pt < 4; ++pt) { const bf16x8 pf = *(const bf16x8*)(Hp + (16 * pt + fr) * 136 + ks * 32 + fq * 8); yy[pt] = MFMA16(pf, qf, yy[pt]); }
        }
        const float ea = __expf(al);
#pragma unroll
        for (int pt = 0; pt < 4; ++pt) yy[pt] = yy[pt] * ea;
#pragma unroll
        for (int ks = 0; ks < 4; ++ks)
            if (2 * ks <= w) {
                const bf16x8 qf = *(const bf16x8*)(Mb + (16 * w + fr) * 136 + ks * 32 + fq * 8);
#pragma unroll
                for (int pt = 0; pt < 4; ++pt) { const bf16x8 pf = *(const bf16x8*)(XT + (16 * pt + fr) * 136 + ks * 32 + fq * 8); yy[pt] = MFMA16(pf, qf, yy[pt]); }
            }
        const float dsk = p->in[I_DSKIP][L * 8 + h];
#pragma unroll
        for (int a2 = 0; a2 < 2; ++a2) {
            const int ch = h * 64 + 32 * a2 + fq * 8;
            const uint4 xq = xvc[a2], zq = zvc[a2];
            const float xs[8] = {lo16(xq.x), hi16(xq.x), lo16(xq.y), hi16(xq.y), lo16(xq.z), hi16(xq.z), lo16(xq.w), hi16(xq.w)};
            const float zs[8] = {lo16(zq.x), hi16(zq.x), lo16(zq.y), hi16(zq.y), lo16(zq.z), hi16(zq.z), lo16(zq.w), hi16(zq.w)};
            float v[8];
#pragma unroll
            for (int e = 0; e < 8; ++e) { v[e] = (yy[2 * a2 + (e >> 2)][e & 3] + dsk * xs[e]) * silu(zs[e]); ssq += v[e] * v[e]; }
            uint4 o; o.x = pk2(v[0], v[1]); o.y = pk2(v[2], v[3]); o.z = pk2(v[4], v[5]); o.w = pk2(v[6], v[7]);
            *(uint4*)(CAT + token * DM + 512 + ch) = o;
        }
        LDS_BARRIER();
    }
#undef S3_LOAD
    asm volatile("s_waitcnt vmcnt(0)" ::: "memory");
    ssq += __shfl_xor(ssq, 16); ssq += __shfl_xor(ssq, 32);
    const float rstd = rsqrtf(ssq * (1.f / 256.f) + EPS);
    {
        uint4 vv[4][2];
#pragma unroll
        for (int j = 0; j < 4; ++j)
#pragma unroll
            for (int a2 = 0; a2 < 2; ++a2) vv[j][a2] = *(const uint4*)(CAT + token * DM + 512 + (g * 4 + j) * 64 + 32 * a2 + fq * 8);
#pragma unroll
        for (int j = 0; j < 4; ++j)
#pragma unroll
            for (int a2 = 0; a2 < 2; ++a2) {
                const int ch = (g * 4 + j) * 64 + 32 * a2 + fq * 8;
                const float4 n0 = *(const float4*)(p->in[I_SSMN] + L * 512 + ch), n1 = *(const float4*)(p->in[I_SSMN] + L * 512 + ch + 4);
                const uint4 v = vv[j][a2];
                uint4 o; o.x = pk2(lo16(v.x) * rstd * n0.x, hi16(v.x) * rstd * n0.y); o.y = pk2(lo16(v.y) * rstd * n0.z, hi16(v.y) * rstd * n0.w);
                o.z = pk2(lo16(v.z) * rstd * n1.x, hi16(v.z) * rstd * n1.y); o.w = pk2(lo16(v.w) * rstd * n1.z, hi16(v.w) * rstd * n1.w);
                *(uint4*)(CAT + token * DM + 512 + ch) = o;
            }
    }
}

__device__ void sample_attn_item(KP p, int L, int item, const bf16_t* PROJ, bf16_t* CAT) {
    SMEM_DECL;
    float* qs = (float*)smem; float* kn = qs + 64; float* vn = kn + 64; float* sc = vn + 64; float* red = sc + 512; float* part = red + 32;
    const int tid = otid(), lane = tid & 63, w = tid >> 6;
    const int n = item >> 2, h = item & 3;
    const size_t row = MP + n; const int ln = L * 32 + n;
    __syncthreads();
    if (tid < 64) { qs[tid] = bf2f(PROJ[row * NPROJ + 256 + h * 64 + tid]); kn[tid] = bf2f(PROJ[row * NPROJ + 512 + h * 64 + tid]); vn[tid] = bf2f(PROJ[row * NPROJ + 768 + h * 64 + tid]); }
    __syncthreads();
    const float* ck = p->in[I_CK] + (size_t)ln * 2048 * 256 + h * 64;
    const float* cv = p->in[I_CV] + (size_t)ln * 2048 * 256 + h * 64;
    float s = -INFINITY;
    if (tid < 387) {
        const int gg = tid / 129, j = tid % 129;
        s = 0.f;
        if (j == 0) { for (int d = 0; d < 64; ++d) s += qs[d] * kn[d]; }
        else { const float* kr = ck + (size_t)(2048 - (j << (2 * gg))) * 256;
#pragma unroll
            for (int d = 0; d < 64; d += 4) { const float4 kv = *(const float4*)(kr + d); s += qs[d] * kv.x + qs[d + 1] * kv.y + qs[d + 2] * kv.z + qs[d + 3] * kv.w; } }
    }
    const float wm = wave_max(s);
    if (lane == 0) red[w] = wm;
    __syncthreads();
    float mx = red[0];
#pragma unroll
    for (int i = 1; i < 8; ++i) mx = fmaxf(mx, red[i]);
    const float pv = (tid < 387) ? __expf(s - mx) : 0.f;
    sc[tid] = pv;
    const float wsum = wave_sum(pv);
    if (lane == 0) red[8 + w] = wsum;
    __syncthreads();
    float tot = 0.f;
#pragma unroll
    for (int i = 0; i < 8; ++i) tot += red[8 + i];
    {
        const int d = lane;
        float o = 0.f;
#pragma unroll 1
        for (int k0 = 0; k0 < 49; k0 += 7) {
            float vv[7], pp[7];
#pragma unroll
            for (int i = 0; i < 7; ++i) {
                const int e = w + 8 * (k0 + i);
                pp[i] = 0.f; vv[i] = 0.f;
                if (e < 387) { const int gg = e / 129, j = e % 129; pp[i] = sc[e];
                    vv[i] = (j == 0) ? vn[d] : cv[(size_t)(2048 - (j << (2 * gg))) * 256 + d]; }
            }
#pragma unroll
            for (int i = 0; i < 7; ++i) o += pp[i] * vv[i];
        }
        part[w * 64 + d] = o;
    }
    __syncthreads();
    if (tid < 64) {
        float o = 0.f;
#pragma unroll
        for (int i = 0; i < 8; ++i) o += part[i * 64 + tid];
        CAT[row * DM + 256 + h * 64 + tid] = f2bf(o / tot);
    }
}

__device__ void sample_ssd_item(KP p, int L, int n, const bf16_t* PROJ, const bf16_t* U, const float* DT, bf16_t* CAT) {
    SMEM_DECL;
    float* us = (float*)smem; float* zs = us + 1024; float* ys = zs + 512; float* red = ys + 512;
    const int tid = otid(), lane = tid & 63, w = tid >> 6;
    const size_t row = MP + n; const int ln = L * 32 + n;
    __syncthreads();
    for (int i = tid; i < 1024; i += NT) us[i] = bf2f(U[row * DM + i]);
    zs[tid] = bf2f(PROJ[row * NPROJ + 1024 + tid]);
    __syncthreads();
    {
        const int h = w, g = h >> 2;
        const float dt = DT[row * 8 + h], a = -__expf(p->in[I_ALOG][L * 8 + h]), dec = __expf(dt * a);
        const float B0 = us[512 + g * 128 + 2 * lane], B1 = us[512 + g * 128 + 2 * lane + 1], C0 = us[768 + g * 128 + 2 * lane], C1 = us[768 + g * 128 + 2 * lane + 1];
        const float* h0 = p->in[I_SSSM] + ((size_t)ln * 8 + h) * 64 * 128;
        float* hs = p->out + O_SSMS + ((size_t)ln * 8 + h) * 64 * 128;
#pragma unroll 1
        for (int r0 = 0; r0 < 64; r0 += 16) {
            float2 hv[16];
#pragma unroll
            for (int i = 0; i < 16; ++i) hv[i] = *(const float2*)(h0 + (r0 + i) * 128 + 2 * lane);
#pragma unroll
            for (int i = 0; i < 16; ++i) {
                const int rr = r0 + i;
                const float x = us[h * 64 + rr];
                float2 hn; hn.x = dec * hv[i].x + dt * x * B0; hn.y = dec * hv[i].y + dt * x * B1;
                *(float2*)(hs + rr * 128 + 2 * lane) = hn;
                const float part = wave_sum(hn.x * C0 + hn.y * C1);
                if (lane == 0) ys[h * 64 + rr] = part;
            }
        }
    }
    __syncthreads();
    {
        const int ch = tid, gch = ch >> 8;
        const float v = (ys[ch] + p->in[I_DSKIP][L * 8 + (ch >> 6)] * us[ch]) * silu(zs[ch]);
        const float part = wave_sum(v * v);
        if (lane == 0) red[w] = part;
        __syncthreads();
        const float tot = red[gch * 4] + red[gch * 4 + 1] + red[gch * 4 + 2] + red[gch * 4 + 3];
        const float rstd = rsqrtf(tot * (1.f / 256.f) + EPS);
        CAT[row * DM + 512 + ch] = f2bf(v * rstd * p->in[I_SSMN][L * 512 + ch]);
    }
}


#define XB_TMO      128
#define XB_XCNT(j)  (256  + 64 * (j))
#define XB_XSUB(j)  (1280 + 64 * (j))
#define XB_XGEN(j)  (2304 + 64 * (j))
#define XB_TOP      3328
#define XB_TOPGEN   3392
#define XCD_BAR_WORDS 3456
#define XB_SPIN_CAP (1u << 18)
__device__ __forceinline__ unsigned xb_ld(unsigned* p)              { return __hip_atomic_load(p, __ATOMIC_RELAXED, __HIP_MEMORY_SCOPE_AGENT); }
__device__ __forceinline__ unsigned xb_add(unsigned* p, unsigned v) { return __hip_atomic_fetch_add(p, v, __ATOMIC_RELAXED, __HIP_MEMORY_SCOPE_AGENT); }
__device__ __forceinline__ unsigned xb_xcc_id() { return (unsigned)__builtin_amdgcn_s_getreg((3 << 11) | 20) & 0xFu; }
#define XB_SPIN(cond, bar) do { unsigned _sp = 0; while (cond) { __builtin_amdgcn_s_sleep(1); \
    if ((++_sp & 255u) == 0u) { if (xb_ld(&(bar)[XB_TMO])) break; if (_sp > XB_SPIN_CAP) { atomicAdd(&(bar)[XB_TMO], 1u); break; } } } } while (0)
struct XcdBarrier { unsigned* bar; unsigned x; volatile LAS unsigned* st; };
__device__ __forceinline__ XcdBarrier xcd_barrier_post(unsigned* bar, volatile LAS unsigned* st) {
    XcdBarrier b; b.bar = bar; b.x = xb_xcc_id(); b.st = st;
    if (__builtin_amdgcn_workitem_id_x() == 0) (void)xb_add(&bar[XB_XCNT(b.x)], 1u);
    return b;
}
__device__ __forceinline__ void xcd_barrier_complete(unsigned* bar, unsigned x, unsigned& nloc, unsigned& nx) {
    const unsigned G = gridDim.x * gridDim.y * gridDim.z;
    unsigned sum, cnt, mine, sp = 0u;
    for (;;) {
        sum = 0u; cnt = 0u; mine = 0u;
#pragma unroll
        for (unsigned j = 0; j < 16; ++j) { const unsigned c = xb_ld(&bar[XB_XCNT(j)]); sum += c; cnt += (c > 0u) ? 1u : 0u; mine = (j == x) ? c : mine; }
        if (sum == G) break;
        __builtin_amdgcn_s_sleep(1);
        if ((++sp & 255u) == 0u) { if (xb_ld(&bar[XB_TMO])) break; if (sp > XB_SPIN_CAP) { atomicAdd(&bar[XB_TMO], 1u); break; } }
    }
    nloc = mine > 0u ? mine : 1u; nx = cnt > 0u ? cnt : 1u;
}
__device__ __forceinline__ void xcd_barrier(const XcdBarrier& b) {
    asm volatile("s_waitcnt vmcnt(0)" ::: "memory");
    __syncthreads();
    if (__builtin_amdgcn_workitem_id_x() == 0) {
        unsigned* bar = b.bar;
        __builtin_amdgcn_s_waitcnt(0);
        unsigned nloc = b.st[0], nx = b.st[1];
        if (nloc == 0u) { xcd_barrier_complete(bar, b.x, nloc, nx); b.st[0] = nloc; b.st[1] = nx; }
        const unsigned old = xb_add(&bar[XB_XSUB(b.x)], 1u);
        const unsigned gen = old / nloc;
        if (old + 1u == (gen + 1u) * nloc) {
            __builtin_amdgcn_fence(__ATOMIC_RELEASE, "agent");
            asm volatile("s_waitcnt vmcnt(0)" ::: "memory");
            const unsigned og = xb_add(&bar[XB_TOP], 1u);
            const unsigned tg = og / nx;
            if (og + 1u == (tg + 1u) * nx) xb_add(&bar[XB_TOPGEN], 1u);
            else XB_SPIN(xb_ld(&bar[XB_TOPGEN]) == tg, bar);
            __builtin_amdgcn_fence(__ATOMIC_ACQUIRE, "agent");
            xb_add(&bar[XB_XGEN(b.x)], 1u);
            asm volatile("s_waitcnt vmcnt(0)" ::: "memory");
        } else {
            XB_SPIN(xb_ld(&bar[XB_XGEN(b.x)]) == gen, bar);
            __builtin_amdgcn_fence(__ATOMIC_ACQUIRE, "agent");
            asm volatile("s_waitcnt vmcnt(0)" ::: "memory");
        }
    }
    __syncthreads();
}

#ifndef PHMASK
#define PHMASK 0xFFFFF
#endif
constexpr int PH_PER_LAYER = 10, NPHASE = 1 + 2 * PH_PER_LAYER + 1;

__global__ void __launch_bounds__(NT, 2) mega(Params pv, int ph_lo, int ph_hi) {
    cg::grid_group grid = cg::this_grid();
    XcdBarrier xb;
    {
        SMEM_DECL;
        volatile LAS unsigned* st = (volatile LAS unsigned*)((LAS unsigned char*)smem + 131072);
        if (__builtin_amdgcn_workitem_id_x() < 4) st[__builtin_amdgcn_workitem_id_x()] = 0u;
        __syncthreads();
        xb = xcd_barrier_post((unsigned*)(pv.ws + WS_BAR), st);
    }
    for (int ph = ph_lo; ph < ph_hi; ++ph) {
        if (ph == ph_lo + 1) grid.sync();
        else if (ph > ph_lo) xcd_barrier(xb);
        KP p = opaque_kp();
        unsigned char* ws = p->ws;
        bf16_t* XB = (bf16_t*)(ws + WS_XB); bf16_t* Ub = (bf16_t*)p->out;
        bf16_t* HB = (bf16_t*)(ws + WS_HB); bf16_t* PROJ = HB;
        bf16_t* CAT = (bf16_t*)(ws + WS_CAT);
        bf16_t* OG = (bf16_t*)(ws + WS_OG);
        float* LSE = (float*)(ws + WS_LSE);
        float* ST = (float*)(ws + WS_ST);
        float* DEC = (float*)(ws + WS_DEC);
        float* DT = (float*)(ws + WS_DT);
        float* X = p->out;
        float* PART = (float*)(ws + WS_PART);
        if (ph == 0) {
            weights_phase(p);
            cache_copy_phase(p);
            copy_phase(p, XB, PART);
            continue;
        }
        if (ph == NPHASE - 1) { final_phase(p, XB, X); continue; }
        const int L = (ph - 1) / PH_PER_LAYER, q = (ph - 1) % PH_PER_LAYER;
        unsigned char* wb = ws + (size_t)L * LAYER_W;
        const bf16_t* XBs = XB + (size_t)MP * DM; const bf16_t* Xs = XBs;
#ifndef REPMASK
#define REPMASK 0
#endif
        for (int rep = 0; rep < 1 + ((REPMASK >> q) & 1); ++rep)
        switch (q) {
        case 0: case 8: { EpiGU e{HB, PART}; const bf16_t* W = (const bf16_t*)(wb + (q == 0 ? OFF_WGU1 : OFF_WGU2)); gemm_phase_cont(XB, W, 1024, MP / 256, 22, e);
            for (int t = blockIdx.x; t < 176; t += gridDim.x) { const int c0 = t * 16, r0 = (c0 >> 7) * 256 + (c0 & 127); FinGU f{HB, c0}; skinny_task<2, true, 4>(XBs, DM, W, 1024, r0, r0 + 128, Xs, f); } } break;
        case 1: case 9: { EpiRes e{XB, PART, 0.5f}; const bf16_t* W = (const bf16_t*)(wb + (q == 1 ? OFF_WD1 : OFF_WD2)); gemm_phase_cont(HB, W, 2816, MP / 256, 4, e);
            for (int t = blockIdx.x; t < 64; t += gridDim.x) { FinRes f{XB, 0.5f, t * 16}; skinny_task<1, false, 11>(HB + (size_t)MP * DFF, DFF, W, 2816, t * 16, 0, nullptr, f); } } break;
        case 2: { EpiProj e{PROJ, NPROJ, PART}; const bf16_t* W = (const bf16_t*)(wb + OFF_WIN); gemm_phase_cont(XB, W, 1024, MP / 256, 10, e);
            for (int t = blockIdx.x; t < 160; t += gridDim.x) { FinProj f{PROJ, t * 16}; skinny_task<1, true, 4>(XBs, DM, W, 1024, t * 16, 0, Xs, f); } } break;
        case 3:
            prep_phase(p, L, PROJ, Ub, CAT, XB, PART, DT);
            for (int it = blockIdx.x; it < MS; it += gridDim.x) prep_sample_item(p, L, it, PROJ, Ub, CAT, XB, DT);
            break;
        case 4:
            {
                int it = blockIdx.x;
                for (; it < 160 + 512; it += gridDim.x) {
                    if (it < 128) sample_attn_item(p, L, it, PROJ, CAT);
                    else if (it < 160) sample_ssd_item(p, L, it - 128, PROJ, Ub, DT, CAT);
                    else s1_item(p, L, it - 160, Ub, DT, ST, DEC);
                }
                attn_items(it - 160 - 512, gridDim.x, PROJ, OG, LSE);
            }
            break;
        case 5: scan_phase(p, L, ST, DEC); break;
        case 6:
            for (int it = blockIdx.x; it < 1024; it += gridDim.x) {
                if (it < 512) s3_item(p, L, it, Ub, PROJ, DT, ST, CAT);
                else combine_item(it - 512, OG, LSE, CAT);
            }
            break;
        case 7: { EpiRes e{XB, PART, 1.0f}; const bf16_t* W = (const bf16_t*)(wb + OFF_WOUT); gemm_phase_cont(CAT, W, 1024, MP / 256, 4, e);
            for (int t = blockIdx.x; t < 64; t += gridDim.x) { FinRes f{XB, 1.0f, t * 16}; skinny_task<1, false, 4>(CAT + (size_t)MP * DM, DM, W, 1024, t * 16, 0, nullptr, f); } } break;
        }
    }
}

constexpr int LDS_BYTES = 131072 + 64 + 4096 + 2048;

extern "C" void kernel_launch(void* const* d_in, const int* in_sizes, int n_in, void* d_out, int out_size, void* d_ws, size_t ws_size, hipStream_t stream) {
    static int grid = 0;
    if (grid == 0) {
        if (n_in != 27 || (size_t)out_size != O_END || ws_size < WS_END) {
            fprintf(stderr, "kernel_launch: unexpected shapes n_in %d out %d ws %zu (need %zu)\n", n_in, out_size, ws_size, (size_t)WS_END); grid = -1; return; }
        int dev = 0, cus = 0, per_cu = 0;
        hipGetDevice(&dev);
        hipDeviceGetAttribute(&cus, hipDeviceAttributeMultiprocessorCount, dev);
        if (hipFuncSetAttribute((const void*)mega, hipFuncAttributeMaxDynamicSharedMemorySize, LDS_BYTES) != hipSuccess) { fprintf(stderr, "hipFuncSetAttribute failed\n"); grid = -1; return; }
        hipOccupancyMaxActiveBlocksPerMultiprocessor(&per_cu, (const void*)mega, NT, LDS_BYTES);
        if (per_cu < 1) { fprintf(stderr, "occupancy query says %d blocks/CU\n", per_cu); per_cu = 1; }
        (void)hipGetLastError();
        grid = cus;
    }
    if (grid < 0) return;
    if (hipMemsetAsync((char*)d_ws + WS_BAR, 0, 16384, stream) != hipSuccess) { fprintf(stderr, "memset failed\n"); return; }
    Params p{};
    for (int i = 0; i < 27; ++i) p.in[i] = (const float*)d_in[i];
    p.out = (float*)d_out; p.ws = (unsigned char*)d_ws;
    int lo = 0, hi = NPHASE;
    void* args[] = {&p, &lo, &hi};
    hipError_t e = hipLaunchCooperativeKernel((const void*)mega, dim3(grid), dim3(NT), args, LDS_BYTES, stream);
    if (e != hipSuccess) fprintf(stderr, "cooperative launch failed: %s (grid %d)\n", hipGetErrorString(e), grid);
}
```

```cpp
#include <hip/hip_runtime.h>
#include <hip/hip_cooperative_groups.h>
#include <cstdio>
#include <cstdint>
namespace cg = cooperative_groups;

typedef unsigned short bf16_t;
typedef short bf16x8 __attribute__((ext_vector_type(8)));
typedef float f32x4 __attribute__((ext_vector_type(4)));

#define NT 512
constexpr int MP = 32768;
constexpr int MS = 32;
constexpr int MTOK = MP + MS;
constexpr int MPAD = 33024;
constexpr int DM = 1024, DFF = 2816, NPROJ = 2560, WINLD = 2568;
constexpr float EPS = 1e-6f;

constexpr size_t SZ_WGU = 5632ull * 1024 * 2, SZ_WD = 1024ull * 2816 * 2, SZ_WIN = 2560ull * 1024 * 2, SZ_WOUT = 1024ull * 1024 * 2;
constexpr size_t OFF_WGU1 = 0, OFF_WD1 = OFF_WGU1 + SZ_WGU, OFF_WIN = OFF_WD1 + SZ_WD, OFF_WOUT = OFF_WIN + SZ_WIN,
                 OFF_WGU2 = OFF_WOUT + SZ_WOUT, OFF_WD2 = OFF_WGU2 + SZ_WGU, LAYER_W = OFF_WD2 + SZ_WD;
constexpr size_t WS_XB = 2 * LAYER_W;
constexpr size_t WS_HB = WS_XB + (size_t)MPAD * 1024 * 2;
constexpr size_t WS_CAT = WS_HB + (size_t)MPAD * 2816 * 2;
constexpr size_t WS_OG = WS_CAT + (size_t)MPAD * 1024 * 2;
constexpr size_t WS_LSE = WS_OG + 3ull * MP * 256 * 2;
constexpr size_t WS_ST = WS_LSE + 3ull * MP * 4 * 4;
constexpr size_t WS_DEC = WS_ST + 256ull * 8 * 64 * 128 * 4;
constexpr size_t WS_DT = WS_DEC + 256 * 8 * 4;
constexpr size_t WS_PART = WS_DT + (size_t)MPAD * 8 * 4;
constexpr size_t WS_WDT = WS_PART + (size_t)MP * 16 * 4;
constexpr size_t WS_BAR = WS_WDT + 2 * 16 * 1024 * 2;
constexpr size_t WS_END = WS_BAR + 16384;

constexpr size_t O_Y = 0, O_POOLP = 33587200ull, O_POOLS = 33617920ull, O_KP = 33863680ull, O_KS = 38057984ull, O_VP = 71612416ull,
                 O_VS = 75806720ull, O_CONVP = 109361152ull, O_CONVS = 109385728ull, O_SSMP = 109582336ull, O_SSMS = 110106624ull,
                 O_END = 114300928ull;

struct Params { const float* in[27]; float* out; unsigned char* ws; };
enum { I_XP = 0, I_XS, I_CPOOL, I_CK, I_CV, I_SCONV, I_SSSM, I_F1N, I_F1G, I_F1U, I_F1D, I_MIXN, I_WIN, I_POOLW, I_POOLSC, I_CONVW, I_CONVB,
       I_DTB, I_ALOG, I_DSKIP, I_SSMN, I_WOUT, I_F2N, I_F2G, I_F2U, I_F2D, I_FINN };

typedef const __attribute__((address_space(4))) Params* KP;
__device__ __forceinline__ int otid() { int t = __builtin_amdgcn_workitem_id_x(); asm volatile("" : "+v"(t)); return t; }
__device__ __forceinline__ KP opaque_kp() { KP k = (KP)__builtin_amdgcn_kernarg_segment_ptr(); asm volatile("" : "+s"(k)); return k; }
__device__ __forceinline__ float bf2f(bf16_t v) { return __uint_as_float(((unsigned)v) << 16); }
__device__ __forceinline__ unsigned pk2(float lo, float hi) { unsigned r; asm("v_cvt_pk_bf16_f32 %0, %1, %2" : "=v"(r) : "v"(lo), "v"(hi)); return r; }
__device__ __forceinline__ bf16_t f2bf(float f) { return (bf16_t)(pk2(f, 0.f) & 0xffffu); }
__device__ __forceinline__ float lo16(unsigned u) { return __uint_as_float(u << 16); }
__device__ __forceinline__ float hi16(unsigned u) { return __uint_as_float(u & 0xffff0000u); }
__device__ __forceinline__ float silu(float x) { return x * __builtin_amdgcn_rcpf(1.f + __expf(-x)); }
__device__ __forceinline__ float wave_sum(float v) {
#pragma unroll
    for (int o = 32; o > 0; o >>= 1) v += __shfl_xor(v, o);
    return v;
}
__device__ __forceinline__ float wave_max(float v) {
#pragma unroll
    for (int o = 32; o > 0; o >>= 1) v = fmaxf(v, __shfl_xor(v, o));
    return v;
}
__device__ const float ROPE_INV[32] = {1.000000000e+00f, 7.498942018e-01f, 5.623413324e-01f, 4.216965139e-01f, 3.162277639e-01f, 2.371373773e-01f, 1.778279394e-01f, 1.333521456e-01f, 1.000000015e-01f, 7.498942316e-02f, 5.623413250e-02f, 4.216964915e-02f, 3.162277490e-02f, 2.371373773e-02f, 1.778279431e-02f, 1.333521400e-02f, 9.999999776e-03f, 7.498942316e-03f, 5.623413250e-03f, 4.216964822e-03f, 3.162277630e-03f, 2.371373819e-03f, 1.778279431e-03f, 1.333521446e-03f, 1.000000047e-03f, 7.498941850e-04f, 5.623413017e-04f, 4.216965172e-04f, 3.162277571e-04f, 2.371373703e-04f, 1.778279402e-04f, 1.333521504e-04f};
__device__ __forceinline__ float rope_inv(int i) { return ROPE_INV[i]; }
__device__ __forceinline__ void rope_cs(float ang, float& c, float& s) {
    const float k = rintf(ang * 0.15915494309189535f);
    float r = fmaf(-k, 6.28318548202514648f, ang); r = fmaf(-k, -1.74845553146951715e-07f, r);
    const float f = r * 0.15915494309189535f;
    s = __builtin_amdgcn_sinf(f); c = __builtin_amdgcn_cosf(f);
}
__device__ __forceinline__ uint4 zero4() { unsigned z; asm volatile("v_mov_b32 %0, 0" : "=v"(z)); uint4 r; r.x = z; r.y = z; r.z = z; r.w = z; return r; }
#define MFMA16(a, b, c) __builtin_amdgcn_mfma_f32_16x16x32_bf16((a), (b), (c), 0, 0, 0)
#define LDS_BARRIER() do { asm volatile("s_waitcnt lgkmcnt(0)" ::: "memory"); __builtin_amdgcn_s_barrier(); asm volatile("" ::: "memory"); } while (0)
#define SMEM_DECL extern __shared__ __attribute__((aligned(16))) unsigned char smem[]

constexpr int BM = 256, BK = 64, HALF = 128, HT = HALF * BK;
__device__ __forceinline__ int lds_byte(int r, int c) { int st = (r >> 4) * 2 + (c >> 5), rr = r & 15, cc = c & 31, ob = rr * 64 + cc * 2; return st * 1024 + (ob ^ (((ob >> 9) & 1) << 5)); }
__device__ __forceinline__ void stage_rc(int b, int& R, int& C) { int st = b / 1024, sb = b % 1024, swz = sb ^ (((sb >> 9) & 1) << 5); R = (st >> 1) * 16 + swz / 64; C = (st & 1) * 32 + (swz % 64) / 2; }

__device__ __forceinline__ void tile_of(int L, int nM, int nN, int& pm, int& pn) {
    const int nwg = nM * nN; int wgid = L;
    { const int q = nwg / 8, r = nwg % 8, xcd = wgid % 8, off = wgid / 8; wgid = (xcd < r ? xcd * (q + 1) : r * (q + 1) + (xcd - r) * q) + off; }
    const int nig = 8 * nN, gid = wgid / nig, fm = gid * 8, gsz = (nM - fm) < 8 ? (nM - fm) : 8;
    pm = fm + ((wgid % nig) % gsz); pn = (wgid % nig) / gsz;
}

#define LAS __attribute__((address_space(3)))
constexpr int HTB = HALF * BK * 2;
__device__ __forceinline__ float row_rstd(const float* PART, int row) {
    const float4* pp = (const float4*)(PART + (size_t)row * 16);
    const float4 a = pp[0], b = pp[1], c = pp[2], d = pp[3];
    const float ss = ((a.x + a.y) + (a.z + a.w)) + ((b.x + b.y) + (b.z + b.w)) + ((c.x + c.y) + (c.z + c.w)) + ((d.x + d.y) + (d.z + d.w));
    return rsqrtf(ss * (1.f / 1024.f) + EPS);
}
template <class Epi>
__device__ __forceinline__ void gemm_phase(const bf16_t* A, const bf16_t* Bt, const int K, const int nM, const int nN, const Epi& epi) {
    SMEM_DECL;
    LAS unsigned char* lds = (LAS unsigned char*)smem;
    const int tid = otid(), wid = __builtin_amdgcn_readfirstlane(tid >> 6), lane = tid & 63, wr = wid >> 2, wc = wid & 3, fr = lane & 15, fq = lane >> 4;
    const int nt = K / BK, ntiles = nM * nN;
    unsigned voff[2];
#pragma unroll
    for (int i = 0; i < 2; ++i) { int R, C; stage_rc(tid * 16 + i * 8192, R, C); voff[i] = (unsigned)(R * K + C) * 2u; }
    const size_t kstep = (size_t)(BK * 2), hstep = (size_t)HALF * K * 2;
    const unsigned ldsw = (unsigned)wid * 1024u;
    const int aoff = lds_byte(wr * 64 + fr, fq * 8), boff = lds_byte(wc * 32 + fr, fq * 8);
#define GSA(b, h) (((b) * 2 + (h)) * HTB)
#define GSB(b, h) ((4 + (b) * 2 + (h)) * HTB)
#define STAGE(bufoff, gbase) do { _Pragma("unroll") for (int _i = 0; _i < 2; ++_i) \
    __builtin_amdgcn_global_load_lds((const unsigned*)((const char*)(gbase) + voff[_i]), (LAS unsigned*)(lds + (bufoff) + ldsw + _i * 8192), 16, 0, 0); } while (0)
#define LDA(dst, b, h) do { _Pragma("unroll") for (int m = 0; m < 4; ++m) _Pragma("unroll") for (int k = 0; k < 2; ++k) dst[m][k] = *(const LAS bf16x8*)(lds + GSA(b, h) + aoff + m * 2048 + k * 1024); } while (0)
#define LDB(dst, b, h) do { _Pragma("unroll") for (int n = 0; n < 2; ++n) _Pragma("unroll") for (int k = 0; k < 2; ++k) dst[n][k] = *(const LAS bf16x8*)(lds + GSB(b, h) + boff + n * 2048 + k * 1024); } while (0)
#define MMA(ai, bj, At_, Bt_) do { __builtin_amdgcn_s_setprio(1); _Pragma("unroll") for (int m = 0; m < 4; ++m) _Pragma("unroll") for (int n = 0; n < 2; ++n) _Pragma("unroll") for (int k = 0; k < 2; ++k) \
      acc[ai][bj][m][n] = __builtin_amdgcn_mfma_f32_16x16x32_bf16(Bt_[n][k], At_[m][k], acc[ai][bj][m][n], 0, 0, 0); \
    __builtin_amdgcn_s_setprio(0); } while (0)
#define WAIT_V(n) asm volatile("s_waitcnt vmcnt(" #n ")" ::: "memory")
#define WAIT_L(n) asm volatile("s_waitcnt lgkmcnt(" #n ")" ::: "memory")
#define BAR __builtin_amdgcn_s_barrier()
#define SCHED __builtin_amdgcn_sched_barrier(0)
    int L = blockIdx.x;
    WAIT_V(0); __syncthreads();
    if (L >= ntiles) return;
    int pm, pn; tile_of(L, nM, nN, pm, pn);
    const char* cA = (const char*)A + (size_t)(pm * 256) * K * 2;
    const char* cB = (const char*)Bt + (size_t)(pn * 256) * K * 2;
    STAGE(GSB(0, 0), cB); STAGE(GSA(0, 0), cA); STAGE(GSB(0, 1), cB + hstep); STAGE(GSA(0, 1), cA + hstep);
    float* rsb = (float*)(smem + 131072 + 64 + 4096);
    int rbuf = 0;
    if (Epi::NEEDS_RS && tid < 256) rsb[tid] = row_rstd(epi.PART, pm * 256 + tid);
    bool first = true;
    for (;;) {
        f32x4 acc[2][2][4][2];
#pragma unroll
        for (int a = 0; a < 2; ++a)
#pragma unroll
            for (int b = 0; b < 2; ++b)
#pragma unroll
                for (int m = 0; m < 4; ++m)
#pragma unroll
                    for (int n = 0; n < 2; ++n) acc[a][b][m][n] = (f32x4){0.f, 0.f, 0.f, 0.f};
        bf16x8 At[4][2], B0[2][2], B1[2][2];
        if (wr == 1) BAR;
        if (first) { WAIT_V(4); } else { asm volatile("s_waitcnt vmcnt(%0)" :: "n"(Epi::NST) : "memory"); }
        BAR;
        STAGE(GSB(1, 0), cB + kstep); STAGE(GSA(1, 0), cA + kstep); STAGE(GSB(1, 1), cB + hstep + kstep);
        WAIT_V(6); BAR;
        for (int t = 0; t < nt - 2; t += 2) {
            const char* a1 = cA + (size_t)(t + 1) * kstep; const char* a2 = a1 + kstep; const char* a3 = a2 + kstep;
            const char* b2 = cB + (size_t)(t + 2) * kstep; const char* b3 = b2 + kstep;
            LDB(B0, 0, 0); SCHED; LDA(At, 0, 0); STAGE(GSA(1, 1), a1 + hstep);
            WAIT_L(8); BAR; WAIT_L(0); MMA(0, 0, At, B0); BAR; SCHED;
            LDB(B1, 0, 1); STAGE(GSB(0, 0), b2);
            BAR; WAIT_L(0); MMA(0, 1, At, B1); BAR;
            LDA(At, 0, 1); STAGE(GSA(0, 0), a2);
            BAR; WAIT_L(0); MMA(1, 0, At, B0); BAR; SCHED;
            STAGE(GSB(0, 1), b2 + hstep);
            WAIT_V(6); BAR; MMA(1, 1, At, B1); BAR;
            LDB(B0, 1, 0); SCHED; LDA(At, 1, 0); STAGE(GSA(0, 1), a2 + hstep);
            WAIT_L(8); BAR; WAIT_L(0); MMA(0, 0, At, B0); BAR; SCHED;
            LDB(B1, 1, 1); STAGE(GSB(1, 0), b3);
            BAR; WAIT_L(0); MMA(0, 1, At, B1); BAR;
            LDA(At, 1, 1); STAGE(GSA(1, 0), a3);
            BAR; WAIT_L(0); MMA(1, 0, At, B0); BAR; SCHED;
            STAGE(GSB(1, 1), b3 + hstep);
            WAIT_V(6); BAR; MMA(1, 1, At, B1); BAR;
        }
        { LDB(B0, 0, 0); LDA(At, 0, 0); STAGE(GSA(1, 1), cA + (size_t)(nt - 1) * kstep + hstep);
          BAR; WAIT_L(0); MMA(0, 0, At, B0); BAR;
          LDB(B1, 0, 1); BAR; WAIT_L(0); MMA(0, 1, At, B1); BAR;
          LDA(At, 0, 1); WAIT_V(4); BAR; WAIT_L(0); MMA(1, 0, At, B0); MMA(1, 1, At, B1); BAR; }
        { LDB(B0, 1, 0); LDA(At, 1, 0); WAIT_V(2); BAR; WAIT_L(0); MMA(0, 0, At, B0); BAR;
          LDB(B1, 1, 1); WAIT_V(0); BAR; WAIT_L(0); MMA(0, 1, At, B1); BAR;
          LDA(At, 1, 1); BAR; WAIT_L(0); MMA(1, 0, At, B0); MMA(1, 1, At, B1); BAR; }
        if (wr == 0) BAR;
        const int brow = pm * 256, bcol = pn * 256;
        L += gridDim.x;
        const bool more = L < ntiles;
        if (more) {
            tile_of(L, nM, nN, pm, pn);
            cA = (const char*)A + (size_t)(pm * 256) * K * 2; cB = (const char*)Bt + (size_t)(pn * 256) * K * 2;
            STAGE(GSB(0, 0), cB); STAGE(GSA(0, 0), cA); STAGE(GSB(0, 1), cB + hstep); STAGE(GSA(0, 1), cA + hstep);
            SCHED;
        }
        float rs_next = 0.f;
        if (Epi::NEEDS_RS && more && tid < 256) rs_next = row_rstd(epi.PART, pm * 256 + tid);
        epi(acc, brow, bcol, wr, wc, fr, fq, rsb + rbuf * 256);
        SCHED;
        if (!more) break;
        if (Epi::NEEDS_RS && tid < 256) rsb[(rbuf ^ 1) * 256 + tid] = rs_next;
        rbuf ^= 1;
        first = false;
    }
    asm volatile("s_waitcnt vmcnt(0)" ::: "memory");
    __syncthreads();
}

template <class Epi>
__device__ __forceinline__ void gemm_phase_cont(const bf16_t* A, const bf16_t* Bt, const int K, const int nM, const int nN, const Epi& epi) {
    SMEM_DECL;
    LAS unsigned char* lds = (LAS unsigned char*)smem;
    const int tid = otid(), wid = __builtin_amdgcn_readfirstlane(tid >> 6), lane = tid & 63, wr = wid >> 2, wc = wid & 3, fr = lane & 15, fq = lane >> 4;
    const int nt = K / BK, ntiles = nM * nN;
    unsigned voff[2];
#pragma unroll
    for (int i = 0; i < 2; ++i) { int R, C; stage_rc(tid * 16 + i * 8192, R, C); voff[i] = (unsigned)(R * K + C) * 2u; }
    const size_t kstep = (size_t)(BK * 2), hstep = (size_t)HALF * K * 2;
    const unsigned ldsw = (unsigned)wid * 1024u;
    const int aoff = lds_byte(wr * 64 + fr, fq * 8), boff = lds_byte(wc * 32 + fr, fq * 8);
    int L = blockIdx.x;
    WAIT_V(0); __syncthreads();
    if (L >= ntiles) return;
    int pm, pn; tile_of(L, nM, nN, pm, pn);
    const char* cA = (const char*)A + (size_t)(pm * 256) * K * 2;
    const char* cB = (const char*)Bt + (size_t)(pn * 256) * K * 2;
    f32x4 acc[2][2][4][2];
#pragma unroll
    for (int a = 0; a < 2; ++a)
#pragma unroll
        for (int b = 0; b < 2; ++b)
#pragma unroll
            for (int m = 0; m < 4; ++m)
#pragma unroll
                for (int n = 0; n < 2; ++n) acc[a][b][m][n] = (f32x4){0.f, 0.f, 0.f, 0.f};
    bf16x8 At[4][2], B0[2][2], B1[2][2];
    float* rsb = (float*)(smem + 131072 + 64 + 4096);
    int rbuf = 0;
    float rs0 = 0.f;
    if (Epi::NEEDS_RS && tid < 256) rs0 = row_rstd(epi.PART, pm * 256 + tid);
    STAGE(GSB(0, 0), cB); STAGE(GSB(0, 1), cB + hstep); STAGE(GSA(0, 0), cA); STAGE(GSA(0, 1), cA + hstep);
    if (wr == 1) BAR;
    WAIT_V(2); BAR;
    STAGE(GSB(1, 0), cB + kstep); STAGE(GSA(1, 0), cA + kstep); STAGE(GSB(1, 1), cB + hstep + kstep);
    WAIT_V(6); BAR;
    if (Epi::NEEDS_RS && tid < 256) rsb[tid] = rs0;
    for (;;) {
        const int Ln = L + gridDim.x; const bool has_next = Ln < ntiles;
        int npm = pm, npn = pn; if (has_next) tile_of(Ln, nM, nN, npm, npn);
        const char* nA = (const char*)A + (size_t)(npm * 256) * K * 2; const char* nB = (const char*)Bt + (size_t)(npn * 256) * K * 2;
        for (int t = 0; t < nt; t += 2) {
            const bool last = (t == nt - 2);
            const char* a1 = cA + (size_t)(t + 1) * kstep;
            const char* a2 = last ? nA : cA + (size_t)(t + 2) * kstep; const char* b2 = last ? nB : cB + (size_t)(t + 2) * kstep;
            const char* a3 = a2 + kstep; const char* b3 = b2 + kstep;
            LDB(B0, 0, 0); LDB(B1, 0, 1); SCHED; LDA(At, 0, 0); STAGE(GSA(1, 1), a1 + hstep);
            WAIT_V(8); WAIT_L(0); BAR; MMA(0, 0, At, B0); MMA(0, 1, At, B1); BAR; SCHED;
            LDA(At, 0, 1); STAGE(GSB(0, 0), b2); STAGE(GSB(0, 1), b2 + hstep); STAGE(GSA(0, 0), a2);
            WAIT_V(8); WAIT_L(0); BAR; MMA(1, 0, At, B0); MMA(1, 1, At, B1); BAR; SCHED;
            LDB(B0, 1, 0); LDB(B1, 1, 1); SCHED; LDA(At, 1, 0); STAGE(GSA(0, 1), a2 + hstep);
            WAIT_V(8); WAIT_L(0); BAR; MMA(0, 0, At, B0); MMA(0, 1, At, B1); BAR; SCHED;
            LDA(At, 1, 1); STAGE(GSB(1, 0), b3); STAGE(GSB(1, 1), b3 + hstep); STAGE(GSA(1, 0), a3);
            WAIT_V(8); WAIT_L(0); BAR; MMA(1, 0, At, B0); MMA(1, 1, At, B1); BAR; SCHED;
        }
        if (wr == 0) BAR;
        float rs_next = 0.f;
        if (Epi::NEEDS_RS && has_next && tid < 256) rs_next = row_rstd(epi.PART, npm * 256 + tid);
        epi(acc, pm * 256, pn * 256, wr, wc, fr, fq, rsb + rbuf * 256);
        SCHED;
        if (!has_next) break;
        if (Epi::NEEDS_RS && tid < 256) rsb[(rbuf ^ 1) * 256 + tid] = rs_next;
        rbuf ^= 1;
#pragma unroll
        for (int a = 0; a < 2; ++a)
#pragma unroll
            for (int b = 0; b < 2; ++b)
#pragma unroll
                for (int m = 0; m < 4; ++m)
#pragma unroll
                    for (int n = 0; n < 2; ++n) acc[a][b][m][n] = (f32x4){0.f, 0.f, 0.f, 0.f};
        L = Ln; pm = npm; pn = npn; cA = nA; cB = nB;
        if (wr == 1) BAR;
    }
    WAIT_V(0);
    BAR;
    __syncthreads();
}

struct EpiGU {
    static constexpr int NST = 16; static constexpr bool NEEDS_RS = true;
    bf16_t* __restrict__ H; const float* __restrict__ PART;
    __device__ __forceinline__ void operator()(const f32x4 (&acc)[2][2][4][2], int brow, int bcol, int wr, int wc, int fr, int fq, const float* rsl) const {
        const int cbase = (bcol >> 8) * 128 + wc * 32 + fq * 8;
        float rs[2][4];
#pragma unroll
        for (int ai = 0; ai < 2; ++ai)
#pragma unroll
            for (int m = 0; m < 4; ++m) rs[ai][m] = rsl[ai * 128 + wr * 64 + m * 16 + fr];
#pragma unroll
        for (int ai = 0; ai < 2; ++ai)
#pragma unroll
            for (int m = 0; m < 4; ++m) {
                const int row = brow + ai * 128 + wr * 64 + m * 16 + fr;
                const f32x4 g0 = acc[ai][0][m][0] * rs[ai][m], u0 = acc[ai][1][m][0] * rs[ai][m], g1 = acc[ai][0][m][1] * rs[ai][m], u1 = acc[ai][1][m][1] * rs[ai][m];
                uint4 o; o.x = pk2(silu(g0[0]) * u0[0], silu(g0[1]) * u0[1]); o.y = pk2(silu(g0[2]) * u0[2], silu(g0[3]) * u0[3]);
                o.z = pk2(silu(g1[0]) * u1[0], silu(g1[1]) * u1[1]); o.w = pk2(silu(g1[2]) * u1[2], silu(g1[3]) * u1[3]);
                *(uint4*)(H + (size_t)row * DFF + cbase) = o;
            }
    }
};
struct EpiRes {
    static constexpr int NST = 16; static constexpr bool NEEDS_RS = false;
    bf16_t* XB; float* PART; float scale;
    __device__ __forceinline__ void operator()(const f32x4 (&acc)[2][2][4][2], int brow, int bcol, int wr, int wc, int fr, int fq, const float*) const {
        uint4 v[2][4][2];
#pragma unroll
        for (int ai = 0; ai < 2; ++ai)
#pragma unroll
            for (int m = 0; m < 4; ++m)
#pragma unroll
                for (int bj = 0; bj < 2; ++bj)
                    v[ai][m][bj] = *(const uint4*)(XB + (size_t)(brow + ai * 128 + wr * 64 + m * 16 + fr) * DM + bcol + bj * 128 + wc * 32 + fq * 8);
#pragma unroll
        for (int ai = 0; ai < 2; ++ai)
#pragma unroll
            for (int m = 0; m < 4; ++m) {
                const int row = brow + ai * 128 + wr * 64 + m * 16 + fr;
                float ss = 0.f;
#pragma unroll
                for (int bj = 0; bj < 2; ++bj) {
                    const uint4 xv = v[ai][m][bj]; const f32x4 a0 = acc[ai][bj][m][0], a1 = acc[ai][bj][m][1];
                    uint4 o; o.x = pk2(lo16(xv.x) + scale * a0[0], hi16(xv.x) + scale * a0[1]); o.y = pk2(lo16(xv.y) + scale * a0[2], hi16(xv.y) + scale * a0[3]);
                    o.z = pk2(lo16(xv.z) + scale * a1[0], hi16(xv.z) + scale * a1[1]); o.w = pk2(lo16(xv.w) + scale * a1[2], hi16(xv.w) + scale * a1[3]);
                    *(uint4*)(XB + (size_t)row * DM + bcol + bj * 128 + wc * 32 + fq * 8) = o;
                    const float r0 = lo16(o.x), r1 = hi16(o.x), r2 = lo16(o.y), r3 = hi16(o.y), r4 = lo16(o.z), r5 = hi16(o.z), r6 = lo16(o.w), r7 = hi16(o.w);
                    ss += (r0 * r0 + r1 * r1) + (r2 * r2 + r3 * r3) + (r4 * r4 + r5 * r5) + (r6 * r6 + r7 * r7);
                }
                ss += __shfl_xor(ss, 16); ss += __shfl_xor(ss, 32);
                if (fq == 0) PART[(size_t)row * 16 + (bcol >> 8) * 4 + wc] = ss;
            }
    }
};
struct EpiProj {
    static constexpr int NST = 32; static constexpr bool NEEDS_RS = true;
    bf16_t* __restrict__ P; int ld; const float* __restrict__ PART;
    __device__ __forceinline__ void operator()(const f32x4 (&acc)[2][2][4][2], int brow, int bcol, int wr, int wc, int fr, int fq, const float* rsl) const {
        float rs[2][4];
#pragma unroll
        for (int ai = 0; ai < 2; ++ai)
#pragma unroll
            for (int m = 0; m < 4; ++m) rs[ai][m] = rsl[ai * 128 + wr * 64 + m * 16 + fr];
#pragma unroll
        for (int ai = 0; ai < 2; ++ai)
#pragma unroll
            for (int m = 0; m < 4; ++m) {
                const int row = brow + ai * 128 + wr * 64 + m * 16 + fr;
#pragma unroll
                for (int bj = 0; bj < 2; ++bj) {
                    const f32x4 a0 = acc[ai][bj][m][0] * rs[ai][m], a1 = acc[ai][bj][m][1] * rs[ai][m];
                    uint4 o; o.x = pk2(a0[0], a0[1]); o.y = pk2(a0[2], a0[3]); o.z = pk2(a1[0], a1[1]); o.w = pk2(a1[2], a1[3]);
                    *(uint4*)(P + (size_t)row * ld + bcol + bj * 128 + wc * 32 + fq * 8) = o;
                }
            }
    }
};

template <int NB, bool RS, int NKS, class Fin>
__device__ __forceinline__ void skinny_task(const bf16_t* __restrict__ A, int lda, const bf16_t* __restrict__ Bt, int K, int brow0, int brow1, const bf16_t* Xs, const Fin& fin) {
    SMEM_DECL;
    float* red = (float*)smem;
    float* rsd = red + 8 * NB * 2 * 64 * 4;
    const int tid = otid(), lane = tid & 63, w = tid >> 6, fr = lane & 15, fq = lane >> 4;
    const int kw = K >> 3;
    f32x4 acc[NB][2];
#pragma unroll
    for (int nb = 0; nb < NB; ++nb) { acc[nb][0] = (f32x4){0.f, 0.f, 0.f, 0.f}; acc[nb][1] = (f32x4){0.f, 0.f, 0.f, 0.f}; }
    __syncthreads();
    float rsv[4];
    if (RS) {
#pragma unroll
        for (int rr = 0; rr < 4; ++rr) {
            const bf16_t* xr = Xs + (size_t)(w * 4 + rr) * DM;
            float ss = 0.f;
#pragma unroll
            for (int i = 0; i < 2; ++i) { const uint4 v = *(const uint4*)(xr + i * 512 + lane * 8);
                ss += lo16(v.x) * lo16(v.x) + hi16(v.x) * hi16(v.x) + lo16(v.y) * lo16(v.y) + hi16(v.y) * hi16(v.y) + lo16(v.z) * lo16(v.z) + hi16(v.z) * hi16(v.z) + lo16(v.w) * lo16(v.w) + hi16(v.w) * hi16(v.w); }
            rsv[rr] = ss;
        }
    }
    {
        bf16x8 a0[NKS], a1[NKS], b0[NKS], b1[NKS];
#pragma unroll
        for (int ks = 0; ks < NKS; ++ks) {
            const int k0 = w * kw + ks * 32 + fq * 8;
            a0[ks] = *(const bf16x8*)(A + (size_t)fr * lda + k0); a1[ks] = *(const bf16x8*)(A + (size_t)(16 + fr) * lda + k0);
            b0[ks] = *(const bf16x8*)(Bt + (size_t)(brow0 + fr) * K + k0);
            if (NB == 2) b1[ks] = *(const bf16x8*)(Bt + (size_t)(brow1 + fr) * K + k0);
        }
#pragma unroll
        for (int ks = 0; ks < NKS; ++ks) {
            acc[0][0] = MFMA16(b0[ks], a0[ks], acc[0][0]); acc[0][1] = MFMA16(b0[ks], a1[ks], acc[0][1]);
            if (NB == 2) { acc[NB - 1][0] = MFMA16(b1[ks], a0[ks], acc[NB - 1][0]); acc[NB - 1][1] = MFMA16(b1[ks], a1[ks], acc[NB - 1][1]); }
        }
    }
    if (RS) {
#pragma unroll
        for (int rr = 0; rr < 4; ++rr) { const float ss = wave_sum(rsv[rr]); if (lane == 0) rsd[w * 4 + rr] = rsqrtf(ss * (1.f / 1024.f) + EPS); }
    }
#pragma unroll
    for (int nb = 0; nb < NB; ++nb)
#pragma unroll
        for (int mt = 0; mt < 2; ++mt) { float4 v; v.x = acc[nb][mt][0]; v.y = acc[nb][mt][1]; v.z = acc[nb][mt][2]; v.w = acc[nb][mt][3];
            *(float4*)(red + (((w * NB + nb) * 2 + mt) * 64 + lane) * 4) = v; }
    __syncthreads();
    {
        const int mt = tid >> 8, ln = (tid >> 2) & 63, jj = tid & 3;
        float v0 = 0.f, v1 = 0.f;
#pragma unroll
        for (int ww = 0; ww < 8; ++ww) {
            v0 += red[(((ww * NB + 0) * 2 + mt) * 64 + ln) * 4 + jj];
            if (NB == 2) v1 += red[(((ww * NB + NB - 1) * 2 + mt) * 64 + ln) * 4 + jj];
        }
        const float rs = RS ? rsd[mt * 16 + (ln & 15)] : 1.f;
        fin(mt * 16 + (ln & 15), (ln >> 4) * 4 + jj, v0 * rs, v1 * rs);
    }
}

struct FinGU { bf16_t* H; int c0; __device__ __forceinline__ void operator()(int m, int j, float g, float u) const { const int col = (c0 & ~31) + 8 * (j >> 2) + 4 * ((c0 >> 4) & 1) + (j & 3); H[(size_t)(MP + m) * DFF + col] = f2bf(silu(g) * u); } };
struct FinRes { bf16_t* XB; float scale; int c0; __device__ __forceinline__ void operator()(int m, int j, float v, float) const { const size_t o = (size_t)(MP + m) * DM + (c0 & ~31) + 8 * (j >> 2) + 4 * ((c0 >> 4) & 1) + (j & 3); XB[o] = f2bf(bf2f(XB[o]) + scale * v); } };
struct FinProj { bf16_t* P; int c0; __device__ __forceinline__ void operator()(int m, int j, float v, float) const { const int col = (c0 & ~31) + 8 * (j >> 2) + 4 * ((c0 >> 4) & 1) + (j & 3); P[(size_t)(MP + m) * NPROJ + col] = f2bf(v); } };

__device__ __forceinline__ void transpose_tile(const float* __restrict__ src, int ldn, int K, int k0, int c0, bf16_t* __restrict__ dst, int drow0, const float* __restrict__ gk, bool perm) {
    SMEM_DECL;
    float* tile = (float*)smem;
    const int tid = otid();
    __syncthreads();
    {
        float4 v[8];
#pragma unroll
        for (int r = 0; r < 8; ++r) { const int id = tid + r * NT, k = id >> 4, n4 = (id & 15) * 4; v[r] = *(const float4*)(src + (size_t)(k0 + k) * ldn + c0 + n4); }
#pragma unroll
        for (int r = 0; r < 8; ++r) { const int id = tid + r * NT, k = id >> 4, n4 = (id & 15) * 4; const float gs = gk ? gk[k0 + k] : 1.f;
            float* t = tile + k * 65 + n4; t[0] = v[r].x * gs; t[1] = v[r].y * gs; t[2] = v[r].z * gs; t[3] = v[r].w * gs; }
    }
    __syncthreads();
#pragma unroll
    for (int r = 0; r < 4; ++r) {
        const int id = tid + r * NT, a = id & 3, n16 = (id >> 2) & 15, rest = id >> 6, n = (rest & 3) * 16 + n16, kc = (rest >> 2) * 4 + a;
        const int c32 = n & 31, nd = perm ? (n & ~31) + 16 * ((c32 >> 2) & 1) + 4 * (c32 >> 3) + (c32 & 3) : n;
        const float* t = tile + (8 * kc) * 65 + n;
        uint4 o; o.x = pk2(t[0], t[65]); o.y = pk2(t[130], t[195]); o.z = pk2(t[260], t[325]); o.w = pk2(t[390], t[455]);
        *(uint4*)(dst + (size_t)(drow0 + nd) * K + k0 + 8 * kc) = o;
    }
}

__device__ void weights_phase(KP p) {
    for (int it = blockIdx.x; it < 2 * 1280; it += gridDim.x) {
        const int L = it / 1280; int r = it % 1280;
        unsigned char* wb = p->ws + (size_t)L * LAYER_W;
        if (r < 528 || r >= 752) {
            const bool second = r >= 752; if (second) r -= 752;
            const float* G = (second ? p->in[I_F2G] : p->in[I_F1G]) + (size_t)L * 1024 * 2816;
            const float* U = (second ? p->in[I_F2U] : p->in[I_F1U]) + (size_t)L * 1024 * 2816;
            const float* D = (second ? p->in[I_F2D] : p->in[I_F1D]) + (size_t)L * 2816 * 1024;
            bf16_t* wgu = (bf16_t*)(wb + (second ? OFF_WGU2 : OFF_WGU1));
            bf16_t* wd = (bf16_t*)(wb + (second ? OFF_WD2 : OFF_WD1));
            if (r < 352) { const bool up = r >= 176; if (up) r -= 176; const int kt = r / 44, nt = r % 44, c0 = nt * 64;
                transpose_tile(up ? U : G, 2816, 1024, kt * 256, c0, wgu, (c0 >> 7) * 256 + (c0 & 127) + (up ? 128 : 0), (second ? p->in[I_F2N] : p->in[I_F1N]) + L * 1024, true); }
            else { r -= 352; const int kt = r / 16, nt = r % 16; transpose_tile(D, 1024, 2816, kt * 256, nt * 64, wd, nt * 64, nullptr, true); }
        } else if (r < 688) { r -= 528; const int kt = r / 40, nt = r % 40;
            transpose_tile(p->in[I_WIN] + (size_t)L * 1024 * WINLD, WINLD, 1024, kt * 256, nt * 64, (bf16_t*)(wb + OFF_WIN), nt * 64, p->in[I_MIXN] + L * 1024, true);
        } else { r -= 688; const int kt = r / 16, nt = r % 16;
            transpose_tile(p->in[I_WOUT] + (size_t)L * 1024 * 1024, 1024, 1024, kt * 256, nt * 64, (bf16_t*)(wb + OFF_WOUT), nt * 64, nullptr, true); }
    }
    for (int e = blockIdx.x * NT + otid(); e < 2 * 16 * 1024; e += gridDim.x * NT) {
        const int L = e >> 14, h = (e >> 10) & 15, k = e & 1023;
        ((bf16_t*)(p->ws + WS_WDT))[e] = h < 8 ? f2bf(p->in[I_WIN][((size_t)L * 1024 + k) * WINLD + 2560 + h] * p->in[I_MIXN][L * 1024 + k]) : (bf16_t)0;
    }
    __syncthreads();
}

__device__ void cache_copy_phase(KP p) {
    constexpr unsigned per = 2047u * 256u / 4u;
    constexpr unsigned total = 128u * per;
    const unsigned stride = gridDim.x * NT;
    const float* ck = p->in[I_CK]; const float* cv = p->in[I_CV]; float* out = p->out;
#define CC_IDX(j) unsigned i##j = ib + (j) * stride; i##j = i##j < total ? i##j : total - 1u; \
    const unsigned seg##j = i##j / per, e##j = i##j % per, kv##j = seg##j >> 6, ln##j = seg##j & 63u; \
    const float4* s##j = (const float4*)((kv##j ? cv : ck) + (size_t)ln##j * 2048 * 256 + 256) + e##j; \
    float4* d##j = (float4*)(out + (kv##j ? O_VS : O_KS) + (size_t)ln##j * 2048 * 256) + e##j;
    for (unsigned ib = blockIdx.x * NT + otid(); ib < total; ib += 8u * stride) {
        CC_IDX(0) CC_IDX(1) CC_IDX(2) CC_IDX(3) CC_IDX(4) CC_IDX(5) CC_IDX(6) CC_IDX(7)
        const float4 v0 = *s0, v1 = *s1, v2 = *s2, v3 = *s3, v4 = *s4, v5 = *s5, v6 = *s6, v7 = *s7;
        *d0 = v0; *d1 = v1; *d2 = v2; *d3 = v3; *d4 = v4; *d5 = v5; *d6 = v6; *d7 = v7;
    }
#undef CC_IDX
}

__device__ void copy_phase(KP p, bf16_t* XB, float* PART) {
    const int lane = otid() & 63, wave = otid() >> 6;
    const int nw = gridDim.x * 8;
    for (int row0 = blockIdx.x * 8 + wave; row0 < MTOK; row0 += 4 * nw) {
        float4 v[4][4];
#pragma unroll
        for (int r = 0; r < 4; ++r) {
            int row = row0 + r * nw; row = row < MTOK ? row : MTOK - 1;
            const float* src = row < MP ? p->in[I_XP] + (size_t)row * DM : p->in[I_XS] + (size_t)(row - MP) * DM;
#pragma unroll
            for (int i = 0; i < 4; ++i) v[r][i] = *(const float4*)(src + i * 256 + lane * 4);
        }
#pragma unroll
        for (int r = 0; r < 4; ++r) {
            int row = row0 + r * nw; row = row < MTOK ? row : MTOK - 1;
            float ss = 0.f;
#pragma unroll
            for (int i = 0; i < 4; ++i) ss += v[r][i].x * v[r][i].x + v[r][i].y * v[r][i].y + v[r][i].z * v[r][i].z + v[r][i].w * v[r][i].w;
            ss = wave_sum(ss);
#pragma unroll
            for (int i = 0; i < 4; ++i) { uint2 o; o.x = pk2(v[r][i].x, v[r][i].y); o.y = pk2(v[r][i].z, v[r][i].w); *(uint2*)(XB + (size_t)row * DM + i * 256 + lane * 4) = o; }
            if (row < MP && lane < 16) PART[(size_t)row * 16 + lane] = lane == 0 ? ss : 0.f;
        }
    }
}
__device__ void final_phase(KP p, const bf16_t* XB, float* Y) {
    const int lane = otid() & 63, wave = otid() >> 6;
    const int nw = gridDim.x * 8;
    float4 gv[4];
#pragma unroll
    for (int i = 0; i < 4; ++i) gv[i] = *(const float4*)(p->in[I_FINN] + i * 256 + lane * 4);
    for (int row0 = blockIdx.x * 8 + wave; row0 < MTOK; row0 += 4 * nw) {
        uint2 u[4][4];
#pragma unroll
        for (int r = 0; r < 4; ++r) {
            int row = row0 + r * nw; row = row < MTOK ? row : MTOK - 1;
#pragma unroll
            for (int i = 0; i < 4; ++i) u[r][i] = *(const uint2*)(XB + (size_t)row * DM + i * 256 + lane * 4);
        }
#pragma unroll
        for (int r = 0; r < 4; ++r) {
            int row = row0 + r * nw; row = row < MTOK ? row : MTOK - 1;
            float4 v[4]; float ss = 0.f;
#pragma unroll
            for (int i = 0; i < 4; ++i) { v[i] = make_float4(lo16(u[r][i].x), hi16(u[r][i].x), lo16(u[r][i].y), hi16(u[r][i].y)); ss += v[i].x * v[i].x + v[i].y * v[i].y + v[i].z * v[i].z + v[i].w * v[i].w; }
            ss = wave_sum(ss);
            const float rstd = rsqrtf(ss * (1.f / 1024.f) + EPS);
#pragma unroll
            for (int i = 0; i < 4; ++i) { float4 o; o.x = v[i].x * rstd * gv[i].x; o.y = v[i].y * rstd * gv[i].y; o.z = v[i].z * rstd * gv[i].z; o.w = v[i].w * rstd * gv[i].w;
                *(float4*)(Y + (size_t)row * DM + i * 256 + lane * 4) = o; }
        }
    }
}

__device__ void prep_phase(KP p, int L, bf16_t* PROJ, bf16_t* U, bf16_t* CAT, const bf16_t* XB, const float* PART, float* DT) {
    SMEM_DECL;
    float* PW = (float*)smem; float* XA = PW + 16384; float* Dm = XA + 31 * 256; float* CS = Dm + 4096; float* INV = CS + 1024; float* DTP = INV + 32;
    const int tid = otid(), lane = tid & 63, w = tid >> 6, fr = lane & 15, fq = lane >> 4;
    __syncthreads();
    bf16_t* PWT = (bf16_t*)PW;
    bf16_t* DmB = (bf16_t*)Dm;
    for (int i = tid; i < 16384; i += NT) { const int gg = i >> 12, c = (i >> 6) & 63, dd = i & 63; PWT[(gg * 64 + 32 * (dd >> 5) + 16 * ((dd >> 2) & 1) + 4 * ((dd >> 3) & 3) + (dd & 3)) * 72 + c] = f2bf(p->in[I_POOLW][L * 16384 + i]); }
    if (tid < 32) INV[tid] = rope_inv(tid);
    __syncthreads();
    float* out = p->out;
    const bf16_t* wdt = (const bf16_t*)(p->ws + WS_WDT) + (size_t)L * 16 * 1024;
    const int tiles_per = (2048 + gridDim.x - 1) / gridDim.x;
    for (int tile = blockIdx.x * tiles_per; tile < 2048 && tile < (blockIdx.x + 1) * tiles_per; ++tile) {
        const int token0 = tile * 16, b = token0 >> 13, t0 = token0 & 8191;
        bf16x8 da[4], db[4];
#pragma unroll
        for (int ks = 0; ks < 4; ++ks) { const int k0 = w * 128 + ks * 32 + fq * 8;
            da[ks] = *(const bf16x8*)(XB + (size_t)(token0 + fr) * DM + k0); db[ks] = *(const bf16x8*)(wdt + fr * 1024 + k0); }
        uint4 xav[2];
#pragma unroll
        for (int it = 0; it < 2; ++it) { const int id = tid + it * NT, rr = id >> 5, ch = id & 31, t = t0 - 15 + rr;
            xav[it] = zero4();
            if (id < 992 && t >= 0) xav[it] = *(const uint4*)(PROJ + (size_t)(b * 8192 + t) * NPROJ + ch * 8); }
        const int r_tk = tid >> 5, r_rest = tid & 31, r_qk = r_rest >> 4, r_h = (r_rest >> 2) & 3, r_i0 = (r_rest & 3) * 8;
        bf16_t* rbase = PROJ + (size_t)(token0 + r_tk) * NPROJ + 256 + r_qk * 256 + r_h * 64 + r_i0;
        const uint4 rxa = *(const uint4*)rbase, rxb = *(const uint4*)(rbase + 32);
        uint4 vld = zero4();
        if (t0 >= 6144) vld = *(const uint4*)(PROJ + (size_t)(token0 + (tid >> 5)) * NPROJ + 768 + (tid & 31) * 8);
        const int q4 = tid >> 7, c0 = (tid & 127) * 8;
        uint4 xr[7];
#pragma unroll
        for (int rr = 0; rr < 7; ++rr) { const int tt = t0 + q4 * 4 - 3 + rr;
            xr[rr] = zero4();
            if (tt >= 0) xr[rr] = *(const uint4*)(PROJ + (size_t)(b * 8192 + tt) * NPROJ + 1536 + c0); }
        {
            f32x4 acc = (f32x4){0.f, 0.f, 0.f, 0.f};
#pragma unroll
            for (int ks = 0; ks < 4; ++ks) acc = MFMA16(db[ks], da[ks], acc);
            if (fq < 2) { float4 v; v.x = acc[0]; v.y = acc[1]; v.z = acc[2]; v.w = acc[3]; *(float4*)(DTP + (w * 16 + fr) * 8 + fq * 4) = v; }
        }
#pragma unroll
        for (int it = 0; it < 2; ++it) { const int id = tid + it * NT, rr = id >> 5, ch = id & 31;
            if (id < 992) { float* d = XA + rr * 256 + ch * 8; const uint4 v = xav[it];
                d[0] = lo16(v.x); d[1] = hi16(v.x); d[2] = lo16(v.y); d[3] = hi16(v.y); d[4] = lo16(v.z); d[5] = hi16(v.z); d[6] = lo16(v.w); d[7] = hi16(v.w); } }
        { const int tk = tid >> 5, i = tid & 31; float c, sn; rope_cs((float)(t0 + tk) * INV[i], c, sn); CS[(tk * 32 + i) * 2] = c; CS[(tk * 32 + i) * 2 + 1] = sn; }
        __syncthreads();
        if (tid < 128) {
            const int tk = tid >> 3, h = tid & 7;
            float d = 0.f;
#pragma unroll
            for (int ww = 0; ww < 8; ++ww) d += DTP[(ww * 16 + tk) * 8 + h];
            const float x = d * row_rstd(PART, token0 + tk) + p->in[I_DTB][L * 8 + h];
            DT[(size_t)(token0 + tk) * 8 + h] = x > 20.f ? x : log1pf(__expf(x));
        }
        for (int id = tid; id < 4096; id += NT) {
            const int tk = id >> 8, ch = id & 255, g = ch >> 6, ww = 2 << g, t = t0 + tk;
            float sum = 0.f;
            for (int i = 0; i < ww; ++i) sum += XA[(15 + tk - i) * 256 + ch];
            const float xc = XA[(15 + tk) * 256 + ch];
            const int cnt = (t + 1) < ww ? (t + 1) : ww;
            DmB[tk * 264 + ch] = f2bf(sum / (float)cnt - xc);
            if (t >= 8177) out[O_POOLP + ((size_t)(L * 4 + b) * 15 + (t - 8177)) * 256 + ch] = xc;
        }
        __syncthreads();
        {
            const int g = w >> 1;
            f32x4 r[2];
#pragma unroll
            for (int dq = 0; dq < 2; ++dq) {
                const int dtile = (w & 1) * 2 + dq;
                r[dq] = (f32x4){0.f, 0.f, 0.f, 0.f};
#pragma unroll
                for (int ks = 0; ks < 2; ++ks) {
                    const bf16x8 pf = *(const bf16x8*)(PWT + (g * 64 + 16 * dtile + fr) * 72 + ks * 32 + fq * 8);
                    const bf16x8 qf = *(const bf16x8*)(DmB + fr * 264 + g * 64 + ks * 32 + fq * 8);
                    r[dq] = MFMA16(pf, qf, r[dq]);
                }
            }
            const int o = g * 64 + 32 * (w & 1) + fq * 8;
            const float4 p0 = *(const float4*)(p->in[I_POOLSC] + L * 256 + o), p1 = *(const float4*)(p->in[I_POOLSC] + L * 256 + o + 4);
            uint4 ov; ov.x = pk2(r[0][0] * p0.x, r[0][1] * p0.y); ov.y = pk2(r[0][2] * p0.z, r[0][3] * p0.w);
            ov.z = pk2(r[1][0] * p1.x, r[1][1] * p1.y); ov.w = pk2(r[1][2] * p1.z, r[1][3] * p1.w);
            *(uint4*)(CAT + (size_t)(token0 + fr) * DM + o) = ov;
        }
        {
            const int t = t0 + r_tk;
            const float x1[8] = {lo16(rxa.x), hi16(rxa.x), lo16(rxa.y), hi16(rxa.y), lo16(rxa.z), hi16(rxa.z), lo16(rxa.w), hi16(rxa.w)};
            const float x2[8] = {lo16(rxb.x), hi16(rxb.x), lo16(rxb.y), hi16(rxb.y), lo16(rxb.z), hi16(rxb.z), lo16(rxb.w), hi16(rxb.w)};
            float r1[8], r2[8];
            const float sc = r_qk == 0 ? 0.125f : 1.f;
#pragma unroll
            for (int e = 0; e < 8; e += 2) {
                const float4 cs = *(const float4*)(CS + (r_tk * 32 + r_i0 + e) * 2);
                r1[e] = (x1[e] * cs.x - x2[e] * cs.y) * sc; r2[e] = (x2[e] * cs.x + x1[e] * cs.y) * sc;
                r1[e + 1] = (x1[e + 1] * cs.z - x2[e + 1] * cs.w) * sc; r2[e + 1] = (x2[e + 1] * cs.z + x1[e + 1] * cs.w) * sc;
            }
            uint4 o1, o2;
            o1.x = pk2(r1[0], r1[1]); o1.y = pk2(r1[2], r1[3]); o1.z = pk2(r1[4], r1[5]); o1.w = pk2(r1[6], r1[7]);
            o2.x = pk2(r2[0], r2[1]); o2.y = pk2(r2[2], r2[3]); o2.z = pk2(r2[4], r2[5]); o2.w = pk2(r2[6], r2[7]);
            *(uint4*)rbase = o1; *(uint4*)(rbase + 32) = o2;
            if (r_qk == 1 && t >= 6144) {
                float* kp = out + O_KP + (((size_t)(L * 4 + b) * 2048 + (t - 6144)) * 4 + r_h) * 64 + r_i0;
                *(float4*)kp = make_float4(r1[0], r1[1], r1[2], r1[3]); *(float4*)(kp + 4) = make_float4(r1[4], r1[5], r1[6], r1[7]);
                *(float4*)(kp + 32) = make_float4(r2[0], r2[1], r2[2], r2[3]); *(float4*)(kp + 36) = make_float4(r2[4], r2[5], r2[6], r2[7]);
            }
        }
        if (t0 >= 6144) {
            const int tk = tid >> 5, cc = (tid & 31) * 8, t = t0 + tk;
            float* vp = out + O_VP + ((size_t)(L * 4 + b) * 2048 + (t - 6144)) * 256 + cc;
            *(float4*)vp = make_float4(lo16(vld.x), hi16(vld.x), lo16(vld.y), hi16(vld.y)); *(float4*)(vp + 4) = make_float4(lo16(vld.z), hi16(vld.z), lo16(vld.w), hi16(vld.w));
        }
        {
            float wv[4][8], bv[8];
            { const float4 b0 = *(const float4*)(p->in[I_CONVB] + L * 1024 + c0), b1 = *(const float4*)(p->in[I_CONVB] + L * 1024 + c0 + 4);
              bv[0] = b0.x; bv[1] = b0.y; bv[2] = b0.z; bv[3] = b0.w; bv[4] = b1.x; bv[5] = b1.y; bv[6] = b1.z; bv[7] = b1.w; }
#pragma unroll
            for (int tau = 0; tau < 4; ++tau) {
                const float* cw = p->in[I_CONVW] + (size_t)(L * 4 + tau) * 1024 + c0;
                const float4 w0 = *(const float4*)cw, w1 = *(const float4*)(cw + 4);
                wv[tau][0] = w0.x; wv[tau][1] = w0.y; wv[tau][2] = w0.z; wv[tau][3] = w0.w; wv[tau][4] = w1.x; wv[tau][5] = w1.y; wv[tau][6] = w1.z; wv[tau][7] = w1.w;
            }
            float acc[4][8];
#pragma unroll
            for (int it = 0; it < 4; ++it)
#pragma unroll
                for (int e = 0; e < 8; ++e) acc[it][e] = bv[e];
#pragma unroll
            for (int rr = 0; rr < 7; ++rr) {
                const float xf[8] = {lo16(xr[rr].x), hi16(xr[rr].x), lo16(xr[rr].y), hi16(xr[rr].y), lo16(xr[rr].z), hi16(xr[rr].z), lo16(xr[rr].w), hi16(xr[rr].w)};
#pragma unroll
                for (int it = 0; it < 4; ++it) {
                    const int tau = rr - it;
                    if (tau >= 0 && tau < 4) {
#pragma unroll
                        for (int e = 0; e < 8; ++e) acc[it][e] += xf[e] * wv[tau][e];
                    }
                }
            }
#pragma unroll
            for (int it = 0; it < 4; ++it) {
                const int tk = q4 * 4 + it, t = t0 + tk;
                uint4 o; o.x = pk2(silu(acc[it][0]), silu(acc[it][1])); o.y = pk2(silu(acc[it][2]), silu(acc[it][3]));
                o.z = pk2(silu(acc[it][4]), silu(acc[it][5])); o.w = pk2(silu(acc[it][6]), silu(acc[it][7]));
                *(uint4*)(U + (size_t)(token0 + tk) * DM + c0) = o;
                if (t >= 8189) { float* cp = out + O_CONVP + ((size_t)(L * 4 + b) * 3 + (t - 8189)) * 1024 + c0; const uint4 xv = xr[it + 3];
                    *(float4*)cp = make_float4(lo16(xv.x), hi16(xv.x), lo16(xv.y), hi16(xv.y)); *(float4*)(cp + 4) = make_float4(lo16(xv.z), hi16(xv.z), lo16(xv.w), hi16(xv.w)); }
            }
        }
        __syncthreads();
    }
}

__device__ void prep_sample_item(KP p, int L, int item, bf16_t* PROJ, bf16_t* U, bf16_t* CAT, const bf16_t* XB, float* DT) {
    const int n = item >> 2, part = item & 3;
    SMEM_DECL;
    float* dsm = (float*)smem;
    const int tid = otid();
    const size_t row = MP + n;
    float* out = p->out;
    const int ln = L * 32 + n;
    __syncthreads();
    if (part == 0) {
        const int lane = tid & 63, h = tid >> 6;
        const bf16_t* wdt = (const bf16_t*)(p->ws + WS_WDT) + (size_t)L * 16 * 1024 + h * 1024;
        float d = 0.f, ss = 0.f;
#pragma unroll
        for (int i = 0; i < 16; ++i) { const int k = i * 64 + lane; const float xf = bf2f(XB[row * DM + k]); ss += xf * xf; d += xf * bf2f(wdt[k]); }
        d = wave_sum(d); ss = wave_sum(ss);
        if (lane == 0) { const float x = d * rsqrtf(ss * (1.f / 1024.f) + EPS) + p->in[I_DTB][L * 8 + h]; DT[row * 8 + h] = x > 20.f ? x : log1pf(__expf(x)); }
    }
    if (part == 1) {
    if (tid < 256) {
        const int ch = tid, g = ch >> 6, w = 2 << g;
        const float* cp = p->in[I_CPOOL] + (size_t)ln * 15 * 256;
        const float xn = bf2f(PROJ[row * NPROJ + ch]);
        float cpr[15];
#pragma unroll
        for (int i = 1; i < 16; ++i) cpr[i - 1] = cp[(15 - i) * 256 + ch];
        float sum = xn;
#pragma unroll
        for (int i = 1; i < 16; ++i) sum += (i < w) ? cpr[i - 1] : 0.f;
        dsm[ch] = sum / (float)w - xn;
        float* ps = out + O_POOLS + (size_t)ln * 15 * 256;
        float cpv[14];
#pragma unroll
        for (int j = 0; j < 14; ++j) cpv[j] = cp[(j + 1) * 256 + ch];
#pragma unroll
        for (int j = 0; j < 14; ++j) ps[j * 256 + ch] = cpv[j];
        ps[14 * 256 + ch] = xn;
    }
    __syncthreads();
    if (tid < 256) {
        const int o = tid, g = o >> 6, dout = o & 63;
        const float* pw = p->in[I_POOLW] + (size_t)(L * 4 + g) * 4096;
        float acc = 0.f;
#pragma unroll 32
        for (int c = 0; c < 64; ++c) acc += dsm[g * 64 + c] * pw[c * 64 + dout];
        CAT[row * DM + o] = f2bf(acc * p->in[I_POOLSC][L * 256 + o]);
    }
    }
    if (part == 2 && tid < 256) {
        const int qk = tid >> 7, h = (tid >> 5) & 3, i = tid & 31;
        const float inv = rope_inv(i);
        float c, s; rope_cs(16384.f * inv, c, s);
        bf16_t* base = PROJ + row * NPROJ + 256 + qk * 256 + h * 64;
        const float x1 = bf2f(base[i]), x2 = bf2f(base[i + 32]);
        float r1 = x1 * c - x2 * s, r2 = x2 * c + x1 * s;
        if (qk == 0) { r1 *= 0.125f; r2 *= 0.125f; }
        base[i] = f2bf(r1); base[i + 32] = f2bf(r2);
        if (qk == 1) { float* ks = out + O_KS + (((size_t)ln * 2048 + 2047) * 4 + h) * 64; ks[i] = r1; ks[i + 32] = r2; }
        out[O_VS + ((size_t)ln * 2048 + 2047) * 256 + tid] = bf2f(PROJ[row * NPROJ + 768 + tid]);
    }
    if (part == 3)
    for (int c = tid; c < 1024; c += NT) {
        const float* sc = p->in[I_SCONV] + (size_t)ln * 3 * 1024;
        const float* cw = p->in[I_CONVW] + (size_t)L * 4 * 1024;
        const float xnew = bf2f(PROJ[row * NPROJ + 1536 + c]);
        const float s0 = sc[c], s1 = sc[1024 + c], s2 = sc[2048 + c];
        const float acc = p->in[I_CONVB][L * 1024 + c] + s0 * cw[c] + s1 * cw[1024 + c] + s2 * cw[2048 + c] + xnew * cw[3072 + c];
        U[row * DM + c] = f2bf(silu(acc));
        float* cs = out + O_CONVS + (size_t)ln * 3 * 1024;
        cs[c] = s1; cs[1024 + c] = s2; cs[2048 + c] = xnew;
    }
    __syncthreads();
}

struct AttnPf { uint4 k[4], v[4]; bf16x8 q[2]; };
__device__ __forceinline__ void attn_decode(int a, int& b, int& h, int& br, int& dsh, int& r, int& n) {
    const int bh = a / 192, rem = a % 192, idx = rem & 63; br = rem >> 6;
    b = bh >> 2; h = bh & 3; dsh = br * 2; const int nb = 64 >> dsh; r = idx / nb; n = idx % nb;
}
__device__ __forceinline__ void attn_load(int a, const bf16_t* PROJ, int tid, AttnPf& pf) {
    int b, h, br, dsh, r, n; attn_decode(a, b, h, br, dsh, r, n);
    const int lane = tid & 63, w = tid >> 6, fr = lane & 15, fq = lane >> 4;
#pragma unroll
    for (int it = 0; it < 4; ++it) {
        const int id = tid + it * NT, rowk = id >> 3, ch = id & 7, lk = (n - 1) * 128 + rowk;
        pf.k[it] = zero4();
        if (lk >= 0) pf.k[it] = *(const uint4*)(PROJ + (size_t)(b * 8192 + (lk << dsh) + r) * NPROJ + 512 + h * 64 + ch * 8);
    }
#pragma unroll
    for (int it = 0; it < 4; ++it) {
        const int id = tid + it * NT, key = id & 255, ch = id >> 8, lk = (n - 1) * 128 + key;
        pf.v[it] = zero4();
        if (lk >= 0) pf.v[it] = *(const uint4*)(PROJ + (size_t)(b * 8192 + (lk << dsh) + r) * NPROJ + 768 + h * 64 + ch * 8);
    }
    const int qi = 16 * w + fr, lq = n * 128 + qi;
    const size_t tq = (size_t)b * 8192 + ((size_t)lq << dsh) + r;
#pragma unroll
    for (int ks = 0; ks < 2; ++ks) pf.q[ks] = *(const bf16x8*)(PROJ + tq * NPROJ + 256 + h * 64 + ks * 32 + fq * 8);
}
__device__ void attn_items(int a0, int astep, const bf16_t* PROJ, bf16_t* OG, float* LSE) {
    SMEM_DECL;
    bf16_t* Ks = (bf16_t*)smem;
    bf16_t* Vt = (bf16_t*)(smem + 272 * 144);
    const int tid = otid(), lane = tid & 63, w = tid >> 6, fr = lane & 15, fq = lane >> 4;
    AttnPf pf;
    if (a0 < 3072) attn_load(a0, PROJ, tid, pf);
#pragma unroll 1
    for (int a = a0; a < 3072; a += astep) {
        int b, h, br, dsh, r, n; attn_decode(a, b, h, br, dsh, r, n);
        LDS_BARRIER();
#pragma unroll
        for (int it = 0; it < 4; ++it) { const int id = tid + it * NT, rowk = id >> 3, ch = id & 7; *(uint4*)(Ks + rowk * 72 + ch * 8) = pf.k[it]; }
        if (tid < 128) { const uint4 z = zero4(); *(uint4*)(Ks + (256 + (tid >> 3)) * 72 + (tid & 7) * 8) = z; }
#pragma unroll
        for (int it = 0; it < 4; ++it) {
            const int id = tid + it * NT, key = id & 255, ch = id >> 8; const uint4 v = pf.v[it];
            bf16_t* d = Vt + (32 * (ch >> 2) + 4 * (ch & 3)) * 280 + key;
            d[0] = (bf16_t)(v.x & 0xffff); d[280] = (bf16_t)(v.x >> 16); d[560] = (bf16_t)(v.y & 0xffff); d[840] = (bf16_t)(v.y >> 16);
            d[16 * 280] = (bf16_t)(v.z & 0xffff); d[17 * 280] = (bf16_t)(v.z >> 16); d[18 * 280] = (bf16_t)(v.w & 0xffff); d[19 * 280] = (bf16_t)(v.w >> 16);
        }
        { const int d = tid >> 3, kk = (tid & 7) * 2; *(unsigned*)(Vt + d * 280 + 256 + kk) = 0u; }
        const bf16x8 qf0 = pf.q[0], qf1 = pf.q[1];
        if (a + astep < 3072) attn_load(a + astep, PROJ, tid, pf);
        LDS_BARRIER();
        const int qi = 16 * w + fr, lq = n * 128 + qi;
        const size_t tq = (size_t)b * 8192 + ((size_t)lq << dsh) + r;
        f32x4 s[10];
#pragma unroll
        for (int t = 0; t < 10; ++t) {
            s[t] = (f32x4){0.f, 0.f, 0.f, 0.f};
            const bf16x8 kf0 = *(const bf16x8*)(Ks + (16 * (w + t) + fr) * 72 + fq * 8);
            const bf16x8 kf1 = *(const bf16x8*)(Ks + (16 * (w + t) + fr) * 72 + 32 + fq * 8);
            s[t] = MFMA16(kf0, qf0, s[t]); s[t] = MFMA16(kf1, qf1, s[t]);
        }
        float mx = -INFINITY;
#pragma unroll
        for (int t = 0; t < 10; ++t)
#pragma unroll
            for (int jj = 0; jj < 4; ++jj) {
                const int key = 16 * (w + t) + fq * 4 + jj, dist = 128 + qi - key;
                const bool valid = (dist >= 0) && (dist <= 128) && (key < 256) && (n > 0 || key >= 128);
                const float sv = valid ? s[t][jj] : -INFINITY;
                s[t][jj] = sv; mx = fmaxf(mx, sv);
            }
        mx = fmaxf(mx, __shfl_xor(mx, 16)); mx = fmaxf(mx, __shfl_xor(mx, 32));
        float lsum = 0.f;
#pragma unroll
        for (int t = 0; t < 10; ++t)
#pragma unroll
            for (int jj = 0; jj < 4; ++jj) { const float pv = __expf(s[t][jj] - mx); s[t][jj] = pv; lsum += pv; }
        lsum += __shfl_xor(lsum, 16); lsum += __shfl_xor(lsum, 32);
        f32x4 o[4];
#pragma unroll
        for (int dt = 0; dt < 4; ++dt) o[dt] = (f32x4){0.f, 0.f, 0.f, 0.f};
#pragma unroll
        for (int kp = 0; kp < 5; ++kp) {
            const int ta = 2 * kp, tb = 2 * kp + 1;
            union { bf16x8 v; unsigned u[4]; } pfr;
            pfr.u[0] = pk2(s[ta][0], s[ta][1]); pfr.u[1] = pk2(s[ta][2], s[ta][3]); pfr.u[2] = pk2(s[tb][0], s[tb][1]); pfr.u[3] = pk2(s[tb][2], s[tb][3]);
#pragma unroll
            for (int dt = 0; dt < 4; ++dt) {
                union { bf16x8 v; uint2 u[2]; } vf;
                vf.u[0] = *(const uint2*)(Vt + (16 * dt + fr) * 280 + 16 * (w + ta) + fq * 4);
                vf.u[1] = *(const uint2*)(Vt + (16 * dt + fr) * 280 + 16 * (w + tb) + fq * 4);
                o[dt] = MFMA16(vf.v, pfr.v, o[dt]);
            }
        }
        const float inv = 1.f / lsum;
#pragma unroll
        for (int a2 = 0; a2 < 2; ++a2) {
            uint4 ov; ov.x = pk2(o[2 * a2][0] * inv, o[2 * a2][1] * inv); ov.y = pk2(o[2 * a2][2] * inv, o[2 * a2][3] * inv);
            ov.z = pk2(o[2 * a2 + 1][0] * inv, o[2 * a2 + 1][1] * inv); ov.w = pk2(o[2 * a2 + 1][2] * inv, o[2 * a2 + 1][3] * inv);
            *(uint4*)(OG + ((size_t)br * MP + tq) * 256 + h * 64 + 32 * a2 + fq * 8) = ov;
        }
        if (fq == 0) LSE[((size_t)br * MP + tq) * 4 + h] = mx + __logf(lsum);
    }
}

__device__ void combine_item(int item, const bf16_t* __restrict__ OG, const float* __restrict__ LSE, bf16_t* __restrict__ CAT) {
    const int tid = otid();
    uint4 a[4], bb[4], c[4]; float l0[4], l1[4], l2[4];
#pragma unroll
    for (int it = 0; it < 4; ++it) {
        const int id = tid + it * NT, tk = id >> 5, ch = id & 31, h = ch >> 3;
        const size_t token = (size_t)item * 64 + tk;
        l0[it] = LSE[token * 4 + h]; l1[it] = LSE[((size_t)MP + token) * 4 + h]; l2[it] = LSE[(2ull * MP + token) * 4 + h];
        a[it] = *(const uint4*)(OG + token * 256 + ch * 8); bb[it] = *(const uint4*)(OG + ((size_t)MP + token) * 256 + ch * 8);
        c[it] = *(const uint4*)(OG + (2ull * MP + token) * 256 + ch * 8);
    }
#pragma unroll
    for (int it = 0; it < 4; ++it) {
        const int id = tid + it * NT, tk = id >> 5, ch = id & 31;
        const size_t token = (size_t)item * 64 + tk;
        const float m = fmaxf(l0[it], fmaxf(l1[it], l2[it]));
        float w0 = __expf(l0[it] - m), w1 = __expf(l1[it] - m), w2 = __expf(l2[it] - m);
        const float inv = 1.f / (w0 + w1 + w2); w0 *= inv; w1 *= inv; w2 *= inv;
        uint4 o;
        o.x = pk2(w0 * lo16(a[it].x) + w1 * lo16(bb[it].x) + w2 * lo16(c[it].x), w0 * hi16(a[it].x) + w1 * hi16(bb[it].x) + w2 * hi16(c[it].x));
        o.y = pk2(w0 * lo16(a[it].y) + w1 * lo16(bb[it].y) + w2 * lo16(c[it].y), w0 * hi16(a[it].y) + w1 * hi16(bb[it].y) + w2 * hi16(c[it].y));
        o.z = pk2(w0 * lo16(a[it].z) + w1 * lo16(bb[it].z) + w2 * lo16(c[it].z), w0 * hi16(a[it].z) + w1 * hi16(bb[it].z) + w2 * hi16(c[it].z));
        o.w = pk2(w0 * lo16(a[it].w) + w1 * lo16(bb[it].w) + w2 * lo16(c[it].w), w0 * hi16(a[it].w) + w1 * hi16(bb[it].w) + w2 * hi16(c[it].w));
        *(uint4*)(CAT + token * DM + 256 + ch * 8) = o;
    }
}

__device__ __forceinline__ void ssd_acs(KP p, int L, int g, int token0, const float* DT, float* acs, float* dts) {
    const int lane = otid() & 63, w = otid() >> 6;
    if (w < 4) {
        const int h = g * 4 + w; const float a = -__expf(p->in[I_ALOG][L * 8 + h]);
        const float d0 = DT[(size_t)(token0 + 2 * lane) * 8 + h], d1 = DT[(size_t)(token0 + 2 * lane + 1) * 8 + h];
        const float v0 = d0 * a, v1 = d1 * a, sum = v0 + v1; float inc = sum;
#pragma unroll
        for (int off = 1; off < 64; off <<= 1) { const float t = __shfl_up(inc, off); if (lane >= off) inc += t; }
        const float exc = inc - sum;
        acs[w * 128 + 2 * lane] = exc + v0; acs[w * 128 + 2 * lane + 1] = exc + v0 + v1;
        dts[w * 128 + 2 * lane] = d0; dts[w * 128 + 2 * lane + 1] = d1;
    }
}

__device__ void s1_item(KP p, int L, int item, const bf16_t* U, const float* DT, float* ST, float* DEC) {
    SMEM_DECL;
    bf16_t* BT = (bf16_t*)smem;
    bf16_t* XWT = (bf16_t*)(smem + 34816);
    float* acs = (float*)(smem + 104448);
    float* dts = (float*)(smem + 106496);
    const int tid = otid(), lane = tid & 63, w = tid >> 6, fr = lane & 15, fq = lane >> 4;
    const int cb = item >> 1, g = item & 1, token0 = cb * 128;
    __syncthreads();
    ssd_acs(p, L, g, token0, DT, acs, dts);
    __syncthreads();
    { const int j = tid >> 7, l = tid & 127; const float wv = __expf(acs[j * 128 + 127] - acs[j * 128 + l]) * dts[j * 128 + l];
      if (tid < 4) DEC[cb * 8 + g * 4 + tid] = __expf(acs[tid * 128 + 127]);
      __syncthreads();
      dts[j * 128 + l] = wv; }
    __syncthreads();
#pragma unroll
    for (int it = 0; it < 4; ++it) {
        const int id = tid + it * NT, l = id & 127, ch = id >> 7;
        const uint4 v = *(const uint4*)(U + (size_t)(token0 + l) * DM + 512 + g * 128 + ch * 8);
        bf16_t* d = BT + (ch * 8) * 136 + l;
        d[0] = (bf16_t)(v.x & 0xffff); d[136] = (bf16_t)(v.x >> 16); d[272] = (bf16_t)(v.y & 0xffff); d[408] = (bf16_t)(v.y >> 16);
        d[544] = (bf16_t)(v.z & 0xffff); d[680] = (bf16_t)(v.z >> 16); d[816] = (bf16_t)(v.w & 0xffff); d[952] = (bf16_t)(v.w >> 16);
    }
#pragma unroll
    for (int it = 0; it < 8; ++it) {
        const int id = tid + it * NT, l = id & 127, ch = id >> 7, j = ch >> 3;
        const uint4 v = *(const uint4*)(U + (size_t)(token0 + l) * DM + g * 256 + ch * 8);
        const float wv = dts[j * 128 + l];
        bf16_t* d = XWT + (ch * 8) * 136 + l;
        d[0] = f2bf(lo16(v.x) * wv); d[136] = f2bf(hi16(v.x) * wv); d[272] = f2bf(lo16(v.y) * wv); d[408] = f2bf(hi16(v.y) * wv);
        d[544] = f2bf(lo16(v.z) * wv); d[680] = f2bf(hi16(v.z) * wv); d[816] = f2bf(lo16(v.w) * wv); d[952] = f2bf(hi16(v.w) * wv);
    }
    __syncthreads();
    f32x4 acc[2][8];
#pragma unroll
    for (int qq = 0; qq < 2; ++qq)
#pragma unroll
        for (int nt = 0; nt < 8; ++nt) acc[qq][nt] = (f32x4){0.f, 0.f, 0.f, 0.f};
#pragma unroll
    for (int ks = 0; ks < 4; ++ks) {
        bf16x8 qf[2];
#pragma unroll
        for (int qq = 0; qq < 2; ++qq) qf[qq] = *(const bf16x8*)(XWT + (16 * (2 * w + qq) + fr) * 136 + ks * 32 + fq * 8);
#pragma unroll
        for (int nt = 0; nt < 8; ++nt) {
            const bf16x8 pf = *(const bf16x8*)(BT + (16 * nt + fr) * 136 + ks * 32 + fq * 8);
#pragma unroll
            for (int qq = 0; qq < 2; ++qq) acc[qq][nt] = MFMA16(pf, qf[qq], acc[qq][nt]);
        }
    }
#pragma unroll
    for (int qq = 0; qq < 2; ++qq) {
        const int rowjp = 16 * (2 * w + qq) + fr, j = rowjp >> 6, pp = rowjp & 63, h = g * 4 + j;
        float* dst = ST + ((size_t)(cb * 8 + h) * 64 + pp) * 128 + fq * 4;
#pragma unroll
        for (int nt = 0; nt < 8; ++nt) { float4 v; v.x = acc[qq][nt][0]; v.y = acc[qq][nt][1]; v.z = acc[qq][nt][2]; v.w = acc[qq][nt][3]; *(float4*)(dst + 16 * nt) = v; }
    }
}

__device__ void scan_phase(KP p, int L, float* ST, const float* DEC) {
    for (int e = blockIdx.x * NT + otid(); e < 131072; e += gridDim.x * NT) {
        const int idx = e * 2, n = idx & 127, pp = (idx >> 7) & 63, h = (idx >> 13) & 7, b = idx >> 16;
        float2 hr = {0.f, 0.f};
        float* base = ST + ((size_t)((b * 64) * 8 + h) * 64 + pp) * 128 + n;
        const float* dbase = DEC + (b * 64) * 8 + h;
#pragma unroll 1
        for (int c0 = 0; c0 < 64; c0 += 16) {
            float2 t[16]; float d[16];
#pragma unroll
            for (int j = 0; j < 16; ++j) { t[j] = *(const float2*)(base + (size_t)(c0 + j) * 65536); d[j] = dbase[(c0 + j) * 8]; }
#pragma unroll
            for (int j = 0; j < 16; ++j) { *(float2*)(base + (size_t)(c0 + j) * 65536) = hr; hr.x = d[j] * hr.x + t[j].x; hr.y = d[j] * hr.y + t[j].y; }
        }
        *(float2*)(p->out + O_SSMP + (((size_t)(L * 4 + b) * 8 + h) * 64 + pp) * 128 + n) = hr;
    }
}

__device__ void s3_item(KP p, int L, int item, const bf16_t* U, const bf16_t* PROJ, const float* DT, const float* ST, bf16_t* CAT) {
    SMEM_DECL;
    bf16_t* Cs = (bf16_t*)smem;
    bf16_t* Bs = (bf16_t*)(smem + 34816);
    bf16_t* XT = (bf16_t*)(smem + 69632);
    bf16_t* Hp = (bf16_t*)(smem + 87040);
    float* acs = (float*)(smem + 104448);
    float* dts = (float*)(smem + 106496);
    const int tid = otid(), lane = tid & 63, w = tid >> 6, fr = lane & 15, fq = lane >> 4;
    const int cb = item >> 1, g = item & 1, token0 = cb * 128;
    const int l = 16 * w + fr;
    const size_t token = (size_t)token0 + l;
    uint4 xt[2]; float4 hp[4]; uint4 xv[2], zv[2];
#define S3_LOAD(hh) do { \
        _Pragma("unroll") for (int it = 0; it < 2; ++it) { const int id = tid + it * NT, s_ = id & 127, ch = id >> 7; \
            xt[it] = *(const uint4*)(U + (size_t)(token0 + s_) * DM + (hh) * 64 + ch * 8); } \
        _Pragma("unroll") for (int it = 0; it < 4; ++it) { const int id = tid + it * NT, pp = id >> 5, c4 = id & 31; \
            hp[it] = *(const float4*)(ST + ((size_t)(cb * 8 + (hh)) * 64 + pp) * 128 + c4 * 4); } \
        _Pragma("unroll") for (int a2 = 0; a2 < 2; ++a2) { const int ch = (hh) * 64 + 32 * a2 + fq * 8; \
            xv[a2] = *(const uint4*)(U + token * DM + ch); zv[a2] = *(const uint4*)(PROJ + token * NPROJ + 1024 + ch); } } while (0)
    LDS_BARRIER();
    S3_LOAD(g * 4);
    ssd_acs(p, L, g, token0, DT, acs, dts);
#pragma unroll
    for (int it = 0; it < 4; ++it) {
        const int id = tid + it * NT, ll = id >> 4, ch = id & 15;
        *(uint4*)(Cs + ll * 136 + ch * 8) = *(const uint4*)(U + (size_t)(token0 + ll) * DM + 768 + g * 128 + ch * 8);
        *(uint4*)(Bs + ll * 136 + ch * 8) = *(const uint4*)(U + (size_t)(token0 + ll) * DM + 512 + g * 128 + ch * 8);
    }
    LDS_BARRIER();
    f32x4 cbv[8];
#pragma unroll
    for (int st = 0; st < 8; ++st) cbv[st] = (f32x4){0.f, 0.f, 0.f, 0.f};
#pragma unroll
    for (int ks = 0; ks < 4; ++ks) {
        const bf16x8 qf = *(const bf16x8*)(Cs + (16 * w + fr) * 136 + ks * 32 + fq * 8);
#pragma unroll
        for (int st = 0; st < 8; ++st)
            if (st <= w) { const bf16x8 pf = *(const bf16x8*)(Bs + (16 * st + fr) * 136 + ks * 32 + fq * 8); cbv[st] = MFMA16(pf, qf, cbv[st]); }
    }
    LDS_BARRIER();
    bf16_t* Mb = Bs;
    float ssq = 0.f;
#pragma unroll 1
    for (int j = 0; j < 4; ++j) {
        const int h = g * 4 + j;
#pragma unroll
        for (int it = 0; it < 2; ++it) {
            const int id = tid + it * NT, s_ = id & 127, ch = id >> 7; const uint4 v = xt[it];
            bf16_t* d = XT + (32 * (ch >> 2) + 4 * (ch & 3)) * 136 + s_;
            d[0] = (bf16_t)(v.x & 0xffff); d[136] = (bf16_t)(v.x >> 16); d[272] = (bf16_t)(v.y & 0xffff); d[408] = (bf16_t)(v.y >> 16);
            d[16 * 136] = (bf16_t)(v.z & 0xffff); d[17 * 136] = (bf16_t)(v.z >> 16); d[18 * 136] = (bf16_t)(v.w & 0xffff); d[19 * 136] = (bf16_t)(v.w >> 16);
        }
#pragma unroll
        for (int it = 0; it < 4; ++it) {
            const int id = tid + it * NT, pp = id >> 5, c4 = id & 31; const float4 v = hp[it];
            uint2 o; o.x = pk2(v.x, v.y); o.y = pk2(v.z, v.w);
            *(uint2*)(Hp + (32 * (pp >> 5) + 16 * ((pp >> 2) & 1) + 4 * ((pp >> 3) & 3) + (pp & 3)) * 136 + c4 * 4) = o;
        }
        uint4 xvc[2], zvc[2];
#pragma unroll
        for (int a2 = 0; a2 < 2; ++a2) { xvc[a2] = xv[a2]; zvc[a2] = zv[a2]; }
        if (j < 3) S3_LOAD(h + 1);
        const float al = acs[j * 128 + l];
#pragma unroll
        for (int st = 0; st < 8; ++st)
            if (st <= (w | 1)) {
                float mv[4];
#pragma unroll
                for (int jj = 0; jj < 4; ++jj) { const int s_ = 16 * st + fq * 4 + jj;
                    mv[jj] = (s_ <= l) ? cbv[st][jj] * __expf(al - acs[j * 128 + s_]) * dts[j * 128 + s_] : 0.f; }
                uint2 o; o.x = pk2(mv[0], mv[1]); o.y = pk2(mv[2], mv[3]);
                *(uint2*)(Mb + l * 136 + 16 * st + fq * 4) = o;
            }
        LDS_BARRIER();
        f32x4 yy[4];
#pragma unroll
        for (int pt = 0; pt < 4; ++pt) yy[pt] = (f32x4){0.f, 0.f, 0.f, 0.f};
#pragma unroll
        for (int ks = 0; ks < 4; ++ks) {
            const bf16x8 qf = *(const bf16x8*)(Cs + (16 * w + fr) * 136 + ks * 32 + fq * 8);
#pragma unroll
            for (int pt = 0; pt < 4; ++pt) { const bf16x8 pf = *(const bf16x8*)(Hp + (16 * pt + fr) * 136 + ks * 32 + fq * 8); yy[pt] = MFMA16(pf, qf, yy[pt]); }
        }
        const float ea = __expf(al);
#pragma unroll
        for (int pt = 0; pt < 4; ++pt) yy[pt] = yy[pt] * ea;
#pragma unroll
        for (int ks = 0; ks < 4; ++ks)
            if (2 * ks <= w) {
                const bf16x8 qf = *(const bf16x8*)(Mb + (16 * w + fr) * 136 + ks * 32 + fq * 8);
#pragma unroll
                for (int pt = 0; pt < 4; ++pt) { const bf16x8 pf = *(const bf16x8*)(XT + (16 * pt + fr) * 136 + ks * 32 + fq * 8); yy[pt] = MFMA16(pf, qf, yy[pt]); }
            }
        const float dsk = p->in[I_DSKIP][L * 8 + h];
#pragma unroll
        for (int a2 = 0; a2 < 2; ++a2) {
            const int ch = h * 64 + 32 * a2 + fq * 8;
            const uint4 xq = xvc[a2], zq = zvc[a2];
            const float xs[8] = {lo16(xq.x), hi16(xq.x), lo16(xq.y), hi16(xq.y), lo16(xq.z), hi16(xq.z), lo16(xq.w), hi16(xq.w)};
            const float zs[8] = {lo16(zq.x), hi16(zq.x), lo16(zq.y), hi16(zq.y), lo16(zq.z), hi16(zq.z), lo16(zq.w), hi16(zq.w)};
            float v[8];
#pragma unroll
            for (int e = 0; e < 8; ++e) { v[e] = (yy[2 * a2 + (e >> 2)][e & 3] + dsk * xs[e]) * silu(zs[e]); ssq += v[e] * v[e]; }
            uint4 o; o.x = pk2(v[0], v[1]); o.y = pk2(v[2], v[3]); o.z = pk2(v[4], v[5]); o.w = pk2(v[6], v[7]);
            *(uint4*)(CAT + token * DM + 512 + ch) = o;
        }
        LDS_BARRIER();
    }
#undef S3_LOAD
    asm volatile("s_waitcnt vmcnt(0)" ::: "memory");
    ssq += __shfl_xor(ssq, 16); ssq += __shfl_xor(ssq, 32);
    const float rstd = rsqrtf(ssq * (1.f / 256.f) + EPS);
    {
        uint4 vv[4][2];
#pragma unroll
        for (int j = 0; j < 4; ++j)
#pragma unroll
            for (int a2 = 0; a2 < 2; ++a2) vv[j][a2] = *(const uint4*)(CAT + token * DM + 512 + (g * 4 + j) * 64 + 32 * a2 + fq * 8);
#pragma unroll
        for (int j = 0; j < 4; ++j)
#pragma unroll
            for (int a2 = 0; a2 < 2; ++a2) {
                const int ch = (g * 4 + j) * 64 + 32 * a2 + fq * 8;
                const float4 n0 = *(const float4*)(p->in[I_SSMN] + L * 512 + ch), n1 = *(const float4*)(p->in[I_SSMN] + L * 512 + ch + 4);
                const uint4 v = vv[j][a2];
                uint4 o; o.x = pk2(lo16(v.x) * rstd * n0.x, hi16(v.x) * rstd * n0.y); o.y = pk2(lo16(v.y) * rstd * n0.z, hi16(v.y) * rstd * n0.w);
                o.z = pk2(lo16(v.z) * rstd * n1.x, hi16(v.z) * rstd * n1.y); o.w = pk2(lo16(v.w) * rstd * n1.z, hi16(v.w) * rstd * n1.w);
                *(uint4*)(CAT + token * DM + 512 + ch) = o;
            }
    }
}

__device__ void sample_attn_item(KP p, int L, int item, const bf16_t* PROJ, bf16_t* CAT) {
    SMEM_DECL;
    float* qs = (float*)smem; float* kn = qs + 64; float* vn = kn + 64; float* sc = vn + 64; float* red = sc + 512; float* part = red + 32;
    const int tid = otid(), lane = tid & 63, w = tid >> 6;
    const int n = item >> 2, h = item & 3;
    const size_t row = MP + n; const int ln = L * 32 + n;
    __syncthreads();
    if (tid < 64) { qs[tid] = bf2f(PROJ[row * NPROJ + 256 + h * 64 + tid]); kn[tid] = bf2f(PROJ[row * NPROJ + 512 + h * 64 + tid]); vn[tid] = bf2f(PROJ[row * NPROJ + 768 + h * 64 + tid]); }
    __syncthreads();
    const float* ck = p->in[I_CK] + (size_t)ln * 2048 * 256 + h * 64;
    const float* cv = p->in[I_CV] + (size_t)ln * 2048 * 256 + h * 64;
    float s = -INFINITY;
    if (tid < 387) {
        const int gg = tid / 129, j = tid % 129;
        s = 0.f;
        if (j == 0) { for (int d = 0; d < 64; ++d) s += qs[d] * kn[d]; }
        else { const float* kr = ck + (size_t)(2048 - (j << (2 * gg))) * 256;
#pragma unroll
            for (int d = 0; d < 64; d += 4) { const float4 kv = *(const float4*)(kr + d); s += qs[d] * kv.x + qs[d + 1] * kv.y + qs[d + 2] * kv.z + qs[d + 3] * kv.w; } }
    }
    const float wm = wave_max(s);
    if (lane == 0) red[w] = wm;
    __syncthreads();
    float mx = red[0];
#pragma unroll
    for (int i = 1; i < 8; ++i) mx = fmaxf(mx, red[i]);
    const float pv = (tid < 387) ? __expf(s - mx) : 0.f;
    sc[tid] = pv;
    const float wsum = wave_sum(pv);
    if (lane == 0) red[8 + w] = wsum;
    __syncthreads();
    float tot = 0.f;
#pragma unroll
    for (int i = 0; i < 8; ++i) tot += red[8 + i];
    {
        const int eg = tid >> 4, d4 = (tid & 15) * 4;
        float4 vv[13]; float pp[13];
#pragma unroll
        for (int i = 0; i < 13; ++i) {
            const int e = eg + 32 * i;
            pp[i] = 0.f; vv[i] = make_float4(0.f, 0.f, 0.f, 0.f);
            if (e < 387) { const int gg = e / 129, j = e % 129; pp[i] = sc[e];
                vv[i] = (j == 0) ? *(const float4*)(vn + d4) : *(const float4*)(cv + (size_t)(2048 - (j << (2 * gg))) * 256 + d4); }
        }
        float4 o = make_float4(0.f, 0.f, 0.f, 0.f);
#pragma unroll
        for (int i = 0; i < 13; ++i) { o.x += pp[i] * vv[i].x; o.y += pp[i] * vv[i].y; o.z += pp[i] * vv[i].z; o.w += pp[i] * vv[i].w; }
        *(float4*)(part + eg * 64 + d4) = o;
    }
    __syncthreads();
    if (tid < 64) {
        float o = 0.f;
#pragma unroll
        for (int i = 0; i < 32; ++i) o += part[i * 64 + tid];
        CAT[row * DM + 256 + h * 64 + tid] = f2bf(o / tot);
    }
}

__device__ void sample_ssd_item(KP p, int L, int n, const bf16_t* PROJ, const bf16_t* U, const float* DT, bf16_t* CAT) {
    SMEM_DECL;
    float* us = (float*)smem; float* zs = us + 1024; float* ys = zs + 512; float* red = ys + 512;
    const int tid = otid(), lane = tid & 63, w = tid >> 6;
    const size_t row = MP + n; const int ln = L * 32 + n;
    __syncthreads();
    for (int i = tid; i < 1024; i += NT) us[i] = bf2f(U[row * DM + i]);
    zs[tid] = bf2f(PROJ[row * NPROJ + 1024 + tid]);
    __syncthreads();
    {
        const int h = w, g = h >> 2;
        const float dt = DT[row * 8 + h], a = -__expf(p->in[I_ALOG][L * 8 + h]), dec = __expf(dt * a);
        const float B0 = us[512 + g * 128 + 2 * lane], B1 = us[512 + g * 128 + 2 * lane + 1], C0 = us[768 + g * 128 + 2 * lane], C1 = us[768 + g * 128 + 2 * lane + 1];
        const float* h0 = p->in[I_SSSM] + ((size_t)ln * 8 + h) * 64 * 128;
        float* hs = p->out + O_SSMS + ((size_t)ln * 8 + h) * 64 * 128;
#pragma unroll 1
        for (int r0 = 0; r0 < 64; r0 += 32) {
            float2 hv[32];
#pragma unroll
            for (int i = 0; i < 32; ++i) hv[i] = *(const float2*)(h0 + (r0 + i) * 128 + 2 * lane);
#pragma unroll
            for (int i = 0; i < 32; ++i) {
                const int rr = r0 + i;
                const float x = us[h * 64 + rr];
                float2 hn; hn.x = dec * hv[i].x + dt * x * B0; hn.y = dec * hv[i].y + dt * x * B1;
                *(float2*)(hs + rr * 128 + 2 * lane) = hn;
                const float part = wave_sum(hn.x * C0 + hn.y * C1);
                if (lane == 0) ys[h * 64 + rr] = part;
            }
        }
    }
    __syncthreads();
    {
        const int ch = tid, gch = ch >> 8;
        const float v = (ys[ch] + p->in[I_DSKIP][L * 8 + (ch >> 6)] * us[ch]) * silu(zs[ch]);
        const float part = wave_sum(v * v);
        if (lane == 0) red[w] = part;
        __syncthreads();
        const float tot = red[gch * 4] + red[gch * 4 + 1] + red[gch * 4 + 2] + red[gch * 4 + 3];
        const float rstd = rsqrtf(tot * (1.f / 256.f) + EPS);
        CAT[row * DM + 512 + ch] = f2bf(v * rstd * p->in[I_SSMN][L * 512 + ch]);
    }
}


#define XB_TMO      128
#define XB_XCNT(j)  (256  + 64 * (j))
#define XB_XSUB(j)  (1280 + 64 * (j))
#define XB_XGEN(j)  (2304 + 64 * (j))
#define XB_TOP      3328
#define XB_TOPGEN   3392
#define XCD_BAR_WORDS 3456
#define XB_SPIN_CAP (1u << 18)
__device__ __forceinline__ unsigned xb_ld(unsigned* p)              { return __hip_atomic_load(p, __ATOMIC_RELAXED, __HIP_MEMORY_SCOPE_AGENT); }
__device__ __forceinline__ unsigned xb_add(unsigned* p, unsigned v) { return __hip_atomic_fetch_add(p, v, __ATOMIC_RELAXED, __HIP_MEMORY_SCOPE_AGENT); }
__device__ __forceinline__ unsigned xb_xcc_id() { return (unsigned)__builtin_amdgcn_s_getreg((3 << 11) | 20) & 0xFu; }
#define XB_SPIN(cond, bar) do { unsigned _sp = 0; while (cond) { __builtin_amdgcn_s_sleep(1); \
    if ((++_sp & 255u) == 0u) { if (xb_ld(&(bar)[XB_TMO])) break; if (_sp > XB_SPIN_CAP) { atomicAdd(&(bar)[XB_TMO], 1u); break; } } } } while (0)
struct XcdBarrier { unsigned* bar; unsigned x; volatile LAS unsigned* st; };
__device__ __forceinline__ XcdBarrier xcd_barrier_post(unsigned* bar, volatile LAS unsigned* st) {
    XcdBarrier b; b.bar = bar; b.x = xb_xcc_id(); b.st = st;
    if (__builtin_amdgcn_workitem_id_x() == 0) (void)xb_add(&bar[XB_XCNT(b.x)], 1u);
    return b;
}
__device__ __forceinline__ void xcd_barrier_complete(unsigned* bar, unsigned x, unsigned& nloc, unsigned& nx) {
    const unsigned G = gridDim.x * gridDim.y * gridDim.z;
    unsigned sum, cnt, mine, sp = 0u;
    for (;;) {
        sum = 0u; cnt = 0u; mine = 0u;
#pragma unroll
        for (unsigned j = 0; j < 16; ++j) { const unsigned c = xb_ld(&bar[XB_XCNT(j)]); sum += c; cnt += (c > 0u) ? 1u : 0u; mine = (j == x) ? c : mine; }
        if (sum == G) break;
        __builtin_amdgcn_s_sleep(1);
        if ((++sp & 255u) == 0u) { if (xb_ld(&bar[XB_TMO])) break; if (sp > XB_SPIN_CAP) { atomicAdd(&bar[XB_TMO], 1u); break; } }
    }
    nloc = mine > 0u ? mine : 1u; nx = cnt > 0u ? cnt : 1u;
}
__device__ __forceinline__ void xcd_barrier(const XcdBarrier& b) {
    asm volatile("s_waitcnt vmcnt(0)" ::: "memory");
    __syncthreads();
    if (__builtin_amdgcn_workitem_id_x() == 0) {
        unsigned* bar = b.bar;
        __builtin_amdgcn_s_waitcnt(0);
        unsigned nloc = b.st[0], nx = b.st[1];
        if (nloc == 0u) { xcd_barrier_complete(bar, b.x, nloc, nx); b.st[0] = nloc; b.st[1] = nx; }
        const unsigned old = xb_add(&bar[XB_XSUB(b.x)], 1u);
        const unsigned gen = old / nloc;
        if (old + 1u == (gen + 1u) * nloc) {
            __builtin_amdgcn_fence(__ATOMIC_RELEASE, "agent");
            asm volatile("s_waitcnt vmcnt(0)" ::: "memory");
            const unsigned og = xb_add(&bar[XB_TOP], 1u);
            const unsigned tg = og / nx;
            if (og + 1u == (tg + 1u) * nx) xb_add(&bar[XB_TOPGEN], 1u);
            else XB_SPIN(xb_ld(&bar[XB_TOPGEN]) == tg, bar);
            __builtin_amdgcn_fence(__ATOMIC_ACQUIRE, "agent");
            xb_add(&bar[XB_XGEN(b.x)], 1u);
            asm volatile("s_waitcnt vmcnt(0)" ::: "memory");
        } else {
            XB_SPIN(xb_ld(&bar[XB_XGEN(b.x)]) == gen, bar);
            __builtin_amdgcn_fence(__ATOMIC_ACQUIRE, "agent");
            asm volatile("s_waitcnt vmcnt(0)" ::: "memory");
        }
    }
    __syncthreads();
}

#ifndef PHMASK
#define PHMASK 0xFFFFF
#endif
constexpr int PH_PER_LAYER = 10, NPHASE = 1 + 2 * PH_PER_LAYER + 1;

__global__ void __launch_bounds__(NT, 2) mega(Params pv, int ph_lo, int ph_hi) {
    cg::grid_group grid = cg::this_grid();
    XcdBarrier xb;
    {
        SMEM_DECL;
        volatile LAS unsigned* st = (volatile LAS unsigned*)((LAS unsigned char*)smem + 131072);
        if (__builtin_amdgcn_workitem_id_x() < 4) st[__builtin_amdgcn_workitem_id_x()] = 0u;
        __syncthreads();
        xb = xcd_barrier_post((unsigned*)(pv.ws + WS_BAR), st);
    }
    for (int ph = ph_lo; ph < ph_hi; ++ph) {
        if (ph == ph_lo + 1) grid.sync();
        else if (ph > ph_lo) xcd_barrier(xb);
        KP p = opaque_kp();
        unsigned char* ws = p->ws;
        bf16_t* XB = (bf16_t*)(ws + WS_XB); bf16_t* Ub = (bf16_t*)p->out;
        bf16_t* HB = (bf16_t*)(ws + WS_HB); bf16_t* PROJ = HB;
        bf16_t* CAT = (bf16_t*)(ws + WS_CAT);
        bf16_t* OG = (bf16_t*)(ws + WS_OG);
        float* LSE = (float*)(ws + WS_LSE);
        float* ST = (float*)(ws + WS_ST);
        float* DEC = (float*)(ws + WS_DEC);
        float* DT = (float*)(ws + WS_DT);
        float* X = p->out;
        float* PART = (float*)(ws + WS_PART);
        if (ph == 0) {
            weights_phase(p);
            cache_copy_phase(p);
            copy_phase(p, XB, PART);
            continue;
        }
        if (ph == NPHASE - 1) { final_phase(p, XB, X); continue; }
        const int L = (ph - 1) / PH_PER_LAYER, q = (ph - 1) % PH_PER_LAYER;
        unsigned char* wb = ws + (size_t)L * LAYER_W;
        const bf16_t* XBs = XB + (size_t)MP * DM; const bf16_t* Xs = XBs;
#ifndef REPMASK
#define REPMASK 0
#endif
        for (int rep = 0; rep < 1 + ((REPMASK >> q) & 1); ++rep)
        switch (q) {
        case 0: case 8: { EpiGU e{HB, PART}; const bf16_t* W = (const bf16_t*)(wb + (q == 0 ? OFF_WGU1 : OFF_WGU2)); gemm_phase_cont(XB, W, 1024, MP / 256, 22, e);
            for (int t = blockIdx.x; t < 176; t += gridDim.x) { const int c0 = t * 16, r0 = (c0 >> 7) * 256 + (c0 & 127); FinGU f{HB, c0}; skinny_task<2, true, 4>(XBs, DM, W, 1024, r0, r0 + 128, Xs, f); } } break;
        case 1: case 9: { EpiRes e{XB, PART, 0.5f}; const bf16_t* W = (const bf16_t*)(wb + (q == 1 ? OFF_WD1 : OFF_WD2)); gemm_phase_cont(HB, W, 2816, MP / 256, 4, e);
            for (int t = blockIdx.x; t < 64; t += gridDim.x) { FinRes f{XB, 0.5f, t * 16}; skinny_task<1, false, 11>(HB + (size_t)MP * DFF, DFF, W, 2816, t * 16, 0, nullptr, f); } } break;
        case 2: { EpiProj e{PROJ, NPROJ, PART}; const bf16_t* W = (const bf16_t*)(wb + OFF_WIN); gemm_phase_cont(XB, W, 1024, MP / 256, 10, e);
            for (int t = blockIdx.x; t < 160; t += gridDim.x) { FinProj f{PROJ, t * 16}; skinny_task<1, true, 4>(XBs, DM, W, 1024, t * 16, 0, Xs, f); } } break;
        case 3:
            prep_phase(p, L, PROJ, Ub, CAT, XB, PART, DT);
            for (int it = blockIdx.x; it < 4 * MS; it += gridDim.x) prep_sample_item(p, L, it, PROJ, Ub, CAT, XB, DT);
            break;
        case 4:
            {
                int it = blockIdx.x;
                for (; it < 160 + 512; it += gridDim.x) {
                    if (it < 128) sample_attn_item(p, L, it, PROJ, CAT);
                    else if (it < 160) sample_ssd_item(p, L, it - 128, PROJ, Ub, DT, CAT);
                    else s1_item(p, L, it - 160, Ub, DT, ST, DEC);
                }
                attn_items(it - 160 - 512, gridDim.x, PROJ, OG, LSE);
            }
            break;
        case 5: scan_phase(p, L, ST, DEC); break;
        case 6:
            for (int it = blockIdx.x; it < 1024; it += gridDim.x) {
                if (it < 512) s3_item(p, L, it, Ub, PROJ, DT, ST, CAT);
                else combine_item(it - 512, OG, LSE, CAT);
            }
            break;
        case 7: { EpiRes e{XB, PART, 1.0f}; const bf16_t* W = (const bf16_t*)(wb + OFF_WOUT); gemm_phase_cont(CAT, W, 1024, MP / 256, 4, e);
            for (int t = blockIdx.x; t < 64; t += gridDim.x) { FinRes f{XB, 1.0f, t * 16}; skinny_task<1, false, 4>(CAT + (size_t)MP * DM, DM, W, 1024, t * 16, 0, nullptr, f); } } break;
        }
    }
}

constexpr int LDS_BYTES = 131072 + 64 + 4096 + 2048;

extern "C" void kernel_launch(void* const* d_in, const int* in_sizes, int n_in, void* d_out, int out_size, void* d_ws, size_t ws_size, hipStream_t stream) {
    static int grid = 0;
    if (grid == 0) {
        if (n_in != 27 || (size_t)out_size != O_END || ws_size < WS_END) {
            fprintf(stderr, "kernel_launch: unexpected shapes n_in %d out %d ws %zu (need %zu)\n", n_in, out_size, ws_size, (size_t)WS_END); grid = -1; return; }
        int dev = 0, cus = 0, per_cu = 0;
        hipGetDevice(&dev);
        hipDeviceGetAttribute(&cus, hipDeviceAttributeMultiprocessorCount, dev);
        if (hipFuncSetAttribute((const void*)mega, hipFuncAttributeMaxDynamicSharedMemorySize, LDS_BYTES) != hipSuccess) { fprintf(stderr, "hipFuncSetAttribute failed\n"); grid = -1; return; }
        hipOccupancyMaxActiveBlocksPerMultiprocessor(&per_cu, (const void*)mega, NT, LDS_BYTES);
        if (per_cu < 1) { fprintf(stderr, "occupancy query says %d blocks/CU\n", per_cu); per_cu = 1; }
        (void)hipGetLastError();
        grid = cus;
    }
    if (grid < 0) return;
    if (hipMemsetAsync((char*)d_ws + WS_BAR, 0, 16384, stream) != hipSuccess) { fprintf(stderr, "memset failed\n"); return; }
    Params p{};
    for (int i = 0; i < 27; ++i) p.in[i] = (const float*)d_in[i];
    p.out = (float*)d_out; p.ws = (unsigned char*)d_ws;
    int lo = 0, hi = NPHASE;
    void* args[] = {&p, &lo, &hi};
    hipError_t e = hipLaunchCooperativeKernel((const void*)mega, dim3(grid), dim3(NT), args, LDS_BYTES, stream);
    if (e != hipSuccess) fprintf(stderr, "cooperative launch failed: %s (grid %d)\n", hipGetErrorString(e), grid);
}
```

```cpp
#include <hip/hip_runtime.h>
#include <hip/hip_cooperative_groups.h>
#include <cstdio>
#include <cstdint>
namespace cg = cooperative_groups;

typedef unsigned short bf16_t;
typedef short bf16x8 __attribute__((ext_vector_type(8)));
typedef float f32x4 __attribute__((ext_vector_type(4)));

#define NT 512
constexpr int MP = 32768;
constexpr int MS = 32;
constexpr int MTOK = MP + MS;
constexpr int MPAD = 33024;
constexpr int DM = 1024, DFF = 2816, NPROJ = 2560, WINLD = 2568;
constexpr float EPS = 1e-6f;

constexpr size_t SZ_WGU = 5632ull * 1024 * 2, SZ_WD = 1024ull * 2816 * 2, SZ_WIN = 2560ull * 1024 * 2, SZ_WOUT = 1024ull * 1024 * 2;
constexpr size_t OFF_WGU1 = 0, OFF_WD1 = OFF_WGU1 + SZ_WGU, OFF_WIN = OFF_WD1 + SZ_WD, OFF_WOUT = OFF_WIN + SZ_WIN,
                 OFF_WGU2 = OFF_WOUT + SZ_WOUT, OFF_WD2 = OFF_WGU2 + SZ_WGU, LAYER_W = OFF_WD2 + SZ_WD;
constexpr size_t WS_XB = 2 * LAYER_W;
constexpr size_t WS_HB = WS_XB + (size_t)MPAD * 1024 * 2;
constexpr size_t WS_CAT = WS_HB + (size_t)MPAD * 2816 * 2;
constexpr size_t WS_OG = WS_CAT + (size_t)MPAD * 1024 * 2;
constexpr size_t WS_LSE = WS_OG + 3ull * MP * 256 * 2;
constexpr size_t WS_ST = WS_LSE + 3ull * MP * 4 * 4;
constexpr size_t WS_DEC = WS_ST + 256ull * 8 * 64 * 128 * 4;
constexpr size_t WS_DT = WS_DEC + 256 * 8 * 4;
constexpr size_t WS_PART = WS_DT + (size_t)MPAD * 8 * 4;
constexpr size_t WS_WDT = WS_PART + (size_t)MP * 16 * 4;
constexpr size_t WS_BAR = WS_WDT + 2 * 16 * 1024 * 2;
constexpr size_t WS_END = WS_BAR + 16384;

constexpr size_t O_Y = 0, O_POOLP = 33587200ull, O_POOLS = 33617920ull, O_KP = 33863680ull, O_KS = 38057984ull, O_VP = 71612416ull,
                 O_VS = 75806720ull, O_CONVP = 109361152ull, O_CONVS = 109385728ull, O_SSMP = 109582336ull, O_SSMS = 110106624ull,
                 O_END = 114300928ull;

struct Params { const float* in[27]; float* out; unsigned char* ws; };
enum { I_XP = 0, I_XS, I_CPOOL, I_CK, I_CV, I_SCONV, I_SSSM, I_F1N, I_F1G, I_F1U, I_F1D, I_MIXN, I_WIN, I_POOLW, I_POOLSC, I_CONVW, I_CONVB,
       I_DTB, I_ALOG, I_DSKIP, I_SSMN, I_WOUT, I_F2N, I_F2G, I_F2U, I_F2D, I_FINN };

typedef const __attribute__((address_space(4))) Params* KP;
__device__ __forceinline__ int otid() { int t = __builtin_amdgcn_workitem_id_x(); asm volatile("" : "+v"(t)); return t; }
__device__ __forceinline__ KP opaque_kp() { KP k = (KP)__builtin_amdgcn_kernarg_segment_ptr(); asm volatile("" : "+s"(k)); return k; }
__device__ __forceinline__ float bf2f(bf16_t v) { return __uint_as_float(((unsigned)v) << 16); }
__device__ __forceinline__ unsigned pk2(float lo, float hi) { unsigned r; asm("v_cvt_pk_bf16_f32 %0, %1, %2" : "=v"(r) : "v"(lo), "v"(hi)); return r; }
__device__ __forceinline__ bf16_t f2bf(float f) { return (bf16_t)(pk2(f, 0.f) & 0xffffu); }
__device__ __forceinline__ float lo16(unsigned u) { return __uint_as_float(u << 16); }
__device__ __forceinline__ float hi16(unsigned u) { return __uint_as_float(u & 0xffff0000u); }
__device__ __forceinline__ float silu(float x) { return x * __builtin_amdgcn_rcpf(1.f + __expf(-x)); }
__device__ __forceinline__ float wave_sum(float v) {
#pragma unroll
    for (int o = 32; o > 0; o >>= 1) v += __shfl_xor(v, o);
    return v;
}
__device__ __forceinline__ float wave_max(float v) {
#pragma unroll
    for (int o = 32; o > 0; o >>= 1) v = fmaxf(v, __shfl_xor(v, o));
    return v;
}
__device__ const float ROPE_INV[32] = {1.000000000e+00f, 7.498942018e-01f, 5.623413324e-01f, 4.216965139e-01f, 3.162277639e-01f, 2.371373773e-01f, 1.778279394e-01f, 1.333521456e-01f, 1.000000015e-01f, 7.498942316e-02f, 5.623413250e-02f, 4.216964915e-02f, 3.162277490e-02f, 2.371373773e-02f, 1.778279431e-02f, 1.333521400e-02f, 9.999999776e-03f, 7.498942316e-03f, 5.623413250e-03f, 4.216964822e-03f, 3.162277630e-03f, 2.371373819e-03f, 1.778279431e-03f, 1.333521446e-03f, 1.000000047e-03f, 7.498941850e-04f, 5.623413017e-04f, 4.216965172e-04f, 3.162277571e-04f, 2.371373703e-04f, 1.778279402e-04f, 1.333521504e-04f};
__device__ __forceinline__ float rope_inv(int i) { return ROPE_INV[i]; }
__device__ __forceinline__ void rope_cs(float ang, float& c, float& s) {
    const float k = rintf(ang * 0.15915494309189535f);
    float r = fmaf(-k, 6.28318548202514648f, ang); r = fmaf(-k, -1.74845553146951715e-07f, r);
    const float f = r * 0.15915494309189535f;
    s = __builtin_amdgcn_sinf(f); c = __builtin_amdgcn_cosf(f);
}
__device__ __forceinline__ uint4 zero4() { unsigned z; asm volatile("v_mov_b32 %0, 0" : "=v"(z)); uint4 r; r.x = z; r.y = z; r.z = z; r.w = z; return r; }
#define MFMA16(a, b, c) __builtin_amdgcn_mfma_f32_16x16x32_bf16((a), (b), (c), 0, 0, 0)
#define LDS_BARRIER() do { asm volatile("s_waitcnt lgkmcnt(0)" ::: "memory"); __builtin_amdgcn_s_barrier(); asm volatile("" ::: "memory"); } while (0)
#define SMEM_DECL extern __shared__ __attribute__((aligned(16))) unsigned char smem[]

constexpr int BM = 256, BK = 64, HALF = 128, HT = HALF * BK;
__device__ __forceinline__ int lds_byte(int r, int c) { int st = (r >> 4) * 2 + (c >> 5), rr = r & 15, cc = c & 31, ob = rr * 64 + cc * 2; return st * 1024 + (ob ^ (((ob >> 9) & 1) << 5)); }
__device__ __forceinline__ void stage_rc(int b, int& R, int& C) { int st = b / 1024, sb = b % 1024, swz = sb ^ (((sb >> 9) & 1) << 5); R = (st >> 1) * 16 + swz / 64; C = (st & 1) * 32 + (swz % 64) / 2; }

__device__ __forceinline__ void tile_of(int L, int nM, int nN, int& pm, int& pn) {
    const int nwg = nM * nN; int wgid = L;
    { const int q = nwg / 8, r = nwg % 8, xcd = wgid % 8, off = wgid / 8; wgid = (xcd < r ? xcd * (q + 1) : r * (q + 1) + (xcd - r) * q) + off; }
    const int nig = 8 * nN, gid = wgid / nig, fm = gid * 8, gsz = (nM - fm) < 8 ? (nM - fm) : 8;
    pm = fm + ((wgid % nig) % gsz); pn = (wgid % nig) / gsz;
}

#define LAS __attribute__((address_space(3)))
constexpr int HTB = HALF * BK * 2;
__device__ __forceinline__ float row_rstd(const float* PART, int row) {
    const float4* pp = (const float4*)(PART + (size_t)row * 16);
    const float4 a = pp[0], b = pp[1], c = pp[2], d = pp[3];
    const float ss = ((a.x + a.y) + (a.z + a.w)) + ((b.x + b.y) + (b.z + b.w)) + ((c.x + c.y) + (c.z + c.w)) + ((d.x + d.y) + (d.z + d.w));
    return rsqrtf(ss * (1.f / 1024.f) + EPS);
}
template <class Epi>
__device__ __forceinline__ void gemm_phase(const bf16_t* A, const bf16_t* Bt, const int K, const int nM, const int nN, const Epi& epi) {
    SMEM_DECL;
    LAS unsigned char* lds = (LAS unsigned char*)smem;
    const int tid = otid(), wid = __builtin_amdgcn_readfirstlane(tid >> 6), lane = tid & 63, wr = wid >> 2, wc = wid & 3, fr = lane & 15, fq = lane >> 4;
    const int nt = K / BK, ntiles = nM * nN;
    unsigned voff[2];
#pragma unroll
    for (int i = 0; i < 2; ++i) { int R, C; stage_rc(tid * 16 + i * 8192, R, C); voff[i] = (unsigned)(R * K + C) * 2u; }
    const size_t kstep = (size_t)(BK * 2), hstep = (size_t)HALF * K * 2;
    const unsigned ldsw = (unsigned)wid * 1024u;
    const int aoff = lds_byte(wr * 64 + fr, fq * 8), boff = lds_byte(wc * 32 + fr, fq * 8);
#define GSA(b, h) (((b) * 2 + (h)) * HTB)
#define GSB(b, h) ((4 + (b) * 2 + (h)) * HTB)
#define STAGE(bufoff, gbase) do { _Pragma("unroll") for (int _i = 0; _i < 2; ++_i) \
    __builtin_amdgcn_global_load_lds((const unsigned*)((const char*)(gbase) + voff[_i]), (LAS unsigned*)(lds + (bufoff) + ldsw + _i * 8192), 16, 0, 0); } while (0)
#define LDA(dst, b, h) do { _Pragma("unroll") for (int m = 0; m < 4; ++m) _Pragma("unroll") for (int k = 0; k < 2; ++k) dst[m][k] = *(const LAS bf16x8*)(lds + GSA(b, h) + aoff + m * 2048 + k * 1024); } while (0)
#define LDB(dst, b, h) do { _Pragma("unroll") for (int n = 0; n < 2; ++n) _Pragma("unroll") for (int k = 0; k < 2; ++k) dst[n][k] = *(const LAS bf16x8*)(lds + GSB(b, h) + boff + n * 2048 + k * 1024); } while (0)
#define MMA(ai, bj, At_, Bt_) do { __builtin_amdgcn_s_setprio(1); _Pragma("unroll") for (int m = 0; m < 4; ++m) _Pragma("unroll") for (int n = 0; n < 2; ++n) _Pragma("unroll") for (int k = 0; k < 2; ++k) \
      acc[ai][bj][m][n] = __builtin_amdgcn_mfma_f32_16x16x32_bf16(Bt_[n][k], At_[m][k], acc[ai][bj][m][n], 0, 0, 0); \
    __builtin_amdgcn_s_setprio(0); } while (0)
#define WAIT_V(n) asm volatile("s_waitcnt vmcnt(" #n ")" ::: "memory")
#define WAIT_L(n) asm volatile("s_waitcnt lgkmcnt(" #n ")" ::: "memory")
#define BAR __builtin_amdgcn_s_barrier()
#define SCHED __builtin_amdgcn_sched_barrier(0)
    int L = blockIdx.x;
    WAIT_V(0); __syncthreads();
    if (L >= ntiles) return;
    int pm, pn; tile_of(L, nM, nN, pm, pn);
    const char* cA = (const char*)A + (size_t)(pm * 256) * K * 2;
    const char* cB = (const char*)Bt + (size_t)(pn * 256) * K * 2;
    STAGE(GSB(0, 0), cB); STAGE(GSA(0, 0), cA); STAGE(GSB(0, 1), cB + hstep); STAGE(GSA(0, 1), cA + hstep);
    float* rsb = (float*)(smem + 131072 + 64 + 4096);
    int rbuf = 0;
    if (Epi::NEEDS_RS && tid < 256) rsb[tid] = row_rstd(epi.PART, pm * 256 + tid);
    bool first = true;
    for (;;) {
        f32x4 acc[2][2][4][2];
#pragma unroll
        for (int a = 0; a < 2; ++a)
#pragma unroll
            for (int b = 0; b < 2; ++b)
#pragma unroll
                for (int m = 0; m < 4; ++m)
#pragma unroll
                    for (int n = 0; n < 2; ++n) acc[a][b][m][n] = (f32x4){0.f, 0.f, 0.f, 0.f};
        bf16x8 At[4][2], B0[2][2], B1[2][2];
        if (wr == 1) BAR;
        if (first) { WAIT_V(4); } else { asm volatile("s_waitcnt vmcnt(%0)" :: "n"(Epi::NST) : "memory"); }
        BAR;
        STAGE(GSB(1, 0), cB + kstep); STAGE(GSA(1, 0), cA + kstep); STAGE(GSB(1, 1), cB + hstep + kstep);
        WAIT_V(6); BAR;
        for (int t = 0; t < nt - 2; t += 2) {
            const char* a1 = cA + (size_t)(t + 1) * kstep; const char* a2 = a1 + kstep; const char* a3 = a2 + kstep;
            const char* b2 = cB + (size_t)(t + 2) * kstep; const char* b3 = b2 + kstep;
            LDB(B0, 0, 0); SCHED; LDA(At, 0, 0); STAGE(GSA(1, 1), a1 + hstep);
            WAIT_L(8); BAR; WAIT_L(0); MMA(0, 0, At, B0); BAR; SCHED;
            LDB(B1, 0, 1); STAGE(GSB(0, 0), b2);
            BAR; WAIT_L(0); MMA(0, 1, At, B1); BAR;
            LDA(At, 0, 1); STAGE(GSA(0, 0), a2);
            BAR; WAIT_L(0); MMA(1, 0, At, B0); BAR; SCHED;
            STAGE(GSB(0, 1), b2 + hstep);
            WAIT_V(6); BAR; MMA(1, 1, At, B1); BAR;
            LDB(B0, 1, 0); SCHED; LDA(At, 1, 0); STAGE(GSA(0, 1), a2 + hstep);
            WAIT_L(8); BAR; WAIT_L(0); MMA(0, 0, At, B0); BAR; SCHED;
            LDB(B1, 1, 1); STAGE(GSB(1, 0), b3);
            BAR; WAIT_L(0); MMA(0, 1, At, B1); BAR;
            LDA(At, 1, 1); STAGE(GSA(1, 0), a3);
            BAR; WAIT_L(0); MMA(1, 0, At, B0); BAR; SCHED;
            STAGE(GSB(1, 1), b3 + hstep);
            WAIT_V(6); BAR; MMA(1, 1, At, B1); BAR;
        }
        { LDB(B0, 0, 0); LDA(At, 0, 0); STAGE(GSA(1, 1), cA + (size_t)(nt - 1) * kstep + hstep);
          BAR; WAIT_L(0); MMA(0, 0, At, B0); BAR;
          LDB(B1, 0, 1); BAR; WAIT_L(0); MMA(0, 1, At, B1); BAR;
          LDA(At, 0, 1); WAIT_V(4); BAR; WAIT_L(0); MMA(1, 0, At, B0); MMA(1, 1, At, B1); BAR; }
        { LDB(B0, 1, 0); LDA(At, 1, 0); WAIT_V(2); BAR; WAIT_L(0); MMA(0, 0, At, B0); BAR;
          LDB(B1, 1, 1); WAIT_V(0); BAR; WAIT_L(0); MMA(0, 1, At, B1); BAR;
          LDA(At, 1, 1); BAR; WAIT_L(0); MMA(1, 0, At, B0); MMA(1, 1, At, B1); BAR; }
        if (wr == 0) BAR;
        const int brow = pm * 256, bcol = pn * 256;
        L += gridDim.x;
        const bool more = L < ntiles;
        if (more) {
            tile_of(L, nM, nN, pm, pn);
            cA = (const char*)A + (size_t)(pm * 256) * K * 2; cB = (const char*)Bt + (size_t)(pn * 256) * K * 2;
            STAGE(GSB(0, 0), cB); STAGE(GSA(0, 0), cA); STAGE(GSB(0, 1), cB + hstep); STAGE(GSA(0, 1), cA + hstep);
            SCHED;
        }
        float rs_next = 0.f;
        if (Epi::NEEDS_RS && more && tid < 256) rs_next = row_rstd(epi.PART, pm * 256 + tid);
        epi(acc, brow, bcol, wr, wc, fr, fq, rsb + rbuf * 256);
        SCHED;
        if (!more) break;
        if (Epi::NEEDS_RS && tid < 256) rsb[(rbuf ^ 1) * 256 + tid] = rs_next;
        rbuf ^= 1;
        first = false;
    }
    asm volatile("s_waitcnt vmcnt(0)" ::: "memory");
    __syncthreads();
}

template <class Epi>
__device__ __forceinline__ void gemm_phase_cont(const bf16_t* A, const bf16_t* Bt, const int K, const int nM, const int nN, const Epi& epi) {
    SMEM_DECL;
    LAS unsigned char* lds = (LAS unsigned char*)smem;
    const int tid = otid(), wid = __builtin_amdgcn_readfirstlane(tid >> 6), lane = tid & 63, wr = wid >> 2, wc = wid & 3, fr = lane & 15, fq = lane >> 4;
    const int nt = K / BK, ntiles = nM * nN;
    unsigned voff[2];
#pragma unroll
    for (int i = 0; i < 2; ++i) { int R, C; stage_rc(tid * 16 + i * 8192, R, C); voff[i] = (unsigned)(R * K + C) * 2u; }
    const size_t kstep = (size_t)(BK * 2), hstep = (size_t)HALF * K * 2;
    const unsigned ldsw = (unsigned)wid * 1024u;
    const int aoff = lds_byte(wr * 64 + fr, fq * 8), boff = lds_byte(wc * 32 + fr, fq * 8);
    int L = blockIdx.x;
    WAIT_V(0); __syncthreads();
    if (L >= ntiles) return;
    int pm, pn; tile_of(L, nM, nN, pm, pn);
    const char* cA = (const char*)A + (size_t)(pm * 256) * K * 2;
    const char* cB = (const char*)Bt + (size_t)(pn * 256) * K * 2;
    f32x4 acc[2][2][4][2];
#pragma unroll
    for (int a = 0; a < 2; ++a)
#pragma unroll
        for (int b = 0; b < 2; ++b)
#pragma unroll
            for (int m = 0; m < 4; ++m)
#pragma unroll
                for (int n = 0; n < 2; ++n) acc[a][b][m][n] = (f32x4){0.f, 0.f, 0.f, 0.f};
    bf16x8 At[4][2], B0[2][2], B1[2][2];
    float* rsb = (float*)(smem + 131072 + 64 + 4096);
    int rbuf = 0;
    float rs0 = 0.f;
    if (Epi::NEEDS_RS && tid < 256) rs0 = row_rstd(epi.PART, pm * 256 + tid);
    STAGE(GSB(0, 0), cB); STAGE(GSB(0, 1), cB + hstep); STAGE(GSA(0, 0), cA); STAGE(GSA(0, 1), cA + hstep);
    if (wr == 1) BAR;
    WAIT_V(2); BAR;
    STAGE(GSB(1, 0), cB + kstep); STAGE(GSA(1, 0), cA + kstep); STAGE(GSB(1, 1), cB + hstep + kstep);
    WAIT_V(6); BAR;
    if (Epi::NEEDS_RS && tid < 256) rsb[tid] = rs0;
    for (;;) {
        const int Ln = L + gridDim.x; const bool has_next = Ln < ntiles;
        int npm = pm, npn = pn; if (has_next) tile_of(Ln, nM, nN, npm, npn);
        const char* nA = (const char*)A + (size_t)(npm * 256) * K * 2; const char* nB = (const char*)Bt + (size_t)(npn * 256) * K * 2;
        for (int t = 0; t < nt; t += 2) {
            const bool last = (t == nt - 2);
            const char* a1 = cA + (size_t)(t + 1) * kstep;
            const char* a2 = last ? nA : cA + (size_t)(t + 2) * kstep; const char* b2 = last ? nB : cB + (size_t)(t + 2) * kstep;
            const char* a3 = a2 + kstep; const char* b3 = b2 + kstep;
            LDB(B0, 0, 0); LDB(B1, 0, 1); SCHED; LDA(At, 0, 0); STAGE(GSA(1, 1), a1 + hstep);
            WAIT_V(8); WAIT_L(0); BAR; MMA(0, 0, At, B0); MMA(0, 1, At, B1); BAR; SCHED;
            LDA(At, 0, 1); STAGE(GSB(0, 0), b2); STAGE(GSB(0, 1), b2 + hstep); STAGE(GSA(0, 0), a2);
            WAIT_V(8); WAIT_L(0); BAR; MMA(1, 0, At, B0); MMA(1, 1, At, B1); BAR; SCHED;
            LDB(B0, 1, 0); LDB(B1, 1, 1); SCHED; LDA(At, 1, 0); STAGE(GSA(0, 1), a2 + hstep);
            WAIT_V(8); WAIT_L(0); BAR; MMA(0, 0, At, B0); MMA(0, 1, At, B1); BAR; SCHED;
            LDA(At, 1, 1); STAGE(GSB(1, 0), b3); STAGE(GSB(1, 1), b3 + hstep); STAGE(GSA(1, 0), a3);
            WAIT_V(8); WAIT_L(0); BAR; MMA(1, 0, At, B0); MMA(1, 1, At, B1); BAR; SCHED;
        }
        if (wr == 0) BAR;
        float rs_next = 0.f;
        if (Epi::NEEDS_RS && has_next && tid < 256) rs_next = row_rstd(epi.PART, npm * 256 + tid);
        epi(acc, pm * 256, pn * 256, wr, wc, fr, fq, rsb + rbuf * 256);
        SCHED;
        if (!has_next) break;
        if (Epi::NEEDS_RS && tid < 256) rsb[(rbuf ^ 1) * 256 + tid] = rs_next;
        rbuf ^= 1;
#pragma unroll
        for (int a = 0; a < 2; ++a)
#pragma unroll
            for (int b = 0; b < 2; ++b)
#pragma unroll
                for (int m = 0; m < 4; ++m)
#pragma unroll
                    for (int n = 0; n < 2; ++n) acc[a][b][m][n] = (f32x4){0.f, 0.f, 0.f, 0.f};
        L = Ln; pm = npm; pn = npn; cA = nA; cB = nB;
        if (wr == 1) BAR;
    }
    WAIT_V(0);
    BAR;
    __syncthreads();
}

struct EpiGU {
    static constexpr int NST = 16; static constexpr bool NEEDS_RS = true;
    bf16_t* __restrict__ H; const float* __restrict__ PART;
    __device__ __forceinline__ void operator()(const f32x4 (&acc)[2][2][4][2], int brow, int bcol, int wr, int wc, int fr, int fq, const float* rsl) const {
        const int cbase = (bcol >> 8) * 128 + wc * 32 + fq * 8;
        float rs[2][4];
#pragma unroll
        for (int ai = 0; ai < 2; ++ai)
#pragma unroll
            for (int m = 0; m < 4; ++m) rs[ai][m] = rsl[ai * 128 + wr * 64 + m * 16 + fr];
#pragma unroll
        for (int ai = 0; ai < 2; ++ai)
#pragma unroll
            for (int m = 0; m < 4; ++m) {
                const int row = brow + ai * 128 + wr * 64 + m * 16 + fr;
                const f32x4 g0 = acc[ai][0][m][0] * rs[ai][m], u0 = acc[ai][1][m][0] * rs[ai][m], g1 = acc[ai][0][m][1] * rs[ai][m], u1 = acc[ai][1][m][1] * rs[ai][m];
                uint4 o; o.x = pk2(silu(g0[0]) * u0[0], silu(g0[1]) * u0[1]); o.y = pk2(silu(g0[2]) * u0[2], silu(g0[3]) * u0[3]);
                o.z = pk2(silu(g1[0]) * u1[0], silu(g1[1]) * u1[1]); o.w = pk2(silu(g1[2]) * u1[2], silu(g1[3]) * u1[3]);
                *(uint4*)(H + (size_t)row * DFF + cbase) = o;
            }
    }
};
struct EpiRes {
    static constexpr int NST = 16; static constexpr bool NEEDS_RS = false;
    bf16_t* XB; float* PART; float scale;
    __device__ __forceinline__ void operator()(const f32x4 (&acc)[2][2][4][2], int brow, int bcol, int wr, int wc, int fr, int fq, const float*) const {
        uint4 v[2][4][2];
#pragma unroll
        for (int ai = 0; ai < 2; ++ai)
#pragma unroll
            for (int m = 0; m < 4; ++m)
#pragma unroll
                for (int bj = 0; bj < 2; ++bj)
                    v[ai][m][bj] = *(const uint4*)(XB + (size_t)(brow + ai * 128 + wr * 64 + m * 16 + fr) * DM + bcol + bj * 128 + wc * 32 + fq * 8);
#pragma unroll
        for (int ai = 0; ai < 2; ++ai)
#pragma unroll
            for (int m = 0; m < 4; ++m) {
                const int row = brow + ai * 128 + wr * 64 + m * 16 + fr;
                float ss = 0.f;
#pragma unroll
                for (int bj = 0; bj < 2; ++bj) {
                    const uint4 xv = v[ai][m][bj]; const f32x4 a0 = acc[ai][bj][m][0], a1 = acc[ai][bj][m][1];
                    uint4 o; o.x = pk2(lo16(xv.x) + scale * a0[0], hi16(xv.x) + scale * a0[1]); o.y = pk2(lo16(xv.y) + scale * a0[2], hi16(xv.y) + scale * a0[3]);
                    o.z = pk2(lo16(xv.z) + scale * a1[0], hi16(xv.z) + scale * a1[1]); o.w = pk2(lo16(xv.w) + scale * a1[2], hi16(xv.w) + scale * a1[3]);
                    *(uint4*)(XB + (size_t)row * DM + bcol + bj * 128 + wc * 32 + fq * 8) = o;
                    const float r0 = lo16(o.x), r1 = hi16(o.x), r2 = lo16(o.y), r3 = hi16(o.y), r4 = lo16(o.z), r5 = hi16(o.z), r6 = lo16(o.w), r7 = hi16(o.w);
                    ss += (r0 * r0 + r1 * r1) + (r2 * r2 + r3 * r3) + (r4 * r4 + r5 * r5) + (r6 * r6 + r7 * r7);
                }
                ss += __shfl_xor(ss, 16); ss += __shfl_xor(ss, 32);
                if (fq == 0) PART[(size_t)row * 16 + (bcol >> 8) * 4 + wc] = ss;
            }
    }
};
struct EpiProj {
    static constexpr int NST = 32; static constexpr bool NEEDS_RS = true;
    bf16_t* __restrict__ P; int ld; const float* __restrict__ PART;
    __device__ __forceinline__ void operator()(const f32x4 (&acc)[2][2][4][2], int brow, int bcol, int wr, int wc, int fr, int fq, const float* rsl) const {
        float rs[2][4];
#pragma unroll
        for (int ai = 0; ai < 2; ++ai)
#pragma unroll
            for (int m = 0; m < 4; ++m) rs[ai][m] = rsl[ai * 128 + wr * 64 + m * 16 + fr];
#pragma unroll
        for (int ai = 0; ai < 2; ++ai)
#pragma unroll
            for (int m = 0; m < 4; ++m) {
                const int row = brow + ai * 128 + wr * 64 + m * 16 + fr;
#pragma unroll
                for (int bj = 0; bj < 2; ++bj) {
                    const f32x4 a0 = acc[ai][bj][m][0] * rs[ai][m], a1 = acc[ai][bj][m][1] * rs[ai][m];
                    uint4 o; o.x = pk2(a0[0], a0[1]); o.y = pk2(a0[2], a0[3]); o.z = pk2(a1[0], a1[1]); o.w = pk2(a1[2], a1[3]);
                    *(uint4*)(P + (size_t)row * ld + bcol + bj * 128 + wc * 32 + fq * 8) = o;
                }
            }
    }
};

template <int NB, bool RS, int NKS, class Fin>
__device__ __forceinline__ void skinny_task(const bf16_t* __restrict__ A, int lda, const bf16_t* __restrict__ Bt, int K, int brow0, int brow1, const bf16_t* Xs, const Fin& fin) {
    SMEM_DECL;
    float* red = (float*)smem;
    float* rsd = red + 8 * NB * 2 * 64 * 4;
    const int tid = otid(), lane = tid & 63, w = tid >> 6, fr = lane & 15, fq = lane >> 4;
    const int kw = K >> 3;
    f32x4 acc[NB][2];
#pragma unroll
    for (int nb = 0; nb < NB; ++nb) { acc[nb][0] = (f32x4){0.f, 0.f, 0.f, 0.f}; acc[nb][1] = (f32x4){0.f, 0.f, 0.f, 0.f}; }
    __syncthreads();
    float rsv[4];
    if (RS) {
#pragma unroll
        for (int rr = 0; rr < 4; ++rr) {
            const bf16_t* xr = Xs + (size_t)(w * 4 + rr) * DM;
            float ss = 0.f;
#pragma unroll
            for (int i = 0; i < 2; ++i) { const uint4 v = *(const uint4*)(xr + i * 512 + lane * 8);
                ss += lo16(v.x) * lo16(v.x) + hi16(v.x) * hi16(v.x) + lo16(v.y) * lo16(v.y) + hi16(v.y) * hi16(v.y) + lo16(v.z) * lo16(v.z) + hi16(v.z) * hi16(v.z) + lo16(v.w) * lo16(v.w) + hi16(v.w) * hi16(v.w); }
            rsv[rr] = ss;
        }
    }
    {
        bf16x8 a0[NKS], a1[NKS], b0[NKS], b1[NKS];
#pragma unroll
        for (int ks = 0; ks < NKS; ++ks) {
            const int k0 = w * kw + ks * 32 + fq * 8;
            a0[ks] = *(const bf16x8*)(A + (size_t)fr * lda + k0); a1[ks] = *(const bf16x8*)(A + (size_t)(16 + fr) * lda + k0);
            b0[ks] = *(const bf16x8*)(Bt + (size_t)(brow0 + fr) * K + k0);
            if (NB == 2) b1[ks] = *(const bf16x8*)(Bt + (size_t)(brow1 + fr) * K + k0);
        }
#pragma unroll
        for (int ks = 0; ks < NKS; ++ks) {
            acc[0][0] = MFMA16(b0[ks], a0[ks], acc[0][0]); acc[0][1] = MFMA16(b0[ks], a1[ks], acc[0][1]);
            if (NB == 2) { acc[NB - 1][0] = MFMA16(b1[ks], a0[ks], acc[NB - 1][0]); acc[NB - 1][1] = MFMA16(b1[ks], a1[ks], acc[NB - 1][1]); }
        }
    }
    if (RS) {
#pragma unroll
        for (int rr = 0; rr < 4; ++rr) { const float ss = wave_sum(rsv[rr]); if (lane == 0) rsd[w * 4 + rr] = rsqrtf(ss * (1.f / 1024.f) + EPS); }
    }
#pragma unroll
    for (int nb = 0; nb < NB; ++nb)
#pragma unroll
        for (int mt = 0; mt < 2; ++mt) { float4 v; v.x = acc[nb][mt][0]; v.y = acc[nb][mt][1]; v.z = acc[nb][mt][2]; v.w = acc[nb][mt][3];
            *(float4*)(red + (((w * NB + nb) * 2 + mt) * 64 + lane) * 4) = v; }
    __syncthreads();
    {
        const int mt = tid >> 8, ln = (tid >> 2) & 63, jj = tid & 3;
        float v0 = 0.f, v1 = 0.f;
#pragma unroll
        for (int ww = 0; ww < 8; ++ww) {
            v0 += red[(((ww * NB + 0) * 2 + mt) * 64 + ln) * 4 + jj];
            if (NB == 2) v1 += red[(((ww * NB + NB - 1) * 2 + mt) * 64 + ln) * 4 + jj];
        }
        const float rs = RS ? rsd[mt * 16 + (ln & 15)] : 1.f;
        fin(mt * 16 + (ln & 15), (ln >> 4) * 4 + jj, v0 * rs, v1 * rs);
    }
}

struct FinGU { bf16_t* H; int c0; __device__ __forceinline__ void operator()(int m, int j, float g, float u) const { const int col = (c0 & ~31) + 8 * (j >> 2) + 4 * ((c0 >> 4) & 1) + (j & 3); H[(size_t)(MP + m) * DFF + col] = f2bf(silu(g) * u); } };
struct FinRes { bf16_t* XB; float scale; int c0; __device__ __forceinline__ void operator()(int m, int j, float v, float) const { const size_t o = (size_t)(MP + m) * DM + (c0 & ~31) + 8 * (j >> 2) + 4 * ((c0 >> 4) & 1) + (j & 3); XB[o] = f2bf(bf2f(XB[o]) + scale * v); } };
struct FinProj { bf16_t* P; int c0; __device__ __forceinline__ void operator()(int m, int j, float v, float) const { const int col = (c0 & ~31) + 8 * (j >> 2) + 4 * ((c0 >> 4) & 1) + (j & 3); P[(size_t)(MP + m) * NPROJ + col] = f2bf(v); } };

__device__ __forceinline__ void transpose_tile(const float* __restrict__ src, int ldn, int K, int k0, int c0, bf16_t* __restrict__ dst, int drow0, const float* __restrict__ gk, bool perm) {
    SMEM_DECL;
    float* tile = (float*)smem;
    const int tid = otid();
    __syncthreads();
    {
        float4 v[8];
#pragma unroll
        for (int r = 0; r < 8; ++r) { const int id = tid + r * NT, k = id >> 4, n4 = (id & 15) * 4; v[r] = *(const float4*)(src + (size_t)(k0 + k) * ldn + c0 + n4); }
#pragma unroll
        for (int r = 0; r < 8; ++r) { const int id = tid + r * NT, k = id >> 4, n4 = (id & 15) * 4; const float gs = gk ? gk[k0 + k] : 1.f;
            float* t = tile + k * 65 + n4; t[0] = v[r].x * gs; t[1] = v[r].y * gs; t[2] = v[r].z * gs; t[3] = v[r].w * gs; }
    }
    __syncthreads();
#pragma unroll
    for (int r = 0; r < 4; ++r) {
        const int id = tid + r * NT, a = id & 3, n16 = (id >> 2) & 15, rest = id >> 6, n = (rest & 3) * 16 + n16, kc = (rest >> 2) * 4 + a;
        const int c32 = n & 31, nd = perm ? (n & ~31) + 16 * ((c32 >> 2) & 1) + 4 * (c32 >> 3) + (c32 & 3) : n;
        const float* t = tile + (8 * kc) * 65 + n;
        uint4 o; o.x = pk2(t[0], t[65]); o.y = pk2(t[130], t[195]); o.z = pk2(t[260], t[325]); o.w = pk2(t[390], t[455]);
        *(uint4*)(dst + (size_t)(drow0 + nd) * K + k0 + 8 * kc) = o;
    }
}

__device__ void weights_phase(KP p) {
    for (int it = blockIdx.x; it < 2 * 1280; it += gridDim.x) {
        const int L = it / 1280; int r = it % 1280;
        unsigned char* wb = p->ws + (size_t)L * LAYER_W;
        if (r < 528 || r >= 752) {
            const bool second = r >= 752; if (second) r -= 752;
            const float* G = (second ? p->in[I_F2G] : p->in[I_F1G]) + (size_t)L * 1024 * 2816;
            const float* U = (second ? p->in[I_F2U] : p->in[I_F1U]) + (size_t)L * 1024 * 2816;
            const float* D = (second ? p->in[I_F2D] : p->in[I_F1D]) + (size_t)L * 2816 * 1024;
            bf16_t* wgu = (bf16_t*)(wb + (second ? OFF_WGU2 : OFF_WGU1));
            bf16_t* wd = (bf16_t*)(wb + (second ? OFF_WD2 : OFF_WD1));
            if (r < 352) { const bool up = r >= 176; if (up) r -= 176; const int kt = r / 44, nt = r % 44, c0 = nt * 64;
                transpose_tile(up ? U : G, 2816, 1024, kt * 256, c0, wgu, (c0 >> 7) * 256 + (c0 & 127) + (up ? 128 : 0), (second ? p->in[I_F2N] : p->in[I_F1N]) + L * 1024, true); }
            else { r -= 352; const int kt = r / 16, nt = r % 16; transpose_tile(D, 1024, 2816, kt * 256, nt * 64, wd, nt * 64, nullptr, true); }
        } else if (r < 688) { r -= 528; const int kt = r / 40, nt = r % 40;
            transpose_tile(p->in[I_WIN] + (size_t)L * 1024 * WINLD, WINLD, 1024, kt * 256, nt * 64, (bf16_t*)(wb + OFF_WIN), nt * 64, p->in[I_MIXN] + L * 1024, true);
        } else { r -= 688; const int kt = r / 16, nt = r % 16;
            transpose_tile(p->in[I_WOUT] + (size_t)L * 1024 * 1024, 1024, 1024, kt * 256, nt * 64, (bf16_t*)(wb + OFF_WOUT), nt * 64, nullptr, true); }
    }
    for (int e = blockIdx.x * NT + otid(); e < 2 * 16 * 1024; e += gridDim.x * NT) {
        const int L = e >> 14, h = (e >> 10) & 15, k = e & 1023;
        ((bf16_t*)(p->ws + WS_WDT))[e] = h < 8 ? f2bf(p->in[I_WIN][((size_t)L * 1024 + k) * WINLD + 2560 + h] * p->in[I_MIXN][L * 1024 + k]) : (bf16_t)0;
    }
    __syncthreads();
}

__device__ void cache_copy_phase(KP p) {
    constexpr unsigned per = 2047u * 256u / 4u;
    constexpr unsigned total = 128u * per;
    const unsigned stride = gridDim.x * NT;
    const float* ck = p->in[I_CK]; const float* cv = p->in[I_CV]; float* out = p->out;
#define CC_IDX(j) unsigned i##j = ib + (j) * stride; i##j = i##j < total ? i##j : total - 1u; \
    const unsigned seg##j = i##j / per, e##j = i##j % per, kv##j = seg##j >> 6, ln##j = seg##j & 63u; \
    const float4* s##j = (const float4*)((kv##j ? cv : ck) + (size_t)ln##j * 2048 * 256 + 256) + e##j; \
    float4* d##j = (float4*)(out + (kv##j ? O_VS : O_KS) + (size_t)ln##j * 2048 * 256) + e##j;
    for (unsigned ib = blockIdx.x * NT + otid(); ib < total; ib += 8u * stride) {
        CC_IDX(0) CC_IDX(1) CC_IDX(2) CC_IDX(3) CC_IDX(4) CC_IDX(5) CC_IDX(6) CC_IDX(7)
        const float4 v0 = *s0, v1 = *s1, v2 = *s2, v3 = *s3, v4 = *s4, v5 = *s5, v6 = *s6, v7 = *s7;
        *d0 = v0; *d1 = v1; *d2 = v2; *d3 = v3; *d4 = v4; *d5 = v5; *d6 = v6; *d7 = v7;
    }
#undef CC_IDX
}

__device__ void copy_phase(KP p, bf16_t* XB, float* PART) {
    const int lane = otid() & 63, wave = otid() >> 6;
    const int nw = gridDim.x * 8;
    for (int row0 = blockIdx.x * 8 + wave; row0 < MTOK; row0 += 4 * nw) {
        float4 v[4][4];
#pragma unroll
        for (int r = 0; r < 4; ++r) {
            int row = row0 + r * nw; row = row < MTOK ? row : MTOK - 1;
            const float* src = row < MP ? p->in[I_XP] + (size_t)row * DM : p->in[I_XS] + (size_t)(row - MP) * DM;
#pragma unroll
            for (int i = 0; i < 4; ++i) v[r][i] = *(const float4*)(src + i * 256 + lane * 4);
        }
#pragma unroll
        for (int r = 0; r < 4; ++r) {
            int row = row0 + r * nw; row = row < MTOK ? row : MTOK - 1;
            float ss = 0.f;
#pragma unroll
            for (int i = 0; i < 4; ++i) ss += v[r][i].x * v[r][i].x + v[r][i].y * v[r][i].y + v[r][i].z * v[r][i].z + v[r][i].w * v[r][i].w;
            ss = wave_sum(ss);
#pragma unroll
            for (int i = 0; i < 4; ++i) { uint2 o; o.x = pk2(v[r][i].x, v[r][i].y); o.y = pk2(v[r][i].z, v[r][i].w); *(uint2*)(XB + (size_t)row * DM + i * 256 + lane * 4) = o; }
            if (row < MP && lane < 16) PART[(size_t)row * 16 + lane] = lane == 0 ? ss : 0.f;
        }
    }
}
__device__ void final_phase(KP p, const bf16_t* XB, float* Y) {
    const int lane = otid() & 63, wave = otid() >> 6;
    const int nw = gridDim.x * 8;
    float4 gv[4];
#pragma unroll
    for (int i = 0; i < 4; ++i) gv[i] = *(const float4*)(p->in[I_FINN] + i * 256 + lane * 4);
    for (int row0 = blockIdx.x * 8 + wave; row0 < MTOK; row0 += 4 * nw) {
        uint2 u[4][4];
#pragma unroll
        for (int r = 0; r < 4; ++r) {
            int row = row0 + r * nw; row = row < MTOK ? row : MTOK - 1;
#pragma unroll
            for (int i = 0; i < 4; ++i) u[r][i] = *(const uint2*)(XB + (size_t)row * DM + i * 256 + lane * 4);
        }
#pragma unroll
        for (int r = 0; r < 4; ++r) {
            int row = row0 + r * nw; row = row < MTOK ? row : MTOK - 1;
            float4 v[4]; float ss = 0.f;
#pragma unroll
            for (int i = 0; i < 4; ++i) { v[i] = make_float4(lo16(u[r][i].x), hi16(u[r][i].x), lo16(u[r][i].y), hi16(u[r][i].y)); ss += v[i].x * v[i].x + v[i].y * v[i].y + v[i].z * v[i].z + v[i].w * v[i].w; }
            ss = wave_sum(ss);
            const float rstd = rsqrtf(ss * (1.f / 1024.f) + EPS);
#pragma unroll
            for (int i = 0; i < 4; ++i) { float4 o; o.x = v[i].x * rstd * gv[i].x; o.y = v[i].y * rstd * gv[i].y; o.z = v[i].z * rstd * gv[i].z; o.w = v[i].w * rstd * gv[i].w;
                *(float4*)(Y + (size_t)row * DM + i * 256 + lane * 4) = o; }
        }
    }
}

__device__ void prep_phase(KP p, int L, bf16_t* PROJ, bf16_t* U, bf16_t* CAT, const bf16_t* XB, const float* PART, float* DT) {
    SMEM_DECL;
    float* PW = (float*)smem; float* XA = PW + 16384; float* Dm = XA + 31 * 256; float* CS = Dm + 4096; float* INV = CS + 1024; float* DTP = INV + 32;
    const int tid = otid(), lane = tid & 63, w = tid >> 6, fr = lane & 15, fq = lane >> 4;
    __syncthreads();
    bf16_t* PWT = (bf16_t*)PW;
    bf16_t* DmB = (bf16_t*)Dm;
    for (int i = tid; i < 16384; i += NT) { const int gg = i >> 12, c = (i >> 6) & 63, dd = i & 63; PWT[(gg * 64 + 32 * (dd >> 5) + 16 * ((dd >> 2) & 1) + 4 * ((dd >> 3) & 3) + (dd & 3)) * 72 + c] = f2bf(p->in[I_POOLW][L * 16384 + i]); }
    if (tid < 32) INV[tid] = rope_inv(tid);
    __syncthreads();
    float* out = p->out;
    const bf16_t* wdt = (const bf16_t*)(p->ws + WS_WDT) + (size_t)L * 16 * 1024;
    const int tiles_per = (2048 + gridDim.x - 1) / gridDim.x;
    for (int tile = blockIdx.x * tiles_per; tile < 2048 && tile < (blockIdx.x + 1) * tiles_per; ++tile) {
        const int token0 = tile * 16, b = token0 >> 13, t0 = token0 & 8191;
        bf16x8 da[4], db[4];
#pragma unroll
        for (int ks = 0; ks < 4; ++ks) { const int k0 = w * 128 + ks * 32 + fq * 8;
            da[ks] = *(const bf16x8*)(XB + (size_t)(token0 + fr) * DM + k0); db[ks] = *(const bf16x8*)(wdt + fr * 1024 + k0); }
        uint4 xav[2];
#pragma unroll
        for (int it = 0; it < 2; ++it) { const int id = tid + it * NT, rr = id >> 5, ch = id & 31, t = t0 - 15 + rr;
            xav[it] = zero4();
            if (id < 992 && t >= 0) xav[it] = *(const uint4*)(PROJ + (size_t)(b * 8192 + t) * NPROJ + ch * 8); }
        const int r_tk = tid >> 5, r_rest = tid & 31, r_qk = r_rest >> 4, r_h = (r_rest >> 2) & 3, r_i0 = (r_rest & 3) * 8;
        bf16_t* rbase = PROJ + (size_t)(token0 + r_tk) * NPROJ + 256 + r_qk * 256 + r_h * 64 + r_i0;
        const uint4 rxa = *(const uint4*)rbase, rxb = *(const uint4*)(rbase + 32);
        uint4 vld = zero4();
        if (t0 >= 6144) vld = *(const uint4*)(PROJ + (size_t)(token0 + (tid >> 5)) * NPROJ + 768 + (tid & 31) * 8);
        const int q4 = tid >> 7, c0 = (tid & 127) * 8;
        uint4 xr[7];
#pragma unroll
        for (int rr = 0; rr < 7; ++rr) { const int tt = t0 + q4 * 4 - 3 + rr;
            xr[rr] = zero4();
            if (tt >= 0) xr[rr] = *(const uint4*)(PROJ + (size_t)(b * 8192 + tt) * NPROJ + 1536 + c0); }
        {
            f32x4 acc = (f32x4){0.f, 0.f, 0.f, 0.f};
#pragma unroll
            for (int ks = 0; ks < 4; ++ks) acc = MFMA16(db[ks], da[ks], acc);
            if (fq < 2) { float4 v; v.x = acc[0]; v.y = acc[1]; v.z = acc[2]; v.w = acc[3]; *(float4*)(DTP + (w * 16 + fr) * 8 + fq * 4) = v; }
        }
#pragma unroll
        for (int it = 0; it < 2; ++it) { const int id = tid + it * NT, rr = id >> 5, ch = id & 31;
            if (id < 992) { float* d = XA + rr * 256 + ch * 8; const uint4 v = xav[it];
                d[0] = lo16(v.x); d[1] = hi16(v.x); d[2] = lo16(v.y); d[3] = hi16(v.y); d[4] = lo16(v.z); d[5] = hi16(v.z); d[6] = lo16(v.w); d[7] = hi16(v.w); } }
        { const int tk = tid >> 5, i = tid & 31; float c, sn; rope_cs((float)(t0 + tk) * INV[i], c, sn); CS[(tk * 32 + i) * 2] = c; CS[(tk * 32 + i) * 2 + 1] = sn; }
        __syncthreads();
        if (tid < 128) {
            const int tk = tid >> 3, h = tid & 7;
            float d = 0.f;
#pragma unroll
            for (int ww = 0; ww < 8; ++ww) d += DTP[(ww * 16 + tk) * 8 + h];
            const float x = d * row_rstd(PART, token0 + tk) + p->in[I_DTB][L * 8 + h];
            DT[(size_t)(token0 + tk) * 8 + h] = x > 20.f ? x : log1pf(__expf(x));
        }
        for (int id = tid; id < 4096; id += NT) {
            const int tk = id >> 8, ch = id & 255, g = ch >> 6, ww = 2 << g, t = t0 + tk;
            float sum = 0.f;
            for (int i = 0; i < ww; ++i) sum += XA[(15 + tk - i) * 256 + ch];
            const float xc = XA[(15 + tk) * 256 + ch];
            const int cnt = (t + 1) < ww ? (t + 1) : ww;
            DmB[tk * 264 + ch] = f2bf(sum / (float)cnt - xc);
            if (t >= 8177) out[O_POOLP + ((size_t)(L * 4 + b) * 15 + (t - 8177)) * 256 + ch] = xc;
        }
        __syncthreads();
        {
            const int g = w >> 1;
            f32x4 r[2];
#pragma unroll
            for (int dq = 0; dq < 2; ++dq) {
                const int dtile = (w & 1) * 2 + dq;
                r[dq] = (f32x4){0.f, 0.f, 0.f, 0.f};
#pragma unroll
                for (int ks = 0; ks < 2; ++ks) {
                    const bf16x8 pf = *(const bf16x8*)(PWT + (g * 64 + 16 * dtile + fr) * 72 + ks * 32 + fq * 8);
                    const bf16x8 qf = *(const bf16x8*)(DmB + fr * 264 + g * 64 + ks * 32 + fq * 8);
                    r[dq] = MFMA16(pf, qf, r[dq]);
                }
            }
            const int o = g * 64 + 32 * (w & 1) + fq * 8;
            const float4 p0 = *(const float4*)(p->in[I_POOLSC] + L * 256 + o), p1 = *(const float4*)(p->in[I_POOLSC] + L * 256 + o + 4);
            uint4 ov; ov.x = pk2(r[0][0] * p0.x, r[0][1] * p0.y); ov.y = pk2(r[0][2] * p0.z, r[0][3] * p0.w);
            ov.z = pk2(r[1][0] * p1.x, r[1][1] * p1.y); ov.w = pk2(r[1][2] * p1.z, r[1][3] * p1.w);
            *(uint4*)(CAT + (size_t)(token0 + fr) * DM + o) = ov;
        }
        {
            const int t = t0 + r_tk;
            const float x1[8] = {lo16(rxa.x), hi16(rxa.x), lo16(rxa.y), hi16(rxa.y), lo16(rxa.z), hi16(rxa.z), lo16(rxa.w), hi16(rxa.w)};
            const float x2[8] = {lo16(rxb.x), hi16(rxb.x), lo16(rxb.y), hi16(rxb.y), lo16(rxb.z), hi16(rxb.z), lo16(rxb.w), hi16(rxb.w)};
            float r1[8], r2[8];
            const float sc = r_qk == 0 ? 0.125f : 1.f;
#pragma unroll
            for (int e = 0; e < 8; e += 2) {
                const float4 cs = *(const float4*)(CS + (r_tk * 32 + r_i0 + e) * 2);
                r1[e] = (x1[e] * cs.x - x2[e] * cs.y) * sc; r2[e] = (x2[e] * cs.x + x1[e] * cs.y) * sc;
                r1[e + 1] = (x1[e + 1] * cs.z - x2[e + 1] * cs.w) * sc; r2[e + 1] = (x2[e + 1] * cs.z + x1[e + 1] * cs.w) * sc;
            }
            uint4 o1, o2;
            o1.x = pk2(r1[0], r1[1]); o1.y = pk2(r1[2], r1[3]); o1.z = pk2(r1[4], r1[5]); o1.w = pk2(r1[6], r1[7]);
            o2.x = pk2(r2[0], r2[1]); o2.y = pk2(r2[2], r2[3]); o2.z = pk2(r2[4], r2[5]); o2.w = pk2(r2[6], r2[7]);
            *(uint4*)rbase = o1; *(uint4*)(rbase + 32) = o2;
            if (r_qk == 1 && t >= 6144) {
                float* kp = out + O_KP + (((size_t)(L * 4 + b) * 2048 + (t - 6144)) * 4 + r_h) * 64 + r_i0;
                *(float4*)kp = make_float4(r1[0], r1[1], r1[2], r1[3]); *(float4*)(kp + 4) = make_float4(r1[4], r1[5], r1[6], r1[7]);
                *(float4*)(kp + 32) = make_float4(r2[0], r2[1], r2[2], r2[3]); *(float4*)(kp + 36) = make_float4(r2[4], r2[5], r2[6], r2[7]);
            }
        }
        if (t0 >= 6144) {
            const int tk = tid >> 5, cc = (tid & 31) * 8, t = t0 + tk;
            float* vp = out + O_VP + ((size_t)(L * 4 + b) * 2048 + (t - 6144)) * 256 + cc;
            *(float4*)vp = make_float4(lo16(vld.x), hi16(vld.x), lo16(vld.y), hi16(vld.y)); *(float4*)(vp + 4) = make_float4(lo16(vld.z), hi16(vld.z), lo16(vld.w), hi16(vld.w));
        }
        {
            float wv[4][8], bv[8];
            { const float4 b0 = *(const float4*)(p->in[I_CONVB] + L * 1024 + c0), b1 = *(const float4*)(p->in[I_CONVB] + L * 1024 + c0 + 4);
              bv[0] = b0.x; bv[1] = b0.y; bv[2] = b0.z; bv[3] = b0.w; bv[4] = b1.x; bv[5] = b1.y; bv[6] = b1.z; bv[7] = b1.w; }
#pragma unroll
            for (int tau = 0; tau < 4; ++tau) {
                const float* cw = p->in[I_CONVW] + (size_t)(L * 4 + tau) * 1024 + c0;
                const float4 w0 = *(const float4*)cw, w1 = *(const float4*)(cw + 4);
                wv[tau][0] = w0.x; wv[tau][1] = w0.y; wv[tau][2] = w0.z; wv[tau][3] = w0.w; wv[tau][4] = w1.x; wv[tau][5] = w1.y; wv[tau][6] = w1.z; wv[tau][7] = w1.w;
            }
            float acc[4][8];
#pragma unroll
            for (int it = 0; it < 4; ++it)
#pragma unroll
                for (int e = 0; e < 8; ++e) acc[it][e] = bv[e];
#pragma unroll
            for (int rr = 0; rr < 7; ++rr) {
                const float xf[8] = {lo16(xr[rr].x), hi16(xr[rr].x), lo16(xr[rr].y), hi16(xr[rr].y), lo16(xr[rr].z), hi16(xr[rr].z), lo16(xr[rr].w), hi16(xr[rr].w)};
#pragma unroll
                for (int it = 0; it < 4; ++it) {
                    const int tau = rr - it;
                    if (tau >= 0 && tau < 4) {
#pragma unroll
                        for (int e = 0; e < 8; ++e) acc[it][e] += xf[e] * wv[tau][e];
                    }
                }
            }
#pragma unroll
            for (int it = 0; it < 4; ++it) {
                const int tk = q4 * 4 + it, t = t0 + tk;
                uint4 o; o.x = pk2(silu(acc[it][0]), silu(acc[it][1])); o.y = pk2(silu(acc[it][2]), silu(acc[it][3]));
                o.z = pk2(silu(acc[it][4]), silu(acc[it][5])); o.w = pk2(silu(acc[it][6]), silu(acc[it][7]));
                *(uint4*)(U + (size_t)(token0 + tk) * DM + c0) = o;
                if (t >= 8189) { float* cp = out + O_CONVP + ((size_t)(L * 4 + b) * 3 + (t - 8189)) * 1024 + c0; const uint4 xv = xr[it + 3];
                    *(float4*)cp = make_float4(lo16(xv.x), hi16(xv.x), lo16(xv.y), hi16(xv.y)); *(float4*)(cp + 4) = make_float4(lo16(xv.z), hi16(xv.z), lo16(xv.w), hi16(xv.w)); }
            }
        }
        __syncthreads();
    }
}

__device__ void prep_sample_item(KP p, int L, int item, bf16_t* PROJ, bf16_t* U, bf16_t* CAT, const bf16_t* XB, float* DT) {
    const int n = item >> 2, part = item & 3;
    SMEM_DECL;
    float* dsm = (float*)smem;
    const int tid = otid();
    const size_t row = MP + n;
    float* out = p->out;
    const int ln = L * 32 + n;
    __syncthreads();
    if (part == 0) {
        const int lane = tid & 63, h = tid >> 6;
        const bf16_t* wdt = (const bf16_t*)(p->ws + WS_WDT) + (size_t)L * 16 * 1024 + h * 1024;
        float d = 0.f, ss = 0.f;
#pragma unroll
        for (int i = 0; i < 16; ++i) { const int k = i * 64 + lane; const float xf = bf2f(XB[row * DM + k]); ss += xf * xf; d += xf * bf2f(wdt[k]); }
        d = wave_sum(d); ss = wave_sum(ss);
        if (lane == 0) { const float x = d * rsqrtf(ss * (1.f / 1024.f) + EPS) + p->in[I_DTB][L * 8 + h]; DT[row * 8 + h] = x > 20.f ? x : log1pf(__expf(x)); }
    }
    if (part == 1) {
    if (tid < 256) {
        const int ch = tid, g = ch >> 6, w = 2 << g;
        const float* cp = p->in[I_CPOOL] + (size_t)ln * 15 * 256;
        const float xn = bf2f(PROJ[row * NPROJ + ch]);
        float cpr[15];
#pragma unroll
        for (int i = 1; i < 16; ++i) cpr[i - 1] = cp[(15 - i) * 256 + ch];
        float sum = xn;
#pragma unroll
        for (int i = 1; i < 16; ++i) sum += (i < w) ? cpr[i - 1] : 0.f;
        dsm[ch] = sum / (float)w - xn;
        float* ps = out + O_POOLS + (size_t)ln * 15 * 256;
        float cpv[14];
#pragma unroll
        for (int j = 0; j < 14; ++j) cpv[j] = cp[(j + 1) * 256 + ch];
#pragma unroll
        for (int j = 0; j < 14; ++j) ps[j * 256 + ch] = cpv[j];
        ps[14 * 256 + ch] = xn;
    }
    __syncthreads();
    if (tid < 256) {
        const int o = tid, g = o >> 6, dout = o & 63;
        const float* pw = p->in[I_POOLW] + (size_t)(L * 4 + g) * 4096;
        float acc = 0.f;
#pragma unroll 32
        for (int c = 0; c < 64; ++c) acc += dsm[g * 64 + c] * pw[c * 64 + dout];
        CAT[row * DM + o] = f2bf(acc * p->in[I_POOLSC][L * 256 + o]);
    }
    }
    if (part == 2 && tid < 256) {
        const int qk = tid >> 7, h = (tid >> 5) & 3, i = tid & 31;
        const float inv = rope_inv(i);
        float c, s; rope_cs(16384.f * inv, c, s);
        bf16_t* base = PROJ + row * NPROJ + 256 + qk * 256 + h * 64;
        const float x1 = bf2f(base[i]), x2 = bf2f(base[i + 32]);
        float r1 = x1 * c - x2 * s, r2 = x2 * c + x1 * s;
        if (qk == 0) { r1 *= 0.125f; r2 *= 0.125f; }
        base[i] = f2bf(r1); base[i + 32] = f2bf(r2);
        if (qk == 1) { float* ks = out + O_KS + (((size_t)ln * 2048 + 2047) * 4 + h) * 64; ks[i] = r1; ks[i + 32] = r2; }
        out[O_VS + ((size_t)ln * 2048 + 2047) * 256 + tid] = bf2f(PROJ[row * NPROJ + 768 + tid]);
    }
    if (part == 3)
    for (int c = tid; c < 1024; c += NT) {
        const float* sc = p->in[I_SCONV] + (size_t)ln * 3 * 1024;
        const float* cw = p->in[I_CONVW] + (size_t)L * 4 * 1024;
        const float xnew = bf2f(PROJ[row * NPROJ + 1536 + c]);
        const float s0 = sc[c], s1 = sc[1024 + c], s2 = sc[2048 + c];
        const float acc = p->in[I_CONVB][L * 1024 + c] + s0 * cw[c] + s1 * cw[1024 + c] + s2 * cw[2048 + c] + xnew * cw[3072 + c];
        U[row * DM + c] = f2bf(silu(acc));
        float* cs = out + O_CONVS + (size_t)ln * 3 * 1024;
        cs[c] = s1; cs[1024 + c] = s2; cs[2048 + c] = xnew;
    }
    __syncthreads();
}

struct AttnPf { uint4 k[4], v[4]; bf16x8 q[2]; };
__device__ __forceinline__ void attn_decode(int a, int& b, int& h, int& br, int& dsh, int& r, int& n) {
    const int bh = a / 192, rem = a % 192, idx = rem & 63; br = rem >> 6;
    b = bh >> 2; h = bh & 3; dsh = br * 2; const int nb = 64 >> dsh; r = idx / nb; n = idx % nb;
}
__device__ __forceinline__ void attn_load(int a, const bf16_t* PROJ, int tid, AttnPf& pf) {
    int b, h, br, dsh, r, n; attn_decode(a, b, h, br, dsh, r, n);
    const int lane = tid & 63, w = tid >> 6, fr = lane & 15, fq = lane >> 4;
#pragma unroll
    for (int it = 0; it < 4; ++it) {
        const int id = tid + it * NT, rowk = id >> 3, ch = id & 7, lk = (n - 1) * 128 + rowk;
        pf.k[it] = zero4();
        if (lk >= 0) pf.k[it] = *(const uint4*)(PROJ + (size_t)(b * 8192 + (lk << dsh) + r) * NPROJ + 512 + h * 64 + ch * 8);
    }
#pragma unroll
    for (int it = 0; it < 4; ++it) {
        const int id = tid + it * NT, key = id & 255, ch = id >> 8, lk = (n - 1) * 128 + key;
        pf.v[it] = zero4();
        if (lk >= 0) pf.v[it] = *(const uint4*)(PROJ + (size_t)(b * 8192 + (lk << dsh) + r) * NPROJ + 768 + h * 64 + ch * 8);
    }
    const int qi = 16 * w + fr, lq = n * 128 + qi;
    const size_t tq = (size_t)b * 8192 + ((size_t)lq << dsh) + r;
#pragma unroll
    for (int ks = 0; ks < 2; ++ks) pf.q[ks] = *(const bf16x8*)(PROJ + tq * NPROJ + 256 + h * 64 + ks * 32 + fq * 8);
}
__device__ void attn_items(int a0, int astep, const bf16_t* PROJ, bf16_t* OG, float* LSE) {
    SMEM_DECL;
    bf16_t* Ks = (bf16_t*)smem;
    bf16_t* Vt = (bf16_t*)(smem + 272 * 144);
    const int tid = otid(), lane = tid & 63, w = tid >> 6, fr = lane & 15, fq = lane >> 4;
    AttnPf pf;
    if (a0 < 3072) attn_load(a0, PROJ, tid, pf);
#pragma unroll 1
    for (int a = a0; a < 3072; a += astep) {
        int b, h, br, dsh, r, n; attn_decode(a, b, h, br, dsh, r, n);
        LDS_BARRIER();
#pragma unroll
        for (int it = 0; it < 4; ++it) { const int id = tid + it * NT, rowk = id >> 3, ch = id & 7; *(uint4*)(Ks + rowk * 72 + ch * 8) = pf.k[it]; }
        if (tid < 128) { const uint4 z = zero4(); *(uint4*)(Ks + (256 + (tid >> 3)) * 72 + (tid & 7) * 8) = z; }
#pragma unroll
        for (int it = 0; it < 4; ++it) {
            const int id = tid + it * NT, key = id & 255, ch = id >> 8; const uint4 v = pf.v[it];
            bf16_t* d = Vt + (32 * (ch >> 2) + 4 * (ch & 3)) * 280 + key;
            d[0] = (bf16_t)(v.x & 0xffff); d[280] = (bf16_t)(v.x >> 16); d[560] = (bf16_t)(v.y & 0xffff); d[840] = (bf16_t)(v.y >> 16);
            d[16 * 280] = (bf16_t)(v.z & 0xffff); d[17 * 280] = (bf16_t)(v.z >> 16); d[18 * 280] = (bf16_t)(v.w & 0xffff); d[19 * 280] = (bf16_t)(v.w >> 16);
        }
        { const int d = tid >> 3, kk = (tid & 7) * 2; *(unsigned*)(Vt + d * 280 + 256 + kk) = 0u; }
        const bf16x8 qf0 = pf.q[0], qf1 = pf.q[1];
        if (a + astep < 3072) attn_load(a + astep, PROJ, tid, pf);
        LDS_BARRIER();
        const int qi = 16 * w + fr, lq = n * 128 + qi;
        const size_t tq = (size_t)b * 8192 + ((size_t)lq << dsh) + r;
        f32x4 s[10];
#pragma unroll
        for (int t = 0; t < 10; ++t) {
            s[t] = (f32x4){0.f, 0.f, 0.f, 0.f};
            const bf16x8 kf0 = *(const bf16x8*)(Ks + (16 * (w + t) + fr) * 72 + fq * 8);
            const bf16x8 kf1 = *(const bf16x8*)(Ks + (16 * (w + t) + fr) * 72 + 32 + fq * 8);
            s[t] = MFMA16(kf0, qf0, s[t]); s[t] = MFMA16(kf1, qf1, s[t]);
        }
        float mx = -INFINITY;
#pragma unroll
        for (int t = 0; t < 10; ++t)
#pragma unroll
            for (int jj = 0; jj < 4; ++jj) {
                const int key = 16 * (w + t) + fq * 4 + jj, dist = 128 + qi - key;
                const bool valid = (dist >= 0) && (dist <= 128) && (key < 256) && (n > 0 || key >= 128);
                const float sv = valid ? s[t][jj] : -INFINITY;
                s[t][jj] = sv; mx = fmaxf(mx, sv);
            }
        mx = fmaxf(mx, __shfl_xor(mx, 16)); mx = fmaxf(mx, __shfl_xor(mx, 32));
        float lsum = 0.f;
#pragma unroll
        for (int t = 0; t < 10; ++t)
#pragma unroll
            for (int jj = 0; jj < 4; ++jj) { const float pv = __expf(s[t][jj] - mx); s[t][jj] = pv; lsum += pv; }
        lsum += __shfl_xor(lsum, 16); lsum += __shfl_xor(lsum, 32);
        f32x4 o[4];
#pragma unroll
        for (int dt = 0; dt < 4; ++dt) o[dt] = (f32x4){0.f, 0.f, 0.f, 0.f};
#pragma unroll
        for (int kp = 0; kp < 5; ++kp) {
            const int ta = 2 * kp, tb = 2 * kp + 1;
            union { bf16x8 v; unsigned u[4]; } pfr;
            pfr.u[0] = pk2(s[ta][0], s[ta][1]); pfr.u[1] = pk2(s[ta][2], s[ta][3]); pfr.u[2] = pk2(s[tb][0], s[tb][1]); pfr.u[3] = pk2(s[tb][2], s[tb][3]);
#pragma unroll
            for (int dt = 0; dt < 4; ++dt) {
                union { bf16x8 v; uint2 u[2]; } vf;
                vf.u[0] = *(const uint2*)(Vt + (16 * dt + fr) * 280 + 16 * (w + ta) + fq * 4);
                vf.u[1] = *(const uint2*)(Vt + (16 * dt + fr) * 280 + 16 * (w + tb) + fq * 4);
                o[dt] = MFMA16(vf.v, pfr.v, o[dt]);
            }
        }
        const float inv = 1.f / lsum;
#pragma unroll
        for (int a2 = 0; a2 < 2; ++a2) {
            uint4 ov; ov.x = pk2(o[2 * a2][0] * inv, o[2 * a2][1] * inv); ov.y = pk2(o[2 * a2][2] * inv, o[2 * a2][3] * inv);
            ov.z = pk2(o[2 * a2 + 1][0] * inv, o[2 * a2 + 1][1] * inv); ov.w = pk2(o[2 * a2 + 1][2] * inv, o[2 * a2 + 1][3] * inv);
            *(uint4*)(OG + ((size_t)br * MP + tq) * 256 + h * 64 + 32 * a2 + fq * 8) = ov;
        }
        if (fq == 0) LSE[((size_t)br * MP + tq) * 4 + h] = mx + __logf(lsum);
    }
}

__device__ void combine_item(int item, const bf16_t* __restrict__ OG, const float* __restrict__ LSE, bf16_t* __restrict__ CAT) {
    const int tid = otid();
    uint4 a[4], bb[4], c[4]; float l0[4], l1[4], l2[4];
#pragma unroll
    for (int it = 0; it < 4; ++it) {
        const int id = tid + it * NT, tk = id >> 5, ch = id & 31, h = ch >> 3;
        const size_t token = (size_t)item * 64 + tk;
        l0[it] = LSE[token * 4 + h]; l1[it] = LSE[((size_t)MP + token) * 4 + h]; l2[it] = LSE[(2ull * MP + token) * 4 + h];
        a[it] = *(const uint4*)(OG + token * 256 + ch * 8); bb[it] = *(const uint4*)(OG + ((size_t)MP + token) * 256 + ch * 8);
        c[it] = *(const uint4*)(OG + (2ull * MP + token) * 256 + ch * 8);
    }
#pragma unroll
    for (int it = 0; it < 4; ++it) {
        const int id = tid + it * NT, tk = id >> 5, ch = id & 31;
        const size_t token = (size_t)item * 64 + tk;
        const float m = fmaxf(l0[it], fmaxf(l1[it], l2[it]));
        float w0 = __expf(l0[it] - m), w1 = __expf(l1[it] - m), w2 = __expf(l2[it] - m);
        const float inv = 1.f / (w0 + w1 + w2); w0 *= inv; w1 *= inv; w2 *= inv;
        uint4 o;
        o.x = pk2(w0 * lo16(a[it].x) + w1 * lo16(bb[it].x) + w2 * lo16(c[it].x), w0 * hi16(a[it].x) + w1 * hi16(bb[it].x) + w2 * hi16(c[it].x));
        o.y = pk2(w0 * lo16(a[it].y) + w1 * lo16(bb[it].y) + w2 * lo16(c[it].y), w0 * hi16(a[it].y) + w1 * hi16(bb[it].y) + w2 * hi16(c[it].y));
        o.z = pk2(w0 * lo16(a[it].z) + w1 * lo16(bb[it].z) + w2 * lo16(c[it].z), w0 * hi16(a[it].z) + w1 * hi16(bb[it].z) + w2 * hi16(c[it].z));
        o.w = pk2(w0 * lo16(a[it].w) + w1 * lo16(bb[it].w) + w2 * lo16(c[it].w), w0 * hi16(a[it].w) + w1 * hi16(bb[it].w) + w2 * hi16(c[it].w));
        *(uint4*)(CAT + token * DM + 256 + ch * 8) = o;
    }
}

__device__ __forceinline__ void ssd_acs(KP p, int L, int g, int token0, const float* DT, float* acs, float* dts) {
    const int lane = otid() & 63, w = otid() >> 6;
    if (w < 4) {
        const int h = g * 4 + w; const float a = -__expf(p->in[I_ALOG][L * 8 + h]);
        const float d0 = DT[(size_t)(token0 + 2 * lane) * 8 + h], d1 = DT[(size_t)(token0 + 2 * lane + 1) * 8 + h];
        const float v0 = d0 * a, v1 = d1 * a, sum = v0 + v1; float inc = sum;
#pragma unroll
        for (int off = 1; off < 64; off <<= 1) { const float t = __shfl_up(inc, off); if (lane >= off) inc += t; }
        const float exc = inc - sum;
        acs[w * 128 + 2 * lane] = exc + v0; acs[w * 128 + 2 * lane + 1] = exc + v0 + v1;
        dts[w * 128 + 2 * lane] = d0; dts[w * 128 + 2 * lane + 1] = d1;
    }
}

__device__ void s1_item(KP p, int L, int item, const bf16_t* U, const float* DT, float* ST, float* DEC) {
    SMEM_DECL;
    bf16_t* BT = (bf16_t*)smem;
    bf16_t* XWT = (bf16_t*)(smem + 34816);
    float* acs = (float*)(smem + 104448);
    float* dts = (float*)(smem + 106496);
    const int tid = otid(), lane = tid & 63, w = tid >> 6, fr = lane & 15, fq = lane >> 4;
    const int cb = item >> 1, g = item & 1, token0 = cb * 128;
    __syncthreads();
    ssd_acs(p, L, g, token0, DT, acs, dts);
    __syncthreads();
    { const int j = tid >> 7, l = tid & 127; const float wv = __expf(acs[j * 128 + 127] - acs[j * 128 + l]) * dts[j * 128 + l];
      if (tid < 4) DEC[cb * 8 + g * 4 + tid] = __expf(acs[tid * 128 + 127]);
      __syncthreads();
      dts[j * 128 + l] = wv; }
    __syncthreads();
#pragma unroll
    for (int it = 0; it < 4; ++it) {
        const int id = tid + it * NT, l = id & 127, ch = id >> 7;
        const uint4 v = *(const uint4*)(U + (size_t)(token0 + l) * DM + 512 + g * 128 + ch * 8);
        bf16_t* d = BT + (ch * 8) * 136 + l;
        d[0] = (bf16_t)(v.x & 0xffff); d[136] = (bf16_t)(v.x >> 16); d[272] = (bf16_t)(v.y & 0xffff); d[408] = (bf16_t)(v.y >> 16);
        d[544] = (bf16_t)(v.z & 0xffff); d[680] = (bf16_t)(v.z >> 16); d[816] = (bf16_t)(v.w & 0xffff); d[952] = (bf16_t)(v.w >> 16);
    }
#pragma unroll
    for (int it = 0; it < 8; ++it) {
        const int id = tid + it * NT, l = id & 127, ch = id >> 7, j = ch >> 3;
        const uint4 v = *(const uint4*)(U + (size_t)(token0 + l) * DM + g * 256 + ch * 8);
        const float wv = dts[j * 128 + l];
        bf16_t* d = XWT + (ch * 8) * 136 + l;
        d[0] = f2bf(lo16(v.x) * wv); d[136] = f2bf(hi16(v.x) * wv); d[272] = f2bf(lo16(v.y) * wv); d[408] = f2bf(hi16(v.y) * wv);
        d[544] = f2bf(lo16(v.z) * wv); d[680] = f2bf(hi16(v.z) * wv); d[816] = f2bf(lo16(v.w) * wv); d[952] = f2bf(hi16(v.w) * wv);
    }
    __syncthreads();
    f32x4 acc[2][8];
#pragma unroll
    for (int qq = 0; qq < 2; ++qq)
#pragma unroll
        for (int nt = 0; nt < 8; ++nt) acc[qq][nt] = (f32x4){0.f, 0.f, 0.f, 0.f};
#pragma unroll
    for (int ks = 0; ks < 4; ++ks) {
        bf16x8 qf[2];
#pragma unroll
        for (int qq = 0; qq < 2; ++qq) qf[qq] = *(const bf16x8*)(XWT + (16 * (2 * w + qq) + fr) * 136 + ks * 32 + fq * 8);
#pragma unroll
        for (int nt = 0; nt < 8; ++nt) {
            const bf16x8 pf = *(const bf16x8*)(BT + (16 * nt + fr) * 136 + ks * 32 + fq * 8);
#pragma unroll
            for (int qq = 0; qq < 2; ++qq) acc[qq][nt] = MFMA16(pf, qf[qq], acc[qq][nt]);
        }
    }
#pragma unroll
    for (int qq = 0; qq < 2; ++qq) {
        const int rowjp = 16 * (2 * w + qq) + fr, j = rowjp >> 6, pp = rowjp & 63, h = g * 4 + j;
        float* dst = ST + ((size_t)(cb * 8 + h) * 64 + pp) * 128 + fq * 4;
#pragma unroll
        for (int nt = 0; nt < 8; ++nt) { float4 v; v.x = acc[qq][nt][0]; v.y = acc[qq][nt][1]; v.z = acc[qq][nt][2]; v.w = acc[qq][nt][3]; *(float4*)(dst + 16 * nt) = v; }
    }
}

__device__ void scan_phase(KP p, int L, float* ST, const float* DEC) {
    const int tid = otid();
    if (tid < 256) {
        for (int e = blockIdx.x * 256 + tid; e < 65536; e += gridDim.x * 256) {
            const int idx = e * 4, n = idx & 127, pp = (idx >> 7) & 63, h = (idx >> 13) & 7, b = idx >> 16;
            float4 hr = make_float4(0.f, 0.f, 0.f, 0.f);
            float* base = ST + ((size_t)((b * 64) * 8 + h) * 64 + pp) * 128 + n;
            const float* dbase = DEC + (b * 64) * 8 + h;
#pragma unroll 1
            for (int c0 = 0; c0 < 64; c0 += 16) {
                float4 t[16]; float d[16];
#pragma unroll
                for (int j = 0; j < 16; ++j) { t[j] = *(const float4*)(base + (size_t)(c0 + j) * 65536); d[j] = dbase[(c0 + j) * 8]; }
#pragma unroll
                for (int j = 0; j < 16; ++j) { *(float4*)(base + (size_t)(c0 + j) * 65536) = hr;
                    hr.x = d[j] * hr.x + t[j].x; hr.y = d[j] * hr.y + t[j].y; hr.z = d[j] * hr.z + t[j].z; hr.w = d[j] * hr.w + t[j].w; }
            }
            *(float4*)(p->out + O_SSMP + (((size_t)(L * 4 + b) * 8 + h) * 64 + pp) * 128 + n) = hr;
        }
    }
}

__device__ void s3_item(KP p, int L, int item, const bf16_t* U, const bf16_t* PROJ, const float* DT, const float* ST, bf16_t* CAT) {
    SMEM_DECL;
    bf16_t* Cs = (bf16_t*)smem;
    bf16_t* Bs = (bf16_t*)(smem + 34816);
    bf16_t* XT = (bf16_t*)(smem + 69632);
    bf16_t* Hp = (bf16_t*)(smem + 87040);
    float* acs = (float*)(smem + 104448);
    float* dts = (float*)(smem + 106496);
    const int tid = otid(), lane = tid & 63, w = tid >> 6, fr = lane & 15, fq = lane >> 4;
    const int cb = item >> 1, g = item & 1, token0 = cb * 128;
    const int l = 16 * w + fr;
    const size_t token = (size_t)token0 + l;
    uint4 xt[2]; float4 hp[4]; uint4 xv[2], zv[2];
#define S3_LOAD(hh) do { \
        _Pragma("unroll") for (int it = 0; it < 2; ++it) { const int id = tid + it * NT, s_ = id & 127, ch = id >> 7; \
            xt[it] = *(const uint4*)(U + (size_t)(token0 + s_) * DM + (hh) * 64 + ch * 8); } \
        _Pragma("unroll") for (int it = 0; it < 4; ++it) { const int id = tid + it * NT, pp = id >> 5, c4 = id & 31; \
            hp[it] = *(const float4*)(ST + ((size_t)(cb * 8 + (hh)) * 64 + pp) * 128 + c4 * 4); } \
        _Pragma("unroll") for (int a2 = 0; a2 < 2; ++a2) { const int ch = (hh) * 64 + 32 * a2 + fq * 8; \
            xv[a2] = *(const uint4*)(U + token * DM + ch); zv[a2] = *(const uint4*)(PROJ + token * NPROJ + 1024 + ch); } } while (0)
    LDS_BARRIER();
    S3_LOAD(g * 4);
    ssd_acs(p, L, g, token0, DT, acs, dts);
#pragma unroll
    for (int it = 0; it < 4; ++it) {
        const int id = tid + it * NT, ll = id >> 4, ch = id & 15;
        *(uint4*)(Cs + ll * 136 + ch * 8) = *(const uint4*)(U + (size_t)(token0 + ll) * DM + 768 + g * 128 + ch * 8);
        *(uint4*)(Bs + ll * 136 + ch * 8) = *(const uint4*)(U + (size_t)(token0 + ll) * DM + 512 + g * 128 + ch * 8);
    }
    LDS_BARRIER();
    f32x4 cbv[8];
#pragma unroll
    for (int st = 0; st < 8; ++st) cbv[st] = (f32x4){0.f, 0.f, 0.f, 0.f};
#pragma unroll
    for (int ks = 0; ks < 4; ++ks) {
        const bf16x8 qf = *(const bf16x8*)(Cs + (16 * w + fr) * 136 + ks * 32 + fq * 8);
#pragma unroll
        for (int st = 0; st < 8; ++st)
            if (st <= w) { const bf16x8 pf = *(const bf16x8*)(Bs + (16 * st + fr) * 136 + ks * 32 + fq * 8); cbv[st] = MFMA16(pf, qf, cbv[st]); }
    }
    LDS_BARRIER();
    bf16_t* Mb = Bs;
    float ssq = 0.f;
#pragma unroll 1
    for (int j = 0; j < 4; ++j) {
        const int h = g * 4 + j;
#pragma unroll
        for (int it = 0; it < 2; ++it) {
            const int id = tid + it * NT, s_ = id & 127, ch = id >> 7; const uint4 v = xt[it];
            bf16_t* d = XT + (32 * (ch >> 2) + 4 * (ch & 3)) * 136 + s_;
            d[0] = (bf16_t)(v.x & 0xffff); d[136] = (bf16_t)(v.x >> 16); d[272] = (bf16_t)(v.y & 0xffff); d[408] = (bf16_t)(v.y >> 16);
            d[16 * 136] = (bf16_t)(v.z & 0xffff); d[17 * 136] = (bf16_t)(v.z >> 16); d[18 * 136] = (bf16_t)(v.w & 0xffff); d[19 * 136] = (bf16_t)(v.w >> 16);
        }
#pragma unroll
        for (int it = 0; it < 4; ++it) {
            const int id = tid + it * NT, pp = id >> 5, c4 = id & 31; const float4 v = hp[it];
            uint2 o; o.x = pk2(v.x, v.y); o.y = pk2(v.z, v.w);
            *(uint2*)(Hp + (32 * (pp >> 5) + 16 * ((pp >> 2) & 1) + 4 * ((pp >> 3) & 3) + (pp & 3)) * 136 + c4 * 4) = o;
        }
        uint4 xvc[2], zvc[2];
#pragma unroll
        for (int a2 = 0; a2 < 2; ++a2) { xvc[a2] = xv[a2]; zvc[a2] = zv[a2]; }
        if (j < 3) S3_LOAD(h + 1);
        const float al = acs[j * 128 + l];
#pragma unroll
        for (int st = 0; st < 8; ++st)
            if (st <= (w | 1)) {
                float mv[4];
#pragma unroll
                for (int jj = 0; jj < 4; ++jj) { const int s_ = 16 * st + fq * 4 + jj;
                    mv[jj] = (s_ <= l) ? cbv[st][jj] * __expf(al - acs[j * 128 + s_]) * dts[j * 128 + s_] : 0.f; }
                uint2 o; o.x = pk2(mv[0], mv[1]); o.y = pk2(mv[2], mv[3]);
                *(uint2*)(Mb + l * 136 + 16 * st + fq * 4) = o;
            }
        LDS_BARRIER();
        f32x4 yy[4];
#pragma unroll
        for (int pt = 0; pt < 4; ++pt) yy[pt] = (f32x4){0.f, 0.f, 0.f, 0.f};
#pragma unroll
        for (int ks = 0; ks < 4; ++ks) {
            const bf16x8 qf = *(const bf16x8*)(Cs + (16 * w + fr) * 136 + ks * 32 + fq * 8);
#pragma unroll
            for (int pt = 0; pt < 4; ++pt) { const bf16x8 pf = *(const bf16x8*)(Hp + (16 * pt + fr) * 136 + ks * 32 + fq * 8); yy[pt] = MFMA16(pf, qf, yy[pt]); }
        }
        const float ea = __expf(al);
#pragma unroll
        for (int pt = 0; pt < 4; ++pt) yy[pt] = yy[pt] * ea;
#pragma unroll
        for (int ks = 0; ks < 4; ++ks)
            if (2 * ks <= w) {
                const bf16x8 qf = *(const bf16x8*)(Mb + (16 * w + fr) * 136 + ks * 32 + fq * 8);
#pragma unroll
                for (int pt = 0; pt < 4; ++pt) { const bf16x8 pf = *(const bf16x8*)(XT + (16 * pt + fr) * 136 + ks * 32 + fq * 8); yy[pt] = MFMA16(pf, qf, yy[pt]); }
            }
        const float dsk = p->in[I_DSKIP][L * 8 + h];
#pragma unroll
        for (int a2 = 0; a2 < 2; ++a2) {
            const int ch = h * 64 + 32 * a2 + fq * 8;
            const uint4 xq = xvc[a2], zq = zvc[a2];
            const float xs[8] = {lo16(xq.x), hi16(xq.x), lo16(xq.y), hi16(xq.y), lo16(xq.z), hi16(xq.z), lo16(xq.w), hi16(xq.w)};
            const float zs[8] = {lo16(zq.x), hi16(zq.x), lo16(zq.y), hi16(zq.y), lo16(zq.z), hi16(zq.z), lo16(zq.w), hi16(zq.w)};
            float v[8];
#pragma unroll
            for (int e = 0; e < 8; ++e) { v[e] = (yy[2 * a2 + (e >> 2)][e & 3] + dsk * xs[e]) * silu(zs[e]); ssq += v[e] * v[e]; }
            uint4 o; o.x = pk2(v[0], v[1]); o.y = pk2(v[2], v[3]); o.z = pk2(v[4], v[5]); o.w = pk2(v[6], v[7]);
            *(uint4*)(CAT + token * DM + 512 + ch) = o;
        }
        LDS_BARRIER();
    }
#undef S3_LOAD
    asm volatile("s_waitcnt vmcnt(0)" ::: "memory");
    ssq += __shfl_xor(ssq, 16); ssq += __shfl_xor(ssq, 32);
    const float rstd = rsqrtf(ssq * (1.f / 256.f) + EPS);
    {
        uint4 vv[4][2];
#pragma unroll
        for (int j = 0; j < 4; ++j)
#pragma unroll
            for (int a2 = 0; a2 < 2; ++a2) vv[j][a2] = *(const uint4*)(CAT + token * DM + 512 + (g * 4 + j) * 64 + 32 * a2 + fq * 8);
#pragma unroll
        for (int j = 0; j < 4; ++j)
#pragma unroll
            for (int a2 = 0; a2 < 2; ++a2) {
                const int ch = (g * 4 + j) * 64 + 32 * a2 + fq * 8;
                const float4 n0 = *(const float4*)(p->in[I_SSMN] + L * 512 + ch), n1 = *(const float4*)(p->in[I_SSMN] + L * 512 + ch + 4);
                const uint4 v = vv[j][a2];
                uint4 o; o.x = pk2(lo16(v.x) * rstd * n0.x, hi16(v.x) * rstd * n0.y); o.y = pk2(lo16(v.y) * rstd * n0.z, hi16(v.y) * rstd * n0.w);
                o.z = pk2(lo16(v.z) * rstd * n1.x, hi16(v.z) * rstd * n1.y); o.w = pk2(lo16(v.w) * rstd * n1.z, hi16(v.w) * rstd * n1.w);
                *(uint4*)(CAT + token * DM + 512 + ch) = o;
            }
    }
}

__device__ void sample_attn_item(KP p, int L, int item, const bf16_t* PROJ, bf16_t* CAT) {
    SMEM_DECL;
    float* qs = (float*)smem; float* kn = qs + 64; float* vn = kn + 64; float* sc = vn + 64; float* red = sc + 512; float* part = red + 32;
    const int tid = otid(), lane = tid & 63, w = tid >> 6;
    const int n = item >> 2, h = item & 3;
    const size_t row = MP + n; const int ln = L * 32 + n;
    __syncthreads();
    if (tid < 64) { qs[tid] = bf2f(PROJ[row * NPROJ + 256 + h * 64 + tid]); kn[tid] = bf2f(PROJ[row * NPROJ + 512 + h * 64 + tid]); vn[tid] = bf2f(PROJ[row * NPROJ + 768 + h * 64 + tid]); }
    __syncthreads();
    const float* ck = p->in[I_CK] + (size_t)ln * 2048 * 256 + h * 64;
    const float* cv = p->in[I_CV] + (size_t)ln * 2048 * 256 + h * 64;
    float s = -INFINITY;
    if (tid < 387) {
        const int gg = tid / 129, j = tid % 129;
        s = 0.f;
        if (j == 0) { for (int d = 0; d < 64; ++d) s += qs[d] * kn[d]; }
        else { const float* kr = ck + (size_t)(2048 - (j << (2 * gg))) * 256;
#pragma unroll
            for (int d = 0; d < 64; d += 4) { const float4 kv = *(const float4*)(kr + d); s += qs[d] * kv.x + qs[d + 1] * kv.y + qs[d + 2] * kv.z + qs[d + 3] * kv.w; } }
    }
    const float wm = wave_max(s);
    if (lane == 0) red[w] = wm;
    __syncthreads();
    float mx = red[0];
#pragma unroll
    for (int i = 1; i < 8; ++i) mx = fmaxf(mx, red[i]);
    const float pv = (tid < 387) ? __expf(s - mx) : 0.f;
    sc[tid] = pv;
    const float wsum = wave_sum(pv);
    if (lane == 0) red[8 + w] = wsum;
    __syncthreads();
    float tot = 0.f;
#pragma unroll
    for (int i = 0; i < 8; ++i) tot += red[8 + i];
    {
        const int eg = tid >> 4, d4 = (tid & 15) * 4;
        float4 vv[13]; float pp[13];
#pragma unroll
        for (int i = 0; i < 13; ++i) {
            const int e = eg + 32 * i;
            pp[i] = 0.f; vv[i] = make_float4(0.f, 0.f, 0.f, 0.f);
            if (e < 387) { const int gg = e / 129, j = e % 129; pp[i] = sc[e];
                vv[i] = (j == 0) ? *(const float4*)(vn + d4) : *(const float4*)(cv + (size_t)(2048 - (j << (2 * gg))) * 256 + d4); }
        }
        float4 o = make_float4(0.f, 0.f, 0.f, 0.f);
#pragma unroll
        for (int i = 0; i < 13; ++i) { o.x += pp[i] * vv[i].x; o.y += pp[i] * vv[i].y; o.z += pp[i] * vv[i].z; o.w += pp[i] * vv[i].w; }
        *(float4*)(part + eg * 64 + d4) = o;
    }
    __syncthreads();
    if (tid < 64) {
        float o = 0.f;
#pragma unroll
        for (int i = 0; i < 32; ++i) o += part[i * 64 + tid];
        CAT[row * DM + 256 + h * 64 + tid] = f2bf(o / tot);
    }
}

__device__ void sample_ssd_item(KP p, int L, int n, const bf16_t* PROJ, const bf16_t* U, const float* DT, bf16_t* CAT) {
    SMEM_DECL;
    float* us = (float*)smem; float* zs = us + 1024; float* ys = zs + 512; float* red = ys + 512;
    const int tid = otid(), lane = tid & 63, w = tid >> 6;
    const size_t row = MP + n; const int ln = L * 32 + n;
    __syncthreads();
    for (int i = tid; i < 1024; i += NT) us[i] = bf2f(U[row * DM + i]);
    zs[tid] = bf2f(PROJ[row * NPROJ + 1024 + tid]);
    __syncthreads();
    {
        const int h = w, g = h >> 2;
        const float dt = DT[row * 8 + h], a = -__expf(p->in[I_ALOG][L * 8 + h]), dec = __expf(dt * a);
        const float B0 = us[512 + g * 128 + 2 * lane], B1 = us[512 + g * 128 + 2 * lane + 1], C0 = us[768 + g * 128 + 2 * lane], C1 = us[768 + g * 128 + 2 * lane + 1];
        const float* h0 = p->in[I_SSSM] + ((size_t)ln * 8 + h) * 64 * 128;
        float* hs = p->out + O_SSMS + ((size_t)ln * 8 + h) * 64 * 128;
#pragma unroll 1
        for (int r0 = 0; r0 < 64; r0 += 32) {
            float2 hv[32];
#pragma unroll
            for (int i = 0; i < 32; ++i) hv[i] = *(const float2*)(h0 + (r0 + i) * 128 + 2 * lane);
#pragma unroll
            for (int i = 0; i < 32; ++i) {
                const int rr = r0 + i;
                const float x = us[h * 64 + rr];
                float2 hn; hn.x = dec * hv[i].x + dt * x * B0; hn.y = dec * hv[i].y + dt * x * B1;
                *(float2*)(hs + rr * 128 + 2 * lane) = hn;
                const float part = wave_sum(hn.x * C0 + hn.y * C1);
                if (lane == 0) ys[h * 64 + rr] = part;
            }
        }
    }
    __syncthreads();
    {
        const int ch = tid, gch = ch >> 8;
        const float v = (ys[ch] + p->in[I_DSKIP][L * 8 + (ch >> 6)] * us[ch]) * silu(zs[ch]);
        const float part = wave_sum(v * v);
        if (lane == 0) red[w] = part;
        __syncthreads();
        const float tot = red[gch * 4] + red[gch * 4 + 1] + red[gch * 4 + 2] + red[gch * 4 + 3];
        const float rstd = rsqrtf(tot * (1.f / 256.f) + EPS);
        CAT[row * DM + 512 + ch] = f2bf(v * rstd * p->in[I_SSMN][L * 512 + ch]);
    }
}


#define XB_TMO      128
#define XB_XCNT(j)  (256  + 64 * (j))
#define XB_XSUB(j)  (1280 + 64 * (j))
#define XB_XGEN(j)  (2304 + 64 * (j))
#define XB_TOP      3328
#define XB_TOPGEN   3392
#define XCD_BAR_WORDS 3456
#define XB_SPIN_CAP (1u << 18)
__device__ __forceinline__ unsigned xb_ld(unsigned* p)              { return __hip_atomic_load(p, __ATOMIC_RELAXED, __HIP_MEMORY_SCOPE_AGENT); }
__device__ __forceinline__ unsigned xb_add(unsigned* p, unsigned v) { return __hip_atomic_fetch_add(p, v, __ATOMIC_RELAXED, __HIP_MEMORY_SCOPE_AGENT); }
__device__ __forceinline__ unsigned xb_xcc_id() { return (unsigned)__builtin_amdgcn_s_getreg((3 << 11) | 20) & 0xFu; }
#define XB_SPIN(cond, bar) do { unsigned _sp = 0; while (cond) { __builtin_amdgcn_s_sleep(1); \
    if ((++_sp & 255u) == 0u) { if (xb_ld(&(bar)[XB_TMO])) break; if (_sp > XB_SPIN_CAP) { atomicAdd(&(bar)[XB_TMO], 1u); break; } } } } while (0)
struct XcdBarrier { unsigned* bar; unsigned x; volatile LAS unsigned* st; };
__device__ __forceinline__ XcdBarrier xcd_barrier_post(unsigned* bar, volatile LAS unsigned* st) {
    XcdBarrier b; b.bar = bar; b.x = xb_xcc_id(); b.st = st;
    if (__builtin_amdgcn_workitem_id_x() == 0) (void)xb_add(&bar[XB_XCNT(b.x)], 1u);
    return b;
}
__device__ __forceinline__ void xcd_barrier_complete(unsigned* bar, unsigned x, unsigned& nloc, unsigned& nx) {
    const unsigned G = gridDim.x * gridDim.y * gridDim.z;
    unsigned sum, cnt, mine, sp = 0u;
    for (;;) {
        sum = 0u; cnt = 0u; mine = 0u;
#pragma unroll
        for (unsigned j = 0; j < 16; ++j) { const unsigned c = xb_ld(&bar[XB_XCNT(j)]); sum += c; cnt += (c > 0u) ? 1u : 0u; mine = (j == x) ? c : mine; }
        if (sum == G) break;
        __builtin_amdgcn_s_sleep(1);
        if ((++sp & 255u) == 0u) { if (xb_ld(&bar[XB_TMO])) break; if (sp > XB_SPIN_CAP) { atomicAdd(&bar[XB_TMO], 1u); break; } }
    }
    nloc = mine > 0u ? mine : 1u; nx = cnt > 0u ? cnt : 1u;
}
__device__ __forceinline__ void xcd_barrier(const XcdBarrier& b) {
    asm volatile("s_waitcnt vmcnt(0)" ::: "memory");
    __syncthreads();
    if (__builtin_amdgcn_workitem_id_x() == 0) {
        unsigned* bar = b.bar;
        __builtin_amdgcn_s_waitcnt(0);
        unsigned nloc = b.st[0], nx = b.st[1];
        if (nloc == 0u) { xcd_barrier_complete(bar, b.x, nloc, nx); b.st[0] = nloc; b.st[1] = nx; }
        const unsigned old = xb_add(&bar[XB_XSUB(b.x)], 1u);
        const unsigned gen = old / nloc;
        if (old + 1u == (gen + 1u) * nloc) {
            __builtin_amdgcn_fence(__ATOMIC_RELEASE, "agent");
            asm volatile("s_waitcnt vmcnt(0)" ::: "memory");
            const unsigned og = xb_add(&bar[XB_TOP], 1u);
            const unsigned tg = og / nx;
            if (og + 1u == (tg + 1u) * nx) xb_add(&bar[XB_TOPGEN], 1u);
            else XB_SPIN(xb_ld(&bar[XB_TOPGEN]) == tg, bar);
            __builtin_amdgcn_fence(__ATOMIC_ACQUIRE, "agent");
            xb_add(&bar[XB_XGEN(b.x)], 1u);
            asm volatile("s_waitcnt vmcnt(0)" ::: "memory");
        } else {
            XB_SPIN(xb_ld(&bar[XB_XGEN(b.x)]) == gen, bar);
            __builtin_amdgcn_fence(__ATOMIC_ACQUIRE, "agent");
            asm volatile("s_waitcnt vmcnt(0)" ::: "memory");
        }
    }
    __syncthreads();
}

#ifndef PHMASK
#define PHMASK 0xFFFFF
#endif
constexpr int PH_PER_LAYER = 10, NPHASE = 1 + 2 * PH_PER_LAYER + 1;

__global__ void __launch_bounds__(NT, 2) mega(Params pv, int ph_lo, int ph_hi) {
    cg::grid_group grid = cg::this_grid();
    XcdBarrier xb;
    {
        SMEM_DECL;
        volatile LAS unsigned* st = (volatile LAS unsigned*)((LAS unsigned char*)smem + 131072);
        if (__builtin_amdgcn_workitem_id_x() < 4) st[__builtin_amdgcn_workitem_id_x()] = 0u;
        __syncthreads();
        xb = xcd_barrier_post((unsigned*)(pv.ws + WS_BAR), st);
    }
    for (int ph = ph_lo; ph < ph_hi; ++ph) {
        if (ph == ph_lo + 1) grid.sync();
        else if (ph > ph_lo) xcd_barrier(xb);
        KP p = opaque_kp();
        unsigned char* ws = p->ws;
        bf16_t* XB = (bf16_t*)(ws + WS_XB); bf16_t* Ub = (bf16_t*)p->out;
        bf16_t* HB = (bf16_t*)(ws + WS_HB); bf16_t* PROJ = HB;
        bf16_t* CAT = (bf16_t*)(ws + WS_CAT);
        bf16_t* OG = (bf16_t*)(ws + WS_OG);
        float* LSE = (float*)(ws + WS_LSE);
        float* ST = (float*)(ws + WS_ST);
        float* DEC = (float*)(ws + WS_DEC);
        float* DT = (float*)(ws + WS_DT);
        float* X = p->out;
        float* PART = (float*)(ws + WS_PART);
        if (ph == 0) {
            weights_phase(p);
            cache_copy_phase(p);
            copy_phase(p, XB, PART);
            continue;
        }
        if (ph == NPHASE - 1) { final_phase(p, XB, X); continue; }
        const int L = (ph - 1) / PH_PER_LAYER, q = (ph - 1) % PH_PER_LAYER;
        unsigned char* wb = ws + (size_t)L * LAYER_W;
        const bf16_t* XBs = XB + (size_t)MP * DM; const bf16_t* Xs = XBs;
#ifndef REPMASK
#define REPMASK 0
#endif
        for (int rep = 0; rep < 1 + ((REPMASK >> q) & 1); ++rep)
        switch (q) {
        case 0: case 8: { EpiGU e{HB, PART}; const bf16_t* W = (const bf16_t*)(wb + (q == 0 ? OFF_WGU1 : OFF_WGU2)); gemm_phase_cont(XB, W, 1024, MP / 256, 22, e);
            for (int t = blockIdx.x; t < 176; t += gridDim.x) { const int c0 = t * 16, r0 = (c0 >> 7) * 256 + (c0 & 127); FinGU f{HB, c0}; skinny_task<2, true, 4>(XBs, DM, W, 1024, r0, r0 + 128, Xs, f); } } break;
        case 1: case 9: { EpiRes e{XB, PART, 0.5f}; const bf16_t* W = (const bf16_t*)(wb + (q == 1 ? OFF_WD1 : OFF_WD2)); gemm_phase_cont(HB, W, 2816, MP / 256, 4, e);
            for (int t = blockIdx.x; t < 64; t += gridDim.x) { FinRes f{XB, 0.5f, t * 16}; skinny_task<1, false, 11>(HB + (size_t)MP * DFF, DFF, W, 2816, t * 16, 0, nullptr, f); } } break;
        case 2: { EpiProj e{PROJ, NPROJ, PART}; const bf16_t* W = (const bf16_t*)(wb + OFF_WIN); gemm_phase_cont(XB, W, 1024, MP / 256, 10, e);
            for (int t = blockIdx.x; t < 160; t += gridDim.x) { FinProj f{PROJ, t * 16}; skinny_task<1, true, 4>(XBs, DM, W, 1024, t * 16, 0, Xs, f); } } break;
        case 3:
            prep_phase(p, L, PROJ, Ub, CAT, XB, PART, DT);
            for (int it = blockIdx.x; it < 4 * MS; it += gridDim.x) prep_sample_item(p, L, it, PROJ, Ub, CAT, XB, DT);
            break;
        case 4:
            {
                int it = blockIdx.x;
                for (; it < 160 + 512; it += gridDim.x) {
                    if (it < 128) sample_attn_item(p, L, it, PROJ, CAT);
                    else if (it < 160) sample_ssd_item(p, L, it - 128, PROJ, Ub, DT, CAT);
                    else s1_item(p, L, it - 160, Ub, DT, ST, DEC);
                }
                attn_items(it - 160 - 512, gridDim.x, PROJ, OG, LSE);
            }
            break;
        case 5: scan_phase(p, L, ST, DEC); break;
        case 6:
            for (int it = blockIdx.x; it < 1024; it += gridDim.x) {
                if (it < 512) s3_item(p, L, it, Ub, PROJ, DT, ST, CAT);
                else combine_item(it - 512, OG, LSE, CAT);
            }
            break;
        case 7: { EpiRes e{XB, PART, 1.0f}; const bf16_t* W = (const bf16_t*)(wb + OFF_WOUT); gemm_phase_cont(CAT, W, 1024, MP / 256, 4, e);
            for (int t = blockIdx.x; t < 64; t += gridDim.x) { FinRes f{XB, 1.0f, t * 16}; skinny_task<1, false, 4>(CAT + (size_t)MP * DM, DM, W, 1024, t * 16, 0, nullptr, f); } } break;
        }
    }
}

constexpr int LDS_BYTES = 131072 + 64 + 4096 + 2048;

extern "C" void kernel_launch(void* const* d_in, const int* in_sizes, int n_in, void* d_out, int out_size, void* d_ws, size_t ws_size, hipStream_t stream) {
    static int grid = 0;
    if (grid == 0) {
        if (n_in != 27 || (size_t)out_size != O_END || ws_size < WS_END) {
            fprintf(stderr, "kernel_launch: unexpected shapes n_in %d out %d ws %zu (need %zu)\n", n_in, out_size, ws_size, (size_t)WS_END); grid = -1; return; }
        int dev = 0, cus = 0, per_cu = 0;
        hipGetDevice(&dev);
        hipDeviceGetAttribute(&cus, hipDeviceAttributeMultiprocessorCount, dev);
        if (hipFuncSetAttribute((const void*)mega, hipFuncAttributeMaxDynamicSharedMemorySize, LDS_BYTES) != hipSuccess) { fprintf(stderr, "hipFuncSetAttribute failed\n"); grid = -1; return; }
        hipOccupancyMaxActiveBlocksPerMultiprocessor(&per_cu, (const void*)mega, NT, LDS_BYTES);
        if (per_cu < 1) { fprintf(stderr, "occupancy query says %d blocks/CU\n", per_cu); per_cu = 1; }
        (void)hipGetLastError();
        grid = cus;
    }
    if (grid < 0) return;
    if (hipMemsetAsync((char*)d_ws + WS_BAR, 0, 16384, stream) != hipSuccess) { fprintf(stderr, "memset failed\n"); return; }
    Params p{};
    for (int i = 0; i < 27; ++i) p.in[i] = (const float*)d_in[i];
    p.out = (float*)d_out; p.ws = (unsigned char*)d_ws;
    int lo = 0, hi = NPHASE;
    void* args[] = {&p, &lo, &hi};
    hipError_t e = hipLaunchCooperativeKernel((const void*)mega, dim3(grid), dim3(NT), args, LDS_BYTES, stream);
    if (e != hipSuccess) fprintf(stderr, "cooperative launch failed: %s (grid %d)\n", hipGetErrorString(e), grid);
}
```

```cpp
#include <hip/hip_runtime.h>
#include <hip/hip_cooperative_groups.h>
#include <cstdio>
#include <cstdint>
namespace cg = cooperative_groups;

typedef unsigned short bf16_t;
typedef short bf16x8 __attribute__((ext_vector_type(8)));
typedef float f32x4 __attribute__((ext_vector_type(4)));

#define NT 512
constexpr int MP = 32768;
constexpr int MS = 32;
constexpr int MTOK = MP + MS;
constexpr int MPAD = 33024;
constexpr int DM = 1024, DFF = 2816, NPROJ = 2560, WINLD = 2568;
constexpr float EPS = 1e-6f;

constexpr size_t SZ_WGU = 5632ull * 1024 * 2, SZ_WD = 1024ull * 2816 * 2, SZ_WIN = 2560ull * 1024 * 2, SZ_WOUT = 1024ull * 1024 * 2;
constexpr size_t OFF_WGU1 = 0, OFF_WD1 = OFF_WGU1 + SZ_WGU, OFF_WIN = OFF_WD1 + SZ_WD, OFF_WOUT = OFF_WIN + SZ_WIN,
                 OFF_WGU2 = OFF_WOUT + SZ_WOUT, OFF_WD2 = OFF_WGU2 + SZ_WGU, LAYER_W = OFF_WD2 + SZ_WD;
constexpr size_t WS_XB = 2 * LAYER_W;
constexpr size_t WS_HB = WS_XB + (size_t)MPAD * 1024 * 2;
constexpr size_t WS_CAT = WS_HB + (size_t)MPAD * 2816 * 2;
constexpr size_t WS_OG = WS_CAT + (size_t)MPAD * 1024 * 2;
constexpr size_t WS_LSE = WS_OG + 3ull * MP * 256 * 2;
constexpr size_t WS_ST = WS_LSE + 3ull * MP * 4 * 4;
constexpr size_t WS_DEC = WS_ST + 256ull * 8 * 64 * 128 * 4;
constexpr size_t WS_DT = WS_DEC + 256 * 8 * 4;
constexpr size_t WS_PART = WS_DT + (size_t)MPAD * 8 * 4;
constexpr size_t WS_WDT = WS_PART + (size_t)MP * 16 * 4;
constexpr size_t WS_BAR = WS_WDT + 2 * 16 * 1024 * 2;
constexpr size_t WS_END = WS_BAR + 16384;

constexpr size_t O_Y = 0, O_POOLP = 33587200ull, O_POOLS = 33617920ull, O_KP = 33863680ull, O_KS = 38057984ull, O_VP = 71612416ull,
                 O_VS = 75806720ull, O_CONVP = 109361152ull, O_CONVS = 109385728ull, O_SSMP = 109582336ull, O_SSMS = 110106624ull,
                 O_END = 114300928ull;

struct Params { const float* in[27]; float* out; unsigned char* ws; };
enum { I_XP = 0, I_XS, I_CPOOL, I_CK, I_CV, I_SCONV, I_SSSM, I_F1N, I_F1G, I_F1U, I_F1D, I_MIXN, I_WIN, I_POOLW, I_POOLSC, I_CONVW, I_CONVB,
       I_DTB, I_ALOG, I_DSKIP, I_SSMN, I_WOUT, I_F2N, I_F2G, I_F2U, I_F2D, I_FINN };

typedef const __attribute__((address_space(4))) Params* KP;
__device__ __forceinline__ int otid() { int t = __builtin_amdgcn_workitem_id_x(); asm volatile("" : "+v"(t)); return t; }
__device__ __forceinline__ KP opaque_kp() { KP k = (KP)__builtin_amdgcn_kernarg_segment_ptr(); asm volatile("" : "+s"(k)); return k; }
__device__ __forceinline__ float bf2f(bf16_t v) { return __uint_as_float(((unsigned)v) << 16); }
__device__ __forceinline__ unsigned pk2(float lo, float hi) { unsigned r; asm("v_cvt_pk_bf16_f32 %0, %1, %2" : "=v"(r) : "v"(lo), "v"(hi)); return r; }
__device__ __forceinline__ bf16_t f2bf(float f) { return (bf16_t)(pk2(f, 0.f) & 0xffffu); }
__device__ __forceinline__ float lo16(unsigned u) { return __uint_as_float(u << 16); }
__device__ __forceinline__ float hi16(unsigned u) { return __uint_as_float(u & 0xffff0000u); }
__device__ __forceinline__ float silu(float x) { return x * __builtin_amdgcn_rcpf(1.f + __expf(-x)); }
__device__ __forceinline__ float wave_sum(float v) {
#pragma unroll
    for (int o = 32; o > 0; o >>= 1) v += __shfl_xor(v, o);
    return v;
}
__device__ __forceinline__ float wave_max(float v) {
#pragma unroll
    for (int o = 32; o > 0; o >>= 1) v = fmaxf(v, __shfl_xor(v, o));
    return v;
}
__device__ const float ROPE_INV[32] = {1.000000000e+00f, 7.498942018e-01f, 5.623413324e-01f, 4.216965139e-01f, 3.162277639e-01f, 2.371373773e-01f, 1.778279394e-01f, 1.333521456e-01f, 1.000000015e-01f, 7.498942316e-02f, 5.623413250e-02f, 4.216964915e-02f, 3.162277490e-02f, 2.371373773e-02f, 1.778279431e-02f, 1.333521400e-02f, 9.999999776e-03f, 7.498942316e-03f, 5.623413250e-03f, 4.216964822e-03f, 3.162277630e-03f, 2.371373819e-03f, 1.778279431e-03f, 1.333521446e-03f, 1.000000047e-03f, 7.498941850e-04f, 5.623413017e-04f, 4.216965172e-04f, 3.162277571e-04f, 2.371373703e-04f, 1.778279402e-04f, 1.333521504e-04f};
__device__ __forceinline__ float rope_inv(int i) { return ROPE_INV[i]; }
__device__ __forceinline__ void rope_cs(float ang, float& c, float& s) {
    const float k = rintf(ang * 0.15915494309189535f);
    float r = fmaf(-k, 6.28318548202514648f, ang); r = fmaf(-k, -1.74845553146951715e-07f, r);
    const float f = r * 0.15915494309189535f;
    s = __builtin_amdgcn_sinf(f); c = __builtin_amdgcn_cosf(f);
}
__device__ __forceinline__ uint4 zero4() { unsigned z; asm volatile("v_mov_b32 %0, 0" : "=v"(z)); uint4 r; r.x = z; r.y = z; r.z = z; r.w = z; return r; }
#define MFMA16(a, b, c) __builtin_amdgcn_mfma_f32_16x16x32_bf16((a), (b), (c), 0, 0, 0)
#define LDS_BARRIER() do { asm volatile("s_waitcnt lgkmcnt(0)" ::: "memory"); __builtin_amdgcn_s_barrier(); asm volatile("" ::: "memory"); } while (0)
#define SMEM_DECL extern __shared__ __attribute__((aligned(16))) unsigned char smem[]

constexpr int BM = 256, BK = 64, HALF = 128, HT = HALF * BK;
__device__ __forceinline__ int lds_byte(int r, int c) { int st = (r >> 4) * 2 + (c >> 5), rr = r & 15, cc = c & 31, ob = rr * 64 + cc * 2; return st * 1024 + (ob ^ (((ob >> 9) & 1) << 5)); }
__device__ __forceinline__ void stage_rc(int b, int& R, int& C) { int st = b / 1024, sb = b % 1024, swz = sb ^ (((sb >> 9) & 1) << 5); R = (st >> 1) * 16 + swz / 64; C = (st & 1) * 32 + (swz % 64) / 2; }

__device__ __forceinline__ void tile_of(int L, int nM, int nN, int& pm, int& pn) {
    const int nwg = nM * nN; int wgid = L;
    { const int q = nwg / 8, r = nwg % 8, xcd = wgid % 8, off = wgid / 8; wgid = (xcd < r ? xcd * (q + 1) : r * (q + 1) + (xcd - r) * q) + off; }
    const int nig = 8 * nN, gid = wgid / nig, fm = gid * 8, gsz = (nM - fm) < 8 ? (nM - fm) : 8;
    pm = fm + ((wgid % nig) % gsz); pn = (wgid % nig) / gsz;
}

#define LAS __attribute__((address_space(3)))
constexpr int HTB = HALF * BK * 2;
__device__ __forceinline__ float row_rstd(const float* PART, int row) {
    const float4* pp = (const float4*)(PART + (size_t)row * 16);
    const float4 a = pp[0], b = pp[1], c = pp[2], d = pp[3];
    const float ss = ((a.x + a.y) + (a.z + a.w)) + ((b.x + b.y) + (b.z + b.w)) + ((c.x + c.y) + (c.z + c.w)) + ((d.x + d.y) + (d.z + d.w));
    return rsqrtf(ss * (1.f / 1024.f) + EPS);
}
template <class Epi>
__device__ __forceinline__ void gemm_phase(const bf16_t* A, const bf16_t* Bt, const int K, const int nM, const int nN, const Epi& epi) {
    SMEM_DECL;
    LAS unsigned char* lds = (LAS unsigned char*)smem;
    const int tid = otid(), wid = __builtin_amdgcn_readfirstlane(tid >> 6), lane = tid & 63, wr = wid >> 2, wc = wid & 3, fr = lane & 15, fq = lane >> 4;
    const int nt = K / BK, ntiles = nM * nN;
    unsigned voff[2];
#pragma unroll
    for (int i = 0; i < 2; ++i) { int R, C; stage_rc(tid * 16 + i * 8192, R, C); voff[i] = (unsigned)(R * K + C) * 2u; }
    const size_t kstep = (size_t)(BK * 2), hstep = (size_t)HALF * K * 2;
    const unsigned ldsw = (unsigned)wid * 1024u;
    const int aoff = lds_byte(wr * 64 + fr, fq * 8), boff = lds_byte(wc * 32 + fr, fq * 8);
#define GSA(b, h) (((b) * 2 + (h)) * HTB)
#define GSB(b, h) ((4 + (b) * 2 + (h)) * HTB)
#define STAGE(bufoff, gbase) do { _Pragma("unroll") for (int _i = 0; _i < 2; ++_i) \
    __builtin_amdgcn_global_load_lds((const unsigned*)((const char*)(gbase) + voff[_i]), (LAS unsigned*)(lds + (bufoff) + ldsw + _i * 8192), 16, 0, 0); } while (0)
#define LDA(dst, b, h) do { _Pragma("unroll") for (int m = 0; m < 4; ++m) _Pragma("unroll") for (int k = 0; k < 2; ++k) dst[m][k] = *(const LAS bf16x8*)(lds + GSA(b, h) + aoff + m * 2048 + k * 1024); } while (0)
#define LDB(dst, b, h) do { _Pragma("unroll") for (int n = 0; n < 2; ++n) _Pragma("unroll") for (int k = 0; k < 2; ++k) dst[n][k] = *(const LAS bf16x8*)(lds + GSB(b, h) + boff + n * 2048 + k * 1024); } while (0)
#define MMA(ai, bj, At_, Bt_) do { __builtin_amdgcn_s_setprio(1); _Pragma("unroll") for (int m = 0; m < 4; ++m) _Pragma("unroll") for (int n = 0; n < 2; ++n) _Pragma("unroll") for (int k = 0; k < 2; ++k) \
      acc[ai][bj][m][n] = __builtin_amdgcn_mfma_f32_16x16x32_bf16(Bt_[n][k], At_[m][k], acc[ai][bj][m][n], 0, 0, 0); \
    __builtin_amdgcn_s_setprio(0); } while (0)
#define WAIT_V(n) asm volatile("s_waitcnt vmcnt(" #n ")" ::: "memory")
#define WAIT_L(n) asm volatile("s_waitcnt lgkmcnt(" #n ")" ::: "memory")
#define BAR __builtin_amdgcn_s_barrier()
#define SCHED __builtin_amdgcn_sched_barrier(0)
    int L = blockIdx.x;
    WAIT_V(0); __syncthreads();
    if (L >= ntiles) return;
    int pm, pn; tile_of(L, nM, nN, pm, pn);
    const char* cA = (const char*)A + (size_t)(pm * 256) * K * 2;
    const char* cB = (const char*)Bt + (size_t)(pn * 256) * K * 2;
    STAGE(GSB(0, 0), cB); STAGE(GSA(0, 0), cA); STAGE(GSB(0, 1), cB + hstep); STAGE(GSA(0, 1), cA + hstep);
    float* rsb = (float*)(smem + 131072 + 64 + 4096);
    int rbuf = 0;
    if (Epi::NEEDS_RS && tid < 256) rsb[tid] = row_rstd(epi.PART, pm * 256 + tid);
    bool first = true;
    for (;;) {
        f32x4 acc[2][2][4][2];
#pragma unroll
        for (int a = 0; a < 2; ++a)
#pragma unroll
            for (int b = 0; b < 2; ++b)
#pragma unroll
                for (int m = 0; m < 4; ++m)
#pragma unroll
                    for (int n = 0; n < 2; ++n) acc[a][b][m][n] = (f32x4){0.f, 0.f, 0.f, 0.f};
        bf16x8 At[4][2], B0[2][2], B1[2][2];
        if (wr == 1) BAR;
        if (first) { WAIT_V(4); } else { asm volatile("s_waitcnt vmcnt(%0)" :: "n"(Epi::NST) : "memory"); }
        BAR;
        STAGE(GSB(1, 0), cB + kstep); STAGE(GSA(1, 0), cA + kstep); STAGE(GSB(1, 1), cB + hstep + kstep);
        WAIT_V(6); BAR;
        for (int t = 0; t < nt - 2; t += 2) {
            const char* a1 = cA + (size_t)(t + 1) * kstep; const char* a2 = a1 + kstep; const char* a3 = a2 + kstep;
            const char* b2 = cB + (size_t)(t + 2) * kstep; const char* b3 = b2 + kstep;
            LDB(B0, 0, 0); SCHED; LDA(At, 0, 0); STAGE(GSA(1, 1), a1 + hstep);
            WAIT_L(8); BAR; WAIT_L(0); MMA(0, 0, At, B0); BAR; SCHED;
            LDB(B1, 0, 1); STAGE(GSB(0, 0), b2);
            BAR; WAIT_L(0); MMA(0, 1, At, B1); BAR;
            LDA(At, 0, 1); STAGE(GSA(0, 0), a2);
            BAR; WAIT_L(0); MMA(1, 0, At, B0); BAR; SCHED;
            STAGE(GSB(0, 1), b2 + hstep);
            WAIT_V(6); BAR; MMA(1, 1, At, B1); BAR;
            LDB(B0, 1, 0); SCHED; LDA(At, 1, 0); STAGE(GSA(0, 1), a2 + hstep);
            WAIT_L(8); BAR; WAIT_L(0); MMA(0, 0, At, B0); BAR; SCHED;
            LDB(B1, 1, 1); STAGE(GSB(1, 0), b3);
            BAR; WAIT_L(0); MMA(0, 1, At, B1); BAR;
            LDA(At, 1, 1); STAGE(GSA(1, 0), a3);
            BAR; WAIT_L(0); MMA(1, 0, At, B0); BAR; SCHED;
            STAGE(GSB(1, 1), b3 + hstep);
            WAIT_V(6); BAR; MMA(1, 1, At, B1); BAR;
        }
        { LDB(B0, 0, 0); LDA(At, 0, 0); STAGE(GSA(1, 1), cA + (size_t)(nt - 1) * kstep + hstep);
          BAR; WAIT_L(0); MMA(0, 0, At, B0); BAR;
          LDB(B1, 0, 1); BAR; WAIT_L(0); MMA(0, 1, At, B1); BAR;
          LDA(At, 0, 1); WAIT_V(4); BAR; WAIT_L(0); MMA(1, 0, At, B0); MMA(1, 1, At, B1); BAR; }
        { LDB(B0, 1, 0); LDA(At, 1, 0); WAIT_V(2); BAR; WAIT_L(0); MMA(0, 0, At, B0); BAR;
          LDB(B1, 1, 1); WAIT_V(0); BAR; WAIT_L(0); MMA(0, 1, At, B1); BAR;
          LDA(At, 1, 1); BAR; WAIT_L(0); MMA(1, 0, At, B0); MMA(1, 1, At, B1); BAR; }
        if (wr == 0) BAR;
        const int brow = pm * 256, bcol = pn * 256;
        L += gridDim.x;
        const bool more = L < ntiles;
        if (more) {
            tile_of(L, nM, nN, pm, pn);
            cA = (const char*)A + (size_t)(pm * 256) * K * 2; cB = (const char*)Bt + (size_t)(pn * 256) * K * 2;
            STAGE(GSB(0, 0), cB); STAGE(GSA(0, 0), cA); STAGE(GSB(0, 1), cB + hstep); STAGE(GSA(0, 1), cA + hstep);
            SCHED;
        }
        float rs_next = 0.f;
        if (Epi::NEEDS_RS && more && tid < 256) rs_next = row_rstd(epi.PART, pm * 256 + tid);
        epi(acc, brow, bcol, wr, wc, fr, fq, rsb + rbuf * 256);
        SCHED;
        if (!more) break;
        if (Epi::NEEDS_RS && tid < 256) rsb[(rbuf ^ 1) * 256 + tid] = rs_next;
        rbuf ^= 1;
        first = false;
    }
    asm volatile("s_waitcnt vmcnt(0)" ::: "memory");
    __syncthreads();
}

template <class Epi>
__device__ __forceinline__ void gemm_phase_cont(const bf16_t* A, const bf16_t* Bt, const int K, const int nM, const int nN, const Epi& epi) {
    SMEM_DECL;
    LAS unsigned char* lds = (LAS unsigned char*)smem;
    const int tid = otid(), wid = __builtin_amdgcn_readfirstlane(tid >> 6), lane = tid & 63, wr = wid >> 2, wc = wid & 3, fr = lane & 15, fq = lane >> 4;
    const int nt = K / BK, ntiles = nM * nN;
    unsigned voff[2];
#pragma unroll
    for (int i = 0; i < 2; ++i) { int R, C; stage_rc(tid * 16 + i * 8192, R, C); voff[i] = (unsigned)(R * K + C) * 2u; }
    const size_t kstep = (size_t)(BK * 2), hstep = (size_t)HALF * K * 2;
    const unsigned ldsw = (unsigned)wid * 1024u;
    const int aoff = lds_byte(wr * 64 + fr, fq * 8), boff = lds_byte(wc * 32 + fr, fq * 8);
    int L = blockIdx.x;
    WAIT_V(0); __syncthreads();
    if (L >= ntiles) return;
    int pm, pn; tile_of(L, nM, nN, pm, pn);
    const char* cA = (const char*)A + (size_t)(pm * 256) * K * 2;
    const char* cB = (const char*)Bt + (size_t)(pn * 256) * K * 2;
    f32x4 acc[2][2][4][2];
#pragma unroll
    for (int a = 0; a < 2; ++a)
#pragma unroll
        for (int b = 0; b < 2; ++b)
#pragma unroll
            for (int m = 0; m < 4; ++m)
#pragma unroll
                for (int n = 0; n < 2; ++n) acc[a][b][m][n] = (f32x4){0.f, 0.f, 0.f, 0.f};
    bf16x8 At[4][2], B0[2][2], B1[2][2];
    float* rsb = (float*)(smem + 131072 + 64 + 4096);
    int rbuf = 0;
    float rs0 = 0.f;
    if (Epi::NEEDS_RS && tid < 256) rs0 = row_rstd(epi.PART, pm * 256 + tid);
    STAGE(GSB(0, 0), cB); STAGE(GSB(0, 1), cB + hstep); STAGE(GSA(0, 0), cA); STAGE(GSA(0, 1), cA + hstep);
    if (wr == 1) BAR;
    WAIT_V(2); BAR;
    STAGE(GSB(1, 0), cB + kstep); STAGE(GSA(1, 0), cA + kstep); STAGE(GSB(1, 1), cB + hstep + kstep);
    WAIT_V(6); BAR;
    if (Epi::NEEDS_RS && tid < 256) rsb[tid] = rs0;
    for (;;) {
        const int Ln = L + gridDim.x; const bool has_next = Ln < ntiles;
        int npm = pm, npn = pn; if (has_next) tile_of(Ln, nM, nN, npm, npn);
        const char* nA = (const char*)A + (size_t)(npm * 256) * K * 2; const char* nB = (const char*)Bt + (size_t)(npn * 256) * K * 2;
        for (int t = 0; t < nt; t += 2) {
            const bool last = (t == nt - 2);
            const char* a1 = cA + (size_t)(t + 1) * kstep;
            const char* a2 = last ? nA : cA + (size_t)(t + 2) * kstep; const char* b2 = last ? nB : cB + (size_t)(t + 2) * kstep;
            const char* a3 = a2 + kstep; const char* b3 = b2 + kstep;
            LDB(B0, 0, 0); LDB(B1, 0, 1); SCHED; LDA(At, 0, 0); STAGE(GSA(1, 1), a1 + hstep);
            WAIT_V(8); WAIT_L(0); BAR; MMA(0, 0, At, B0); MMA(0, 1, At, B1); BAR; SCHED;
            LDA(At, 0, 1); STAGE(GSB(0, 0), b2); STAGE(GSB(0, 1), b2 + hstep); STAGE(GSA(0, 0), a2);
            WAIT_V(8); WAIT_L(0); BAR; MMA(1, 0, At, B0); MMA(1, 1, At, B1); BAR; SCHED;
            LDB(B0, 1, 0); LDB(B1, 1, 1); SCHED; LDA(At, 1, 0); STAGE(GSA(0, 1), a2 + hstep);
            WAIT_V(8); WAIT_L(0); BAR; MMA(0, 0, At, B0); MMA(0, 1, At, B1); BAR; SCHED;
            LDA(At, 1, 1); STAGE(GSB(1, 0), b3); STAGE(GSB(1, 1), b3 + hstep); STAGE(GSA(1, 0), a3);
            WAIT_V(8); WAIT_L(0); BAR; MMA(1, 0, At, B0); MMA(1, 1, At, B1); BAR; SCHED;
        }
        if (wr == 0) BAR;
        float rs_next = 0.f;
        if (Epi::NEEDS_RS && has_next && tid < 256) rs_next = row_rstd(epi.PART, npm * 256 + tid);
        epi(acc, pm * 256, pn * 256, wr, wc, fr, fq, rsb + rbuf * 256);
        SCHED;
        if (!has_next) break;
        if (Epi::NEEDS_RS && tid < 256) rsb[(rbuf ^ 1) * 256 + tid] = rs_next;
        rbuf ^= 1;
#pragma unroll
        for (int a = 0; a < 2; ++a)
#pragma unroll
            for (int b = 0; b < 2; ++b)
#pragma unroll
                for (int m = 0; m < 4; ++m)
#pragma unroll
                    for (int n = 0; n < 2; ++n) acc[a][b][m][n] = (f32x4){0.f, 0.f, 0.f, 0.f};
        L = Ln; pm = npm; pn = npn; cA = nA; cB = nB;
        if (wr == 1) BAR;
    }
    WAIT_V(0);
    BAR;
    __syncthreads();
}

struct EpiGU {
    static constexpr int NST = 16; static constexpr bool NEEDS_RS = true;
    bf16_t* __restrict__ H; const float* __restrict__ PART;
    __device__ __forceinline__ void operator()(const f32x4 (&acc)[2][2][4][2], int brow, int bcol, int wr, int wc, int fr, int fq, const float* rsl) const {
        const int cbase = (bcol >> 8) * 128 + wc * 32 + fq * 8;
        float rs[2][4];
#pragma unroll
        for (int ai = 0; ai < 2; ++ai)
#pragma unroll
            for (int m = 0; m < 4; ++m) rs[ai][m] = rsl[ai * 128 + wr * 64 + m * 16 + fr];
#pragma unroll
        for (int ai = 0; ai < 2; ++ai)
#pragma unroll
            for (int m = 0; m < 4; ++m) {
                const int row = brow + ai * 128 + wr * 64 + m * 16 + fr;
                const f32x4 g0 = acc[ai][0][m][0] * rs[ai][m], u0 = acc[ai][1][m][0] * rs[ai][m], g1 = acc[ai][0][m][1] * rs[ai][m], u1 = acc[ai][1][m][1] * rs[ai][m];
                uint4 o; o.x = pk2(silu(g0[0]) * u0[0], silu(g0[1]) * u0[1]); o.y = pk2(silu(g0[2]) * u0[2], silu(g0[3]) * u0[3]);
                o.z = pk2(silu(g1[0]) * u1[0], silu(g1[1]) * u1[1]); o.w = pk2(silu(g1[2]) * u1[2], silu(g1[3]) * u1[3]);
                *(uint4*)(H + (size_t)row * DFF + cbase) = o;
            }
    }
};
struct EpiRes {
    static constexpr int NST = 16; static constexpr bool NEEDS_RS = false;
    bf16_t* XB; float* PART; float scale;
    __device__ __forceinline__ void operator()(const f32x4 (&acc)[2][2][4][2], int brow, int bcol, int wr, int wc, int fr, int fq, const float*) const {
        uint4 v[2][4][2];
#pragma unroll
        for (int ai = 0; ai < 2; ++ai)
#pragma unroll
            for (int m = 0; m < 4; ++m)
#pragma unroll
                for (int bj = 0; bj < 2; ++bj)
                    v[ai][m][bj] = *(const uint4*)(XB + (size_t)(brow + ai * 128 + wr * 64 + m * 16 + fr) * DM + bcol + bj * 128 + wc * 32 + fq * 8);
#pragma unroll
        for (int ai = 0; ai < 2; ++ai)
#pragma unroll
            for (int m = 0; m < 4; ++m) {
                const int row = brow + ai * 128 + wr * 64 + m * 16 + fr;
                float ss = 0.f;
#pragma unroll
                for (int bj = 0; bj < 2; ++bj) {
                    const uint4 xv = v[ai][m][bj]; const f32x4 a0 = acc[ai][bj][m][0], a1 = acc[ai][bj][m][1];
                    uint4 o; o.x = pk2(lo16(xv.x) + scale * a0[0], hi16(xv.x) + scale * a0[1]); o.y = pk2(lo16(xv.y) + scale * a0[2], hi16(xv.y) + scale * a0[3]);
                    o.z = pk2(lo16(xv.z) + scale * a1[0], hi16(xv.z) + scale * a1[1]); o.w = pk2(lo16(xv.w) + scale * a1[2], hi16(xv.w) + scale * a1[3]);
                    *(uint4*)(XB + (size_t)row * DM + bcol + bj * 128 + wc * 32 + fq * 8) = o;
                    const float r0 = lo16(o.x), r1 = hi16(o.x), r2 = lo16(o.y), r3 = hi16(o.y), r4 = lo16(o.z), r5 = hi16(o.z), r6 = lo16(o.w), r7 = hi16(o.w);
                    ss += (r0 * r0 + r1 * r1) + (r2 * r2 + r3 * r3) + (r4 * r4 + r5 * r5) + (r6 * r6 + r7 * r7);
                }
                ss += __shfl_xor(ss, 16); ss += __shfl_xor(ss, 32);
                if (fq == 0) PART[(size_t)row * 16 + (bcol >> 8) * 4 + wc] = ss;
            }
    }
};
struct EpiProj {
    static constexpr int NST = 32; static constexpr bool NEEDS_RS = true;
    bf16_t* __restrict__ P; int ld; const float* __restrict__ PART;
    __device__ __forceinline__ void operator()(const f32x4 (&acc)[2][2][4][2], int brow, int bcol, int wr, int wc, int fr, int fq, const float* rsl) const {
        float rs[2][4];
#pragma unroll
        for (int ai = 0; ai < 2; ++ai)
#pragma unroll
            for (int m = 0; m < 4; ++m) rs[ai][m] = rsl[ai * 128 + wr * 64 + m * 16 + fr];
#pragma unroll
        for (int ai = 0; ai < 2; ++ai)
#pragma unroll
            for (int m = 0; m < 4; ++m) {
                const int row = brow + ai * 128 + wr * 64 + m * 16 + fr;
#pragma unroll
                for (int bj = 0; bj < 2; ++bj) {
                    const f32x4 a0 = acc[ai][bj][m][0] * rs[ai][m], a1 = acc[ai][bj][m][1] * rs[ai][m];
                    uint4 o; o.x = pk2(a0[0], a0[1]); o.y = pk2(a0[2], a0[3]); o.z = pk2(a1[0], a1[1]); o.w = pk2(a1[2], a1[3]);
                    *(uint4*)(P + (size_t)row * ld + bcol + bj * 128 + wc * 32 + fq * 8) = o;
                }
            }
    }
};

template <int NB, bool RS, int NKS, class Fin>
__device__ __forceinline__ void skinny_task(const bf16_t* __restrict__ A, int lda, const bf16_t* __restrict__ Bt, int K, int brow0, int brow1, const bf16_t* Xs, const Fin& fin) {
    SMEM_DECL;
    float* red = (float*)smem;
    float* rsd = red + 8 * NB * 2 * 64 * 4;
    const int tid = otid(), lane = tid & 63, w = tid >> 6, fr = lane & 15, fq = lane >> 4;
    const int kw = K >> 3;
    f32x4 acc[NB][2];
#pragma unroll
    for (int nb = 0; nb < NB; ++nb) { acc[nb][0] = (f32x4){0.f, 0.f, 0.f, 0.f}; acc[nb][1] = (f32x4){0.f, 0.f, 0.f, 0.f}; }
    __syncthreads();
    float rsv[4];
    if (RS) {
#pragma unroll
        for (int rr = 0; rr < 4; ++rr) {
            const bf16_t* xr = Xs + (size_t)(w * 4 + rr) * DM;
            float ss = 0.f;
#pragma unroll
            for (int i = 0; i < 2; ++i) { const uint4 v = *(const uint4*)(xr + i * 512 + lane * 8);
                ss += lo16(v.x) * lo16(v.x) + hi16(v.x) * hi16(v.x) + lo16(v.y) * lo16(v.y) + hi16(v.y) * hi16(v.y) + lo16(v.z) * lo16(v.z) + hi16(v.z) * hi16(v.z) + lo16(v.w) * lo16(v.w) + hi16(v.w) * hi16(v.w); }
            rsv[rr] = ss;
        }
    }
    {
        bf16x8 a0[NKS], a1[NKS], b0[NKS], b1[NKS];
#pragma unroll
        for (int ks = 0; ks < NKS; ++ks) {
            const int k0 = w * kw + ks * 32 + fq * 8;
            a0[ks] = *(const bf16x8*)(A + (size_t)fr * lda + k0); a1[ks] = *(const bf16x8*)(A + (size_t)(16 + fr) * lda + k0);
            b0[ks] = *(const bf16x8*)(Bt + (size_t)(brow0 + fr) * K + k0);
            if (NB == 2) b1[ks] = *(const bf16x8*)(Bt + (size_t)(brow1 + fr) * K + k0);
        }
#pragma unroll
        for (int ks = 0; ks < NKS; ++ks) {
            acc[0][0] = MFMA16(b0[ks], a0[ks], acc[0][0]); acc[0][1] = MFMA16(b0[ks], a1[ks], acc[0][1]);
            if (NB == 2) { acc[NB - 1][0] = MFMA16(b1[ks], a0[ks], acc[NB - 1][0]); acc[NB - 1][1] = MFMA16(b1[ks], a1[ks], acc[NB - 1][1]); }
        }
    }
    if (RS) {
#pragma unroll
        for (int rr = 0; rr < 4; ++rr) { const float ss = wave_sum(rsv[rr]); if (lane == 0) rsd[w * 4 + rr] = rsqrtf(ss * (1.f / 1024.f) + EPS); }
    }
#pragma unroll
    for (int nb = 0; nb < NB; ++nb)
#pragma unroll
        for (int mt = 0; mt < 2; ++mt) { float4 v; v.x = acc[nb][mt][0]; v.y = acc[nb][mt][1]; v.z = acc[nb][mt][2]; v.w = acc[nb][mt][3];
            *(float4*)(red + (((w * NB + nb) * 2 + mt) * 64 + lane) * 4) = v; }
    __syncthreads();
    {
        const int mt = tid >> 8, ln = (tid >> 2) & 63, jj = tid & 3;
        float v0 = 0.f, v1 = 0.f;
#pragma unroll
        for (int ww = 0; ww < 8; ++ww) {
            v0 += red[(((ww * NB + 0) * 2 + mt) * 64 + ln) * 4 + jj];
            if (NB == 2) v1 += red[(((ww * NB + NB - 1) * 2 + mt) * 64 + ln) * 4 + jj];
        }
        const float rs = RS ? rsd[mt * 16 + (ln & 15)] : 1.f;
        fin(mt * 16 + (ln & 15), (ln >> 4) * 4 + jj, v0 * rs, v1 * rs);
    }
}

struct FinGU { bf16_t* H; int c0; __device__ __forceinline__ void operator()(int m, int j, float g, float u) const { const int col = (c0 & ~31) + 8 * (j >> 2) + 4 * ((c0 >> 4) & 1) + (j & 3); H[(size_t)(MP + m) * DFF + col] = f2bf(silu(g) * u); } };
struct FinRes { bf16_t* XB; float scale; int c0; __device__ __forceinline__ void operator()(int m, int j, float v, float) const { const size_t o = (size_t)(MP + m) * DM + (c0 & ~31) + 8 * (j >> 2) + 4 * ((c0 >> 4) & 1) + (j & 3); XB[o] = f2bf(bf2f(XB[o]) + scale * v); } };
struct FinProj { bf16_t* P; int c0; __device__ __forceinline__ void operator()(int m, int j, float v, float) const { const int col = (c0 & ~31) + 8 * (j >> 2) + 4 * ((c0 >> 4) & 1) + (j & 3); P[(size_t)(MP + m) * NPROJ + col] = f2bf(v); } };

__device__ __forceinline__ void transpose_tile(const float* __restrict__ src, int ldn, int K, int k0, int c0, bf16_t* __restrict__ dst, int drow0, const float* __restrict__ gk, bool perm) {
    SMEM_DECL;
    float* tile = (float*)smem;
    const int tid = otid();
    __syncthreads();
    {
        float4 v[8];
#pragma unroll
        for (int r = 0; r < 8; ++r) { const int id = tid + r * NT, k = id >> 4, n4 = (id & 15) * 4; v[r] = *(const float4*)(src + (size_t)(k0 + k) * ldn + c0 + n4); }
#pragma unroll
        for (int r = 0; r < 8; ++r) { const int id = tid + r * NT, k = id >> 4, n4 = (id & 15) * 4; const float gs = gk ? gk[k0 + k] : 1.f;
            float* t = tile + k * 65 + n4; t[0] = v[r].x * gs; t[1] = v[r].y * gs; t[2] = v[r].z * gs; t[3] = v[r].w * gs; }
    }
    __syncthreads();
#pragma unroll
    for (int r = 0; r < 4; ++r) {
        const int id = tid + r * NT, a = id & 3, n16 = (id >> 2) & 15, rest = id >> 6, n = (rest & 3) * 16 + n16, kc = (rest >> 2) * 4 + a;
        const int c32 = n & 31, nd = perm ? (n & ~31) + 16 * ((c32 >> 2) & 1) + 4 * (c32 >> 3) + (c32 & 3) : n;
        const float* t = tile + (8 * kc) * 65 + n;
        uint4 o; o.x = pk2(t[0], t[65]); o.y = pk2(t[130], t[195]); o.z = pk2(t[260], t[325]); o.w = pk2(t[390], t[455]);
        *(uint4*)(dst + (size_t)(drow0 + nd) * K + k0 + 8 * kc) = o;
    }
}

struct WtItem { const float* src; const float* gk; bf16_t* dst; int ldn, K, k0, c0, drow0; };
__device__ __forceinline__ void wt_decode(KP p, int it, WtItem& w) {
    const int L = it / 1280; int r = it % 1280;
    unsigned char* wb = p->ws + (size_t)L * LAYER_W;
    if (r < 528 || r >= 752) {
        const bool second = r >= 752; if (second) r -= 752;
        if (r < 352) { const bool up = r >= 176; if (up) r -= 176; const int kt = r / 44, nt = r % 44, c0 = nt * 64;
            w.src = (up ? (second ? p->in[I_F2U] : p->in[I_F1U]) : (second ? p->in[I_F2G] : p->in[I_F1G])) + (size_t)L * 1024 * 2816;
            w.ldn = 2816; w.K = 1024; w.k0 = kt * 256; w.c0 = c0; w.dst = (bf16_t*)(wb + (second ? OFF_WGU2 : OFF_WGU1));
            w.drow0 = (c0 >> 7) * 256 + (c0 & 127) + (up ? 128 : 0); w.gk = (second ? p->in[I_F2N] : p->in[I_F1N]) + L * 1024; }
        else { r -= 352; const int kt = r / 16, nt = r % 16;
            w.src = (second ? p->in[I_F2D] : p->in[I_F1D]) + (size_t)L * 2816 * 1024; w.ldn = 1024; w.K = 2816; w.k0 = kt * 256; w.c0 = nt * 64;
            w.dst = (bf16_t*)(wb + (second ? OFF_WD2 : OFF_WD1)); w.drow0 = nt * 64; w.gk = nullptr; }
    } else if (r < 688) { r -= 528; const int kt = r / 40, nt = r % 40;
        w.src = p->in[I_WIN] + (size_t)L * 1024 * WINLD; w.ldn = WINLD; w.K = 1024; w.k0 = kt * 256; w.c0 = nt * 64; w.dst = (bf16_t*)(wb + OFF_WIN); w.drow0 = nt * 64; w.gk = p->in[I_MIXN] + L * 1024;
    } else { r -= 688; const int kt = r / 16, nt = r % 16;
        w.src = p->in[I_WOUT] + (size_t)L * 1024 * 1024; w.ldn = 1024; w.K = 1024; w.k0 = kt * 256; w.c0 = nt * 64; w.dst = (bf16_t*)(wb + OFF_WOUT); w.drow0 = nt * 64; w.gk = nullptr; }
}
#define WT_LOAD(W) do { _Pragma("unroll") for (int r_ = 0; r_ < 8; ++r_) { const int id_ = tid + r_ * NT, k_ = id_ >> 4, n4_ = (id_ & 15) * 4; \
        wv[r_] = *(const float4*)((W).src + (size_t)((W).k0 + k_) * (W).ldn + (W).c0 + n4_); } } while (0)
__device__ void weights_phase(KP p) {
    SMEM_DECL;
    float* tile = (float*)smem;
    const int tid = otid();
    int it = blockIdx.x;
    WtItem cur, nxt;
    float4 wv[8];
    if (it < 2 * 1280) { wt_decode(p, it, cur); WT_LOAD(cur); }
    while (it < 2 * 1280) {
        LDS_BARRIER();
#pragma unroll
        for (int r = 0; r < 8; ++r) { const int id = tid + r * NT, k = id >> 4, n4 = (id & 15) * 4; const float gs = cur.gk ? cur.gk[cur.k0 + k] : 1.f;
            float* t = tile + k * 65 + n4; t[0] = wv[r].x * gs; t[1] = wv[r].y * gs; t[2] = wv[r].z * gs; t[3] = wv[r].w * gs; }
        const int itn = it + gridDim.x;
        if (itn < 2 * 1280) { wt_decode(p, itn, nxt); WT_LOAD(nxt); }
        LDS_BARRIER();
#pragma unroll
        for (int r = 0; r < 4; ++r) {
            const int id = tid + r * NT, a = id & 3, n16 = (id >> 2) & 15, rest = id >> 6, n = (rest & 3) * 16 + n16, kc = (rest >> 2) * 4 + a;
            const int c32 = n & 31, nd = (n & ~31) + 16 * ((c32 >> 2) & 1) + 4 * (c32 >> 3) + (c32 & 3);
            const float* t = tile + (8 * kc) * 65 + n;
            uint4 o; o.x = pk2(t[0], t[65]); o.y = pk2(t[130], t[195]); o.z = pk2(t[260], t[325]); o.w = pk2(t[390], t[455]);
            *(uint4*)(cur.dst + (size_t)(cur.drow0 + nd) * cur.K + cur.k0 + 8 * kc) = o;
        }
        it = itn; cur = nxt;
    }
    __syncthreads();
    for (int e = blockIdx.x * NT + otid(); e < 2 * 16 * 1024; e += gridDim.x * NT) {
        const int L = e >> 14, h = (e >> 10) & 15, k = e & 1023;
        ((bf16_t*)(p->ws + WS_WDT))[e] = h < 8 ? f2bf(p->in[I_WIN][((size_t)L * 1024 + k) * WINLD + 2560 + h] * p->in[I_MIXN][L * 1024 + k]) : (bf16_t)0;
    }
    __syncthreads();
}

__device__ void cache_copy_phase(KP p) {
    constexpr unsigned per = 2047u * 256u / 4u;
    constexpr unsigned total = 128u * per;
    const unsigned stride = gridDim.x * NT;
    const float* ck = p->in[I_CK]; const float* cv = p->in[I_CV]; float* out = p->out;
#define CC_IDX(j) unsigned i##j = ib + (j) * stride; i##j = i##j < total ? i##j : total - 1u; \
    const unsigned seg##j = i##j / per, e##j = i##j % per, kv##j = seg##j >> 6, ln##j = seg##j & 63u; \
    const float4* s##j = (const float4*)((kv##j ? cv : ck) + (size_t)ln##j * 2048 * 256 + 256) + e##j; \
    float4* d##j = (float4*)(out + (kv##j ? O_VS : O_KS) + (size_t)ln##j * 2048 * 256) + e##j;
    for (unsigned ib = blockIdx.x * NT + otid(); ib < total; ib += 8u * stride) {
        CC_IDX(0) CC_IDX(1) CC_IDX(2) CC_IDX(3) CC_IDX(4) CC_IDX(5) CC_IDX(6) CC_IDX(7)
        const float4 v0 = *s0, v1 = *s1, v2 = *s2, v3 = *s3, v4 = *s4, v5 = *s5, v6 = *s6, v7 = *s7;
        *d0 = v0; *d1 = v1; *d2 = v2; *d3 = v3; *d4 = v4; *d5 = v5; *d6 = v6; *d7 = v7;
    }
#undef CC_IDX
}

__device__ void copy_phase(KP p, bf16_t* XB, float* PART) {
    const int lane = otid() & 63, wave = otid() >> 6;
    const int nw = gridDim.x * 8;
    for (int row0 = blockIdx.x * 8 + wave; row0 < MTOK; row0 += 4 * nw) {
        float4 v[4][4];
#pragma unroll
        for (int r = 0; r < 4; ++r) {
            int row = row0 + r * nw; row = row < MTOK ? row : MTOK - 1;
            const float* src = row < MP ? p->in[I_XP] + (size_t)row * DM : p->in[I_XS] + (size_t)(row - MP) * DM;
#pragma unroll
            for (int i = 0; i < 4; ++i) v[r][i] = *(const float4*)(src + i * 256 + lane * 4);
        }
#pragma unroll
        for (int r = 0; r < 4; ++r) {
            int row = row0 + r * nw; row = row < MTOK ? row : MTOK - 1;
            float ss = 0.f;
#pragma unroll
            for (int i = 0; i < 4; ++i) ss += v[r][i].x * v[r][i].x + v[r][i].y * v[r][i].y + v[r][i].z * v[r][i].z + v[r][i].w * v[r][i].w;
            ss = wave_sum(ss);
#pragma unroll
            for (int i = 0; i < 4; ++i) { uint2 o; o.x = pk2(v[r][i].x, v[r][i].y); o.y = pk2(v[r][i].z, v[r][i].w); *(uint2*)(XB + (size_t)row * DM + i * 256 + lane * 4) = o; }
            if (row < MP && lane < 16) PART[(size_t)row * 16 + lane] = lane == 0 ? ss : 0.f;
        }
    }
}
__device__ void final_phase(KP p, const bf16_t* XB, float* Y) {
    const int lane = otid() & 63, wave = otid() >> 6;
    const int nw = gridDim.x * 8;
    float4 gv[4];
#pragma unroll
    for (int i = 0; i < 4; ++i) gv[i] = *(const float4*)(p->in[I_FINN] + i * 256 + lane * 4);
    for (int row0 = blockIdx.x * 8 + wave; row0 < MTOK; row0 += 4 * nw) {
        uint2 u[4][4];
#pragma unroll
        for (int r = 0; r < 4; ++r) {
            int row = row0 + r * nw; row = row < MTOK ? row : MTOK - 1;
#pragma unroll
            for (int i = 0; i < 4; ++i) u[r][i] = *(const uint2*)(XB + (size_t)row * DM + i * 256 + lane * 4);
        }
#pragma unroll
        for (int r = 0; r < 4; ++r) {
            int row = row0 + r * nw; row = row < MTOK ? row : MTOK - 1;
            float4 v[4]; float ss = 0.f;
#pragma unroll
            for (int i = 0; i < 4; ++i) { v[i] = make_float4(lo16(u[r][i].x), hi16(u[r][i].x), lo16(u[r][i].y), hi16(u[r][i].y)); ss += v[i].x * v[i].x + v[i].y * v[i].y + v[i].z * v[i].z + v[i].w * v[i].w; }
            ss = wave_sum(ss);
            const float rstd = rsqrtf(ss * (1.f / 1024.f) + EPS);
#pragma unroll
            for (int i = 0; i < 4; ++i) { float4 o; o.x = v[i].x * rstd * gv[i].x; o.y = v[i].y * rstd * gv[i].y; o.z = v[i].z * rstd * gv[i].z; o.w = v[i].w * rstd * gv[i].w;
                *(float4*)(Y + (size_t)row * DM + i * 256 + lane * 4) = o; }
        }
    }
}

__device__ void prep_phase(KP p, int L, bf16_t* PROJ, bf16_t* U, bf16_t* CAT, const bf16_t* XB, const float* PART, float* DT) {
    SMEM_DECL;
    float* PW = (float*)smem; float* XA = PW + 16384; float* Dm = XA + 31 * 256; float* CS = Dm + 4096; float* INV = CS + 1024; float* DTP = INV + 32;
    const int tid = otid(), lane = tid & 63, w = tid >> 6, fr = lane & 15, fq = lane >> 4;
    __syncthreads();
    bf16_t* PWT = (bf16_t*)PW;
    bf16_t* DmB = (bf16_t*)Dm;
    for (int i = tid; i < 16384; i += NT) { const int gg = i >> 12, c = (i >> 6) & 63, dd = i & 63; PWT[(gg * 64 + 32 * (dd >> 5) + 16 * ((dd >> 2) & 1) + 4 * ((dd >> 3) & 3) + (dd & 3)) * 72 + c] = f2bf(p->in[I_POOLW][L * 16384 + i]); }
    if (tid < 32) INV[tid] = rope_inv(tid);
    __syncthreads();
    float* out = p->out;
    const bf16_t* wdt = (const bf16_t*)(p->ws + WS_WDT) + (size_t)L * 16 * 1024;
    const int tiles_per = (2048 + gridDim.x - 1) / gridDim.x;
    for (int tile = blockIdx.x * tiles_per; tile < 2048 && tile < (blockIdx.x + 1) * tiles_per; ++tile) {
        const int token0 = tile * 16, b = token0 >> 13, t0 = token0 & 8191;
        bf16x8 da[4], db[4];
#pragma unroll
        for (int ks = 0; ks < 4; ++ks) { const int k0 = w * 128 + ks * 32 + fq * 8;
            da[ks] = *(const bf16x8*)(XB + (size_t)(token0 + fr) * DM + k0); db[ks] = *(const bf16x8*)(wdt + fr * 1024 + k0); }
        uint4 xav[2];
#pragma unroll
        for (int it = 0; it < 2; ++it) { const int id = tid + it * NT, rr = id >> 5, ch = id & 31, t = t0 - 15 + rr;
            xav[it] = zero4();
            if (id < 992 && t >= 0) xav[it] = *(const uint4*)(PROJ + (size_t)(b * 8192 + t) * NPROJ + ch * 8); }
        const int r_tk = tid >> 5, r_rest = tid & 31, r_qk = r_rest >> 4, r_h = (r_rest >> 2) & 3, r_i0 = (r_rest & 3) * 8;
        bf16_t* rbase = PROJ + (size_t)(token0 + r_tk) * NPROJ + 256 + r_qk * 256 + r_h * 64 + r_i0;
        const uint4 rxa = *(const uint4*)rbase, rxb = *(const uint4*)(rbase + 32);
        uint4 vld = zero4();
        if (t0 >= 6144) vld = *(const uint4*)(PROJ + (size_t)(token0 + (tid >> 5)) * NPROJ + 768 + (tid & 31) * 8);
        const int q4 = tid >> 7, c0 = (tid & 127) * 8;
        uint4 xr[7];
#pragma unroll
        for (int rr = 0; rr < 7; ++rr) { const int tt = t0 + q4 * 4 - 3 + rr;
            xr[rr] = zero4();
            if (tt >= 0) xr[rr] = *(const uint4*)(PROJ + (size_t)(b * 8192 + tt) * NPROJ + 1536 + c0); }
        {
            f32x4 acc = (f32x4){0.f, 0.f, 0.f, 0.f};
#pragma unroll
            for (int ks = 0; ks < 4; ++ks) acc = MFMA16(db[ks], da[ks], acc);
            if (fq < 2) { float4 v; v.x = acc[0]; v.y = acc[1]; v.z = acc[2]; v.w = acc[3]; *(float4*)(DTP + (w * 16 + fr) * 8 + fq * 4) = v; }
        }
#pragma unroll
        for (int it = 0; it < 2; ++it) { const int id = tid + it * NT, rr = id >> 5, ch = id & 31;
            if (id < 992) { float* d = XA + rr * 256 + ch * 8; const uint4 v = xav[it];
                d[0] = lo16(v.x); d[1] = hi16(v.x); d[2] = lo16(v.y); d[3] = hi16(v.y); d[4] = lo16(v.z); d[5] = hi16(v.z); d[6] = lo16(v.w); d[7] = hi16(v.w); } }
        { const int tk = tid >> 5, i = tid & 31; float c, sn; rope_cs((float)(t0 + tk) * INV[i], c, sn); CS[(tk * 32 + i) * 2] = c; CS[(tk * 32 + i) * 2 + 1] = sn; }
        __syncthreads();
        if (tid < 128) {
            const int tk = tid >> 3, h = tid & 7;
            float d = 0.f;
#pragma unroll
            for (int ww = 0; ww < 8; ++ww) d += DTP[(ww * 16 + tk) * 8 + h];
            const float x = d * row_rstd(PART, token0 + tk) + p->in[I_DTB][L * 8 + h];
            DT[(size_t)(token0 + tk) * 8 + h] = x > 20.f ? x : log1pf(__expf(x));
        }
        for (int id = tid; id < 4096; id += NT) {
            const int tk = id >> 8, ch = id & 255, g = ch >> 6, ww = 2 << g, t = t0 + tk;
            float sum = 0.f;
            for (int i = 0; i < ww; ++i) sum += XA[(15 + tk - i) * 256 + ch];
            const float xc = XA[(15 + tk) * 256 + ch];
            const int cnt = (t + 1) < ww ? (t + 1) : ww;
            DmB[tk * 264 + ch] = f2bf(sum / (float)cnt - xc);
            if (t >= 8177) out[O_POOLP + ((size_t)(L * 4 + b) * 15 + (t - 8177)) * 256 + ch] = xc;
        }
        __syncthreads();
        {
            const int g = w >> 1;
            f32x4 r[2];
#pragma unroll
            for (int dq = 0; dq < 2; ++dq) {
                const int dtile = (w & 1) * 2 + dq;
                r[dq] = (f32x4){0.f, 0.f, 0.f, 0.f};
#pragma unroll
                for (int ks = 0; ks < 2; ++ks) {
                    const bf16x8 pf = *(const bf16x8*)(PWT + (g * 64 + 16 * dtile + fr) * 72 + ks * 32 + fq * 8);
                    const bf16x8 qf = *(const bf16x8*)(DmB + fr * 264 + g * 64 + ks * 32 + fq * 8);
                    r[dq] = MFMA16(pf, qf, r[dq]);
                }
            }
            const int o = g * 64 + 32 * (w & 1) + fq * 8;
            const float4 p0 = *(const float4*)(p->in[I_POOLSC] + L * 256 + o), p1 = *(const float4*)(p->in[I_POOLSC] + L * 256 + o + 4);
            uint4 ov; ov.x = pk2(r[0][0] * p0.x, r[0][1] * p0.y); ov.y = pk2(r[0][2] * p0.z, r[0][3] * p0.w);
            ov.z = pk2(r[1][0] * p1.x, r[1][1] * p1.y); ov.w = pk2(r[1][2] * p1.z, r[1][3] * p1.w);
            *(uint4*)(CAT + (size_t)(token0 + fr) * DM + o) = ov;
        }
        {
            const int t = t0 + r_tk;
            const float x1[8] = {lo16(rxa.x), hi16(rxa.x), lo16(rxa.y), hi16(rxa.y), lo16(rxa.z), hi16(rxa.z), lo16(rxa.w), hi16(rxa.w)};
            const float x2[8] = {lo16(rxb.x), hi16(rxb.x), lo16(rxb.y), hi16(rxb.y), lo16(rxb.z), hi16(rxb.z), lo16(rxb.w), hi16(rxb.w)};
            float r1[8], r2[8];
            const float sc = r_qk == 0 ? 0.125f : 1.f;
#pragma unroll
            for (int e = 0; e < 8; e += 2) {
                const float4 cs = *(const float4*)(CS + (r_tk * 32 + r_i0 + e) * 2);
                r1[e] = (x1[e] * cs.x - x2[e] * cs.y) * sc; r2[e] = (x2[e] * cs.x + x1[e] * cs.y) * sc;
                r1[e + 1] = (x1[e + 1] * cs.z - x2[e + 1] * cs.w) * sc; r2[e + 1] = (x2[e + 1] * cs.z + x1[e + 1] * cs.w) * sc;
            }
            uint4 o1, o2;
            o1.x = pk2(r1[0], r1[1]); o1.y = pk2(r1[2], r1[3]); o1.z = pk2(r1[4], r1[5]); o1.w = pk2(r1[6], r1[7]);
            o2.x = pk2(r2[0], r2[1]); o2.y = pk2(r2[2], r2[3]); o2.z = pk2(r2[4], r2[5]); o2.w = pk2(r2[6], r2[7]);
            *(uint4*)rbase = o1; *(uint4*)(rbase + 32) = o2;
            if (r_qk == 1 && t >= 6144) {
                float* kp = out + O_KP + (((size_t)(L * 4 + b) * 2048 + (t - 6144)) * 4 + r_h) * 64 + r_i0;
                *(float4*)kp = make_float4(r1[0], r1[1], r1[2], r1[3]); *(float4*)(kp + 4) = make_float4(r1[4], r1[5], r1[6], r1[7]);
                *(float4*)(kp + 32) = make_float4(r2[0], r2[1], r2[2], r2[3]); *(float4*)(kp + 36) = make_float4(r2[4], r2[5], r2[6], r2[7]);
            }
        }
        if (t0 >= 6144) {
            const int tk = tid >> 5, cc = (tid & 31) * 8, t = t0 + tk;
            float* vp = out + O_VP + ((size_t)(L * 4 + b) * 2048 + (t - 6144)) * 256 + cc;
            *(float4*)vp = make_float4(lo16(vld.x), hi16(vld.x), lo16(vld.y), hi16(vld.y)); *(float4*)(vp + 4) = make_float4(lo16(vld.z), hi16(vld.z), lo16(vld.w), hi16(vld.w));
        }
        {
            float wv[4][8], bv[8];
            { const float4 b0 = *(const float4*)(p->in[I_CONVB] + L * 1024 + c0), b1 = *(const float4*)(p->in[I_CONVB] + L * 1024 + c0 + 4);
              bv[0] = b0.x; bv[1] = b0.y; bv[2] = b0.z; bv[3] = b0.w; bv[4] = b1.x; bv[5] = b1.y; bv[6] = b1.z; bv[7] = b1.w; }
#pragma unroll
            for (int tau = 0; tau < 4; ++tau) {
                const float* cw = p->in[I_CONVW] + (size_t)(L * 4 + tau) * 1024 + c0;
                const float4 w0 = *(const float4*)cw, w1 = *(const float4*)(cw + 4);
                wv[tau][0] = w0.x; wv[tau][1] = w0.y; wv[tau][2] = w0.z; wv[tau][3] = w0.w; wv[tau][4] = w1.x; wv[tau][5] = w1.y; wv[tau][6] = w1.z; wv[tau][7] = w1.w;
            }
            float acc[4][8];
#pragma unroll
            for (int it = 0; it < 4; ++it)
#pragma unroll
                for (int e = 0; e < 8; ++e) acc[it][e] = bv[e];
#pragma unroll
            for (int rr = 0; rr < 7; ++rr) {
                const float xf[8] = {lo16(xr[rr].x), hi16(xr[rr].x), lo16(xr[rr].y), hi16(xr[rr].y), lo16(xr[rr].z), hi16(xr[rr].z), lo16(xr[rr].w), hi16(xr[rr].w)};
#pragma unroll
                for (int it = 0; it < 4; ++it) {
                    const int tau = rr - it;
                    if (tau >= 0 && tau < 4) {
#pragma unroll
                        for (int e = 0; e < 8; ++e) acc[it][e] += xf[e] * wv[tau][e];
                    }
                }
            }
#pragma unroll
            for (int it = 0; it < 4; ++it) {
                const int tk = q4 * 4 + it, t = t0 + tk;
                uint4 o; o.x = pk2(silu(acc[it][0]), silu(acc[it][1])); o.y = pk2(silu(acc[it][2]), silu(acc[it][3]));
                o.z = pk2(silu(acc[it][4]), silu(acc[it][5])); o.w = pk2(silu(acc[it][6]), silu(acc[it][7]));
                *(uint4*)(U + (size_t)(token0 + tk) * DM + c0) = o;
                if (t >= 8189) { float* cp = out + O_CONVP + ((size_t)(L * 4 + b) * 3 + (t - 8189)) * 1024 + c0; const uint4 xv = xr[it + 3];
                    *(float4*)cp = make_float4(lo16(xv.x), hi16(xv.x), lo16(xv.y), hi16(xv.y)); *(float4*)(cp + 4) = make_float4(lo16(xv.z), hi16(xv.z), lo16(xv.w), hi16(xv.w)); }
            }
        }
        __syncthreads();
    }
}

__device__ void prep_sample_item(KP p, int L, int item, bf16_t* PROJ, bf16_t* U, bf16_t* CAT, const bf16_t* XB, float* DT) {
    const int n = item >> 2, part = item & 3;
    SMEM_DECL;
    float* dsm = (float*)smem;
    const int tid = otid();
    const size_t row = MP + n;
    float* out = p->out;
    const int ln = L * 32 + n;
    __syncthreads();
    if (part == 0) {
        const int lane = tid & 63, h = tid >> 6;
        const bf16_t* wdt = (const bf16_t*)(p->ws + WS_WDT) + (size_t)L * 16 * 1024 + h * 1024;
        float d = 0.f, ss = 0.f;
#pragma unroll
        for (int i = 0; i < 16; ++i) { const int k = i * 64 + lane; const float xf = bf2f(XB[row * DM + k]); ss += xf * xf; d += xf * bf2f(wdt[k]); }
        d = wave_sum(d); ss = wave_sum(ss);
        if (lane == 0) { const float x = d * rsqrtf(ss * (1.f / 1024.f) + EPS) + p->in[I_DTB][L * 8 + h]; DT[row * 8 + h] = x > 20.f ? x : log1pf(__expf(x)); }
    }
    if (part == 1) {
    if (tid < 256) {
        const int ch = tid, g = ch >> 6, w = 2 << g;
        const float* cp = p->in[I_CPOOL] + (size_t)ln * 15 * 256;
        const float xn = bf2f(PROJ[row * NPROJ + ch]);
        float cpr[15];
#pragma unroll
        for (int i = 1; i < 16; ++i) cpr[i - 1] = cp[(15 - i) * 256 + ch];
        float sum = xn;
#pragma unroll
        for (int i = 1; i < 16; ++i) sum += (i < w) ? cpr[i - 1] : 0.f;
        dsm[ch] = sum / (float)w - xn;
        float* ps = out + O_POOLS + (size_t)ln * 15 * 256;
        float cpv[14];
#pragma unroll
        for (int j = 0; j < 14; ++j) cpv[j] = cp[(j + 1) * 256 + ch];
#pragma unroll
        for (int j = 0; j < 14; ++j) ps[j * 256 + ch] = cpv[j];
        ps[14 * 256 + ch] = xn;
    }
    __syncthreads();
    if (tid < 256) {
        const int o = tid, g = o >> 6, dout = o & 63;
        const float* pw = p->in[I_POOLW] + (size_t)(L * 4 + g) * 4096;
        float acc = 0.f;
#pragma unroll 32
        for (int c = 0; c < 64; ++c) acc += dsm[g * 64 + c] * pw[c * 64 + dout];
        CAT[row * DM + o] = f2bf(acc * p->in[I_POOLSC][L * 256 + o]);
    }
    }
    if (part == 2 && tid < 256) {
        const int qk = tid >> 7, h = (tid >> 5) & 3, i = tid & 31;
        const float inv = rope_inv(i);
        float c, s; rope_cs(16384.f * inv, c, s);
        bf16_t* base = PROJ + row * NPROJ + 256 + qk * 256 + h * 64;
        const float x1 = bf2f(base[i]), x2 = bf2f(base[i + 32]);
        float r1 = x1 * c - x2 * s, r2 = x2 * c + x1 * s;
        if (qk == 0) { r1 *= 0.125f; r2 *= 0.125f; }
        base[i] = f2bf(r1); base[i + 32] = f2bf(r2);
        if (qk == 1) { float* ks = out + O_KS + (((size_t)ln * 2048 + 2047) * 4 + h) * 64; ks[i] = r1; ks[i + 32] = r2; }
        out[O_VS + ((size_t)ln * 2048 + 2047) * 256 + tid] = bf2f(PROJ[row * NPROJ + 768 + tid]);
    }
    if (part == 3)
    for (int c = tid; c < 1024; c += NT) {
        const float* sc = p->in[I_SCONV] + (size_t)ln * 3 * 1024;
        const float* cw = p->in[I_CONVW] + (size_t)L * 4 * 1024;
        const float xnew = bf2f(PROJ[row * NPROJ + 1536 + c]);
        const float s0 = sc[c], s1 = sc[1024 + c], s2 = sc[2048 + c];
        const float acc = p->in[I_CONVB][L * 1024 + c] + s0 * cw[c] + s1 * cw[1024 + c] + s2 * cw[2048 + c] + xnew * cw[3072 + c];
        U[row * DM + c] = f2bf(silu(acc));
        float* cs = out + O_CONVS + (size_t)ln * 3 * 1024;
        cs[c] = s1; cs[1024 + c] = s2; cs[2048 + c] = xnew;
    }
    __syncthreads();
}

struct AttnPf { uint4 k[4], v[4]; bf16x8 q[2]; };
__device__ __forceinline__ void attn_decode(int a, int& b, int& h, int& br, int& dsh, int& r, int& n) {
    const int bh = a / 192, rem = a % 192, idx = rem & 63; br = rem >> 6;
    b = bh >> 2; h = bh & 3; dsh = br * 2; const int nb = 64 >> dsh; r = idx / nb; n = idx % nb;
}
__device__ __forceinline__ void attn_load(int a, const bf16_t* PROJ, int tid, AttnPf& pf) {
    int b, h, br, dsh, r, n; attn_decode(a, b, h, br, dsh, r, n);
    const int lane = tid & 63, w = tid >> 6, fr = lane & 15, fq = lane >> 4;
#pragma unroll
    for (int it = 0; it < 4; ++it) {
        const int id = tid + it * NT, rowk = id >> 3, ch = id & 7, lk = (n - 1) * 128 + rowk;
        pf.k[it] = zero4();
        if (lk >= 0) pf.k[it] = *(const uint4*)(PROJ + (size_t)(b * 8192 + (lk << dsh) + r) * NPROJ + 512 + h * 64 + ch * 8);
    }
#pragma unroll
    for (int it = 0; it < 4; ++it) {
        const int id = tid + it * NT, key = id & 255, ch = id >> 8, lk = (n - 1) * 128 + key;
        pf.v[it] = zero4();
        if (lk >= 0) pf.v[it] = *(const uint4*)(PROJ + (size_t)(b * 8192 + (lk << dsh) + r) * NPROJ + 768 + h * 64 + ch * 8);
    }
    const int qi = 16 * w + fr, lq = n * 128 + qi;
    const size_t tq = (size_t)b * 8192 + ((size_t)lq << dsh) + r;
#pragma unroll
    for (int ks = 0; ks < 2; ++ks) pf.q[ks] = *(const bf16x8*)(PROJ + tq * NPROJ + 256 + h * 64 + ks * 32 + fq * 8);
}
__device__ void attn_items(int a0, int astep, const bf16_t* PROJ, bf16_t* OG, float* LSE) {
    SMEM_DECL;
    bf16_t* Ks = (bf16_t*)smem;
    bf16_t* Vt = (bf16_t*)(smem + 272 * 144);
    const int tid = otid(), lane = tid & 63, w = tid >> 6, fr = lane & 15, fq = lane >> 4;
    AttnPf pf;
    if (a0 < 3072) attn_load(a0, PROJ, tid, pf);
#pragma unroll 1
    for (int a = a0; a < 3072; a += astep) {
        int b, h, br, dsh, r, n; attn_decode(a, b, h, br, dsh, r, n);
        LDS_BARRIER();
#pragma unroll
        for (int it = 0; it < 4; ++it) { const int id = tid + it * NT, rowk = id >> 3, ch = id & 7; *(uint4*)(Ks + rowk * 72 + ch * 8) = pf.k[it]; }
        if (tid < 128) { const uint4 z = zero4(); *(uint4*)(Ks + (256 + (tid >> 3)) * 72 + (tid & 7) * 8) = z; }
#pragma unroll
        for (int it = 0; it < 4; ++it) {
            const int id = tid + it * NT, key = id & 255, ch = id >> 8; const uint4 v = pf.v[it];
            bf16_t* d = Vt + (32 * (ch >> 2) + 4 * (ch & 3)) * 280 + key;
            d[0] = (bf16_t)(v.x & 0xffff); d[280] = (bf16_t)(v.x >> 16); d[560] = (bf16_t)(v.y & 0xffff); d[840] = (bf16_t)(v.y >> 16);
            d[16 * 280] = (bf16_t)(v.z & 0xffff); d[17 * 280] = (bf16_t)(v.z >> 16); d[18 * 280] = (bf16_t)(v.w & 0xffff); d[19 * 280] = (bf16_t)(v.w >> 16);
        }
        { const int d = tid >> 3, kk = (tid & 7) * 2; *(unsigned*)(Vt + d * 280 + 256 + kk) = 0u; }
        const bf16x8 qf0 = pf.q[0], qf1 = pf.q[1];
        if (a + astep < 3072) attn_load(a + astep, PROJ, tid, pf);
        LDS_BARRIER();
        const int qi = 16 * w + fr, lq = n * 128 + qi;
        const size_t tq = (size_t)b * 8192 + ((size_t)lq << dsh) + r;
        f32x4 s[10];
#pragma unroll
        for (int t = 0; t < 10; ++t) {
            s[t] = (f32x4){0.f, 0.f, 0.f, 0.f};
            const bf16x8 kf0 = *(const bf16x8*)(Ks + (16 * (w + t) + fr) * 72 + fq * 8);
            const bf16x8 kf1 = *(const bf16x8*)(Ks + (16 * (w + t) + fr) * 72 + 32 + fq * 8);
            s[t] = MFMA16(kf0, qf0, s[t]); s[t] = MFMA16(kf1, qf1, s[t]);
        }
        float mx = -INFINITY;
#pragma unroll
        for (int t = 0; t < 10; ++t)
#pragma unroll
            for (int jj = 0; jj < 4; ++jj) {
                const int key = 16 * (w + t) + fq * 4 + jj, dist = 128 + qi - key;
                const bool valid = (dist >= 0) && (dist <= 128) && (key < 256) && (n > 0 || key >= 128);
                const float sv = valid ? s[t][jj] : -INFINITY;
                s[t][jj] = sv; mx = fmaxf(mx, sv);
            }
        mx = fmaxf(mx, __shfl_xor(mx, 16)); mx = fmaxf(mx, __shfl_xor(mx, 32));
        float lsum = 0.f;
#pragma unroll
        for (int t = 0; t < 10; ++t)
#pragma unroll
            for (int jj = 0; jj < 4; ++jj) { const float pv = __expf(s[t][jj] - mx); s[t][jj] = pv; lsum += pv; }
        lsum += __shfl_xor(lsum, 16); lsum += __shfl_xor(lsum, 32);
        f32x4 o[4];
#pragma unroll
        for (int dt = 0; dt < 4; ++dt) o[dt] = (f32x4){0.f, 0.f, 0.f, 0.f};
#pragma unroll
        for (int kp = 0; kp < 5; ++kp) {
            const int ta = 2 * kp, tb = 2 * kp + 1;
            union { bf16x8 v; unsigned u[4]; } pfr;
            pfr.u[0] = pk2(s[ta][0], s[ta][1]); pfr.u[1] = pk2(s[ta][2], s[ta][3]); pfr.u[2] = pk2(s[tb][0], s[tb][1]); pfr.u[3] = pk2(s[tb][2], s[tb][3]);
#pragma unroll
            for (int dt = 0; dt < 4; ++dt) {
                union { bf16x8 v; uint2 u[2]; } vf;
                vf.u[0] = *(const uint2*)(Vt + (16 * dt + fr) * 280 + 16 * (w + ta) + fq * 4);
                vf.u[1] = *(const uint2*)(Vt + (16 * dt + fr) * 280 + 16 * (w + tb) + fq * 4);
                o[dt] = MFMA16(vf.v, pfr.v, o[dt]);
            }
        }
        const float inv = 1.f / lsum;
#pragma unroll
        for (int a2 = 0; a2 < 2; ++a2) {
            uint4 ov; ov.x = pk2(o[2 * a2][0] * inv, o[2 * a2][1] * inv); ov.y = pk2(o[2 * a2][2] * inv, o[2 * a2][3] * inv);
            ov.z = pk2(o[2 * a2 + 1][0] * inv, o[2 * a2 + 1][1] * inv); ov.w = pk2(o[2 * a2 + 1][2] * inv, o[2 * a2 + 1][3] * inv);
            *(uint4*)(OG + ((size_t)br * MP + tq) * 256 + h * 64 + 32 * a2 + fq * 8) = ov;
        }
        if (fq == 0) LSE[((size_t)br * MP + tq) * 4 + h] = mx + __logf(lsum);
    }
}

__device__ void combine_item(int item, const bf16_t* __restrict__ OG, const float* __restrict__ LSE, bf16_t* __restrict__ CAT) {
    const int tid = otid();
    uint4 a[4], bb[4], c[4]; float l0[4], l1[4], l2[4];
#pragma unroll
    for (int it = 0; it < 4; ++it) {
        const int id = tid + it * NT, tk = id >> 5, ch = id & 31, h = ch >> 3;
        const size_t token = (size_t)item * 64 + tk;
        l0[it] = LSE[token * 4 + h]; l1[it] = LSE[((size_t)MP + token) * 4 + h]; l2[it] = LSE[(2ull * MP + token) * 4 + h];
        a[it] = *(const uint4*)(OG + token * 256 + ch * 8); bb[it] = *(const uint4*)(OG + ((size_t)MP + token) * 256 + ch * 8);
        c[it] = *(const uint4*)(OG + (2ull * MP + token) * 256 + ch * 8);
    }
#pragma unroll
    for (int it = 0; it < 4; ++it) {
        const int id = tid + it * NT, tk = id >> 5, ch = id & 31;
        const size_t token = (size_t)item * 64 + tk;
        const float m = fmaxf(l0[it], fmaxf(l1[it], l2[it]));
        float w0 = __expf(l0[it] - m), w1 = __expf(l1[it] - m), w2 = __expf(l2[it] - m);
        const float inv = 1.f / (w0 + w1 + w2); w0 *= inv; w1 *= inv; w2 *= inv;
        uint4 o;
        o.x = pk2(w0 * lo16(a[it].x) + w1 * lo16(bb[it].x) + w2 * lo16(c[it].x), w0 * hi16(a[it].x) + w1 * hi16(bb[it].x) + w2 * hi16(c[it].x));
        o.y = pk2(w0 * lo16(a[it].y) + w1 * lo16(bb[it].y) + w2 * lo16(c[it].y), w0 * hi16(a[it].y) + w1 * hi16(bb[it].y) + w2 * hi16(c[it].y));
        o.z = pk2(w0 * lo16(a[it].z) + w1 * lo16(bb[it].z) + w2 * lo16(c[it].z), w0 * hi16(a[it].z) + w1 * hi16(bb[it].z) + w2 * hi16(c[it].z));
        o.w = pk2(w0 * lo16(a[it].w) + w1 * lo16(bb[it].w) + w2 * lo16(c[it].w), w0 * hi16(a[it].w) + w1 * hi16(bb[it].w) + w2 * hi16(c[it].w));
        *(uint4*)(CAT + token * DM + 256 + ch * 8) = o;
    }
}

__device__ __forceinline__ void ssd_acs(KP p, int L, int g, int token0, const float* DT, float* acs, float* dts) {
    const int lane = otid() & 63, w = otid() >> 6;
    if (w < 4) {
        const int h = g * 4 + w; const float a = -__expf(p->in[I_ALOG][L * 8 + h]);
        const float d0 = DT[(size_t)(token0 + 2 * lane) * 8 + h], d1 = DT[(size_t)(token0 + 2 * lane + 1) * 8 + h];
        const float v0 = d0 * a, v1 = d1 * a, sum = v0 + v1; float inc = sum;
#pragma unroll
        for (int off = 1; off < 64; off <<= 1) { const float t = __shfl_up(inc, off); if (lane >= off) inc += t; }
        const float exc = inc - sum;
        acs[w * 128 + 2 * lane] = exc + v0; acs[w * 128 + 2 * lane + 1] = exc + v0 + v1;
        dts[w * 128 + 2 * lane] = d0; dts[w * 128 + 2 * lane + 1] = d1;
    }
}

__device__ void s1_item(KP p, int L, int item, const bf16_t* U, const float* DT, float* ST, float* DEC) {
    SMEM_DECL;
    bf16_t* BT = (bf16_t*)smem;
    bf16_t* XWT = (bf16_t*)(smem + 34816);
    float* acs = (float*)(smem + 104448);
    float* dts = (float*)(smem + 106496);
    const int tid = otid(), lane = tid & 63, w = tid >> 6, fr = lane & 15, fq = lane >> 4;
    const int cb = item >> 1, g = item & 1, token0 = cb * 128;
    __syncthreads();
    ssd_acs(p, L, g, token0, DT, acs, dts);
    __syncthreads();
    { const int j = tid >> 7, l = tid & 127; const float wv = __expf(acs[j * 128 + 127] - acs[j * 128 + l]) * dts[j * 128 + l];
      if (tid < 4) DEC[cb * 8 + g * 4 + tid] = __expf(acs[tid * 128 + 127]);
      __syncthreads();
      dts[j * 128 + l] = wv; }
    __syncthreads();
#pragma unroll
    for (int it = 0; it < 4; ++it) {
        const int id = tid + it * NT, l = id & 127, ch = id >> 7;
        const uint4 v = *(const uint4*)(U + (size_t)(token0 + l) * DM + 512 + g * 128 + ch * 8);
        bf16_t* d = BT + (ch * 8) * 136 + l;
        d[0] = (bf16_t)(v.x & 0xffff); d[136] = (bf16_t)(v.x >> 16); d[272] = (bf16_t)(v.y & 0xffff); d[408] = (bf16_t)(v.y >> 16);
        d[544] = (bf16_t)(v.z & 0xffff); d[680] = (bf16_t)(v.z >> 16); d[816] = (bf16_t)(v.w & 0xffff); d[952] = (bf16_t)(v.w >> 16);
    }
#pragma unroll
    for (int it = 0; it < 8; ++it) {
        const int id = tid + it * NT, l = id & 127, ch = id >> 7, j = ch >> 3;
        const uint4 v = *(const uint4*)(U + (size_t)(token0 + l) * DM + g * 256 + ch * 8);
        const float wv = dts[j * 128 + l];
        bf16_t* d = XWT + (ch * 8) * 136 + l;
        d[0] = f2bf(lo16(v.x) * wv); d[136] = f2bf(hi16(v.x) * wv); d[272] = f2bf(lo16(v.y) * wv); d[408] = f2bf(hi16(v.y) * wv);
        d[544] = f2bf(lo16(v.z) * wv); d[680] = f2bf(hi16(v.z) * wv); d[816] = f2bf(lo16(v.w) * wv); d[952] = f2bf(hi16(v.w) * wv);
    }
    __syncthreads();
    f32x4 acc[2][8];
#pragma unroll
    for (int qq = 0; qq < 2; ++qq)
#pragma unroll
        for (int nt = 0; nt < 8; ++nt) acc[qq][nt] = (f32x4){0.f, 0.f, 0.f, 0.f};
#pragma unroll
    for (int ks = 0; ks < 4; ++ks) {
        bf16x8 qf[2];
#pragma unroll
        for (int qq = 0; qq < 2; ++qq) qf[qq] = *(const bf16x8*)(XWT + (16 * (2 * w + qq) + fr) * 136 + ks * 32 + fq * 8);
#pragma unroll
        for (int nt = 0; nt < 8; ++nt) {
            const bf16x8 pf = *(const bf16x8*)(BT + (16 * nt + fr) * 136 + ks * 32 + fq * 8);
#pragma unroll
            for (int qq = 0; qq < 2; ++qq) acc[qq][nt] = MFMA16(pf, qf[qq], acc[qq][nt]);
        }
    }
#pragma unroll
    for (int qq = 0; qq < 2; ++qq) {
        const int rowjp = 16 * (2 * w + qq) + fr, j = rowjp >> 6, pp = rowjp & 63, h = g * 4 + j;
        float* dst = ST + ((size_t)(cb * 8 + h) * 64 + pp) * 128 + fq * 4;
#pragma unroll
        for (int nt = 0; nt < 8; ++nt) { float4 v; v.x = acc[qq][nt][0]; v.y = acc[qq][nt][1]; v.z = acc[qq][nt][2]; v.w = acc[qq][nt][3]; *(float4*)(dst + 16 * nt) = v; }
    }
}

__device__ void scan_phase(KP p, int L, float* ST, const float* DEC) {
    const int tid = otid();
    if (tid < 256) {
        for (int e = blockIdx.x * 256 + tid; e < 65536; e += gridDim.x * 256) {
            const int idx = e * 4, n = idx & 127, pp = (idx >> 7) & 63, h = (idx >> 13) & 7, b = idx >> 16;
            float4 hr = make_float4(0.f, 0.f, 0.f, 0.f);
            float* base = ST + ((size_t)((b * 64) * 8 + h) * 64 + pp) * 128 + n;
            const float* dbase = DEC + (b * 64) * 8 + h;
#pragma unroll 1
            for (int c0 = 0; c0 < 64; c0 += 16) {
                float4 t[16]; float d[16];
#pragma unroll
                for (int j = 0; j < 16; ++j) { t[j] = *(const float4*)(base + (size_t)(c0 + j) * 65536); d[j] = dbase[(c0 + j) * 8]; }
#pragma unroll
                for (int j = 0; j < 16; ++j) { *(float4*)(base + (size_t)(c0 + j) * 65536) = hr;
                    hr.x = d[j] * hr.x + t[j].x; hr.y = d[j] * hr.y + t[j].y; hr.z = d[j] * hr.z + t[j].z; hr.w = d[j] * hr.w + t[j].w; }
            }
            *(float4*)(p->out + O_SSMP + (((size_t)(L * 4 + b) * 8 + h) * 64 + pp) * 128 + n) = hr;
        }
    }
}

__device__ void s3_item(KP p, int L, int item, const bf16_t* U, const bf16_t* PROJ, const float* DT, const float* ST, bf16_t* CAT) {
    SMEM_DECL;
    bf16_t* Cs = (bf16_t*)smem;
    bf16_t* Bs = (bf16_t*)(smem + 34816);
    bf16_t* XT = (bf16_t*)(smem + 69632);
    bf16_t* Hp = (bf16_t*)(smem + 87040);
    float* acs = (float*)(smem + 104448);
    float* dts = (float*)(smem + 106496);
    const int tid = otid(), lane = tid & 63, w = tid >> 6, fr = lane & 15, fq = lane >> 4;
    const int cb = item >> 1, g = item & 1, token0 = cb * 128;
    const int l = 16 * w + fr;
    const size_t token = (size_t)token0 + l;
    uint4 xt[2]; float4 hp[4]; uint4 xv[2], zv[2];
#define S3_LOAD(hh) do { \
        _Pragma("unroll") for (int it = 0; it < 2; ++it) { const int id = tid + it * NT, s_ = id & 127, ch = id >> 7; \
            xt[it] = *(const uint4*)(U + (size_t)(token0 + s_) * DM + (hh) * 64 + ch * 8); } \
        _Pragma("unroll") for (int it = 0; it < 4; ++it) { const int id = tid + it * NT, pp = id >> 5, c4 = id & 31; \
            hp[it] = *(const float4*)(ST + ((size_t)(cb * 8 + (hh)) * 64 + pp) * 128 + c4 * 4); } \
        _Pragma("unroll") for (int a2 = 0; a2 < 2; ++a2) { const int ch = (hh) * 64 + 32 * a2 + fq * 8; \
            xv[a2] = *(const uint4*)(U + token * DM + ch); zv[a2] = *(const uint4*)(PROJ + token * NPROJ + 1024 + ch); } } while (0)
    LDS_BARRIER();
    S3_LOAD(g * 4);
    ssd_acs(p, L, g, token0, DT, acs, dts);
#pragma unroll
    for (int it = 0; it < 4; ++it) {
        const int id = tid + it * NT, ll = id >> 4, ch = id & 15;
        *(uint4*)(Cs + ll * 136 + ch * 8) = *(const uint4*)(U + (size_t)(token0 + ll) * DM + 768 + g * 128 + ch * 8);
        *(uint4*)(Bs + ll * 136 + ch * 8) = *(const uint4*)(U + (size_t)(token0 + ll) * DM + 512 + g * 128 + ch * 8);
    }
    LDS_BARRIER();
    f32x4 cbv[8];
#pragma unroll
    for (int st = 0; st < 8; ++st) cbv[st] = (f32x4){0.f, 0.f, 0.f, 0.f};
#pragma unroll
    for (int ks = 0; ks < 4; ++ks) {
        const bf16x8 qf = *(const bf16x8*)(Cs + (16 * w + fr) * 136 + ks * 32 + fq * 8);
#pragma unroll
        for (int st = 0; st < 8; ++st)
            if (st <= w) { const bf16x8 pf = *(const bf16x8*)(Bs + (16 * st + fr) * 136 + ks * 32 + fq * 8); cbv[st] = MFMA16(pf, qf, cbv[st]); }
    }
    LDS_BARRIER();
    bf16_t* Mb = Bs;
    float ssq = 0.f;
#pragma unroll 1
    for (int j = 0; j < 4; ++j) {
        const int h = g * 4 + j;
#pragma unroll
        for (int it = 0; it < 2; ++it) {
            const int id = tid + it * NT, s_ = id & 127, ch = id >> 7; const uint4 v = xt[it];
            bf16_t* d = XT + (32 * (ch >> 2) + 4 * (ch & 3)) * 136 + s_;
            d[0] = (bf16_t)(v.x & 0xffff); d[136] = (bf16_t)(v.x >> 16); d[272] = (bf16_t)(v.y & 0xffff); d[408] = (bf16_t)(v.y >> 16);
            d[16 * 136] = (bf16_t)(v.z & 0xffff); d[17 * 136] = (bf16_t)(v.z >> 16); d[18 * 136] = (bf16_t)(v.w & 0xffff); d[19 * 136] = (bf16_t)(v.w >> 16);
        }
#pragma unroll
        for (int it = 0; it < 4; ++it) {
            const int id = tid + it * NT, pp = id >> 5, c4 = id & 31; const float4 v = hp[it];
            uint2 o; o.x = pk2(v.x, v.y); o.y = pk2(v.z, v.w);
            *(uint2*)(Hp + (32 * (pp >> 5) + 16 * ((pp >> 2) & 1) + 4 * ((pp >> 3) & 3) + (pp & 3)) * 136 + c4 * 4) = o;
        }
        uint4 xvc[2], zvc[2];
#pragma unroll
        for (int a2 = 0; a2 < 2; ++a2) { xvc[a2] = xv[a2]; zvc[a2] = zv[a2]; }
        if (j < 3) S3_LOAD(h + 1);
        const float al = acs[j * 128 + l];
#pragma unroll
        for (int st = 0; st < 8; ++st)
            if (st <= (w | 1)) {
                float mv[4];
#pragma unroll
                for (int jj = 0; jj < 4; ++jj) { const int s_ = 16 * st + fq * 4 + jj;
                    mv[jj] = (s_ <= l) ? cbv[st][jj] * __expf(al - acs[j * 128 + s_]) * dts[j * 128 + s_] : 0.f; }
                uint2 o; o.x = pk2(mv[0], mv[1]); o.y = pk2(mv[2], mv[3]);
                *(uint2*)(Mb + l * 136 + 16 * st + fq * 4) = o;
            }
        LDS_BARRIER();
        f32x4 yy[4];
#pragma unroll
        for (int pt = 0; pt < 4; ++pt) yy[pt] = (f32x4){0.f, 0.f, 0.f, 0.f};
#pragma unroll
        for (int ks = 0; ks < 4; ++ks) {
            const bf16x8 qf = *(const bf16x8*)(Cs + (16 * w + fr) * 136 + ks * 32 + fq * 8);
#pragma unroll
            for (int pt = 0; pt < 4; ++pt) { const bf16x8 pf = *(const bf16x8*)(Hp + (16 * pt + fr) * 136 + ks * 32 + fq * 8); yy[pt] = MFMA16(pf, qf, yy[pt]); }
        }
        const float ea = __expf(al);
#pragma unroll
        for (int pt = 0; pt < 4; ++pt) yy[pt] = yy[pt] * ea;
#pragma unroll
        for (int ks = 0; ks < 4; ++ks)
            if (2 * ks <= w) {
                const bf16x8 qf = *(const bf16x8*)(Mb + (16 * w + fr) * 136 + ks * 32 + fq * 8);
#pragma unroll
                for (int pt = 0; pt < 4; ++pt) { const bf16x8 pf = *(const bf16x8*)(XT + (16 * pt + fr) * 136 + ks * 32 + fq * 8); yy[pt] = MFMA16(pf, qf, yy[pt]); }
            }
        const float dsk = p->in[I_DSKIP][L * 8 + h];
#pragma unroll
        for (int a2 = 0; a2 < 2; ++a2) {
            const int ch = h * 64 + 32 * a2 + fq * 8;
            const uint4 xq = xvc[a2], zq = zvc[a2];
            const float xs[8] = {lo16(xq.x), hi16(xq.x), lo16(xq.y), hi16(xq.y), lo16(xq.z), hi16(xq.z), lo16(xq.w), hi16(xq.w)};
            const float zs[8] = {lo16(zq.x), hi16(zq.x), lo16(zq.y), hi16(zq.y), lo16(zq.z), hi16(zq.z), lo16(zq.w), hi16(zq.w)};
            float v[8];
#pragma unroll
            for (int e = 0; e < 8; ++e) { v[e] = (yy[2 * a2 + (e >> 2)][e & 3] + dsk * xs[e]) * silu(zs[e]); ssq += v[e] * v[e]; }
            uint4 o; o.x = pk2(v[0], v[1]); o.y = pk2(v[2], v[3]); o.z = pk2(v[4], v[5]); o.w = pk2(v[6], v[7]);
            *(uint4*)(CAT + token * DM + 512 + ch) = o;
        }
        LDS_BARRIER();
    }
#undef S3_LOAD
    asm volatile("s_waitcnt vmcnt(0)" ::: "memory");
    ssq += __shfl_xor(ssq, 16); ssq += __shfl_xor(ssq, 32);
    const float rstd = rsqrtf(ssq * (1.f / 256.f) + EPS);
    {
        uint4 vv[4][2];
#pragma unroll
        for (int j = 0; j < 4; ++j)
#pragma unroll
            for (int a2 = 0; a2 < 2; ++a2) vv[j][a2] = *(const uint4*)(CAT + token * DM + 512 + (g * 4 + j) * 64 + 32 * a2 + fq * 8);
#pragma unroll
        for (int j = 0; j < 4; ++j)
#pragma unroll
            for (int a2 = 0; a2 < 2; ++a2) {
                const int ch = (g * 4 + j) * 64 + 32 * a2 + fq * 8;
                const float4 n0 = *(const float4*)(p->in[I_SSMN] + L * 512 + ch), n1 = *(const float4*)(p->in[I_SSMN] + L * 512 + ch + 4);
                const uint4 v = vv[j][a2];
                uint4 o; o.x = pk2(lo16(v.x) * rstd * n0.x, hi16(v.x) * rstd * n0.y); o.y = pk2(lo16(v.y) * rstd * n0.z, hi16(v.y) * rstd * n0.w);
                o.z = pk2(lo16(v.z) * rstd * n1.x, hi16(v.z) * rstd * n1.y); o.w = pk2(lo16(v.w) * rstd * n1.z, hi16(v.w) * rstd * n1.w);
                *(uint4*)(CAT + token * DM + 512 + ch) = o;
            }
    }
}

__device__ void sample_attn_item(KP p, int L, int item, const bf16_t* PROJ, bf16_t* CAT) {
    SMEM_DECL;
    float* qs = (float*)smem; float* kn = qs + 64; float* vn = kn + 64; float* sc = vn + 64; float* red = sc + 512; float* part = red + 32;
    const int tid = otid(), lane = tid & 63, w = tid >> 6;
    const int n = item >> 2, h = item & 3;
    const size_t row = MP + n; const int ln = L * 32 + n;
    __syncthreads();
    if (tid < 64) { qs[tid] = bf2f(PROJ[row * NPROJ + 256 + h * 64 + tid]); kn[tid] = bf2f(PROJ[row * NPROJ + 512 + h * 64 + tid]); vn[tid] = bf2f(PROJ[row * NPROJ + 768 + h * 64 + tid]); }
    __syncthreads();
    const float* ck = p->in[I_CK] + (size_t)ln * 2048 * 256 + h * 64;
    const float* cv = p->in[I_CV] + (size_t)ln * 2048 * 256 + h * 64;
    float s = -INFINITY;
    if (tid < 387) {
        const int gg = tid / 129, j = tid % 129;
        s = 0.f;
        if (j == 0) { for (int d = 0; d < 64; ++d) s += qs[d] * kn[d]; }
        else { const float* kr = ck + (size_t)(2048 - (j << (2 * gg))) * 256;
#pragma unroll
            for (int d = 0; d < 64; d += 4) { const float4 kv = *(const float4*)(kr + d); s += qs[d] * kv.x + qs[d + 1] * kv.y + qs[d + 2] * kv.z + qs[d + 3] * kv.w; } }
    }
    const float wm = wave_max(s);
    if (lane == 0) red[w] = wm;
    __syncthreads();
    float mx = red[0];
#pragma unroll
    for (int i = 1; i < 8; ++i) mx = fmaxf(mx, red[i]);
    const float pv = (tid < 387) ? __expf(s - mx) : 0.f;
    sc[tid] = pv;
    const float wsum = wave_sum(pv);
    if (lane == 0) red[8 + w] = wsum;
    __syncthreads();
    float tot = 0.f;
#pragma unroll
    for (int i = 0; i < 8; ++i) tot += red[8 + i];
    {
        const int eg = tid >> 4, d4 = (tid & 15) * 4;
        float4 vv[13]; float pp[13];
#pragma unroll
        for (int i = 0; i < 13; ++i) {
            const int e = eg + 32 * i;
            pp[i] = 0.f; vv[i] = make_float4(0.f, 0.f, 0.f, 0.f);
            if (e < 387) { const int gg = e / 129, j = e % 129; pp[i] = sc[e];
                vv[i] = (j == 0) ? *(const float4*)(vn + d4) : *(const float4*)(cv + (size_t)(2048 - (j << (2 * gg))) * 256 + d4); }
        }
        float4 o = make_float4(0.f, 0.f, 0.f, 0.f);
#pragma unroll
        for (int i = 0; i < 13; ++i) { o.x += pp[i] * vv[i].x; o.y += pp[i] * vv[i].y; o.z += pp[i] * vv[i].z; o.w += pp[i] * vv[i].w; }
        *(float4*)(part + eg * 64 + d4) = o;
    }
    __syncthreads();
    if (tid < 64) {
        float o = 0.f;
#pragma unroll
        for (int i = 0; i < 32; ++i) o += part[i * 64 + tid];
        CAT[row * DM + 256 + h * 64 + tid] = f2bf(o / tot);
    }
}

__device__ void sample_ssd_item(KP p, int L, int n, const bf16_t* PROJ, const bf16_t* U, const float* DT, bf16_t* CAT) {
    SMEM_DECL;
    float* us = (float*)smem; float* zs = us + 1024; float* ys = zs + 512; float* red = ys + 512;
    const int tid = otid(), lane = tid & 63, w = tid >> 6;
    const size_t row = MP + n; const int ln = L * 32 + n;
    __syncthreads();
    for (int i = tid; i < 1024; i += NT) us[i] = bf2f(U[row * DM + i]);
    zs[tid] = bf2f(PROJ[row * NPROJ + 1024 + tid]);
    __syncthreads();
    {
        const int h = w, g = h >> 2;
        const float dt = DT[row * 8 + h], a = -__expf(p->in[I_ALOG][L * 8 + h]), dec = __expf(dt * a);
        const float B0 = us[512 + g * 128 + 2 * lane], B1 = us[512 + g * 128 + 2 * lane + 1], C0 = us[768 + g * 128 + 2 * lane], C1 = us[768 + g * 128 + 2 * lane + 1];
        const float* h0 = p->in[I_SSSM] + ((size_t)ln * 8 + h) * 64 * 128;
        float* hs = p->out + O_SSMS + ((size_t)ln * 8 + h) * 64 * 128;
#pragma unroll 1
        for (int r0 = 0; r0 < 64; r0 += 32) {
            float2 hv[32];
#pragma unroll
            for (int i = 0; i < 32; ++i) hv[i] = *(const float2*)(h0 + (r0 + i) * 128 + 2 * lane);
#pragma unroll
            for (int i = 0; i < 32; ++i) {
                const int rr = r0 + i;
                const float x = us[h * 64 + rr];
                float2 hn; hn.x = dec * hv[i].x + dt * x * B0; hn.y = dec * hv[i].y + dt * x * B1;
                *(float2*)(hs + rr * 128 + 2 * lane) = hn;
                const float part = wave_sum(hn.x * C0 + hn.y * C1);
                if (lane == 0) ys[h * 64 + rr] = part;
            }
        }
    }
    __syncthreads();
    {
        const int ch = tid, gch = ch >> 8;
        const float v = (ys[ch] + p->in[I_DSKIP][L * 8 + (ch >> 6)] * us[ch]) * silu(zs[ch]);
        const float part = wave_sum(v * v);
        if (lane == 0) red[w] = part;
        __syncthreads();
        const float tot = red[gch * 4] + red[gch * 4 + 1] + red[gch * 4 + 2] + red[gch * 4 + 3];
        const float rstd = rsqrtf(tot * (1.f / 256.f) + EPS);
        CAT[row * DM + 512 + ch] = f2bf(v * rstd * p->in[I_SSMN][L * 512 + ch]);
    }
}


#define XB_TMO      128
#define XB_XCNT(j)  (256  + 64 * (j))
#define XB_XSUB(j)  (1280 + 64 * (j))
#define XB_XGEN(j)  (2304 + 64 * (j))
#define XB_TOP      3328
#define XB_TOPGEN   3392
#define XCD_BAR_WORDS 3456
#define XB_SPIN_CAP (1u << 18)
__device__ __forceinline__ unsigned xb_ld(unsigned* p)              { return __hip_atomic_load(p, __ATOMIC_RELAXED, __HIP_MEMORY_SCOPE_AGENT); }
__device__ __forceinline__ unsigned xb_add(unsigned* p, unsigned v) { return __hip_atomic_fetch_add(p, v, __ATOMIC_RELAXED, __HIP_MEMORY_SCOPE_AGENT); }
__device__ __forceinline__ unsigned xb_xcc_id() { return (unsigned)__builtin_amdgcn_s_getreg((3 << 11) | 20) & 0xFu; }
#define XB_SPIN(cond, bar) do { unsigned _sp = 0; while (cond) { __builtin_amdgcn_s_sleep(1); \
    if ((++_sp & 255u) == 0u) { if (xb_ld(&(bar)[XB_TMO])) break; if (_sp > XB_SPIN_CAP) { atomicAdd(&(bar)[XB_TMO], 1u); break; } } } } while (0)
struct XcdBarrier { unsigned* bar; unsigned x; volatile LAS unsigned* st; };
__device__ __forceinline__ XcdBarrier xcd_barrier_post(unsigned* bar, volatile LAS unsigned* st) {
    XcdBarrier b; b.bar = bar; b.x = xb_xcc_id(); b.st = st;
    if (__builtin_amdgcn_workitem_id_x() == 0) (void)xb_add(&bar[XB_XCNT(b.x)], 1u);
    return b;
}
__device__ __forceinline__ void xcd_barrier_complete(unsigned* bar, unsigned x, unsigned& nloc, unsigned& nx) {
    const unsigned G = gridDim.x * gridDim.y * gridDim.z;
    unsigned sum, cnt, mine, sp = 0u;
    for (;;) {
        sum = 0u; cnt = 0u; mine = 0u;
#pragma unroll
        for (unsigned j = 0; j < 16; ++j) { const unsigned c = xb_ld(&bar[XB_XCNT(j)]); sum += c; cnt += (c > 0u) ? 1u : 0u; mine = (j == x) ? c : mine; }
        if (sum == G) break;
        __builtin_amdgcn_s_sleep(1);
        if ((++sp & 255u) == 0u) { if (xb_ld(&bar[XB_TMO])) break; if (sp > XB_SPIN_CAP) { atomicAdd(&bar[XB_TMO], 1u); break; } }
    }
    nloc = mine > 0u ? mine : 1u; nx = cnt > 0u ? cnt : 1u;
}
__device__ __forceinline__ void xcd_barrier(const XcdBarrier& b) {
    asm volatile("s_waitcnt vmcnt(0)" ::: "memory");
    __syncthreads();
    if (__builtin_amdgcn_workitem_id_x() == 0) {
        unsigned* bar = b.bar;
        __builtin_amdgcn_s_waitcnt(0);
        unsigned nloc = b.st[0], nx = b.st[1];
        if (nloc == 0u) { xcd_barrier_complete(bar, b.x, nloc, nx); b.st[0] = nloc; b.st[1] = nx; }
        const unsigned old = xb_add(&bar[XB_XSUB(b.x)], 1u);
        const unsigned gen = old / nloc;
        if (old + 1u == (gen + 1u) * nloc) {
            __builtin_amdgcn_fence(__ATOMIC_RELEASE, "agent");
            asm volatile("s_waitcnt vmcnt(0)" ::: "memory");
            const unsigned og = xb_add(&bar[XB_TOP], 1u);
            const unsigned tg = og / nx;
            if (og + 1u == (tg + 1u) * nx) xb_add(&bar[XB_TOPGEN], 1u);
            else XB_SPIN(xb_ld(&bar[XB_TOPGEN]) == tg, bar);
            __builtin_amdgcn_fence(__ATOMIC_ACQUIRE, "agent");
            xb_add(&bar[XB_XGEN(b.x)], 1u);
            asm volatile("s_waitcnt vmcnt(0)" ::: "memory");
        } else {
            XB_SPIN(xb_ld(&bar[XB_XGEN(b.x)]) == gen, bar);
            __builtin_amdgcn_fence(__ATOMIC_ACQUIRE, "agent");
            asm volatile("s_waitcnt vmcnt(0)" ::: "memory");
        }
    }
    __syncthreads();
}

#ifndef PHMASK
#define PHMASK 0xFFFFF
#endif
constexpr int PH_PER_LAYER = 10, NPHASE = 1 + 2 * PH_PER_LAYER + 1;

__global__ void __launch_bounds__(NT, 2) mega(Params pv, int ph_lo, int ph_hi) {
    cg::grid_group grid = cg::this_grid();
    XcdBarrier xb;
    {
        SMEM_DECL;
        volatile LAS unsigned* st = (volatile LAS unsigned*)((LAS unsigned char*)smem + 131072);
        if (__builtin_amdgcn_workitem_id_x() < 4) st[__builtin_amdgcn_workitem_id_x()] = 0u;
        __syncthreads();
        xb = xcd_barrier_post((unsigned*)(pv.ws + WS_BAR), st);
    }
    for (int ph = ph_lo; ph < ph_hi; ++ph) {
        if (ph == ph_lo + 1) grid.sync();
        else if (ph > ph_lo) xcd_barrier(xb);
        KP p = opaque_kp();
        unsigned char* ws = p->ws;
        bf16_t* XB = (bf16_t*)(ws + WS_XB); bf16_t* Ub = (bf16_t*)p->out;
        bf16_t* HB = (bf16_t*)(ws + WS_HB); bf16_t* PROJ = HB;
        bf16_t* CAT = (bf16_t*)(ws + WS_CAT);
        bf16_t* OG = (bf16_t*)(ws + WS_OG);
        float* LSE = (float*)(ws + WS_LSE);
        float* ST = (float*)(ws + WS_ST);
        float* DEC = (float*)(ws + WS_DEC);
        float* DT = (float*)(ws + WS_DT);
        float* X = p->out;
        float* PART = (float*)(ws + WS_PART);
        if (ph == 0) {
            weights_phase(p);
            cache_copy_phase(p);
            copy_phase(p, XB, PART);
            continue;
        }
        if (ph == NPHASE - 1) { final_phase(p, XB, X); continue; }
        const int L = (ph - 1) / PH_PER_LAYER, q = (ph - 1) % PH_PER_LAYER;
        unsigned char* wb = ws + (size_t)L * LAYER_W;
        const bf16_t* XBs = XB + (size_t)MP * DM; const bf16_t* Xs = XBs;
#ifndef REPMASK
#define REPMASK 0
#endif
        for (int rep = 0; rep < 1 + ((REPMASK >> q) & 1); ++rep)
        switch (q) {
        case 0: case 8: { EpiGU e{HB, PART}; const bf16_t* W = (const bf16_t*)(wb + (q == 0 ? OFF_WGU1 : OFF_WGU2)); gemm_phase_cont(XB, W, 1024, MP / 256, 22, e);
            for (int t = blockIdx.x; t < 176; t += gridDim.x) { const int c0 = t * 16, r0 = (c0 >> 7) * 256 + (c0 & 127); FinGU f{HB, c0}; skinny_task<2, true, 4>(XBs, DM, W, 1024, r0, r0 + 128, Xs, f); } } break;
        case 1: case 9: { EpiRes e{XB, PART, 0.5f}; const bf16_t* W = (const bf16_t*)(wb + (q == 1 ? OFF_WD1 : OFF_WD2)); gemm_phase_cont(HB, W, 2816, MP / 256, 4, e);
            for (int t = blockIdx.x; t < 64; t += gridDim.x) { FinRes f{XB, 0.5f, t * 16}; skinny_task<1, false, 11>(HB + (size_t)MP * DFF, DFF, W, 2816, t * 16, 0, nullptr, f); } } break;
        case 2: { EpiProj e{PROJ, NPROJ, PART}; const bf16_t* W = (const bf16_t*)(wb + OFF_WIN); gemm_phase_cont(XB, W, 1024, MP / 256, 10, e);
            for (int t = blockIdx.x; t < 160; t += gridDim.x) { FinProj f{PROJ, t * 16}; skinny_task<1, true, 4>(XBs, DM, W, 1024, t * 16, 0, Xs, f); } } break;
        case 3:
            prep_phase(p, L, PROJ, Ub, CAT, XB, PART, DT);
            for (int it = blockIdx.x; it < 4 * MS; it += gridDim.x) prep_sample_item(p, L, it, PROJ, Ub, CAT, XB, DT);
            break;
        case 4:
            {
                int it = blockIdx.x;
                for (; it < 160 + 512; it += gridDim.x) {
                    if (it < 128) sample_attn_item(p, L, it, PROJ, CAT);
                    else if (it < 160) sample_ssd_item(p, L, it - 128, PROJ, Ub, DT, CAT);
                    else s1_item(p, L, it - 160, Ub, DT, ST, DEC);
                }
                attn_items(it - 160 - 512, gridDim.x, PROJ, OG, LSE);
            }
            break;
        case 5: scan_phase(p, L, ST, DEC); break;
        case 6:
            for (int it = blockIdx.x; it < 1024; it += gridDim.x) {
                if (it < 512) s3_item(p, L, it, Ub, PROJ, DT, ST, CAT);
                else combine_item(it - 512, OG, LSE, CAT);
            }
            break;
        case 7: { EpiRes e{XB, PART, 1.0f}; const bf16_t* W = (const bf16_t*)(wb + OFF_WOUT); gemm_phase_cont(CAT, W, 1024, MP / 256, 4, e);
            for (int t = blockIdx.x; t < 64; t += gridDim.x) { FinRes f{XB, 1.0f, t * 16}; skinny_task<1, false, 4>(CAT + (size_t)MP * DM, DM, W, 1024, t * 16, 0, nullptr, f); } } break;
        }
    }
}

constexpr int LDS_BYTES = 131072 + 64 + 4096 + 2048;

extern "C" void kernel_launch(void* const* d_in, const int* in_sizes, int n_in, void* d_out, int out_size, void* d_ws, size_t ws_size, hipStream_t stream) {
    static int grid = 0;
    if (grid == 0) {
        if (n_in != 27 || (size_t)out_size != O_END || ws_size < WS_END) {
            fprintf(stderr, "kernel_launch: unexpected shapes n_in %d out %d ws %zu (need %zu)\n", n_in, out_size, ws_size, (size_t)WS_END); grid = -1; return; }
        int dev = 0, cus = 0, per_cu = 0;
        hipGetDevice(&dev);
        hipDeviceGetAttribute(&cus, hipDeviceAttributeMultiprocessorCount, dev);
        if (hipFuncSetAttribute((const void*)mega, hipFuncAttributeMaxDynamicSharedMemorySize, LDS_BYTES) != hipSuccess) { fprintf(stderr, "hipFuncSetAttribute failed\n"); grid = -1; return; }
        hipOccupancyMaxActiveBlocksPerMultiprocessor(&per_cu, (const void*)mega, NT, LDS_BYTES);
        if (per_cu < 1) { fprintf(stderr, "occupancy query says %d blocks/CU\n", per_cu); per_cu = 1; }
        (void)hipGetLastError();
        grid = cus;
    }
    if (grid < 0) return;
    if (hipMemsetAsync((char*)d_ws + WS_BAR, 0, 16384, stream) != hipSuccess) { fprintf(stderr, "memset failed\n"); return; }
    Params p{};
    for (int i = 0; i < 27; ++i) p.in[i] = (const float*)d_in[i];
    p.out = (float*)d_out; p.ws = (unsigned char*)d_ws;
    int lo = 0, hi = NPHASE;
    void* args[] = {&p, &lo, &hi};
    hipError_t e = hipLaunchCooperativeKernel((const void*)mega, dim3(grid), dim3(NT), args, LDS_BYTES, stream);
    if (e != hipSuccess) fprintf(stderr, "cooperative launch failed: %s (grid %d)\n", hipGetErrorString(e), grid);
}
```

```cpp
#include <hip/hip_runtime.h>
#include <hip/hip_cooperative_groups.h>
#include <cstdio>
#include <cstdint>
namespace cg = cooperative_groups;

typedef unsigned short bf16_t;
typedef short bf16x8 __attribute__((ext_vector_type(8)));
typedef float f32x4 __attribute__((ext_vector_type(4)));

#define NT 512
constexpr int MP = 32768;
constexpr int MS = 32;
constexpr int MTOK = MP + MS;
constexpr int MPAD = 33024;
constexpr int DM = 1024, DFF = 2816, NPROJ = 2560, WINLD = 2568;
constexpr float EPS = 1e-6f;

constexpr size_t SZ_WGU = 5632ull * 1024 * 2, SZ_WD = 1024ull * 2816 * 2, SZ_WIN = 2560ull * 1024 * 2, SZ_WOUT = 1024ull * 1024 * 2;
constexpr size_t OFF_WGU1 = 0, OFF_WD1 = OFF_WGU1 + SZ_WGU, OFF_WIN = OFF_WD1 + SZ_WD, OFF_WOUT = OFF_WIN + SZ_WIN,
                 OFF_WGU2 = OFF_WOUT + SZ_WOUT, OFF_WD2 = OFF_WGU2 + SZ_WGU, LAYER_W = OFF_WD2 + SZ_WD;
constexpr size_t WS_XB = 2 * LAYER_W;
constexpr size_t WS_HB = WS_XB + (size_t)MPAD * 1024 * 2;
constexpr size_t WS_CAT = WS_HB + (size_t)MPAD * 2816 * 2;
constexpr size_t WS_OG = WS_CAT + (size_t)MPAD * 1024 * 2;
constexpr size_t WS_LSE = WS_OG + 3ull * MP * 256 * 2;
constexpr size_t WS_ST = WS_LSE + 3ull * MP * 4 * 4;
constexpr size_t WS_DEC = WS_ST + 256ull * 8 * 64 * 128 * 4;
constexpr size_t WS_DT = WS_DEC + 256 * 8 * 4;
constexpr size_t WS_PART = WS_DT + (size_t)MPAD * 8 * 4;
constexpr size_t WS_WDT = WS_PART + (size_t)MP * 16 * 4;
constexpr size_t WS_BAR = WS_WDT + 2 * 16 * 1024 * 2;
constexpr size_t WS_END = WS_BAR + 16384;

constexpr size_t O_Y = 0, O_POOLP = 33587200ull, O_POOLS = 33617920ull, O_KP = 33863680ull, O_KS = 38057984ull, O_VP = 71612416ull,
                 O_VS = 75806720ull, O_CONVP = 109361152ull, O_CONVS = 109385728ull, O_SSMP = 109582336ull, O_SSMS = 110106624ull,
                 O_END = 114300928ull;

struct Params { const float* in[27]; float* out; unsigned char* ws; };
enum { I_XP = 0, I_XS, I_CPOOL, I_CK, I_CV, I_SCONV, I_SSSM, I_F1N, I_F1G, I_F1U, I_F1D, I_MIXN, I_WIN, I_POOLW, I_POOLSC, I_CONVW, I_CONVB,
       I_DTB, I_ALOG, I_DSKIP, I_SSMN, I_WOUT, I_F2N, I_F2G, I_F2U, I_F2D, I_FINN };

typedef const __attribute__((address_space(4))) Params* KP;
__device__ __forceinline__ int otid() { int t = __builtin_amdgcn_workitem_id_x(); asm volatile("" : "+v"(t)); return t; }
__device__ __forceinline__ KP opaque_kp() { KP k = (KP)__builtin_amdgcn_kernarg_segment_ptr(); asm volatile("" : "+s"(k)); return k; }
__device__ __forceinline__ float bf2f(bf16_t v) { return __uint_as_float(((unsigned)v) << 16); }
__device__ __forceinline__ unsigned pk2(float lo, float hi) { unsigned r; asm("v_cvt_pk_bf16_f32 %0, %1, %2" : "=v"(r) : "v"(lo), "v"(hi)); return r; }
__device__ __forceinline__ bf16_t f2bf(float f) { return (bf16_t)(pk2(f, 0.f) & 0xffffu); }
__device__ __forceinline__ float lo16(unsigned u) { return __uint_as_float(u << 16); }
__device__ __forceinline__ float hi16(unsigned u) { return __uint_as_float(u & 0xffff0000u); }
__device__ __forceinline__ float silu(float x) { return x * __builtin_amdgcn_rcpf(1.f + __expf(-x)); }
__device__ __forceinline__ float wave_sum(float v) {
#pragma unroll
    for (int o = 32; o > 0; o >>= 1) v += __shfl_xor(v, o);
    return v;
}
__device__ __forceinline__ float wave_max(float v) {
#pragma unroll
    for (int o = 32; o > 0; o >>= 1) v = fmaxf(v, __shfl_xor(v, o));
    return v;
}
__device__ const float ROPE_INV[32] = {1.000000000e+00f, 7.498942018e-01f, 5.623413324e-01f, 4.216965139e-01f, 3.162277639e-01f, 2.371373773e-01f, 1.778279394e-01f, 1.333521456e-01f, 1.000000015e-01f, 7.498942316e-02f, 5.623413250e-02f, 4.216964915e-02f, 3.162277490e-02f, 2.371373773e-02f, 1.778279431e-02f, 1.333521400e-02f, 9.999999776e-03f, 7.498942316e-03f, 5.623413250e-03f, 4.216964822e-03f, 3.162277630e-03f, 2.371373819e-03f, 1.778279431e-03f, 1.333521446e-03f, 1.000000047e-03f, 7.498941850e-04f, 5.623413017e-04f, 4.216965172e-04f, 3.162277571e-04f, 2.371373703e-04f, 1.778279402e-04f, 1.333521504e-04f};
__device__ __forceinline__ float rope_inv(int i) { return ROPE_INV[i]; }
__device__ __forceinline__ void rope_cs(float ang, float& c, float& s) {
    const float k = rintf(ang * 0.15915494309189535f);
    float r = fmaf(-k, 6.28318548202514648f, ang); r = fmaf(-k, -1.74845553146951715e-07f, r);
    const float f = r * 0.15915494309189535f;
    s = __builtin_amdgcn_sinf(f); c = __builtin_amdgcn_cosf(f);
}
__device__ __forceinline__ uint4 zero4() { unsigned z; asm volatile("v_mov_b32 %0, 0" : "=v"(z)); uint4 r; r.x = z; r.y = z; r.z = z; r.w = z; return r; }
#define MFMA16(a, b, c) __builtin_amdgcn_mfma_f32_16x16x32_bf16((a), (b), (c), 0, 0, 0)
#define LDS_BARRIER() do { asm volatile("s_waitcnt lgkmcnt(0)" ::: "memory"); __builtin_amdgcn_s_barrier(); asm volatile("" ::: "memory"); } while (0)
#define SMEM_DECL extern __shared__ __attribute__((aligned(16))) unsigned char smem[]

constexpr int BM = 256, BK = 64, HALF = 128, HT = HALF * BK;
__device__ __forceinline__ int lds_byte(int r, int c) { int st = (r >> 4) * 2 + (c >> 5), rr = r & 15, cc = c & 31, ob = rr * 64 + cc * 2; return st * 1024 + (ob ^ (((ob >> 9) & 1) << 5)); }
__device__ __forceinline__ void stage_rc(int b, int& R, int& C) { int st = b / 1024, sb = b % 1024, swz = sb ^ (((sb >> 9) & 1) << 5); R = (st >> 1) * 16 + swz / 64; C = (st & 1) * 32 + (swz % 64) / 2; }

__device__ __forceinline__ void tile_of(int L, int nM, int nN, int& pm, int& pn) {
    const int nwg = nM * nN; int wgid = L;
    { const int q = nwg / 8, r = nwg % 8, xcd = wgid % 8, off = wgid / 8; wgid = (xcd < r ? xcd * (q + 1) : r * (q + 1) + (xcd - r) * q) + off; }
    const int nig = 8 * nN, gid = wgid / nig, fm = gid * 8, gsz = (nM - fm) < 8 ? (nM - fm) : 8;
    pm = fm + ((wgid % nig) % gsz); pn = (wgid % nig) / gsz;
}

#define LAS __attribute__((address_space(3)))
constexpr int HTB = HALF * BK * 2;
__device__ __forceinline__ float row_rstd(const float* PART, int row) {
    const float4* pp = (const float4*)(PART + (size_t)row * 16);
    const float4 a = pp[0], b = pp[1], c = pp[2], d = pp[3];
    const float ss = ((a.x + a.y) + (a.z + a.w)) + ((b.x + b.y) + (b.z + b.w)) + ((c.x + c.y) + (c.z + c.w)) + ((d.x + d.y) + (d.z + d.w));
    return rsqrtf(ss * (1.f / 1024.f) + EPS);
}
template <class Epi>
__device__ __forceinline__ void gemm_phase(const bf16_t* A, const bf16_t* Bt, const int K, const int nM, const int nN, const Epi& epi) {
    SMEM_DECL;
    LAS unsigned char* lds = (LAS unsigned char*)smem;
    const int tid = otid(), wid = __builtin_amdgcn_readfirstlane(tid >> 6), lane = tid & 63, wr = wid >> 2, wc = wid & 3, fr = lane & 15, fq = lane >> 4;
    const int nt = K / BK, ntiles = nM * nN;
    unsigned voff[2];
#pragma unroll
    for (int i = 0; i < 2; ++i) { int R, C; stage_rc(tid * 16 + i * 8192, R, C); voff[i] = (unsigned)(R * K + C) * 2u; }
    const size_t kstep = (size_t)(BK * 2), hstep = (size_t)HALF * K * 2;
    const unsigned ldsw = (unsigned)wid * 1024u;
    const int aoff = lds_byte(wr * 64 + fr, fq * 8), boff = lds_byte(wc * 32 + fr, fq * 8);
#define GSA(b, h) (((b) * 2 + (h)) * HTB)
#define GSB(b, h) ((4 + (b) * 2 + (h)) * HTB)
#define STAGE(bufoff, gbase) do { _Pragma("unroll") for (int _i = 0; _i < 2; ++_i) \
    __builtin_amdgcn_global_load_lds((const unsigned*)((const char*)(gbase) + voff[_i]), (LAS unsigned*)(lds + (bufoff) + ldsw + _i * 8192), 16, 0, 0); } while (0)
#define LDA(dst, b, h) do { _Pragma("unroll") for (int m = 0; m < 4; ++m) _Pragma("unroll") for (int k = 0; k < 2; ++k) dst[m][k] = *(const LAS bf16x8*)(lds + GSA(b, h) + aoff + m * 2048 + k * 1024); } while (0)
#define LDB(dst, b, h) do { _Pragma("unroll") for (int n = 0; n < 2; ++n) _Pragma("unroll") for (int k = 0; k < 2; ++k) dst[n][k] = *(const LAS bf16x8*)(lds + GSB(b, h) + boff + n * 2048 + k * 1024); } while (0)
#define MMA(ai, bj, At_, Bt_) do { __builtin_amdgcn_s_setprio(1); _Pragma("unroll") for (int m = 0; m < 4; ++m) _Pragma("unroll") for (int n = 0; n < 2; ++n) _Pragma("unroll") for (int k = 0; k < 2; ++k) \
      acc[ai][bj][m][n] = __builtin_amdgcn_mfma_f32_16x16x32_bf16(Bt_[n][k], At_[m][k], acc[ai][bj][m][n], 0, 0, 0); \
    __builtin_amdgcn_s_setprio(0); } while (0)
#define WAIT_V(n) asm volatile("s_waitcnt vmcnt(" #n ")" ::: "memory")
#define WAIT_L(n) asm volatile("s_waitcnt lgkmcnt(" #n ")" ::: "memory")
#define BAR __builtin_amdgcn_s_barrier()
#define SCHED __builtin_amdgcn_sched_barrier(0)
    int L = blockIdx.x;
    WAIT_V(0); __syncthreads();
    if (L >= ntiles) return;
    int pm, pn; tile_of(L, nM, nN, pm, pn);
    const char* cA = (const char*)A + (size_t)(pm * 256) * K * 2;
    const char* cB = (const char*)Bt + (size_t)(pn * 256) * K * 2;
    STAGE(GSB(0, 0), cB); STAGE(GSA(0, 0), cA); STAGE(GSB(0, 1), cB + hstep); STAGE(GSA(0, 1), cA + hstep);
    float* rsb = (float*)(smem + 131072 + 64 + 4096);
    int rbuf = 0;
    if (Epi::NEEDS_RS && tid < 256) rsb[tid] = row_rstd(epi.PART, pm * 256 + tid);
    bool first = true;
    for (;;) {
        f32x4 acc[2][2][4][2];
#pragma unroll
        for (int a = 0; a < 2; ++a)
#pragma unroll
            for (int b = 0; b < 2; ++b)
#pragma unroll
                for (int m = 0; m < 4; ++m)
#pragma unroll
                    for (int n = 0; n < 2; ++n) acc[a][b][m][n] = (f32x4){0.f, 0.f, 0.f, 0.f};
        bf16x8 At[4][2], B0[2][2], B1[2][2];
        if (wr == 1) BAR;
        if (first) { WAIT_V(4); } else { asm volatile("s_waitcnt vmcnt(%0)" :: "n"(Epi::NST) : "memory"); }
        BAR;
        STAGE(GSB(1, 0), cB + kstep); STAGE(GSA(1, 0), cA + kstep); STAGE(GSB(1, 1), cB + hstep + kstep);
        WAIT_V(6); BAR;
        for (int t = 0; t < nt - 2; t += 2) {
            const char* a1 = cA + (size_t)(t + 1) * kstep; const char* a2 = a1 + kstep; const char* a3 = a2 + kstep;
            const char* b2 = cB + (size_t)(t + 2) * kstep; const char* b3 = b2 + kstep;
            LDB(B0, 0, 0); SCHED; LDA(At, 0, 0); STAGE(GSA(1, 1), a1 + hstep);
            WAIT_L(8); BAR; WAIT_L(0); MMA(0, 0, At, B0); BAR; SCHED;
            LDB(B1, 0, 1); STAGE(GSB(0, 0), b2);
            BAR; WAIT_L(0); MMA(0, 1, At, B1); BAR;
            LDA(At, 0, 1); STAGE(GSA(0, 0), a2);
            BAR; WAIT_L(0); MMA(1, 0, At, B0); BAR; SCHED;
            STAGE(GSB(0, 1), b2 + hstep);
            WAIT_V(6); BAR; MMA(1, 1, At, B1); BAR;
            LDB(B0, 1, 0); SCHED; LDA(At, 1, 0); STAGE(GSA(0, 1), a2 + hstep);
            WAIT_L(8); BAR; WAIT_L(0); MMA(0, 0, At, B0); BAR; SCHED;
            LDB(B1, 1, 1); STAGE(GSB(1, 0), b3);
            BAR; WAIT_L(0); MMA(0, 1, At, B1); BAR;
            LDA(At, 1, 1); STAGE(GSA(1, 0), a3);
            BAR; WAIT_L(0); MMA(1, 0, At, B0); BAR; SCHED;
            STAGE(GSB(1, 1), b3 + hstep);
            WAIT_V(6); BAR; MMA(1, 1, At, B1); BAR;
        }
        { LDB(B0, 0, 0); LDA(At, 0, 0); STAGE(GSA(1, 1), cA + (size_t)(nt - 1) * kstep + hstep);
          BAR; WAIT_L(0); MMA(0, 0, At, B0); BAR;
          LDB(B1, 0, 1); BAR; WAIT_L(0); MMA(0, 1, At, B1); BAR;
          LDA(At, 0, 1); WAIT_V(4); BAR; WAIT_L(0); MMA(1, 0, At, B0); MMA(1, 1, At, B1); BAR; }
        { LDB(B0, 1, 0); LDA(At, 1, 0); WAIT_V(2); BAR; WAIT_L(0); MMA(0, 0, At, B0); BAR;
          LDB(B1, 1, 1); WAIT_V(0); BAR; WAIT_L(0); MMA(0, 1, At, B1); BAR;
          LDA(At, 1, 1); BAR; WAIT_L(0); MMA(1, 0, At, B0); MMA(1, 1, At, B1); BAR; }
        if (wr == 0) BAR;
        const int brow = pm * 256, bcol = pn * 256;
        L += gridDim.x;
        const bool more = L < ntiles;
        if (more) {
            tile_of(L, nM, nN, pm, pn);
            cA = (const char*)A + (size_t)(pm * 256) * K * 2; cB = (const char*)Bt + (size_t)(pn * 256) * K * 2;
            STAGE(GSB(0, 0), cB); STAGE(GSA(0, 0), cA); STAGE(GSB(0, 1), cB + hstep); STAGE(GSA(0, 1), cA + hstep);
            SCHED;
        }
        float rs_next = 0.f;
        if (Epi::NEEDS_RS && more && tid < 256) rs_next = row_rstd(epi.PART, pm * 256 + tid);
        epi(acc, brow, bcol, wr, wc, fr, fq, rsb + rbuf * 256);
        SCHED;
        if (!more) break;
        if (Epi::NEEDS_RS && tid < 256) rsb[(rbuf ^ 1) * 256 + tid] = rs_next;
        rbuf ^= 1;
        first = false;
    }
    asm volatile("s_waitcnt vmcnt(0)" ::: "memory");
    __syncthreads();
}

template <class Epi>
__device__ __forceinline__ void gemm_phase_cont(const bf16_t* A, const bf16_t* Bt, const int K, const int nM, const int nN, const Epi& epi) {
    SMEM_DECL;
    LAS unsigned char* lds = (LAS unsigned char*)smem;
    const int tid = otid(), wid = __builtin_amdgcn_readfirstlane(tid >> 6), lane = tid & 63, wr = wid >> 2, wc = wid & 3, fr = lane & 15, fq = lane >> 4;
    const int nt = K / BK, ntiles = nM * nN;
    unsigned voff[2];
#pragma unroll
    for (int i = 0; i < 2; ++i) { int R, C; stage_rc(tid * 16 + i * 8192, R, C); voff[i] = (unsigned)(R * K + C) * 2u; }
    const size_t kstep = (size_t)(BK * 2), hstep = (size_t)HALF * K * 2;
    const unsigned ldsw = (unsigned)wid * 1024u;
    const int aoff = lds_byte(wr * 64 + fr, fq * 8), boff = lds_byte(wc * 32 + fr, fq * 8);
    int L = blockIdx.x;
    WAIT_V(0); __syncthreads();
    if (L >= ntiles) return;
    int pm, pn; tile_of(L, nM, nN, pm, pn);
    const char* cA = (const char*)A + (size_t)(pm * 256) * K * 2;
    const char* cB = (const char*)Bt + (size_t)(pn * 256) * K * 2;
    f32x4 acc[2][2][4][2];
#pragma unroll
    for (int a = 0; a < 2; ++a)
#pragma unroll
        for (int b = 0; b < 2; ++b)
#pragma unroll
            for (int m = 0; m < 4; ++m)
#pragma unroll
                for (int n = 0; n < 2; ++n) acc[a][b][m][n] = (f32x4){0.f, 0.f, 0.f, 0.f};
    bf16x8 At[4][2], B0[2][2], B1[2][2];
    float* rsb = (float*)(smem + 131072 + 64 + 4096);
    int rbuf = 0;
    float rs0 = 0.f;
    if (Epi::NEEDS_RS && tid < 256) rs0 = row_rstd(epi.PART, pm * 256 + tid);
    STAGE(GSB(0, 0), cB); STAGE(GSB(0, 1), cB + hstep); STAGE(GSA(0, 0), cA); STAGE(GSA(0, 1), cA + hstep);
    if (wr == 1) BAR;
    WAIT_V(2); BAR;
    STAGE(GSB(1, 0), cB + kstep); STAGE(GSA(1, 0), cA + kstep); STAGE(GSB(1, 1), cB + hstep + kstep);
    WAIT_V(6); BAR;
    if (Epi::NEEDS_RS && tid < 256) rsb[tid] = rs0;
    for (;;) {
        const int Ln = L + gridDim.x; const bool has_next = Ln < ntiles;
        int npm = pm, npn = pn; if (has_next) tile_of(Ln, nM, nN, npm, npn);
        const char* nA = (const char*)A + (size_t)(npm * 256) * K * 2; const char* nB = (const char*)Bt + (size_t)(npn * 256) * K * 2;
        for (int t = 0; t < nt; t += 2) {
            const bool last = (t == nt - 2);
            const char* a1 = cA + (size_t)(t + 1) * kstep;
            const char* a2 = last ? nA : cA + (size_t)(t + 2) * kstep; const char* b2 = last ? nB : cB + (size_t)(t + 2) * kstep;
            const char* a3 = a2 + kstep; const char* b3 = b2 + kstep;
            LDB(B0, 0, 0); LDB(B1, 0, 1); SCHED; LDA(At, 0, 0); STAGE(GSA(1, 1), a1 + hstep);
            WAIT_V(8); WAIT_L(0); BAR; MMA(0, 0, At, B0); MMA(0, 1, At, B1); BAR; SCHED;
            LDA(At, 0, 1); STAGE(GSB(0, 0), b2); STAGE(GSB(0, 1), b2 + hstep); STAGE(GSA(0, 0), a2);
            WAIT_V(8); WAIT_L(0); BAR; MMA(1, 0, At, B0); MMA(1, 1, At, B1); BAR; SCHED;
            LDB(B0, 1, 0); LDB(B1, 1, 1); SCHED; LDA(At, 1, 0); STAGE(GSA(0, 1), a2 + hstep);
            WAIT_V(8); WAIT_L(0); BAR; MMA(0, 0, At, B0); MMA(0, 1, At, B1); BAR; SCHED;
            LDA(At, 1, 1); STAGE(GSB(1, 0), b3); STAGE(GSB(1, 1), b3 + hstep); STAGE(GSA(1, 0), a3);
            WAIT_V(8); WAIT_L(0); BAR; MMA(1, 0, At, B0); MMA(1, 1, At, B1); BAR; SCHED;
        }
        if (wr == 0) BAR;
        float rs_next = 0.f;
        if (Epi::NEEDS_RS && has_next && tid < 256) rs_next = row_rstd(epi.PART, npm * 256 + tid);
        epi(acc, pm * 256, pn * 256, wr, wc, fr, fq, rsb + rbuf * 256);
        SCHED;
        if (!has_next) break;
        if (Epi::NEEDS_RS && tid < 256) rsb[(rbuf ^ 1) * 256 + tid] = rs_next;
        rbuf ^= 1;
#pragma unroll
        for (int a = 0; a < 2; ++a)
#pragma unroll
            for (int b = 0; b < 2; ++b)
#pragma unroll
                for (int m = 0; m < 4; ++m)
#pragma unroll
                    for (int n = 0; n < 2; ++n) acc[a][b][m][n] = (f32x4){0.f, 0.f, 0.f, 0.f};
        L = Ln; pm = npm; pn = npn; cA = nA; cB = nB;
        if (wr == 1) BAR;
    }
    WAIT_V(0);
    BAR;
    __syncthreads();
}

struct EpiGU {
    static constexpr int NST = 16; static constexpr bool NEEDS_RS = true;
    bf16_t* __restrict__ H; const float* __restrict__ PART;
    __device__ __forceinline__ void operator()(const f32x4 (&acc)[2][2][4][2], int brow, int bcol, int wr, int wc, int fr, int fq, const float* rsl) const {
        const int cbase = (bcol >> 8) * 128 + wc * 32 + fq * 8;
        float rs[2][4];
#pragma unroll
        for (int ai = 0; ai < 2; ++ai)
#pragma unroll
            for (int m = 0; m < 4; ++m) rs[ai][m] = rsl[ai * 128 + wr * 64 + m * 16 + fr];
#pragma unroll
        for (int ai = 0; ai < 2; ++ai)
#pragma unroll
            for (int m = 0; m < 4; ++m) {
                const int row = brow + ai * 128 + wr * 64 + m * 16 + fr;
                const f32x4 g0 = acc[ai][0][m][0] * rs[ai][m], u0 = acc[ai][1][m][0] * rs[ai][m], g1 = acc[ai][0][m][1] * rs[ai][m], u1 = acc[ai][1][m][1] * rs[ai][m];
                uint4 o; o.x = pk2(silu(g0[0]) * u0[0], silu(g0[1]) * u0[1]); o.y = pk2(silu(g0[2]) * u0[2], silu(g0[3]) * u0[3]);
                o.z = pk2(silu(g1[0]) * u1[0], silu(g1[1]) * u1[1]); o.w = pk2(silu(g1[2]) * u1[2], silu(g1[3]) * u1[3]);
                *(uint4*)(H + (size_t)row * DFF + cbase) = o;
            }
    }
};
struct EpiRes {
    static constexpr int NST = 16; static constexpr bool NEEDS_RS = false;
    bf16_t* XB; float* PART; float scale;
    __device__ __forceinline__ void operator()(const f32x4 (&acc)[2][2][4][2], int brow, int bcol, int wr, int wc, int fr, int fq, const float*) const {
        uint4 v[2][4][2];
#pragma unroll
        for (int ai = 0; ai < 2; ++ai)
#pragma unroll
            for (int m = 0; m < 4; ++m)
#pragma unroll
                for (int bj = 0; bj < 2; ++bj)
                    v[ai][m][bj] = *(const uint4*)(XB + (size_t)(brow + ai * 128 + wr * 64 + m * 16 + fr) * DM + bcol + bj * 128 + wc * 32 + fq * 8);
#pragma unroll
        for (int ai = 0; ai < 2; ++ai)
#pragma unroll
            for (int m = 0; m < 4; ++m) {
                const int row = brow + ai * 128 + wr * 64 + m * 16 + fr;
                float ss = 0.f;
#pragma unroll
                for (int bj = 0; bj < 2; ++bj) {
                    const uint4 xv = v[ai][m][bj]; const f32x4 a0 = acc[ai][bj][m][0], a1 = acc[ai][bj][m][1];
                    uint4 o; o.x = pk2(lo16(xv.x) + scale * a0[0], hi16(xv.x) + scale * a0[1]); o.y = pk2(lo16(xv.y) + scale * a0[2], hi16(xv.y) + scale * a0[3]);
                    o.z = pk2(lo16(xv.z) + scale * a1[0], hi16(xv.z) + scale * a1[1]); o.w = pk2(lo16(xv.w) + scale * a1[2], hi16(xv.w) + scale * a1[3]);
                    *(uint4*)(XB + (size_t)row * DM + bcol + bj * 128 + wc * 32 + fq * 8) = o;
                    const float r0 = lo16(o.x), r1 = hi16(o.x), r2 = lo16(o.y), r3 = hi16(o.y), r4 = lo16(o.z), r5 = hi16(o.z), r6 = lo16(o.w), r7 = hi16(o.w);
                    ss += (r0 * r0 + r1 * r1) + (r2 * r2 + r3 * r3) + (r4 * r4 + r5 * r5) + (r6 * r6 + r7 * r7);
                }
                ss += __shfl_xor(ss, 16); ss += __shfl_xor(ss, 32);
                if (fq == 0) PART[(size_t)row * 16 + (bcol >> 8) * 4 + wc] = ss;
            }
    }
};
struct EpiProj {
    static constexpr int NST = 32; static constexpr bool NEEDS_RS = true;
    bf16_t* __restrict__ P; int ld; const float* __restrict__ PART;
    __device__ __forceinline__ void operator()(const f32x4 (&acc)[2][2][4][2], int brow, int bcol, int wr, int wc, int fr, int fq, const float* rsl) const {
        float rs[2][4];
#pragma unroll
        for (int ai = 0; ai < 2; ++ai)
#pragma unroll
            for (int m = 0; m < 4; ++m) rs[ai][m] = rsl[ai * 128 + wr * 64 + m * 16 + fr];
#pragma unroll
        for (int ai = 0; ai < 2; ++ai)
#pragma unroll
            for (int m = 0; m < 4; ++m) {
                const int row = brow + ai * 128 + wr * 64 + m * 16 + fr;
#pragma unroll
                for (int bj = 0; bj < 2; ++bj) {
                    const f32x4 a0 = acc[ai][bj][m][0] * rs[ai][m], a1 = acc[ai][bj][m][1] * rs[ai][m];
                    uint4 o; o.x = pk2(a0[0], a0[1]); o.y = pk2(a0[2], a0[3]); o.z = pk2(a1[0], a1[1]); o.w = pk2(a1[2], a1[3]);
                    *(uint4*)(P + (size_t)row * ld + bcol + bj * 128 + wc * 32 + fq * 8) = o;
                }
            }
    }
};

template <int NB, bool RS, int NKS, class Fin>
__device__ __forceinline__ void skinny_task(const bf16_t* __restrict__ A, int lda, const bf16_t* __restrict__ Bt, int K, int brow0, int brow1, const bf16_t* Xs, const Fin& fin) {
    SMEM_DECL;
    float* red = (float*)smem;
    float* rsd = red + 8 * NB * 2 * 64 * 4;
    const int tid = otid(), lane = tid & 63, w = tid >> 6, fr = lane & 15, fq = lane >> 4;
    const int kw = K >> 3;
    f32x4 acc[NB][2];
#pragma unroll
    for (int nb = 0; nb < NB; ++nb) { acc[nb][0] = (f32x4){0.f, 0.f, 0.f, 0.f}; acc[nb][1] = (f32x4){0.f, 0.f, 0.f, 0.f}; }
    __syncthreads();
    float rsv[4];
    if (RS) {
#pragma unroll
        for (int rr = 0; rr < 4; ++rr) {
            const bf16_t* xr = Xs + (size_t)(w * 4 + rr) * DM;
            float ss = 0.f;
#pragma unroll
            for (int i = 0; i < 2; ++i) { const uint4 v = *(const uint4*)(xr + i * 512 + lane * 8);
                ss += lo16(v.x) * lo16(v.x) + hi16(v.x) * hi16(v.x) + lo16(v.y) * lo16(v.y) + hi16(v.y) * hi16(v.y) + lo16(v.z) * lo16(v.z) + hi16(v.z) * hi16(v.z) + lo16(v.w) * lo16(v.w) + hi16(v.w) * hi16(v.w); }
            rsv[rr] = ss;
        }
    }
    {
        bf16x8 a0[NKS], a1[NKS], b0[NKS], b1[NKS];
#pragma unroll
        for (int ks = 0; ks < NKS; ++ks) {
            const int k0 = w * kw + ks * 32 + fq * 8;
            a0[ks] = *(const bf16x8*)(A + (size_t)fr * lda + k0); a1[ks] = *(const bf16x8*)(A + (size_t)(16 + fr) * lda + k0);
            b0[ks] = *(const bf16x8*)(Bt + (size_t)(brow0 + fr) * K + k0);
            if (NB == 2) b1[ks] = *(const bf16x8*)(Bt + (size_t)(brow1 + fr) * K + k0);
        }
#pragma unroll
        for (int ks = 0; ks < NKS; ++ks) {
            acc[0][0] = MFMA16(b0[ks], a0[ks], acc[0][0]); acc[0][1] = MFMA16(b0[ks], a1[ks], acc[0][1]);
            if (NB == 2) { acc[NB - 1][0] = MFMA16(b1[ks], a0[ks], acc[NB - 1][0]); acc[NB - 1][1] = MFMA16(b1[ks], a1[ks], acc[NB - 1][1]); }
        }
    }
    if (RS) {
#pragma unroll
        for (int rr = 0; rr < 4; ++rr) { const float ss = wave_sum(rsv[rr]); if (lane == 0) rsd[w * 4 + rr] = rsqrtf(ss * (1.f / 1024.f) + EPS); }
    }
#pragma unroll
    for (int nb = 0; nb < NB; ++nb)
#pragma unroll
        for (int mt = 0; mt < 2; ++mt) { float4 v; v.x = acc[nb][mt][0]; v.y = acc[nb][mt][1]; v.z = acc[nb][mt][2]; v.w = acc[nb][mt][3];
            *(float4*)(red + (((w * NB + nb) * 2 + mt) * 64 + lane) * 4) = v; }
    __syncthreads();
    {
        const int mt = tid >> 8, ln = (tid >> 2) & 63, jj = tid & 3;
        float v0 = 0.f, v1 = 0.f;
#pragma unroll
        for (int ww = 0; ww < 8; ++ww) {
            v0 += red[(((ww * NB + 0) * 2 + mt) * 64 + ln) * 4 + jj];
            if (NB == 2) v1 += red[(((ww * NB + NB - 1) * 2 + mt) * 64 + ln) * 4 + jj];
        }
        const float rs = RS ? rsd[mt * 16 + (ln & 15)] : 1.f;
        fin(mt * 16 + (ln & 15), (ln >> 4) * 4 + jj, v0 * rs, v1 * rs);
    }
}

struct FinGU { bf16_t* H; int c0; __device__ __forceinline__ void operator()(int m, int j, float g, float u) const { const int col = (c0 & ~31) + 8 * (j >> 2) + 4 * ((c0 >> 4) & 1) + (j & 3); H[(size_t)(MP + m) * DFF + col] = f2bf(silu(g) * u); } };
struct FinRes { bf16_t* XB; float scale; int c0; __device__ __forceinline__ void operator()(int m, int j, float v, float) const { const size_t o = (size_t)(MP + m) * DM + (c0 & ~31) + 8 * (j >> 2) + 4 * ((c0 >> 4) & 1) + (j & 3); XB[o] = f2bf(bf2f(XB[o]) + scale * v); } };
struct FinProj { bf16_t* P; int c0; __device__ __forceinline__ void operator()(int m, int j, float v, float) const { const int col = (c0 & ~31) + 8 * (j >> 2) + 4 * ((c0 >> 4) & 1) + (j & 3); P[(size_t)(MP + m) * NPROJ + col] = f2bf(v); } };

__device__ __forceinline__ void transpose_tile(const float* __restrict__ src, int ldn, int K, int k0, int c0, bf16_t* __restrict__ dst, int drow0, const float* __restrict__ gk, bool perm) {
    SMEM_DECL;
    float* tile = (float*)smem;
    const int tid = otid();
    __syncthreads();
    {
        float4 v[8];
#pragma unroll
        for (int r = 0; r < 8; ++r) { const int id = tid + r * NT, k = id >> 4, n4 = (id & 15) * 4; v[r] = *(const float4*)(src + (size_t)(k0 + k) * ldn + c0 + n4); }
#pragma unroll
        for (int r = 0; r < 8; ++r) { const int id = tid + r * NT, k = id >> 4, n4 = (id & 15) * 4; const float gs = gk ? gk[k0 + k] : 1.f;
            float* t = tile + k * 65 + n4; t[0] = v[r].x * gs; t[1] = v[r].y * gs; t[2] = v[r].z * gs; t[3] = v[r].w * gs; }
    }
    __syncthreads();
#pragma unroll
    for (int r = 0; r < 4; ++r) {
        const int id = tid + r * NT, a = id & 3, n16 = (id >> 2) & 15, rest = id >> 6, n = (rest & 3) * 16 + n16, kc = (rest >> 2) * 4 + a;
        const int c32 = n & 31, nd = perm ? (n & ~31) + 16 * ((c32 >> 2) & 1) + 4 * (c32 >> 3) + (c32 & 3) : n;
        const float* t = tile + (8 * kc) * 65 + n;
        uint4 o; o.x = pk2(t[0], t[65]); o.y = pk2(t[130], t[195]); o.z = pk2(t[260], t[325]); o.w = pk2(t[390], t[455]);
        *(uint4*)(dst + (size_t)(drow0 + nd) * K + k0 + 8 * kc) = o;
    }
}

struct WtItem { const float* src; const float* gk; bf16_t* dst; int ldn, K, k0, c0, drow0; };
__device__ __forceinline__ void wt_decode(KP p, int it, WtItem& w) {
    const int L = it / 1280; int r = it % 1280;
    unsigned char* wb = p->ws + (size_t)L * LAYER_W;
    if (r < 528 || r >= 752) {
        const bool second = r >= 752; if (second) r -= 752;
        if (r < 352) { const bool up = r >= 176; if (up) r -= 176; const int kt = r / 44, nt = r % 44, c0 = nt * 64;
            w.src = (up ? (second ? p->in[I_F2U] : p->in[I_F1U]) : (second ? p->in[I_F2G] : p->in[I_F1G])) + (size_t)L * 1024 * 2816;
            w.ldn = 2816; w.K = 1024; w.k0 = kt * 256; w.c0 = c0; w.dst = (bf16_t*)(wb + (second ? OFF_WGU2 : OFF_WGU1));
            w.drow0 = (c0 >> 7) * 256 + (c0 & 127) + (up ? 128 : 0); w.gk = (second ? p->in[I_F2N] : p->in[I_F1N]) + L * 1024; }
        else { r -= 352; const int kt = r / 16, nt = r % 16;
            w.src = (second ? p->in[I_F2D] : p->in[I_F1D]) + (size_t)L * 2816 * 1024; w.ldn = 1024; w.K = 2816; w.k0 = kt * 256; w.c0 = nt * 64;
            w.dst = (bf16_t*)(wb + (second ? OFF_WD2 : OFF_WD1)); w.drow0 = nt * 64; w.gk = nullptr; }
    } else if (r < 688) { r -= 528; const int kt = r / 40, nt = r % 40;
        w.src = p->in[I_WIN] + (size_t)L * 1024 * WINLD; w.ldn = WINLD; w.K = 1024; w.k0 = kt * 256; w.c0 = nt * 64; w.dst = (bf16_t*)(wb + OFF_WIN); w.drow0 = nt * 64; w.gk = p->in[I_MIXN] + L * 1024;
    } else { r -= 688; const int kt = r / 16, nt = r % 16;
        w.src = p->in[I_WOUT] + (size_t)L * 1024 * 1024; w.ldn = 1024; w.K = 1024; w.k0 = kt * 256; w.c0 = nt * 64; w.dst = (bf16_t*)(wb + OFF_WOUT); w.drow0 = nt * 64; w.gk = nullptr; }
}
#define WT_LOAD(W) do { _Pragma("unroll") for (int r_ = 0; r_ < 8; ++r_) { const int id_ = tid + r_ * NT, k_ = id_ >> 4, n4_ = (id_ & 15) * 4; \
        wv[r_] = *(const float4*)((W).src + (size_t)((W).k0 + k_) * (W).ldn + (W).c0 + n4_); } } while (0)
__device__ void weights_phase(KP p) {
    SMEM_DECL;
    float* tile = (float*)smem;
    const int tid = otid();
    int it = blockIdx.x;
    WtItem cur, nxt;
    float4 wv[8];
    if (it < 2 * 1280) { wt_decode(p, it, cur); WT_LOAD(cur); }
    while (it < 2 * 1280) {
        LDS_BARRIER();
#pragma unroll
        for (int r = 0; r < 8; ++r) { const int id = tid + r * NT, k = id >> 4, n4 = (id & 15) * 4; const float gs = cur.gk ? cur.gk[cur.k0 + k] : 1.f;
            float* t = tile + k * 65 + n4; t[0] = wv[r].x * gs; t[1] = wv[r].y * gs; t[2] = wv[r].z * gs; t[3] = wv[r].w * gs; }
        const int itn = it + gridDim.x;
        if (itn < 2 * 1280) { wt_decode(p, itn, nxt); WT_LOAD(nxt); }
        LDS_BARRIER();
#pragma unroll
        for (int r = 0; r < 4; ++r) {
            const int id = tid + r * NT, a = id & 3, n16 = (id >> 2) & 15, rest = id >> 6, n = (rest & 3) * 16 + n16, kc = (rest >> 2) * 4 + a;
            const int c32 = n & 31, nd = (n & ~31) + 16 * ((c32 >> 2) & 1) + 4 * (c32 >> 3) + (c32 & 3);
            const float* t = tile + (8 * kc) * 65 + n;
            uint4 o; o.x = pk2(t[0], t[65]); o.y = pk2(t[130], t[195]); o.z = pk2(t[260], t[325]); o.w = pk2(t[390], t[455]);
            *(uint4*)(cur.dst + (size_t)(cur.drow0 + nd) * cur.K + cur.k0 + 8 * kc) = o;
        }
        it = itn; cur = nxt;
    }
    __syncthreads();
    for (int e = blockIdx.x * NT + otid(); e < 2 * 16 * 1024; e += gridDim.x * NT) {
        const int L = e >> 14, h = (e >> 10) & 15, k = e & 1023;
        ((bf16_t*)(p->ws + WS_WDT))[e] = h < 8 ? f2bf(p->in[I_WIN][((size_t)L * 1024 + k) * WINLD + 2560 + h] * p->in[I_MIXN][L * 1024 + k]) : (bf16_t)0;
    }
    __syncthreads();
}

__device__ void cache_copy_phase(KP p) {
    constexpr unsigned per = 2047u * 256u / 4u;
    constexpr unsigned total = 128u * per;
    const unsigned stride = gridDim.x * NT;
    const float* ck = p->in[I_CK]; const float* cv = p->in[I_CV]; float* out = p->out;
#define CC_IDX(j) unsigned i##j = ib + (j) * stride; i##j = i##j < total ? i##j : total - 1u; \
    const unsigned seg##j = i##j / per, e##j = i##j % per, kv##j = seg##j >> 6, ln##j = seg##j & 63u; \
    const float4* s##j = (const float4*)((kv##j ? cv : ck) + (size_t)ln##j * 2048 * 256 + 256) + e##j; \
    float4* d##j = (float4*)(out + (kv##j ? O_VS : O_KS) + (size_t)ln##j * 2048 * 256) + e##j;
    for (unsigned ib = blockIdx.x * NT + otid(); ib < total; ib += 8u * stride) {
        CC_IDX(0) CC_IDX(1) CC_IDX(2) CC_IDX(3) CC_IDX(4) CC_IDX(5) CC_IDX(6) CC_IDX(7)
        const float4 v0 = *s0, v1 = *s1, v2 = *s2, v3 = *s3, v4 = *s4, v5 = *s5, v6 = *s6, v7 = *s7;
        *d0 = v0; *d1 = v1; *d2 = v2; *d3 = v3; *d4 = v4; *d5 = v5; *d6 = v6; *d7 = v7;
    }
#undef CC_IDX
}

__device__ void copy_phase(KP p, bf16_t* XB, float* PART) {
    const int lane = otid() & 63, wave = otid() >> 6;
    const int nw = gridDim.x * 8;
    for (int row0 = blockIdx.x * 8 + wave; row0 < MTOK; row0 += 4 * nw) {
        float4 v[4][4];
#pragma unroll
        for (int r = 0; r < 4; ++r) {
            int row = row0 + r * nw; row = row < MTOK ? row : MTOK - 1;
            const float* src = row < MP ? p->in[I_XP] + (size_t)row * DM : p->in[I_XS] + (size_t)(row - MP) * DM;
#pragma unroll
            for (int i = 0; i < 4; ++i) v[r][i] = *(const float4*)(src + i * 256 + lane * 4);
        }
#pragma unroll
        for (int r = 0; r < 4; ++r) {
            int row = row0 + r * nw; row = row < MTOK ? row : MTOK - 1;
            float ss = 0.f;
#pragma unroll
            for (int i = 0; i < 4; ++i) ss += v[r][i].x * v[r][i].x + v[r][i].y * v[r][i].y + v[r][i].z * v[r][i].z + v[r][i].w * v[r][i].w;
            ss = wave_sum(ss);
#pragma unroll
            for (int i = 0; i < 4; ++i) { uint2 o; o.x = pk2(v[r][i].x, v[r][i].y); o.y = pk2(v[r][i].z, v[r][i].w); *(uint2*)(XB + (size_t)row * DM + i * 256 + lane * 4) = o; }
            if (row < MP && lane < 16) PART[(size_t)row * 16 + lane] = lane == 0 ? ss : 0.f;
        }
    }
}
__device__ void final_phase(KP p, const bf16_t* XB, float* Y) {
    const int lane = otid() & 63, wave = otid() >> 6;
    const int nw = gridDim.x * 8;
    float4 gv[4];
#pragma unroll
    for (int i = 0; i < 4; ++i) gv[i] = *(const float4*)(p->in[I_FINN] + i * 256 + lane * 4);
    for (int row0 = blockIdx.x * 8 + wave; row0 < MTOK; row0 += 4 * nw) {
        uint2 u[4][4];
#pragma unroll
        for (int r = 0; r < 4; ++r) {
            int row = row0 + r * nw; row = row < MTOK ? row : MTOK - 1;
#pragma unroll
            for (int i = 0; i < 4; ++i) u[r][i] = *(const uint2*)(XB + (size_t)row * DM + i * 256 + lane * 4);
        }
#pragma unroll
        for (int r = 0; r < 4; ++r) {
            int row = row0 + r * nw; row = row < MTOK ? row : MTOK - 1;
            float4 v[4]; float ss = 0.f;
#pragma unroll
            for (int i = 0; i < 4; ++i) { v[i] = make_float4(lo16(u[r][i].x), hi16(u[r][i].x), lo16(u[r][i].y), hi16(u[r][i].y)); ss += v[i].x * v[i].x + v[i].y * v[i].y + v[i].z * v[i].z + v[i].w * v[i].w; }
            ss = wave_sum(ss);
            const float rstd = rsqrtf(ss * (1.f / 1024.f) + EPS);
#pragma unroll
            for (int i = 0; i < 4; ++i) { float4 o; o.x = v[i].x * rstd * gv[i].x; o.y = v[i].y * rstd * gv[i].y; o.z = v[i].z * rstd * gv[i].z; o.w = v[i].w * rstd * gv[i].w;
                *(float4*)(Y + (size_t)row * DM + i * 256 + lane * 4) = o; }
        }
    }
}

__device__ void prep_phase(KP p, int L, bf16_t* PROJ, bf16_t* U, bf16_t* CAT, const bf16_t* XB, const float* PART, float* DT) {
    SMEM_DECL;
    float* PW = (float*)smem; float* XA = PW + 16384; float* Dm = XA + 31 * 256; float* CS = Dm + 4096; float* INV = CS + 1024; float* DTP = INV + 32;
    const int tid = otid(), lane = tid & 63, w = tid >> 6, fr = lane & 15, fq = lane >> 4;
    __syncthreads();
    bf16_t* PWT = (bf16_t*)PW;
    bf16_t* DmB = (bf16_t*)Dm;
    {
        const float4* pw4 = (const float4*)(p->in[I_POOLW] + L * 16384);
        const float4 q0 = pw4[tid], q1 = pw4[tid + 512], q2 = pw4[tid + 1024], q3 = pw4[tid + 1536], q4 = pw4[tid + 2048], q5 = pw4[tid + 2560], q6 = pw4[tid + 3072], q7 = pw4[tid + 3584];
#define PWT_PUT(qv, r_) do { const int i_ = (tid + (r_) * 512) * 4, gg = i_ >> 12, c = (i_ >> 6) & 63, d0 = i_ & 63; \
            const int row = gg * 64 + 32 * (d0 >> 5) + 16 * ((d0 >> 2) & 1) + 4 * ((d0 >> 3) & 3); \
            PWT[(row + 0) * 72 + c] = f2bf((qv).x); PWT[(row + 1) * 72 + c] = f2bf((qv).y); PWT[(row + 2) * 72 + c] = f2bf((qv).z); PWT[(row + 3) * 72 + c] = f2bf((qv).w); } while (0)
        PWT_PUT(q0, 0); PWT_PUT(q1, 1); PWT_PUT(q2, 2); PWT_PUT(q3, 3); PWT_PUT(q4, 4); PWT_PUT(q5, 5); PWT_PUT(q6, 6); PWT_PUT(q7, 7);
#undef PWT_PUT
    }
    if (tid < 32) INV[tid] = rope_inv(tid);
    __syncthreads();
    float* out = p->out;
    const bf16_t* wdt = (const bf16_t*)(p->ws + WS_WDT) + (size_t)L * 16 * 1024;
    const int tiles_per = (2048 + gridDim.x - 1) / gridDim.x;
    for (int tile = blockIdx.x * tiles_per; tile < 2048 && tile < (blockIdx.x + 1) * tiles_per; ++tile) {
        const int token0 = tile * 16, b = token0 >> 13, t0 = token0 & 8191;
        bf16x8 da[4], db[4];
#pragma unroll
        for (int ks = 0; ks < 4; ++ks) { const int k0 = w * 128 + ks * 32 + fq * 8;
            da[ks] = *(const bf16x8*)(XB + (size_t)(token0 + fr) * DM + k0); db[ks] = *(const bf16x8*)(wdt + fr * 1024 + k0); }
        uint4 xav[2];
#pragma unroll
        for (int it = 0; it < 2; ++it) { const int id = tid + it * NT, rr = id >> 5, ch = id & 31, t = t0 - 15 + rr;
            xav[it] = zero4();
            if (id < 992 && t >= 0) xav[it] = *(const uint4*)(PROJ + (size_t)(b * 8192 + t) * NPROJ + ch * 8); }
        const int r_tk = tid >> 5, r_rest = tid & 31, r_qk = r_rest >> 4, r_h = (r_rest >> 2) & 3, r_i0 = (r_rest & 3) * 8;
        bf16_t* rbase = PROJ + (size_t)(token0 + r_tk) * NPROJ + 256 + r_qk * 256 + r_h * 64 + r_i0;
        const uint4 rxa = *(const uint4*)rbase, rxb = *(const uint4*)(rbase + 32);
        uint4 vld = zero4();
        if (t0 >= 6144) vld = *(const uint4*)(PROJ + (size_t)(token0 + (tid >> 5)) * NPROJ + 768 + (tid & 31) * 8);
        const int q4 = tid >> 7, c0 = (tid & 127) * 8;
        uint4 xr[7];
#pragma unroll
        for (int rr = 0; rr < 7; ++rr) { const int tt = t0 + q4 * 4 - 3 + rr;
            xr[rr] = zero4();
            if (tt >= 0) xr[rr] = *(const uint4*)(PROJ + (size_t)(b * 8192 + tt) * NPROJ + 1536 + c0); }
        {
            f32x4 acc = (f32x4){0.f, 0.f, 0.f, 0.f};
#pragma unroll
            for (int ks = 0; ks < 4; ++ks) acc = MFMA16(db[ks], da[ks], acc);
            if (fq < 2) { float4 v; v.x = acc[0]; v.y = acc[1]; v.z = acc[2]; v.w = acc[3]; *(float4*)(DTP + (w * 16 + fr) * 8 + fq * 4) = v; }
        }
#pragma unroll
        for (int it = 0; it < 2; ++it) { const int id = tid + it * NT, rr = id >> 5, ch = id & 31;
            if (id < 992) { float* d = XA + rr * 256 + ch * 8; const uint4 v = xav[it];
                d[0] = lo16(v.x); d[1] = hi16(v.x); d[2] = lo16(v.y); d[3] = hi16(v.y); d[4] = lo16(v.z); d[5] = hi16(v.z); d[6] = lo16(v.w); d[7] = hi16(v.w); } }
        { const int tk = tid >> 5, i = tid & 31; float c, sn; rope_cs((float)(t0 + tk) * INV[i], c, sn); CS[(tk * 32 + i) * 2] = c; CS[(tk * 32 + i) * 2 + 1] = sn; }
        __syncthreads();
        if (tid < 128) {
            const int tk = tid >> 3, h = tid & 7;
            float d = 0.f;
#pragma unroll
            for (int ww = 0; ww < 8; ++ww) d += DTP[(ww * 16 + tk) * 8 + h];
            const float x = d * row_rstd(PART, token0 + tk) + p->in[I_DTB][L * 8 + h];
            DT[(size_t)(token0 + tk) * 8 + h] = x > 20.f ? x : log1pf(__expf(x));
        }
        for (int id = tid; id < 4096; id += NT) {
            const int tk = id >> 8, ch = id & 255, g = ch >> 6, ww = 2 << g, t = t0 + tk;
            float sum = 0.f;
            for (int i = 0; i < ww; ++i) sum += XA[(15 + tk - i) * 256 + ch];
            const float xc = XA[(15 + tk) * 256 + ch];
            const int cnt = (t + 1) < ww ? (t + 1) : ww;
            DmB[tk * 264 + ch] = f2bf(sum / (float)cnt - xc);
            if (t >= 8177) out[O_POOLP + ((size_t)(L * 4 + b) * 15 + (t - 8177)) * 256 + ch] = xc;
        }
        __syncthreads();
        {
            const int g = w >> 1;
            f32x4 r[2];
#pragma unroll
            for (int dq = 0; dq < 2; ++dq) {
                const int dtile = (w & 1) * 2 + dq;
                r[dq] = (f32x4){0.f, 0.f, 0.f, 0.f};
#pragma unroll
                for (int ks = 0; ks < 2; ++ks) {
                    const bf16x8 pf = *(const bf16x8*)(PWT + (g * 64 + 16 * dtile + fr) * 72 + ks * 32 + fq * 8);
                    const bf16x8 qf = *(const bf16x8*)(DmB + fr * 264 + g * 64 + ks * 32 + fq * 8);
                    r[dq] = MFMA16(pf, qf, r[dq]);
                }
            }
            const int o = g * 64 + 32 * (w & 1) + fq * 8;
            const float4 p0 = *(const float4*)(p->in[I_POOLSC] + L * 256 + o), p1 = *(const float4*)(p->in[I_POOLSC] + L * 256 + o + 4);
            uint4 ov; ov.x = pk2(r[0][0] * p0.x, r[0][1] * p0.y); ov.y = pk2(r[0][2] * p0.z, r[0][3] * p0.w);
            ov.z = pk2(r[1][0] * p1.x, r[1][1] * p1.y); ov.w = pk2(r[1][2] * p1.z, r[1][3] * p1.w);
            *(uint4*)(CAT + (size_t)(token0 + fr) * DM + o) = ov;
        }
        {
            const int t = t0 + r_tk;
            const float x1[8] = {lo16(rxa.x), hi16(rxa.x), lo16(rxa.y), hi16(rxa.y), lo16(rxa.z), hi16(rxa.z), lo16(rxa.w), hi16(rxa.w)};
            const float x2[8] = {lo16(rxb.x), hi16(rxb.x), lo16(rxb.y), hi16(rxb.y), lo16(rxb.z), hi16(rxb.z), lo16(rxb.w), hi16(rxb.w)};
            float r1[8], r2[8];
            const float sc = r_qk == 0 ? 0.125f : 1.f;
#pragma unroll
            for (int e = 0; e < 8; e += 2) {
                const float4 cs = *(const float4*)(CS + (r_tk * 32 + r_i0 + e) * 2);
                r1[e] = (x1[e] * cs.x - x2[e] * cs.y) * sc; r2[e] = (x2[e] * cs.x + x1[e] * cs.y) * sc;
                r1[e + 1] = (x1[e + 1] * cs.z - x2[e + 1] * cs.w) * sc; r2[e + 1] = (x2[e + 1] * cs.z + x1[e + 1] * cs.w) * sc;
            }
            uint4 o1, o2;
            o1.x = pk2(r1[0], r1[1]); o1.y = pk2(r1[2], r1[3]); o1.z = pk2(r1[4], r1[5]); o1.w = pk2(r1[6], r1[7]);
            o2.x = pk2(r2[0], r2[1]); o2.y = pk2(r2[2], r2[3]); o2.z = pk2(r2[4], r2[5]); o2.w = pk2(r2[6], r2[7]);
            *(uint4*)rbase = o1; *(uint4*)(rbase + 32) = o2;
            if (r_qk == 1 && t >= 6144) {
                float* kp = out + O_KP + (((size_t)(L * 4 + b) * 2048 + (t - 6144)) * 4 + r_h) * 64 + r_i0;
                *(float4*)kp = make_float4(r1[0], r1[1], r1[2], r1[3]); *(float4*)(kp + 4) = make_float4(r1[4], r1[5], r1[6], r1[7]);
                *(float4*)(kp + 32) = make_float4(r2[0], r2[1], r2[2], r2[3]); *(float4*)(kp + 36) = make_float4(r2[4], r2[5], r2[6], r2[7]);
            }
        }
        if (t0 >= 6144) {
            const int tk = tid >> 5, cc = (tid & 31) * 8, t = t0 + tk;
            float* vp = out + O_VP + ((size_t)(L * 4 + b) * 2048 + (t - 6144)) * 256 + cc;
            *(float4*)vp = make_float4(lo16(vld.x), hi16(vld.x), lo16(vld.y), hi16(vld.y)); *(float4*)(vp + 4) = make_float4(lo16(vld.z), hi16(vld.z), lo16(vld.w), hi16(vld.w));
        }
        {
            float wv[4][8], bv[8];
            { const float4 b0 = *(const float4*)(p->in[I_CONVB] + L * 1024 + c0), b1 = *(const float4*)(p->in[I_CONVB] + L * 1024 + c0 + 4);
              bv[0] = b0.x; bv[1] = b0.y; bv[2] = b0.z; bv[3] = b0.w; bv[4] = b1.x; bv[5] = b1.y; bv[6] = b1.z; bv[7] = b1.w; }
#pragma unroll
            for (int tau = 0; tau < 4; ++tau) {
                const float* cw = p->in[I_CONVW] + (size_t)(L * 4 + tau) * 1024 + c0;
                const float4 w0 = *(const float4*)cw, w1 = *(const float4*)(cw + 4);
                wv[tau][0] = w0.x; wv[tau][1] = w0.y; wv[tau][2] = w0.z; wv[tau][3] = w0.w; wv[tau][4] = w1.x; wv[tau][5] = w1.y; wv[tau][6] = w1.z; wv[tau][7] = w1.w;
            }
            float acc[4][8];
#pragma unroll
            for (int it = 0; it < 4; ++it)
#pragma unroll
                for (int e = 0; e < 8; ++e) acc[it][e] = bv[e];
#pragma unroll
            for (int rr = 0; rr < 7; ++rr) {
                const float xf[8] = {lo16(xr[rr].x), hi16(xr[rr].x), lo16(xr[rr].y), hi16(xr[rr].y), lo16(xr[rr].z), hi16(xr[rr].z), lo16(xr[rr].w), hi16(xr[rr].w)};
#pragma unroll
                for (int it = 0; it < 4; ++it) {
                    const int tau = rr - it;
                    if (tau >= 0 && tau < 4) {
#pragma unroll
                        for (int e = 0; e < 8; ++e) acc[it][e] += xf[e] * wv[tau][e];
                    }
                }
            }
#pragma unroll
            for (int it = 0; it < 4; ++it) {
                const int tk = q4 * 4 + it, t = t0 + tk;
                uint4 o; o.x = pk2(silu(acc[it][0]), silu(acc[it][1])); o.y = pk2(silu(acc[it][2]), silu(acc[it][3]));
                o.z = pk2(silu(acc[it][4]), silu(acc[it][5])); o.w = pk2(silu(acc[it][6]), silu(acc[it][7]));
                *(uint4*)(U + (size_t)(token0 + tk) * DM + c0) = o;
                if (t >= 8189) { float* cp = out + O_CONVP + ((size_t)(L * 4 + b) * 3 + (t - 8189)) * 1024 + c0; const uint4 xv = xr[it + 3];
                    *(float4*)cp = make_float4(lo16(xv.x), hi16(xv.x), lo16(xv.y), hi16(xv.y)); *(float4*)(cp + 4) = make_float4(lo16(xv.z), hi16(xv.z), lo16(xv.w), hi16(xv.w)); }
            }
        }
        __syncthreads();
    }
}

__device__ void prep_sample_item(KP p, int L, int item, bf16_t* PROJ, bf16_t* U, bf16_t* CAT, const bf16_t* XB, float* DT) {
    const int n = item >> 2, part = item & 3;
    SMEM_DECL;
    float* dsm = (float*)smem;
    const int tid = otid();
    const size_t row = MP + n;
    float* out = p->out;
    const int ln = L * 32 + n;
    __syncthreads();
    if (part == 0) {
        const int lane = tid & 63, h = tid >> 6;
        const bf16_t* wdt = (const bf16_t*)(p->ws + WS_WDT) + (size_t)L * 16 * 1024 + h * 1024;
        float d = 0.f, ss = 0.f;
#pragma unroll
        for (int i = 0; i < 16; ++i) { const int k = i * 64 + lane; const float xf = bf2f(XB[row * DM + k]); ss += xf * xf; d += xf * bf2f(wdt[k]); }
        d = wave_sum(d); ss = wave_sum(ss);
        if (lane == 0) { const float x = d * rsqrtf(ss * (1.f / 1024.f) + EPS) + p->in[I_DTB][L * 8 + h]; DT[row * 8 + h] = x > 20.f ? x : log1pf(__expf(x)); }
    }
    if (part == 1) {
    if (tid < 256) {
        const int ch = tid, g = ch >> 6, w = 2 << g;
        const float* cp = p->in[I_CPOOL] + (size_t)ln * 15 * 256;
        const float xn = bf2f(PROJ[row * NPROJ + ch]);
        float cpr[15];
#pragma unroll
        for (int i = 1; i < 16; ++i) cpr[i - 1] = cp[(15 - i) * 256 + ch];
        float sum = xn;
#pragma unroll
        for (int i = 1; i < 16; ++i) sum += (i < w) ? cpr[i - 1] : 0.f;
        dsm[ch] = sum / (float)w - xn;
        float* ps = out + O_POOLS + (size_t)ln * 15 * 256;
        float cpv[14];
#pragma unroll
        for (int j = 0; j < 14; ++j) cpv[j] = cp[(j + 1) * 256 + ch];
#pragma unroll
        for (int j = 0; j < 14; ++j) ps[j * 256 + ch] = cpv[j];
        ps[14 * 256 + ch] = xn;
    }
    __syncthreads();
    if (tid < 256) {
        const int o = tid, g = o >> 6, dout = o & 63;
        const float* pw = p->in[I_POOLW] + (size_t)(L * 4 + g) * 4096;
        float acc = 0.f;
#pragma unroll 32
        for (int c = 0; c < 64; ++c) acc += dsm[g * 64 + c] * pw[c * 64 + dout];
        CAT[row * DM + o] = f2bf(acc * p->in[I_POOLSC][L * 256 + o]);
    }
    }
    if (part == 2 && tid < 256) {
        const int qk = tid >> 7, h = (tid >> 5) & 3, i = tid & 31;
        const float inv = rope_inv(i);
        float c, s; rope_cs(16384.f * inv, c, s);
        bf16_t* base = PROJ + row * NPROJ + 256 + qk * 256 + h * 64;
        const float x1 = bf2f(base[i]), x2 = bf2f(base[i + 32]);
        float r1 = x1 * c - x2 * s, r2 = x2 * c + x1 * s;
        if (qk == 0) { r1 *= 0.125f; r2 *= 0.125f; }
        base[i] = f2bf(r1); base[i + 32] = f2bf(r2);
        if (qk == 1) { float* ks = out + O_KS + (((size_t)ln * 2048 + 2047) * 4 + h) * 64; ks[i] = r1; ks[i + 32] = r2; }
        out[O_VS + ((size_t)ln * 2048 + 2047) * 256 + tid] = bf2f(PROJ[row * NPROJ + 768 + tid]);
    }
    if (part == 3)
    for (int c = tid; c < 1024; c += NT) {
        const float* sc = p->in[I_SCONV] + (size_t)ln * 3 * 1024;
        const float* cw = p->in[I_CONVW] + (size_t)L * 4 * 1024;
        const float xnew = bf2f(PROJ[row * NPROJ + 1536 + c]);
        const float s0 = sc[c], s1 = sc[1024 + c], s2 = sc[2048 + c];
        const float acc = p->in[I_CONVB][L * 1024 + c] + s0 * cw[c] + s1 * cw[1024 + c] + s2 * cw[2048 + c] + xnew * cw[3072 + c];
        U[row * DM + c] = f2bf(silu(acc));
        float* cs = out + O_CONVS + (size_t)ln * 3 * 1024;
        cs[c] = s1; cs[1024 + c] = s2; cs[2048 + c] = xnew;
    }
    __syncthreads();
}

struct AttnPf { uint4 k[4], v[4]; bf16x8 q[2]; };
__device__ __forceinline__ void attn_decode(int a, int& b, int& h, int& br, int& dsh, int& r, int& n) {
    const int bh = a / 192, rem = a % 192, idx = rem & 63; br = rem >> 6;
    b = bh >> 2; h = bh & 3; dsh = br * 2; const int nb = 64 >> dsh; r = idx / nb; n = idx % nb;
}
__device__ __forceinline__ void attn_load(int a, const bf16_t* PROJ, int tid, AttnPf& pf) {
    int b, h, br, dsh, r, n; attn_decode(a, b, h, br, dsh, r, n);
    const int lane = tid & 63, w = tid >> 6, fr = lane & 15, fq = lane >> 4;
#pragma unroll
    for (int it = 0; it < 4; ++it) {
        const int id = tid + it * NT, rowk = id >> 3, ch = id & 7, lk = (n - 1) * 128 + rowk;
        pf.k[it] = zero4();
        if (lk >= 0) pf.k[it] = *(const uint4*)(PROJ + (size_t)(b * 8192 + (lk << dsh) + r) * NPROJ + 512 + h * 64 + ch * 8);
    }
#pragma unroll
    for (int it = 0; it < 4; ++it) {
        const int id = tid + it * NT, key = id & 255, ch = id >> 8, lk = (n - 1) * 128 + key;
        pf.v[it] = zero4();
        if (lk >= 0) pf.v[it] = *(const uint4*)(PROJ + (size_t)(b * 8192 + (lk << dsh) + r) * NPROJ + 768 + h * 64 + ch * 8);
    }
    const int qi = 16 * w + fr, lq = n * 128 + qi;
    const size_t tq = (size_t)b * 8192 + ((size_t)lq << dsh) + r;
#pragma unroll
    for (int ks = 0; ks < 2; ++ks) pf.q[ks] = *(const bf16x8*)(PROJ + tq * NPROJ + 256 + h * 64 + ks * 32 + fq * 8);
}
__device__ void attn_items(int a0, int astep, const bf16_t* PROJ, bf16_t* OG, float* LSE) {
    SMEM_DECL;
    bf16_t* Ks = (bf16_t*)smem;
    bf16_t* Vt = (bf16_t*)(smem + 272 * 144);
    const int tid = otid(), lane = tid & 63, w = tid >> 6, fr = lane & 15, fq = lane >> 4;
    AttnPf pf;
    if (a0 < 3072) attn_load(a0, PROJ, tid, pf);
#pragma unroll 1
    for (int a = a0; a < 3072; a += astep) {
        int b, h, br, dsh, r, n; attn_decode(a, b, h, br, dsh, r, n);
        LDS_BARRIER();
#pragma unroll
        for (int it = 0; it < 4; ++it) { const int id = tid + it * NT, rowk = id >> 3, ch = id & 7; *(uint4*)(Ks + rowk * 72 + ch * 8) = pf.k[it]; }
        if (tid < 128) { const uint4 z = zero4(); *(uint4*)(Ks + (256 + (tid >> 3)) * 72 + (tid & 7) * 8) = z; }
#pragma unroll
        for (int it = 0; it < 4; ++it) {
            const int id = tid + it * NT, key = id & 255, ch = id >> 8; const uint4 v = pf.v[it];
            bf16_t* d = Vt + (32 * (ch >> 2) + 4 * (ch & 3)) * 280 + key;
            d[0] = (bf16_t)(v.x & 0xffff); d[280] = (bf16_t)(v.x >> 16); d[560] = (bf16_t)(v.y & 0xffff); d[840] = (bf16_t)(v.y >> 16);
            d[16 * 280] = (bf16_t)(v.z & 0xffff); d[17 * 280] = (bf16_t)(v.z >> 16); d[18 * 280] = (bf16_t)(v.w & 0xffff); d[19 * 280] = (bf16_t)(v.w >> 16);
        }
        { const int d = tid >> 3, kk = (tid & 7) * 2; *(unsigned*)(Vt + d * 280 + 256 + kk) = 0u; }
        const bf16x8 qf0 = pf.q[0], qf1 = pf.q[1];
        if (a + astep < 3072) attn_load(a + astep, PROJ, tid, pf);
        LDS_BARRIER();
        const int qi = 16 * w + fr, lq = n * 128 + qi;
        const size_t tq = (size_t)b * 8192 + ((size_t)lq << dsh) + r;
        f32x4 s[10];
#pragma unroll
        for (int t = 0; t < 10; ++t) {
            s[t] = (f32x4){0.f, 0.f, 0.f, 0.f};
            const bf16x8 kf0 = *(const bf16x8*)(Ks + (16 * (w + t) + fr) * 72 + fq * 8);
            const bf16x8 kf1 = *(const bf16x8*)(Ks + (16 * (w + t) + fr) * 72 + 32 + fq * 8);
            s[t] = MFMA16(kf0, qf0, s[t]); s[t] = MFMA16(kf1, qf1, s[t]);
        }
        float mx = -INFINITY;
#pragma unroll
        for (int t = 0; t < 10; ++t)
#pragma unroll
            for (int jj = 0; jj < 4; ++jj) {
                const int key = 16 * (w + t) + fq * 4 + jj, dist = 128 + qi - key;
                const bool valid = (dist >= 0) && (dist <= 128) && (key < 256) && (n > 0 || key >= 128);
                const float sv = valid ? s[t][jj] : -INFINITY;
                s[t][jj] = sv; mx = fmaxf(mx, sv);
            }
        mx = fmaxf(mx, __shfl_xor(mx, 16)); mx = fmaxf(mx, __shfl_xor(mx, 32));
        float lsum = 0.f;
#pragma unroll
        for (int t = 0; t < 10; ++t)
#pragma unroll
            for (int jj = 0; jj < 4; ++jj) { const float pv = __expf(s[t][jj] - mx); s[t][jj] = pv; lsum += pv; }
        lsum += __shfl_xor(lsum, 16); lsum += __shfl_xor(lsum, 32);
        f32x4 o[4];
#pragma unroll
        for (int dt = 0; dt < 4; ++dt) o[dt] = (f32x4){0.f, 0.f, 0.f, 0.f};
#pragma unroll
        for (int kp = 0; kp < 5; ++kp) {
            const int ta = 2 * kp, tb = 2 * kp + 1;
            union { bf16x8 v; unsigned u[4]; } pfr;
            pfr.u[0] = pk2(s[ta][0], s[ta][1]); pfr.u[1] = pk2(s[ta][2], s[ta][3]); pfr.u[2] = pk2(s[tb][0], s[tb][1]); pfr.u[3] = pk2(s[tb][2], s[tb][3]);
#pragma unroll
            for (int dt = 0; dt < 4; ++dt) {
                union { bf16x8 v; uint2 u[2]; } vf;
                vf.u[0] = *(const uint2*)(Vt + (16 * dt + fr) * 280 + 16 * (w + ta) + fq * 4);
                vf.u[1] = *(const uint2*)(Vt + (16 * dt + fr) * 280 + 16 * (w + tb) + fq * 4);
                o[dt] = MFMA16(vf.v, pfr.v, o[dt]);
            }
        }
        const float inv = 1.f / lsum;
#pragma unroll
        for (int a2 = 0; a2 < 2; ++a2) {
            uint4 ov; ov.x = pk2(o[2 * a2][0] * inv, o[2 * a2][1] * inv); ov.y = pk2(o[2 * a2][2] * inv, o[2 * a2][3] * inv);
            ov.z = pk2(o[2 * a2 + 1][0] * inv, o[2 * a2 + 1][1] * inv); ov.w = pk2(o[2 * a2 + 1][2] * inv, o[2 * a2 + 1][3] * inv);
            *(uint4*)(OG + ((size_t)br * MP + tq) * 256 + h * 64 + 32 * a2 + fq * 8) = ov;
        }
        if (fq == 0) LSE[((size_t)br * MP + tq) * 4 + h] = mx + __logf(lsum);
    }
}

__device__ void combine_item(int item, const bf16_t* __restrict__ OG, const float* __restrict__ LSE, bf16_t* __restrict__ CAT) {
    const int tid = otid();
    uint4 a[4], bb[4], c[4]; float l0[4], l1[4], l2[4];
#pragma unroll
    for (int it = 0; it < 4; ++it) {
        const int id = tid + it * NT, tk = id >> 5, ch = id & 31, h = ch >> 3;
        const size_t token = (size_t)item * 64 + tk;
        l0[it] = LSE[token * 4 + h]; l1[it] = LSE[((size_t)MP + token) * 4 + h]; l2[it] = LSE[(2ull * MP + token) * 4 + h];
        a[it] = *(const uint4*)(OG + token * 256 + ch * 8); bb[it] = *(const uint4*)(OG + ((size_t)MP + token) * 256 + ch * 8);
        c[it] = *(const uint4*)(OG + (2ull * MP + token) * 256 + ch * 8);
    }
#pragma unroll
    for (int it = 0; it < 4; ++it) {
        const int id = tid + it * NT, tk = id >> 5, ch = id & 31;
        const size_t token = (size_t)item * 64 + tk;
        const float m = fmaxf(l0[it], fmaxf(l1[it], l2[it]));
        float w0 = __expf(l0[it] - m), w1 = __expf(l1[it] - m), w2 = __expf(l2[it] - m);
        const float inv = 1.f / (w0 + w1 + w2); w0 *= inv; w1 *= inv; w2 *= inv;
        uint4 o;
        o.x = pk2(w0 * lo16(a[it].x) + w1 * lo16(bb[it].x) + w2 * lo16(c[it].x), w0 * hi16(a[it].x) + w1 * hi16(bb[it].x) + w2 * hi16(c[it].x));
        o.y = pk2(w0 * lo16(a[it].y) + w1 * lo16(bb[it].y) + w2 * lo16(c[it].y), w0 * hi16(a[it].y) + w1 * hi16(bb[it].y) + w2 * hi16(c[it].y));
        o.z = pk2(w0 * lo16(a[it].z) + w1 * lo16(bb[it].z) + w2 * lo16(c[it].z), w0 * hi16(a[it].z) + w1 * hi16(bb[it].z) + w2 * hi16(c[it].z));
        o.w = pk2(w0 * lo16(a[it].w) + w1 * lo16(bb[it].w) + w2 * lo16(c[it].w), w0 * hi16(a[it].w) + w1 * hi16(bb[it].w) + w2 * hi16(c[it].w));
        *(uint4*)(CAT + token * DM + 256 + ch * 8) = o;
    }
}

__device__ __forceinline__ void ssd_acs(KP p, int L, int g, int token0, const float* DT, float* acs, float* dts) {
    const int lane = otid() & 63, w = otid() >> 6;
    if (w < 4) {
        const int h = g * 4 + w; const float a = -__expf(p->in[I_ALOG][L * 8 + h]);
        const float d0 = DT[(size_t)(token0 + 2 * lane) * 8 + h], d1 = DT[(size_t)(token0 + 2 * lane + 1) * 8 + h];
        const float v0 = d0 * a, v1 = d1 * a, sum = v0 + v1; float inc = sum;
#pragma unroll
        for (int off = 1; off < 64; off <<= 1) { const float t = __shfl_up(inc, off); if (lane >= off) inc += t; }
        const float exc = inc - sum;
        acs[w * 128 + 2 * lane] = exc + v0; acs[w * 128 + 2 * lane + 1] = exc + v0 + v1;
        dts[w * 128 + 2 * lane] = d0; dts[w * 128 + 2 * lane + 1] = d1;
    }
}

__device__ void s1_item(KP p, int L, int item, const bf16_t* U, const float* DT, float* ST, float* DEC) {
    SMEM_DECL;
    bf16_t* BT = (bf16_t*)smem;
    bf16_t* XWT = (bf16_t*)(smem + 34816);
    float* acs = (float*)(smem + 104448);
    float* dts = (float*)(smem + 106496);
    const int tid = otid(), lane = tid & 63, w = tid >> 6, fr = lane & 15, fq = lane >> 4;
    const int cb = item >> 1, g = item & 1, token0 = cb * 128;
    __syncthreads();
    ssd_acs(p, L, g, token0, DT, acs, dts);
    __syncthreads();
    { const int j = tid >> 7, l = tid & 127; const float wv = __expf(acs[j * 128 + 127] - acs[j * 128 + l]) * dts[j * 128 + l];
      if (tid < 4) DEC[cb * 8 + g * 4 + tid] = __expf(acs[tid * 128 + 127]);
      __syncthreads();
      dts[j * 128 + l] = wv; }
    __syncthreads();
#pragma unroll
    for (int it = 0; it < 4; ++it) {
        const int id = tid + it * NT, l = id & 127, ch = id >> 7;
        const uint4 v = *(const uint4*)(U + (size_t)(token0 + l) * DM + 512 + g * 128 + ch * 8);
        bf16_t* d = BT + (ch * 8) * 136 + l;
        d[0] = (bf16_t)(v.x & 0xffff); d[136] = (bf16_t)(v.x >> 16); d[272] = (bf16_t)(v.y & 0xffff); d[408] = (bf16_t)(v.y >> 16);
        d[544] = (bf16_t)(v.z & 0xffff); d[680] = (bf16_t)(v.z >> 16); d[816] = (bf16_t)(v.w & 0xffff); d[952] = (bf16_t)(v.w >> 16);
    }
#pragma unroll
    for (int it = 0; it < 8; ++it) {
        const int id = tid + it * NT, l = id & 127, ch = id >> 7, j = ch >> 3;
        const uint4 v = *(const uint4*)(U + (size_t)(token0 + l) * DM + g * 256 + ch * 8);
        const float wv = dts[j * 128 + l];
        bf16_t* d = XWT + (ch * 8) * 136 + l;
        d[0] = f2bf(lo16(v.x) * wv); d[136] = f2bf(hi16(v.x) * wv); d[272] = f2bf(lo16(v.y) * wv); d[408] = f2bf(hi16(v.y) * wv);
        d[544] = f2bf(lo16(v.z) * wv); d[680] = f2bf(hi16(v.z) * wv); d[816] = f2bf(lo16(v.w) * wv); d[952] = f2bf(hi16(v.w) * wv);
    }
    __syncthreads();
    f32x4 acc[2][8];
#pragma unroll
    for (int qq = 0; qq < 2; ++qq)
#pragma unroll
        for (int nt = 0; nt < 8; ++nt) acc[qq][nt] = (f32x4){0.f, 0.f, 0.f, 0.f};
#pragma unroll
    for (int ks = 0; ks < 4; ++ks) {
        bf16x8 qf[2];
#pragma unroll
        for (int qq = 0; qq < 2; ++qq) qf[qq] = *(const bf16x8*)(XWT + (16 * (2 * w + qq) + fr) * 136 + ks * 32 + fq * 8);
#pragma unroll
        for (int nt = 0; nt < 8; ++nt) {
            const bf16x8 pf = *(const bf16x8*)(BT + (16 * nt + fr) * 136 + ks * 32 + fq * 8);
#pragma unroll
            for (int qq = 0; qq < 2; ++qq) acc[qq][nt] = MFMA16(pf, qf[qq], acc[qq][nt]);
        }
    }
#pragma unroll
    for (int qq = 0; qq < 2; ++qq) {
        const int rowjp = 16 * (2 * w + qq) + fr, j = rowjp >> 6, pp = rowjp & 63, h = g * 4 + j;
        float* dst = ST + ((size_t)(cb * 8 + h) * 64 + pp) * 128 + fq * 4;
#pragma unroll
        for (int nt = 0; nt < 8; ++nt) { float4 v; v.x = acc[qq][nt][0]; v.y = acc[qq][nt][1]; v.z = acc[qq][nt][2]; v.w = acc[qq][nt][3]; *(float4*)(dst + 16 * nt) = v; }
    }
}

__device__ void scan_phase(KP p, int L, float* ST, const float* DEC) {
    const int tid = otid();
    if (tid < 256) {
        for (int e = blockIdx.x * 256 + tid; e < 65536; e += gridDim.x * 256) {
            const int idx = e * 4, n = idx & 127, pp = (idx >> 7) & 63, h = (idx >> 13) & 7, b = idx >> 16;
            float4 hr = make_float4(0.f, 0.f, 0.f, 0.f);
            float* base = ST + ((size_t)((b * 64) * 8 + h) * 64 + pp) * 128 + n;
            const float* dbase = DEC + (b * 64) * 8 + h;
#pragma unroll 1
            for (int c0 = 0; c0 < 64; c0 += 16) {
                float4 t[16]; float d[16];
#pragma unroll
                for (int j = 0; j < 16; ++j) { t[j] = *(const float4*)(base + (size_t)(c0 + j) * 65536); d[j] = dbase[(c0 + j) * 8]; }
#pragma unroll
                for (int j = 0; j < 16; ++j) { *(float4*)(base + (size_t)(c0 + j) * 65536) = hr;
                    hr.x = d[j] * hr.x + t[j].x; hr.y = d[j] * hr.y + t[j].y; hr.z = d[j] * hr.z + t[j].z; hr.w = d[j] * hr.w + t[j].w; }
            }
            *(float4*)(p->out + O_SSMP + (((size_t)(L * 4 + b) * 8 + h) * 64 + pp) * 128 + n) = hr;
        }
    }
}

__device__ void s3_item(KP p, int L, int item, const bf16_t* U, const bf16_t* PROJ, const float* DT, const float* ST, bf16_t* CAT) {
    SMEM_DECL;
    bf16_t* Cs = (bf16_t*)smem;
    bf16_t* Bs = (bf16_t*)(smem + 34816);
    bf16_t* XT = (bf16_t*)(smem + 69632);
    bf16_t* Hp = (bf16_t*)(smem + 87040);
    float* acs = (float*)(smem + 104448);
    float* dts = (float*)(smem + 106496);
    const int tid = otid(), lane = tid & 63, w = tid >> 6, fr = lane & 15, fq = lane >> 4;
    const int cb = item >> 1, g = item & 1, token0 = cb * 128;
    const int l = 16 * w + fr;
    const size_t token = (size_t)token0 + l;
    uint4 xt[2]; float4 hp[4]; uint4 xv[2], zv[2];
#define S3_LOAD(hh) do { \
        _Pragma("unroll") for (int it = 0; it < 2; ++it) { const int id = tid + it * NT, s_ = id & 127, ch = id >> 7; \
            xt[it] = *(const uint4*)(U + (size_t)(token0 + s_) * DM + (hh) * 64 + ch * 8); } \
        _Pragma("unroll") for (int it = 0; it < 4; ++it) { const int id = tid + it * NT, pp = id >> 5, c4 = id & 31; \
            hp[it] = *(const float4*)(ST + ((size_t)(cb * 8 + (hh)) * 64 + pp) * 128 + c4 * 4); } \
        _Pragma("unroll") for (int a2 = 0; a2 < 2; ++a2) { const int ch = (hh) * 64 + 32 * a2 + fq * 8; \
            xv[a2] = *(const uint4*)(U + token * DM + ch); zv[a2] = *(const uint4*)(PROJ + token * NPROJ + 1024 + ch); } } while (0)
    LDS_BARRIER();
    S3_LOAD(g * 4);
    ssd_acs(p, L, g, token0, DT, acs, dts);
#pragma unroll
    for (int it = 0; it < 4; ++it) {
        const int id = tid + it * NT, ll = id >> 4, ch = id & 15;
        *(uint4*)(Cs + ll * 136 + ch * 8) = *(const uint4*)(U + (size_t)(token0 + ll) * DM + 768 + g * 128 + ch * 8);
        *(uint4*)(Bs + ll * 136 + ch * 8) = *(const uint4*)(U + (size_t)(token0 + ll) * DM + 512 + g * 128 + ch * 8);
    }
    LDS_BARRIER();
    f32x4 cbv[8];
#pragma unroll
    for (int st = 0; st < 8; ++st) cbv[st] = (f32x4){0.f, 0.f, 0.f, 0.f};
#pragma unroll
    for (int ks = 0; ks < 4; ++ks) {
        const bf16x8 qf = *(const bf16x8*)(Cs + (16 * w + fr) * 136 + ks * 32 + fq * 8);
#pragma unroll
        for (int st = 0; st < 8; ++st)
            if (st <= w) { const bf16x8 pf = *(const bf16x8*)(Bs + (16 * st + fr) * 136 + ks * 32 + fq * 8); cbv[st] = MFMA16(pf, qf, cbv[st]); }
    }
    LDS_BARRIER();
    bf16_t* Mb = Bs;
    float ssq = 0.f;
#pragma unroll 1
    for (int j = 0; j < 4; ++j) {
        const int h = g * 4 + j;
#pragma unroll
        for (int it = 0; it < 2; ++it) {
            const int id = tid + it * NT, s_ = id & 127, ch = id >> 7; const uint4 v = xt[it];
            bf16_t* d = XT + (32 * (ch >> 2) + 4 * (ch & 3)) * 136 + s_;
            d[0] = (bf16_t)(v.x & 0xffff); d[136] = (bf16_t)(v.x >> 16); d[272] = (bf16_t)(v.y & 0xffff); d[408] = (bf16_t)(v.y >> 16);
            d[16 * 136] = (bf16_t)(v.z & 0xffff); d[17 * 136] = (bf16_t)(v.z >> 16); d[18 * 136] = (bf16_t)(v.w & 0xffff); d[19 * 136] = (bf16_t)(v.w >> 16);
        }
#pragma unroll
        for (int it = 0; it < 4; ++it) {
            const int id = tid + it * NT, pp = id >> 5, c4 = id & 31; const float4 v = hp[it];
            uint2 o; o.x = pk2(v.x, v.y); o.y = pk2(v.z, v.w);
            *(uint2*)(Hp + (32 * (pp >> 5) + 16 * ((pp >> 2) & 1) + 4 * ((pp >> 3) & 3) + (pp & 3)) * 136 + c4 * 4) = o;
        }
        uint4 xvc[2], zvc[2];
#pragma unroll
        for (int a2 = 0; a2 < 2; ++a2) { xvc[a2] = xv[a2]; zvc[a2] = zv[a2]; }
        if (j < 3) S3_LOAD(h + 1);
        const float al = acs[j * 128 + l];
#pragma unroll
        for (int st = 0; st < 8; ++st)
            if (st <= (w | 1)) {
                float mv[4];
#pragma unroll
                for (int jj = 0; jj < 4; ++jj) { const int s_ = 16 * st + fq * 4 + jj;
                    mv[jj] = (s_ <= l) ? cbv[st][jj] * __expf(al - acs[j * 128 + s_]) * dts[j * 128 + s_] : 0.f; }
                uint2 o; o.x = pk2(mv[0], mv[1]); o.y = pk2(mv[2], mv[3]);
                *(uint2*)(Mb + l * 136 + 16 * st + fq * 4) = o;
            }
        LDS_BARRIER();
        f32x4 yy[4];
#pragma unroll
        for (int pt = 0; pt < 4; ++pt) yy[pt] = (f32x4){0.f, 0.f, 0.f, 0.f};
#pragma unroll
        for (int ks = 0; ks < 4; ++ks) {
            const bf16x8 qf = *(const bf16x8*)(Cs + (16 * w + fr) * 136 + ks * 32 + fq * 8);
#pragma unroll
            for (int pt = 0; pt < 4; ++pt) { const bf16x8 pf = *(const bf16x8*)(Hp + (16 * pt + fr) * 136 + ks * 32 + fq * 8); yy[pt] = MFMA16(pf, qf, yy[pt]); }
        }
        const float ea = __expf(al);
#pragma unroll
        for (int pt = 0; pt < 4; ++pt) yy[pt] = yy[pt] * ea;
#pragma unroll
        for (int ks = 0; ks < 4; ++ks)
            if (2 * ks <= w) {
                const bf16x8 qf = *(const bf16x8*)(Mb + (16 * w + fr) * 136 + ks * 32 + fq * 8);
#pragma unroll
                for (int pt = 0; pt < 4; ++pt) { const bf16x8 pf = *(const bf16x8*)(XT + (16 * pt + fr) * 136 + ks * 32 + fq * 8); yy[pt] = MFMA16(pf, qf, yy[pt]); }
            }
        const float dsk = p->in[I_DSKIP][L * 8 + h];
#pragma unroll
        for (int a2 = 0; a2 < 2; ++a2) {
            const int ch = h * 64 + 32 * a2 + fq * 8;
            const uint4 xq = xvc[a2], zq = zvc[a2];
            const float xs[8] = {lo16(xq.x), hi16(xq.x), lo16(xq.y), hi16(xq.y), lo16(xq.z), hi16(xq.z), lo16(xq.w), hi16(xq.w)};
            const float zs[8] = {lo16(zq.x), hi16(zq.x), lo16(zq.y), hi16(zq.y), lo16(zq.z), hi16(zq.z), lo16(zq.w), hi16(zq.w)};
            float v[8];
#pragma unroll
            for (int e = 0; e < 8; ++e) { v[e] = (yy[2 * a2 + (e >> 2)][e & 3] + dsk * xs[e]) * silu(zs[e]); ssq += v[e] * v[e]; }
            uint4 o; o.x = pk2(v[0], v[1]); o.y = pk2(v[2], v[3]); o.z = pk2(v[4], v[5]); o.w = pk2(v[6], v[7]);
            *(uint4*)(CAT + token * DM + 512 + ch) = o;
        }
        LDS_BARRIER();
    }
#undef S3_LOAD
    asm volatile("s_waitcnt vmcnt(0)" ::: "memory");
    ssq += __shfl_xor(ssq, 16); ssq += __shfl_xor(ssq, 32);
    const float rstd = rsqrtf(ssq * (1.f / 256.f) + EPS);
    {
        uint4 vv[4][2];
#pragma unroll
        for (int j = 0; j < 4; ++j)
#pragma unroll
            for (int a2 = 0; a2 < 2; ++a2) vv[j][a2] = *(const uint4*)(CAT + token * DM + 512 + (g * 4 + j) * 64 + 32 * a2 + fq * 8);
#pragma unroll
        for (int j = 0; j < 4; ++j)
#pragma unroll
            for (int a2 = 0; a2 < 2; ++a2) {
                const int ch = (g * 4 + j) * 64 + 32 * a2 + fq * 8;
                const float4 n0 = *(const float4*)(p->in[I_SSMN] + L * 512 + ch), n1 = *(const float4*)(p->in[I_SSMN] + L * 512 + ch + 4);
                const uint4 v = vv[j][a2];
                uint4 o; o.x = pk2(lo16(v.x) * rstd * n0.x, hi16(v.x) * rstd * n0.y); o.y = pk2(lo16(v.y) * rstd * n0.z, hi16(v.y) * rstd * n0.w);
                o.z = pk2(lo16(v.z) * rstd * n1.x, hi16(v.z) * rstd * n1.y); o.w = pk2(lo16(v.w) * rstd * n1.z, hi16(v.w) * rstd * n1.w);
                *(uint4*)(CAT + token * DM + 512 + ch) = o;
            }
    }
}

__device__ void sample_attn_item(KP p, int L, int item, const bf16_t* PROJ, bf16_t* CAT) {
    SMEM_DECL;
    float* qs = (float*)smem; float* kn = qs + 64; float* vn = kn + 64; float* sc = vn + 64; float* red = sc + 512; float* part = red + 32;
    const int tid = otid(), lane = tid & 63, w = tid >> 6;
    const int n = item >> 2, h = item & 3;
    const size_t row = MP + n; const int ln = L * 32 + n;
    __syncthreads();
    if (tid < 64) { qs[tid] = bf2f(PROJ[row * NPROJ + 256 + h * 64 + tid]); kn[tid] = bf2f(PROJ[row * NPROJ + 512 + h * 64 + tid]); vn[tid] = bf2f(PROJ[row * NPROJ + 768 + h * 64 + tid]); }
    __syncthreads();
    const float* ck = p->in[I_CK] + (size_t)ln * 2048 * 256 + h * 64;
    const float* cv = p->in[I_CV] + (size_t)ln * 2048 * 256 + h * 64;
    float s = -INFINITY;
    if (tid < 387) {
        const int gg = tid / 129, j = tid % 129;
        s = 0.f;
        if (j == 0) { for (int d = 0; d < 64; ++d) s += qs[d] * kn[d]; }
        else { const float* kr = ck + (size_t)(2048 - (j << (2 * gg))) * 256;
#pragma unroll
            for (int d = 0; d < 64; d += 4) { const float4 kv = *(const float4*)(kr + d); s += qs[d] * kv.x + qs[d + 1] * kv.y + qs[d + 2] * kv.z + qs[d + 3] * kv.w; } }
    }
    const float wm = wave_max(s);
    if (lane == 0) red[w] = wm;
    __syncthreads();
    float mx = red[0];
#pragma unroll
    for (int i = 1; i < 8; ++i) mx = fmaxf(mx, red[i]);
    const float pv = (tid < 387) ? __expf(s - mx) : 0.f;
    sc[tid] = pv;
    const float wsum = wave_sum(pv);
    if (lane == 0) red[8 + w] = wsum;
    __syncthreads();
    float tot = 0.f;
#pragma unroll
    for (int i = 0; i < 8; ++i) tot += red[8 + i];
    {
        const int eg = tid >> 4, d4 = (tid & 15) * 4;
        float4 vv[13]; float pp[13];
#pragma unroll
        for (int i = 0; i < 13; ++i) {
            const int e = eg + 32 * i;
            pp[i] = 0.f; vv[i] = make_float4(0.f, 0.f, 0.f, 0.f);
            if (e < 387) { const int gg = e / 129, j = e % 129; pp[i] = sc[e];
                vv[i] = (j == 0) ? *(const float4*)(vn + d4) : *(const float4*)(cv + (size_t)(2048 - (j << (2 * gg))) * 256 + d4); }
        }
        float4 o = make_float4(0.f, 0.f, 0.f, 0.f);
#pragma unroll
        for (int i = 0; i < 13; ++i) { o.x += pp[i] * vv[i].x; o.y += pp[i] * vv[i].y; o.z += pp[i] * vv[i].z; o.w += pp[i] * vv[i].w; }
        *(float4*)(part + eg * 64 + d4) = o;
    }
    __syncthreads();
    if (tid < 64) {
        float o = 0.f;
#pragma unroll
        for (int i = 0; i < 32; ++i) o += part[i * 64 + tid];
        CAT[row * DM + 256 + h * 64 + tid] = f2bf(o / tot);
    }
}

__device__ void sample_ssd_item(KP p, int L, int n, const bf16_t* PROJ, const bf16_t* U, const float* DT, bf16_t* CAT) {
    SMEM_DECL;
    float* us = (float*)smem; float* zs = us + 1024; float* ys = zs + 512; float* red = ys + 512;
    const int tid = otid(), lane = tid & 63, w = tid >> 6;
    const size_t row = MP + n; const int ln = L * 32 + n;
    __syncthreads();
    for (int i = tid; i < 1024; i += NT) us[i] = bf2f(U[row * DM + i]);
    zs[tid] = bf2f(PROJ[row * NPROJ + 1024 + tid]);
    __syncthreads();
    {
        const int h = w, g = h >> 2;
        const float dt = DT[row * 8 + h], a = -__expf(p->in[I_ALOG][L * 8 + h]), dec = __expf(dt * a);
        const float B0 = us[512 + g * 128 + 2 * lane], B1 = us[512 + g * 128 + 2 * lane + 1], C0 = us[768 + g * 128 + 2 * lane], C1 = us[768 + g * 128 + 2 * lane + 1];
        const float* h0 = p->in[I_SSSM] + ((size_t)ln * 8 + h) * 64 * 128;
        float* hs = p->out + O_SSMS + ((size_t)ln * 8 + h) * 64 * 128;
#pragma unroll 1
        for (int r0 = 0; r0 < 64; r0 += 32) {
            float2 hv[32];
#pragma unroll
            for (int i = 0; i < 32; ++i) hv[i] = *(const float2*)(h0 + (r0 + i) * 128 + 2 * lane);
#pragma unroll
            for (int i = 0; i < 32; ++i) {
                const int rr = r0 + i;
                const float x = us[h * 64 + rr];
                float2 hn; hn.x = dec * hv[i].x + dt * x * B0; hn.y = dec * hv[i].y + dt * x * B1;
                *(float2*)(hs + rr * 128 + 2 * lane) = hn;
                const float part = wave_sum(hn.x * C0 + hn.y * C1);
                if (lane == 0) ys[h * 64 + rr] = part;
            }
        }
    }
    __syncthreads();
    {
        const int ch = tid, gch = ch >> 8;
        const float v = (ys[ch] + p->in[I_DSKIP][L * 8 + (ch >> 6)] * us[ch]) * silu(zs[ch]);
        const float part = wave_sum(v * v);
        if (lane == 0) red[w] = part;
        __syncthreads();
        const float tot = red[gch * 4] + red[gch * 4 + 1] + red[gch * 4 + 2] + red[gch * 4 + 3];
        const float rstd = rsqrtf(tot * (1.f / 256.f) + EPS);
        CAT[row * DM + 512 + ch] = f2bf(v * rstd * p->in[I_SSMN][L * 512 + ch]);
    }
}


#define XB_TMO      128
#define XB_XCNT(j)  (256  + 64 * (j))
#define XB_XSUB(j)  (1280 + 64 * (j))
#define XB_XGEN(j)  (2304 + 64 * (j))
#define XB_TOP      3328
#define XB_TOPGEN   3392
#define XCD_BAR_WORDS 3456
#define XB_SPIN_CAP (1u << 18)
__device__ __forceinline__ unsigned xb_ld(unsigned* p)              { return __hip_atomic_load(p, __ATOMIC_RELAXED, __HIP_MEMORY_SCOPE_AGENT); }
__device__ __forceinline__ unsigned xb_add(unsigned* p, unsigned v) { return __hip_atomic_fetch_add(p, v, __ATOMIC_RELAXED, __HIP_MEMORY_SCOPE_AGENT); }
__device__ __forceinline__ unsigned xb_xcc_id() { return (unsigned)__builtin_amdgcn_s_getreg((3 << 11) | 20) & 0xFu; }
#define XB_SPIN(cond, bar) do { unsigned _sp = 0; while (cond) { __builtin_amdgcn_s_sleep(1); \
    if ((++_sp & 255u) == 0u) { if (xb_ld(&(bar)[XB_TMO])) break; if (_sp > XB_SPIN_CAP) { atomicAdd(&(bar)[XB_TMO], 1u); break; } } } } while (0)
struct XcdBarrier { unsigned* bar; unsigned x; volatile LAS unsigned* st; };
__device__ __forceinline__ XcdBarrier xcd_barrier_post(unsigned* bar, volatile LAS unsigned* st) {
    XcdBarrier b; b.bar = bar; b.x = xb_xcc_id(); b.st = st;
    if (__builtin_amdgcn_workitem_id_x() == 0) (void)xb_add(&bar[XB_XCNT(b.x)], 1u);
    return b;
}
__device__ __forceinline__ void xcd_barrier_complete(unsigned* bar, unsigned x, unsigned& nloc, unsigned& nx) {
    const unsigned G = gridDim.x * gridDim.y * gridDim.z;
    unsigned sum, cnt, mine, sp = 0u;
    for (;;) {
        sum = 0u; cnt = 0u; mine = 0u;
#pragma unroll
        for (unsigned j = 0; j < 16; ++j) { const unsigned c = xb_ld(&bar[XB_XCNT(j)]); sum += c; cnt += (c > 0u) ? 1u : 0u; mine = (j == x) ? c : mine; }
        if (sum == G) break;
        __builtin_amdgcn_s_sleep(1);
        if ((++sp & 255u) == 0u) { if (xb_ld(&bar[XB_TMO])) break; if (sp > XB_SPIN_CAP) { atomicAdd(&bar[XB_TMO], 1u); break; } }
    }
    nloc = mine > 0u ? mine : 1u; nx = cnt > 0u ? cnt : 1u;
}
__device__ __forceinline__ void xcd_barrier(const XcdBarrier& b) {
    asm volatile("s_waitcnt vmcnt(0)" ::: "memory");
    __syncthreads();
    if (__builtin_amdgcn_workitem_id_x() == 0) {
        unsigned* bar = b.bar;
        __builtin_amdgcn_s_waitcnt(0);
        unsigned nloc = b.st[0], nx = b.st[1];
        if (nloc == 0u) { xcd_barrier_complete(bar, b.x, nloc, nx); b.st[0] = nloc; b.st[1] = nx; }
        const unsigned old = xb_add(&bar[XB_XSUB(b.x)], 1u);
        const unsigned gen = old / nloc;
        if (old + 1u == (gen + 1u) * nloc) {
            __builtin_amdgcn_fence(__ATOMIC_RELEASE, "agent");
            asm volatile("s_waitcnt vmcnt(0)" ::: "memory");
            const unsigned og = xb_add(&bar[XB_TOP], 1u);
            const unsigned tg = og / nx;
            if (og + 1u == (tg + 1u) * nx) xb_add(&bar[XB_TOPGEN], 1u);
            else XB_SPIN(xb_ld(&bar[XB_TOPGEN]) == tg, bar);
            __builtin_amdgcn_fence(__ATOMIC_ACQUIRE, "agent");
            xb_add(&bar[XB_XGEN(b.x)], 1u);
            asm volatile("s_waitcnt vmcnt(0)" ::: "memory");
        } else {
            XB_SPIN(xb_ld(&bar[XB_XGEN(b.x)]) == gen, bar);
            __builtin_amdgcn_fence(__ATOMIC_ACQUIRE, "agent");
            asm volatile("s_waitcnt vmcnt(0)" ::: "memory");
        }
    }
    __syncthreads();
}

#ifndef PHMASK
#define PHMASK 0xFFFFF
#endif
constexpr int PH_PER_LAYER = 10, NPHASE = 1 + 2 * PH_PER_LAYER + 1;

__global__ void __launch_bounds__(NT, 2) mega(Params pv, int ph_lo, int ph_hi) {
    cg::grid_group grid = cg::this_grid();
    XcdBarrier xb;
    {
        SMEM_DECL;
        volatile LAS unsigned* st = (volatile LAS unsigned*)((LAS unsigned char*)smem + 131072);
        if (__builtin_amdgcn_workitem_id_x() < 4) st[__builtin_amdgcn_workitem_id_x()] = 0u;
        __syncthreads();
        xb = xcd_barrier_post((unsigned*)(pv.ws + WS_BAR), st);
    }
    for (int ph = ph_lo; ph < ph_hi; ++ph) {
        if (ph == ph_lo + 1) grid.sync();
        else if (ph > ph_lo) xcd_barrier(xb);
        KP p = opaque_kp();
        unsigned char* ws = p->ws;
        bf16_t* XB = (bf16_t*)(ws + WS_XB); bf16_t* Ub = (bf16_t*)p->out;
        bf16_t* HB = (bf16_t*)(ws + WS_HB); bf16_t* PROJ = HB;
        bf16_t* CAT = (bf16_t*)(ws + WS_CAT);
        bf16_t* OG = (bf16_t*)(ws + WS_OG);
        float* LSE = (float*)(ws + WS_LSE);
        float* ST = (float*)(ws + WS_ST);
        float* DEC = (float*)(ws + WS_DEC);
        float* DT = (float*)(ws + WS_DT);
        float* X = p->out;
        float* PART = (float*)(ws + WS_PART);
        if (ph == 0) {
            weights_phase(p);
            cache_copy_phase(p);
            copy_phase(p, XB, PART);
            continue;
        }
        if (ph == NPHASE - 1) { final_phase(p, XB, X); continue; }
        const int L = (ph - 1) / PH_PER_LAYER, q = (ph - 1) % PH_PER_LAYER;
        unsigned char* wb = ws + (size_t)L * LAYER_W;
        const bf16_t* XBs = XB + (size_t)MP * DM; const bf16_t* Xs = XBs;
#ifndef REPMASK
#define REPMASK 0
#endif
        for (int rep = 0; rep < 1 + ((REPMASK >> q) & 1); ++rep)
        switch (q) {
        case 0: case 8: { EpiGU e{HB, PART}; const bf16_t* W = (const bf16_t*)(wb + (q == 0 ? OFF_WGU1 : OFF_WGU2)); gemm_phase_cont(XB, W, 1024, MP / 256, 22, e);
            for (int t = blockIdx.x; t < 176; t += gridDim.x) { const int c0 = t * 16, r0 = (c0 >> 7) * 256 + (c0 & 127); FinGU f{HB, c0}; skinny_task<2, true, 4>(XBs, DM, W, 1024, r0, r0 + 128, Xs, f); } } break;
        case 1: case 9: { EpiRes e{XB, PART, 0.5f}; const bf16_t* W = (const bf16_t*)(wb + (q == 1 ? OFF_WD1 : OFF_WD2)); gemm_phase_cont(HB, W, 2816, MP / 256, 4, e);
            for (int t = blockIdx.x; t < 64; t += gridDim.x) { FinRes f{XB, 0.5f, t * 16}; skinny_task<1, false, 11>(HB + (size_t)MP * DFF, DFF, W, 2816, t * 16, 0, nullptr, f); } } break;
        case 2: { EpiProj e{PROJ, NPROJ, PART}; const bf16_t* W = (const bf16_t*)(wb + OFF_WIN); gemm_phase_cont(XB, W, 1024, MP / 256, 10, e);
            for (int t = blockIdx.x; t < 160; t += gridDim.x) { FinProj f{PROJ, t * 16}; skinny_task<1, true, 4>(XBs, DM, W, 1024, t * 16, 0, Xs, f); } } break;
        case 3:
            prep_phase(p, L, PROJ, Ub, CAT, XB, PART, DT);
            for (int it = blockIdx.x; it < 4 * MS; it += gridDim.x) prep_sample_item(p, L, it, PROJ, Ub, CAT, XB, DT);
            break;
        case 4:
            {
                int it = blockIdx.x;
                for (; it < 160 + 512; it += gridDim.x) {
                    if (it < 128) sample_attn_item(p, L, it, PROJ, CAT);
                    else if (it < 160) sample_ssd_item(p, L, it - 128, PROJ, Ub, DT, CAT);
                    else s1_item(p, L, it - 160, Ub, DT, ST, DEC);
                }
                attn_items(it - 160 - 512, gridDim.x, PROJ, OG, LSE);
            }
            break;
        case 5: scan_phase(p, L, ST, DEC); break;
        case 6:
            for (int it = blockIdx.x; it < 1024; it += gridDim.x) {
                if (it < 512) s3_item(p, L, it, Ub, PROJ, DT, ST, CAT);
                else combine_item(it - 512, OG, LSE, CAT);
            }
            break;
        case 7: { EpiRes e{XB, PART, 1.0f}; const bf16_t* W = (const bf16_t*)(wb + OFF_WOUT); gemm_phase_cont(CAT, W, 1024, MP / 256, 4, e);
            for (int t = blockIdx.x; t < 64; t += gridDim.x) { FinRes f{XB, 1.0f, t * 16}; skinny_task<1, false, 4>(CAT + (size_t)MP * DM, DM, W, 1024, t * 16, 0, nullptr, f); } } break;
        }
    }
}

constexpr int LDS_BYTES = 131072 + 64 + 4096 + 2048;

extern "C" void kernel_launch(void* const* d_in, const int* in_sizes, int n_in, void* d_out, int out_size, void* d_ws, size_t ws_size, hipStream_t stream) {
    static int grid = 0;
    if (grid == 0) {
        if (n_in != 27 || (size_t)out_size != O_END || ws_size < WS_END) {
            fprintf(stderr, "kernel_launch: unexpected shapes n_in %d out %d ws %zu (need %zu)\n", n_in, out_size, ws_size, (size_t)WS_END); grid = -1; return; }
        int dev = 0, cus = 0, per_cu = 0;
        hipGetDevice(&dev);
        hipDeviceGetAttribute(&cus, hipDeviceAttributeMultiprocessorCount, dev);
        if (hipFuncSetAttribute((const void*)mega, hipFuncAttributeMaxDynamicSharedMemorySize, LDS_BYTES) != hipSuccess) { fprintf(stderr, "hipFuncSetAttribute failed\n"); grid = -1; return; }
        hipOccupancyMaxActiveBlocksPerMultiprocessor(&per_cu, (const void*)mega, NT, LDS_BYTES);
        if (per_cu < 1) { fprintf(stderr, "occupancy query says %d blocks/CU\n", per_cu); per_cu = 1; }
        (void)hipGetLastError();
        grid = cus;
    }
    if (grid < 0) return;
    if (hipMemsetAsync((char*)d_ws + WS_BAR, 0, 16384, stream) != hipSuccess) { fprintf(stderr, "memset failed\n"); return; }
    Params p{};
    for (int i = 0; i < 27; ++i) p.in[i] = (const float*)d_in[i];
    p.out = (float*)d_out; p.ws = (unsigned char*)d_ws;
    int lo = 0, hi = NPHASE;
    void* args[] = {&p, &lo, &hi};
    hipError_t e = hipLaunchCooperativeKernel((const void*)mega, dim3(grid), dim3(NT), args, LDS_BYTES, stream);
    if (e != hipSuccess) fprintf(stderr, "cooperative launch failed: %s (grid %d)\n", hipGetErrorString(e), grid);
}
```
